# Optimizing an MI355X kernel written in HIP

```python
import jax, jax.numpy as jnp
from jax import lax
import numpy as np

D_MODEL = 1024
BATCH = 8
SEQ = 4096
DEPTH = 1

CHUNK = 64
N_META = 16
NORM_EPS = 1e-5
D_FF = 2816

RWKV_HEAD = 64
RWKV_HEADS = 8
RWKV_WIDTH = RWKV_HEADS * RWKV_HEAD
LORA_W = 32
LORA_A = 32
LORA_G = 96
GN_EPS = 64e-5

ATTN_HEAD = 64
ATTN_HEADS = 8
ATTN_KV_HEADS = 2
ATTN_GROUP = ATTN_HEADS // ATTN_KV_HEADS
ATTN_WIDTH = ATTN_HEADS * ATTN_HEAD
WINDOW = 128
WIN_CHUNKS = WINDOW // CHUNK
NEG_INF = -1e30

MIX_WIDTH = RWKV_WIDTH + ATTN_WIDTH
RWKV_COLS = 3 * RWKV_WIDTH + LORA_W + LORA_A + LORA_G
ATTN_COLS = (ATTN_HEADS + 2 * ATTN_KV_HEADS) * ATTN_HEAD
IN_COLS = RWKV_COLS + ATTN_COLS

kernel_name = "hymba_rwkv7_swa_sink_macaron"


def rmsnorm(x, g):
    xf = x.astype(jnp.float32)
    y = xf * lax.rsqrt(jnp.mean(xf * xf, axis=-1, keepdims=True) + NORM_EPS)
    return (y * g.astype(jnp.float32)).astype(x.dtype)


def swiglu(x, w_gate, w_up, w_down):
    return (jax.nn.silu(x @ w_gate) * (x @ w_up)) @ w_down


def token_shift(z):
    return jnp.pad(z, ((0, 0), (1, 0), (0, 0)))[:, :-1]


def alibi_slopes(n_heads):
    return jnp.exp2(-8.0 * (jnp.arange(n_heads, dtype=jnp.float32) + 1.0) / n_heads)


def rwkv7_mix(z, mu, w0, w2, a0, a2, g2, k_k, k_a, r_k, ln_w, ln_b):
    f32 = jnp.float32
    B, L, _ = z.shape
    zf = z.astype(f32)
    zf = zf + (token_shift(zf) - zf) * mu.astype(f32)
    s1 = RWKV_WIDTH
    s2 = 2 * RWKV_WIDTH
    s3 = 3 * RWKV_WIDTH
    s4 = s3 + LORA_W
    s5 = s4 + LORA_A
    zr, zk, zv, zw, za, zg = jnp.split(zf, [s1, s2, s3, s4, s5], axis=-1)
    w_log = -jax.nn.softplus(-(w0.astype(f32) + jnp.tanh(zw) @ w2.astype(f32))) - 0.5
    decay = jnp.exp(-jnp.exp(w_log))
    a = jax.nn.sigmoid(a0.astype(f32) + za @ a2.astype(f32))
    g = jax.nn.sigmoid(zg) @ g2.astype(f32)
    hs = lambda t: t.reshape(B, L, RWKV_HEADS, RWKV_HEAD)
    kk = hs(zk * k_k.astype(f32))
    kk = kk / jnp.maximum(jnp.sqrt(jnp.sum(kk * kk, axis=-1, keepdims=True)), 1e-12)
    k = zk * (1.0 + (a - 1.0) * k_a.astype(f32))
    r_h, k_h, v_h, a_h, w_h = hs(zr), hs(k), hs(zv), hs(a), hs(decay)
    tm = lambda t: jnp.transpose(t, (1, 0, 2, 3))

    def step(S, inp):
        r_t, w_t, k_t, v_t, kk_t, a_t = inp
        sa = jnp.einsum('bhvk,bhk->bhv', S, -kk_t)
        S = (S * w_t[:, :, None, :]
             + sa[..., None] * (kk_t * a_t)[:, :, None, :]
             + v_t[..., None] * k_t[:, :, None, :])
        y_t = jnp.einsum('bhvk,bhk->bhv', S, r_t)
        return S, y_t

    S0 = jnp.zeros((B, RWKV_HEADS, RWKV_HEAD, RWKV_HEAD), f32)
    _, y = lax.scan(step, S0, (tm(r_h), tm(w_h), tm(k_h), tm(v_h), tm(kk), tm(a_h)))
    y = jnp.transpose(y, (1, 0, 2, 3))
    mean = jnp.mean(y, axis=-1, keepdims=True)
    var = jnp.mean(jnp.square(y - mean), axis=-1, keepdims=True)
    y = ((y - mean) * lax.rsqrt(var + GN_EPS)).reshape(B, L, RWKV_WIDTH)
    y = y * ln_w.astype(f32) + ln_b.astype(f32)
    bonus = jnp.sum(r_h * k_h * r_k.astype(f32), axis=-1, keepdims=True) * v_h
    out = (y + bonus.reshape(B, L, RWKV_WIDTH)) * g
    return out.astype(z.dtype)


def swa_sink_attention(q, k, v, sinks):
    f32 = jnp.float32
    B, L = q.shape[0], q.shape[1]
    n_real = L - N_META
    nc = n_real // CHUNK
    scale = ATTN_HEAD ** -0.5
    slopes = alibi_slopes(ATTN_HEADS).reshape(ATTN_KV_HEADS, ATTN_GROUP)
    sink = sinks.astype(f32).reshape(ATTN_KV_HEADS, ATTN_GROUP)
    q = q.reshape(B, L, ATTN_KV_HEADS, ATTN_GROUP, ATTN_HEAD)
    qm = q[:, :N_META]
    qr = q[:, N_META:].reshape(B, nc, CHUNK, ATTN_KV_HEADS, ATTN_GROUP, ATTN_HEAD)
    km, vm = k[:, :N_META], v[:, :N_META]
    kr = k[:, N_META:].reshape(B, nc, CHUNK, ATTN_KV_HEADS, ATTN_HEAD)
    vr = v[:, N_META:].reshape(B, nc, CHUNK, ATTN_KV_HEADS, ATTN_HEAD)
    pad = ((0, 0), (WIN_CHUNKS, 0), (0, 0), (0, 0), (0, 0))
    kp, vp = jnp.pad(kr, pad), jnp.pad(vr, pad)
    kw = jnp.concatenate([kp[:, i:i + nc] for i in range(WIN_CHUNKS + 1)], axis=2)
    vw = jnp.concatenate([vp[:, i:i + nc] for i in range(WIN_CHUNKS + 1)], axis=2)
    n_wk = (WIN_CHUNKS + 1) * CHUNK
    c = jnp.arange(nc)
    q_pos = N_META + c[:, None] * CHUNK + jnp.arange(CHUNK)[None, :]
    k_pos = N_META + (c[:, None] - WIN_CHUNKS) * CHUNK + jnp.arange(n_wk)[None, :]
    k_valid = k_pos >= N_META
    m_pos = jnp.arange(N_META)
    dist_w = jnp.abs(q_pos[:, :, None] - k_pos[:, None, :]).astype(f32)
    dist_m = jnp.abs(q_pos[:, :, None] - m_pos[None, None, :]).astype(f32)
    sl5 = slopes[:, :, None, None, None]
    s_w = jnp.einsum('bcqkgd,bcskd->bkgcqs', qr, kw).astype(f32) * scale - sl5 * dist_w
    s_w = jnp.where(k_valid[:, None, :], s_w, NEG_INF)
    s_m = jnp.einsum('bcqkgd,bmkd->bkgcqm', qr, km).astype(f32) * scale - sl5 * dist_m
    s_sink = jnp.broadcast_to(sink[:, :, None, None, None], s_m.shape[:-1] + (1,))
    p = jax.nn.softmax(jnp.concatenate([s_sink, s_m, s_w], axis=-1), axis=-1)
    p_m = p[..., 1:1 + N_META].astype(v.dtype)
    p_w = p[..., 1 + N_META:].astype(v.dtype)
    o_r = (jnp.einsum('bkgcqm,bmkd->bcqkgd', p_m, vm)
           + jnp.einsum('bkgcqs,bcskd->bcqkgd', p_w, vw)).reshape(B, n_real, ATTN_WIDTH)
    dist_mm = jnp.abs(m_pos[:, None] - m_pos[None, :]).astype(f32)
    s_mm = jnp.einsum('bqkgd,bmkd->bkgqm', qm, km).astype(f32) * scale - slopes[:, :, None, None] * dist_mm
    s_msink = jnp.broadcast_to(sink[:, :, None, None], s_mm.shape[:-1] + (1,))
    pm = jax.nn.softmax(jnp.concatenate([s_msink, s_mm], axis=-1), axis=-1)[..., 1:].astype(v.dtype)
    o_m = jnp.einsum('bkgqm,bmkd->bqkgd', pm, vm).reshape(B, N_META, ATTN_WIDTH)
    return jnp.concatenate([o_m, o_r], axis=1)


def setup_inputs(seed: int = 0) -> dict:
    key = jax.random.key(seed)
    ks = iter(jax.random.split(key, 40))
    f32 = jnp.float32

    def nrm(shape, scale):
        return jax.random.normal(next(ks), shape, f32) * scale

    def gain(shape):
        return 1.0 + 0.02 * jax.random.normal(next(ks), shape, f32)

    Ld = DEPTH
    return {
        "x": nrm((BATCH, SEQ, D_MODEL), 1.0),
        "meta_tokens": nrm((N_META, D_MODEL), 1.0),
        "ffn1_norm": gain((Ld, D_MODEL)),
        "ffn1_w_gate": nrm((Ld, D_MODEL, D_FF), D_MODEL ** -0.5),
        "ffn1_w_up": nrm((Ld, D_MODEL, D_FF), D_MODEL ** -0.5),
        "ffn1_w_down": nrm((Ld, D_FF, D_MODEL), D_FF ** -0.5),
        "mix_norm": gain((Ld, D_MODEL)),
        "w_in": nrm((Ld, D_MODEL, IN_COLS), D_MODEL ** -0.5),
        "b_attn": nrm((Ld, ATTN_COLS), 0.02),
        "rwkv_mu": jax.random.uniform(next(ks), (Ld, RWKV_COLS), f32),
        "rwkv_w0": jax.random.uniform(next(ks), (Ld, RWKV_WIDTH), f32, -6.0, 1.0),
        "rwkv_w2": nrm((Ld, LORA_W, RWKV_WIDTH), 0.1),
        "rwkv_a0": nrm((Ld, RWKV_WIDTH), 0.1),
        "rwkv_a2": nrm((Ld, LORA_A, RWKV_WIDTH), 0.1),
        "rwkv_g2": nrm((Ld, LORA_G, RWKV_WIDTH), LORA_G ** -0.5),
        "rwkv_k_k": 0.85 + 0.02 * jax.random.normal(next(ks), (Ld, RWKV_WIDTH), f32),
        "rwkv_k_a": gain((Ld, RWKV_WIDTH)),
        "rwkv_r_k": nrm((Ld, RWKV_HEADS, RWKV_HEAD), 0.1),
        "rwkv_ln_w": gain((Ld, RWKV_WIDTH)),
        "rwkv_ln_b": nrm((Ld, RWKV_WIDTH), 0.02),
        "attn_sinks": nrm((Ld, ATTN_HEADS), 0.5),
        "w_out": nrm((Ld, MIX_WIDTH, D_MODEL), MIX_WIDTH ** -0.5),
        "ffn2_norm": gain((Ld, D_MODEL)),
        "ffn2_w_gate": nrm((Ld, D_MODEL, D_FF), D_MODEL ** -0.5),
        "ffn2_w_up": nrm((Ld, D_MODEL, D_FF), D_MODEL ** -0.5),
        "ffn2_w_down": nrm((Ld, D_FF, D_MODEL), D_FF ** -0.5),
        "final_norm": gain((D_MODEL,)),
    }


def reference(x, meta_tokens, ffn1_norm, ffn1_w_gate, ffn1_w_up, ffn1_w_down, mix_norm, w_in, b_attn,
              rwkv_mu, rwkv_w0, rwkv_w2, rwkv_a0, rwkv_a2, rwkv_g2, rwkv_k_k, rwkv_k_a, rwkv_r_k,
              rwkv_ln_w, rwkv_ln_b, attn_sinks, w_out, ffn2_norm, ffn2_w_gate, ffn2_w_up, ffn2_w_down,
              final_norm):
    B = x.shape[0]
    meta = jnp.broadcast_to(meta_tokens[None].astype(x.dtype), (B, N_META, D_MODEL))
    h = jnp.concatenate([meta, x], axis=1)
    L = h.shape[1]
    for l in range(DEPTH):
        h = h + 0.5 * swiglu(rmsnorm(h, ffn1_norm[l]), ffn1_w_gate[l], ffn1_w_up[l], ffn1_w_down[l])
        z = rmsnorm(h, mix_norm[l]) @ w_in[l]
        z_rwkv = z[..., :RWKV_COLS]
        z_attn = z[..., RWKV_COLS:] + b_attn[l]
        y_rwkv = rwkv7_mix(z_rwkv, rwkv_mu[l], rwkv_w0[l], rwkv_w2[l], rwkv_a0[l], rwkv_a2[l], rwkv_g2[l],
                           rwkv_k_k[l], rwkv_k_a[l], rwkv_r_k[l], rwkv_ln_w[l], rwkv_ln_b[l])
        kv_w = ATTN_KV_HEADS * ATTN_HEAD
        q = z_attn[..., :ATTN_WIDTH].reshape(B, L, ATTN_HEADS, ATTN_HEAD)
        k = z_attn[..., ATTN_WIDTH:ATTN_WIDTH + kv_w].reshape(B, L, ATTN_KV_HEADS, ATTN_HEAD)
        v = z_attn[..., ATTN_WIDTH + kv_w:].reshape(B, L, ATTN_KV_HEADS, ATTN_HEAD)
        y_attn = swa_sink_attention(q, k, v, attn_sinks[l])
        h = h + jnp.concatenate([y_rwkv, y_attn], axis=-1) @ w_out[l]
        h = h + 0.5 * swiglu(rmsnorm(h, ffn2_norm[l]), ffn2_w_gate[l], ffn2_w_up[l], ffn2_w_down[l])
    return rmsnorm(h, final_norm)[:, N_META:]
```

```cpp
#include <hip/hip_runtime.h>
#include <cstdio>
#include <cstdint>
namespace pg8 {
#define PG8_LAS __attribute__((address_space(3)))
typedef unsigned short bf16_t;
typedef short bf16x8 __attribute__((ext_vector_type(8)));
typedef float f32x4 __attribute__((ext_vector_type(4)));
typedef unsigned u32x4 __attribute__((ext_vector_type(4)));
constexpr int BM = 256, BK = 64, HALF = 128, HTB = HALF * BK * 2  , STAGE_BYTES = 8 * HTB, NXCD = 8, WGM = 8;

__host__ __device__ __forceinline__ int lds_byte(int r, int c) { const int st = (r >> 4) * 2 + (c >> 5), rr = r & 15, cc = c & 31, ob = rr * 64 + cc * 2; return st * 1024 + (ob ^ (((ob >> 9) & 1) << 5)); }
__host__ __device__ __forceinline__ void stage_rc(int b, int& R, int& C) { const int st = b / 1024, sb = b % 1024, swz = sb ^ (((sb >> 9) & 1) << 5); R = (st >> 1) * 16 + swz / 64; C = (st & 1) * 32 + (swz % 64) / 2; }
__host__ __device__ __forceinline__ int perm32(int rho) { const int n = rho >> 4, i = rho & 15; return 8 * (i >> 2) + 4 * n + (i & 3); }

struct Unit { int pm, pn; };
struct Gemm { const bf16_t* A; const bf16_t* Bt; int M, N, K; };

struct StaticOrder {
    int nM, nN, nwg, G, c;
    __host__ __device__ void init(int M, int N, int G_, int c_) { nM = M / BM; nN = N / BM; nwg = nM * nN; G = G_; c = c_; }
    __host__ __device__ bool next(int i, Unit& u) const {
        const long L = (long)i * G + c; if (L >= nwg) return false;
        int wgid = (int)L; { const int q = nwg / NXCD, r = nwg % NXCD, xcd = wgid % NXCD, off = wgid / NXCD; wgid = (xcd < r ? xcd * (q + 1) : r * (q + 1) + (xcd - r) * q) + off; }
        const int nig = WGM * nN, gid = wgid / nig, fm = gid * WGM, gsz = (nM - fm) < WGM ? (nM - fm) : WGM;
        u.pm = fm + ((wgid % nig) % gsz); u.pn = (wgid % nig) / gsz; return true;
    }
    __device__ __forceinline__ void a_ready(const Unit&) const {}
    __device__ __forceinline__ void done(const Unit&) const {}
};

__device__ __forceinline__ unsigned cvt_pk_bf16(float lo, float hi) { unsigned r; asm volatile("v_cvt_pk_bf16_f32 %0, %1, %2" : "=v"(r) : "v"(lo), "v"(hi)); return r; }
typedef float f32x2 __attribute__((ext_vector_type(2)));
typedef unsigned u32x2 __attribute__((ext_vector_type(2)));
__device__ __forceinline__ float rstd_from16(const float* ssq, int row) {
    const f32x4* p = (const f32x4*)(ssq + (size_t)row * 16);
    const f32x4 a = p[0], b = p[1], c = p[2], d = p[3];
    const float s = ((a[0] + a[1]) + (a[2] + a[3])) + ((b[0] + b[1]) + (b[2] + b[3])) + ((c[0] + c[1]) + (c[2] + c[3])) + ((d[0] + d[1]) + (d[2] + d[3]));
    return __builtin_amdgcn_rsqf(s * (1.0f / 1024.0f) + 1e-5f);
}
__device__ __forceinline__ float silu_mul(float g, float u) { return g * __builtin_amdgcn_rcpf(1.0f + __builtin_amdgcn_exp2f(-1.4426950408889634f * g)) * u; }
struct EpiSwiglu {
    static constexpr bool PERM = true, AFTER_DRAIN = false;
    bf16_t* U; const float* ssq; int ldu;
    __device__ __forceinline__ void operator()(const f32x4 (&acc)[2][2][4][2], const Unit& u, int wr, int wc, int fr, int fq) const {
        const int row0 = u.pm * BM + wr * 64 + fr, col0 = u.pn * HALF + wc * 32 + 8 * fq;
#pragma unroll
        for (int ai = 0; ai < 2; ++ai)
#pragma unroll
            for (int m = 0; m < 4; ++m) { const int row = row0 + ai * HALF + m * 16; const float rs = rstd_from16(ssq, row);
                const f32x4 g0 = acc[ai][0][m][0] * rs, g1 = acc[ai][0][m][1] * rs, u0 = acc[ai][1][m][0] * rs, u1 = acc[ai][1][m][1] * rs;
                u32x4 w; w.x = cvt_pk_bf16(silu_mul(g0[0], u0[0]), silu_mul(g0[1], u0[1])); w.y = cvt_pk_bf16(silu_mul(g0[2], u0[2]), silu_mul(g0[3], u0[3]));
                w.z = cvt_pk_bf16(silu_mul(g1[0], u1[0]), silu_mul(g1[1], u1[1])); w.w = cvt_pk_bf16(silu_mul(g1[2], u1[2]), silu_mul(g1[3], u1[3]));
                *(u32x4*)(U + (size_t)row * ldu + col0) = w; }
    }
};
struct EpiZ {
    static constexpr bool PERM = true, AFTER_DRAIN = false;
    bf16_t* Z; const float* ssq; const float* bias; int ldz, ncols, bias_from;
    __device__ __forceinline__ void operator()(const f32x4 (&acc)[2][2][4][2], const Unit& u, int wr, int wc, int fr, int fq) const {
        const int row0 = u.pm * BM + wr * 64 + fr, col0 = u.pn * BM + wc * 32 + 8 * fq;
        f32x4 bv[2][2];
#pragma unroll
        for (int bj = 0; bj < 2; ++bj)
#pragma unroll
            for (int n = 0; n < 2; ++n) { const int c = col0 + bj * HALF + 4 * n; bv[bj][n] = (c >= bias_from && c < ncols) ? *(const f32x4*)(bias + (c - bias_from)) : (f32x4){0.f, 0.f, 0.f, 0.f}; }
#pragma unroll
        for (int ai = 0; ai < 2; ++ai)
#pragma unroll
            for (int m = 0; m < 4; ++m) { const int row = row0 + ai * HALF + m * 16; const float rs = rstd_from16(ssq, row);
#pragma unroll
                for (int bj = 0; bj < 2; ++bj) { const int c = col0 + bj * HALF; if (c < ncols) {
                    const f32x4 v0 = acc[ai][bj][m][0] * rs + bv[bj][0], v1 = acc[ai][bj][m][1] * rs + bv[bj][1];
                    u32x4 w; w.x = cvt_pk_bf16(v0[0], v0[1]); w.y = cvt_pk_bf16(v0[2], v0[3]); w.z = cvt_pk_bf16(v1[0], v1[1]); w.w = cvt_pk_bf16(v1[2], v1[3]);
                    *(u32x4*)(Z + (size_t)row * ldz + c) = w; } } }
    }
};
template <bool WB> struct EpiResid {
    static constexpr bool PERM = false, AFTER_DRAIN = false;
    const float* base; float* out; bf16_t* outb; float* ssq; float scale;
    __device__ __forceinline__ void operator()(const f32x4 (&acc)[2][2][4][2], const Unit& u, int wr, int wc, int fr, int fq) const {
        const int row0 = u.pm * BM + wr * 64 + fr, col0 = u.pn * BM + wc * 32 + 4 * fq;
#pragma unroll
        for (int ai = 0; ai < 2; ++ai)
#pragma unroll
            for (int m = 0; m < 4; ++m) { const int row = row0 + ai * HALF + m * 16; const size_t off = (size_t)row * 1024 + col0; float ss = 0.f;
#pragma unroll
                for (int bj = 0; bj < 2; ++bj)
#pragma unroll
                    for (int n = 0; n < 2; ++n) { const size_t o2 = off + bj * HALF + n * 16; const f32x4 bs = *(const f32x4*)(base + o2); const f32x4 o = bs + acc[ai][bj][m][n] * scale;
                        *(f32x4*)(out + o2) = o; ss += (o[0] * o[0] + o[1] * o[1]) + (o[2] * o[2] + o[3] * o[3]);
                        if (WB) { u32x2 w; w.x = cvt_pk_bf16(o[0], o[1]); w.y = cvt_pk_bf16(o[2], o[3]); *(u32x2*)(outb + o2) = w; } }
                ss += __shfl_xor(ss, 16); ss += __shfl_xor(ss, 32);
                if (fq == 0) ssq[(size_t)row * 16 + u.pn * 4 + wc] = ss; }
    }
};
template <class Epi, class Sched, bool ALIGN_EPI = false, bool SP2 = false>
__device__ __forceinline__ void gemm_phase(PG8_LAS unsigned char* lds, const Gemm g, const Sched& S, const Epi& E) {
    const int tid = threadIdx.x, wid = __builtin_amdgcn_readfirstlane(tid >> 6), lane = tid & 63, wr = wid >> 2, wc = wid & 3, fr = lane & 15, fq = lane >> 4;
    const int K = g.K, nt = K / BK;
    unsigned voffA[2], voffB[2];
#pragma unroll
    for (int i = 0; i < 2; ++i) { int R, C; stage_rc(tid * 16 + i * 8192, R, C); const int Rb = Epi::PERM ? ((R & ~31) + perm32(R & 31)) : R;
        voffA[i] = (unsigned)(R * K + C) * 2u; voffB[i] = (unsigned)(Rb * K + C) * 2u; }
    const size_t kstep = (size_t)(BK * 2);
    const size_t hstep = (size_t)HALF * K * 2;
    const size_t tstep = 2 * hstep;
    const unsigned ldsw = (unsigned)wid * 1024u;
    const int aoff = lds_byte(wr * 64 + fr, fq * 8), boff = lds_byte(wc * 32 + fr, fq * 8);
#define PG8_SA(b, h) (((b) * 2 + (h)) * HTB)
#define PG8_SB(b, h) ((4 + (b) * 2 + (h)) * HTB)
#define PG8_STAGE(bufoff, gbase, voff) do { _Pragma("unroll") for (int _i = 0; _i < 2; ++_i) \
        __builtin_amdgcn_global_load_lds((const unsigned*)((const char*)(gbase) + (voff)[_i]), (PG8_LAS unsigned*)(lds + (bufoff) + ldsw + _i * 8192), 16, 0, 0); } while (0)
#define PG8_LDA(dst, b, h) do { _Pragma("unroll") for (int m = 0; m < 4; ++m) _Pragma("unroll") for (int k = 0; k < 2; ++k) dst[m][k] = *(const PG8_LAS bf16x8*)(lds + PG8_SA(b, h) + aoff + m * 2048 + k * 1024); } while (0)
#define PG8_LDB(dst, b, h) do { _Pragma("unroll") for (int n = 0; n < 2; ++n) _Pragma("unroll") for (int k = 0; k < 2; ++k) dst[n][k] = *(const PG8_LAS bf16x8*)(lds + PG8_SB(b, h) + boff + n * 2048 + k * 1024); } while (0)
#define PG8_MMA(ai, bj, At, Bt) do { __builtin_amdgcn_s_setprio(1); _Pragma("unroll") for (int m = 0; m < 4; ++m) _Pragma("unroll") for (int n = 0; n < 2; ++n) _Pragma("unroll") for (int k = 0; k < 2; ++k) \
        acc[ai][bj][m][n] = __builtin_amdgcn_mfma_f32_16x16x32_bf16(Bt[n][k], At[m][k], acc[ai][bj][m][n], 0, 0, 0); __builtin_amdgcn_s_setprio(0); } while (0)
#define PG8_WAIT_V(n) asm volatile("s_waitcnt vmcnt(" #n ")" ::: "memory")
#define PG8_WAIT_L(n) asm volatile("s_waitcnt lgkmcnt(" #n ")" ::: "memory")
#define PG8_BAR __builtin_amdgcn_s_barrier()
#define PG8_SCHED __builtin_amdgcn_sched_barrier(0)
    Unit cur, nxt; int ui = 0;
    if (!S.next(0, cur)) return;
    f32x4 acc[2][2][4][2];
#pragma unroll
    for (int a = 0; a < 2; ++a)
#pragma unroll
        for (int b = 0; b < 2; ++b)
#pragma unroll
            for (int m = 0; m < 4; ++m)
#pragma unroll
                for (int n = 0; n < 2; ++n) acc[a][b][m][n] = (f32x4){0.f, 0.f, 0.f, 0.f};
    bf16x8 At[4][2], B0[2][2], B1[2][2];
    const char* cA = (const char*)g.A + (size_t)cur.pm * tstep; const char* cB = (const char*)g.Bt + (size_t)cur.pn * tstep;
    S.a_ready(cur);
    if constexpr (SP2) {
        PG8_STAGE(PG8_SB(0, 0), cB, voffB); PG8_STAGE(PG8_SB(0, 1), cB + hstep, voffB); PG8_STAGE(PG8_SA(0, 0), cA, voffA); PG8_STAGE(PG8_SA(0, 1), cA + hstep, voffA);
        if (wr == 1) PG8_BAR;
        PG8_WAIT_V(2); PG8_BAR;
        PG8_STAGE(PG8_SB(1, 0), cB + kstep, voffB); PG8_STAGE(PG8_SA(1, 0), cA + kstep, voffA); PG8_STAGE(PG8_SB(1, 1), cB + hstep + kstep, voffB);
        PG8_WAIT_V(6); PG8_BAR;
    } else {
        PG8_STAGE(PG8_SB(0, 0), cB, voffB); PG8_STAGE(PG8_SA(0, 0), cA, voffA); PG8_STAGE(PG8_SB(0, 1), cB + hstep, voffB); PG8_STAGE(PG8_SA(0, 1), cA + hstep, voffA);
        if (wr == 1) PG8_BAR;
        PG8_WAIT_V(4); PG8_BAR;
        PG8_STAGE(PG8_SB(1, 0), cB + kstep, voffB); PG8_STAGE(PG8_SA(1, 0), cA + kstep, voffA); PG8_STAGE(PG8_SB(1, 1), cB + hstep + kstep, voffB);
        PG8_WAIT_V(6); PG8_BAR;
    }
    for (;;) {
        const bool has_next = S.next(ui + 1, nxt);
        const char* nA = has_next ? (const char*)g.A + (size_t)nxt.pm * tstep : cA; const char* nB = has_next ? (const char*)g.Bt + (size_t)nxt.pn * tstep : cB;
        for (int t = 0; t < nt; t += 2) {
            const bool last = (t == nt - 2);
            const char* a1 = cA + (size_t)(t + 1) * kstep;
            const char* a2 = last ? nA : cA + (size_t)(t + 2) * kstep; const char* b2 = last ? nB : cB + (size_t)(t + 2) * kstep;
            const char* a3 = a2 + kstep; const char* b3 = b2 + kstep;
            if (last && has_next) S.a_ready(nxt);
            if constexpr (SP2) {
            PG8_LDB(B0, 0, 0); PG8_LDB(B1, 0, 1); PG8_SCHED; PG8_LDA(At, 0, 0); PG8_STAGE(PG8_SA(1, 1), a1 + hstep, voffA);
            PG8_WAIT_V(8); PG8_WAIT_L(0); PG8_BAR; PG8_MMA(0, 0, At, B0); PG8_MMA(0, 1, At, B1); PG8_BAR; PG8_SCHED;
            PG8_LDA(At, 0, 1); PG8_STAGE(PG8_SB(0, 0), b2, voffB); PG8_STAGE(PG8_SB(0, 1), b2 + hstep, voffB); PG8_STAGE(PG8_SA(0, 0), a2, voffA);
            PG8_WAIT_V(8); PG8_WAIT_L(0); PG8_BAR; PG8_MMA(1, 0, At, B0); PG8_MMA(1, 1, At, B1); PG8_BAR; PG8_SCHED;
            PG8_LDB(B0, 1, 0); PG8_LDB(B1, 1, 1); PG8_SCHED; PG8_LDA(At, 1, 0); PG8_STAGE(PG8_SA(0, 1), a2 + hstep, voffA);
            PG8_WAIT_V(8); PG8_WAIT_L(0); PG8_BAR; PG8_MMA(0, 0, At, B0); PG8_MMA(0, 1, At, B1); PG8_BAR; PG8_SCHED;
            PG8_LDA(At, 1, 1); PG8_STAGE(PG8_SB(1, 0), b3, voffB); PG8_STAGE(PG8_SB(1, 1), b3 + hstep, voffB); PG8_STAGE(PG8_SA(1, 0), a3, voffA);
            PG8_WAIT_V(8); PG8_WAIT_L(0); PG8_BAR; PG8_MMA(1, 0, At, B0); PG8_MMA(1, 1, At, B1); PG8_BAR; PG8_SCHED;
            } else {
            PG8_LDB(B0, 0, 0); PG8_SCHED; PG8_LDA(At, 0, 0); PG8_STAGE(PG8_SA(1, 1), a1 + hstep, voffA);
            PG8_WAIT_L(8); PG8_BAR; PG8_WAIT_L(0); PG8_MMA(0, 0, At, B0); PG8_BAR; PG8_SCHED;
            PG8_LDB(B1, 0, 1); PG8_STAGE(PG8_SB(0, 0), b2, voffB);
            PG8_BAR; PG8_WAIT_L(0); PG8_MMA(0, 1, At, B1); PG8_BAR;
            PG8_LDA(At, 0, 1); PG8_STAGE(PG8_SA(0, 0), a2, voffA);
            PG8_BAR; PG8_WAIT_L(0); PG8_MMA(1, 0, At, B0); PG8_BAR; PG8_SCHED;
            PG8_STAGE(PG8_SB(0, 1), b2 + hstep, voffB);
            PG8_WAIT_V(6); PG8_BAR; PG8_MMA(1, 1, At, B1); PG8_BAR;
            PG8_LDB(B0, 1, 0); PG8_SCHED; PG8_LDA(At, 1, 0); PG8_STAGE(PG8_SA(0, 1), a2 + hstep, voffA);
            PG8_WAIT_L(8); PG8_BAR; PG8_WAIT_L(0); PG8_MMA(0, 0, At, B0); PG8_BAR; PG8_SCHED;
            PG8_LDB(B1, 1, 1); PG8_STAGE(PG8_SB(1, 0), b3, voffB);
            PG8_BAR; PG8_WAIT_L(0); PG8_MMA(0, 1, At, B1); PG8_BAR;
            PG8_LDA(At, 1, 1); PG8_STAGE(PG8_SA(1, 0), a3, voffA);
            PG8_BAR; PG8_WAIT_L(0); PG8_MMA(1, 0, At, B0); PG8_BAR; PG8_SCHED;
            PG8_STAGE(PG8_SB(1, 1), b3 + hstep, voffB);
            PG8_WAIT_V(6); PG8_BAR; PG8_MMA(1, 1, At, B1); PG8_BAR;
            }
        }
        if constexpr (ALIGN_EPI) { if (wr == 0) PG8_BAR; }
        if constexpr (!Epi::AFTER_DRAIN) { E(acc, cur, wr, wc, fr, fq); S.done(cur); }
        if (!has_next) break;
#pragma unroll
        for (int a = 0; a < 2; ++a)
#pragma unroll
            for (int b = 0; b < 2; ++b)
#pragma unroll
                for (int m = 0; m < 4; ++m)
#pragma unroll
                    for (int n = 0; n < 2; ++n) acc[a][b][m][n] = (f32x4){0.f, 0.f, 0.f, 0.f};
        cur = nxt; cA = nA; cB = nB; ++ui;
        if constexpr (ALIGN_EPI) { if (wr == 1) PG8_BAR; }
    }
    PG8_WAIT_V(0);
    if constexpr (!ALIGN_EPI) { if (wr == 0) PG8_BAR; }
    PG8_BAR;
    if constexpr (Epi::AFTER_DRAIN) { E.fused(acc, cur, wr, wc, fr, fq, lds, wid, lane); S.done(cur); }
#undef PG8_SA
#undef PG8_SB
#undef PG8_STAGE
#undef PG8_LDA
#undef PG8_LDB
#undef PG8_MMA
#undef PG8_WAIT_V
#undef PG8_WAIT_L
#undef PG8_BAR
#undef PG8_SCHED
}
}
#include <hip/hip_cooperative_groups.h>
namespace cg = cooperative_groups;
constexpr int NWAVES = 8;
constexpr int MR = 32768, DM = 1024, FF = 2816, NGU = 5632, NIN = 2464, NINP = 2560, TSEQ = 4096, NBATCH = 8, NHEAD = 8, NMETA = 16;
constexpr int ZC_W = 1536, ZC_Q = 1696, ZC_K = 2208, ZC_V = 2336;
constexpr int PV = 320;
constexpr size_t MiB = 1u << 20;
constexpr size_t WS_CTL = 0, CTL_ZERO_BYTES = 1 * MiB;
constexpr size_t WS_WGU1 = 2 * MiB, WS_WD1 = 13 * MiB, WS_WIN = 19 * MiB, WS_WOUT = 24 * MiB, WS_WGU2 = 26 * MiB, WS_WD2 = 37 * MiB, WS_LT = 43 * MiB;
constexpr size_t WS_SSQ1 = 44 * MiB, WS_SSQ2 = 46 * MiB, WS_SSQ3 = 48 * MiB, WS_SSQ4 = 50 * MiB, WS_META = 52 * MiB;
constexpr size_t MO_XMB = 0, MO_UM = 64 * 1024, MO_H1MB = 256 * 1024, MO_SSQM1 = 320 * 1024, MO_SSQM2 = 324 * 1024, MO_ZM = 384 * 1024, MO_PM = 512 * 1024;
constexpr size_t WS_XB = 56 * MiB, WS_BIG = 120 * MiB, WS_P = 296 * MiB, WS_END = 456 * MiB;
constexpr int CW_BAR = 4096;
constexpr int RING_BYTES = 131072, LDSCTL_OFF = RING_BYTES, MISC_OFF = LDSCTL_OFF + 320, LDS_BYTES = 147456;

#define GAS __attribute__((address_space(1)))
#define LAS __attribute__((address_space(3)))
typedef unsigned short bf16;
typedef unsigned v4u __attribute__((ext_vector_type(4)));
typedef unsigned v2u __attribute__((ext_vector_type(2)));
typedef float f32x4 __attribute__((ext_vector_type(4)));
typedef float f32x2 __attribute__((ext_vector_type(2)));
typedef short bf16x8 __attribute__((ext_vector_type(8)));
typedef short bf16x4 __attribute__((ext_vector_type(4)));
typedef GAS unsigned gu32;
#define LDS_WAIT() asm volatile("s_waitcnt lgkmcnt(0)" ::: "memory")
__device__ __forceinline__ unsigned f2bf(float f) { unsigned u = __builtin_bit_cast(unsigned, f); return (u + 0x7fffu + ((u >> 16) & 1u)) >> 16; }
__device__ __forceinline__ unsigned pk2(float lo, float hi) { return pg8::cvt_pk_bf16(lo, hi); }
__device__ __forceinline__ float bflo(unsigned w) { return __builtin_bit_cast(float, w << 16); }
__device__ __forceinline__ float bfhi(unsigned w) { return __builtin_bit_cast(float, w & 0xffff0000u); }
__device__ __forceinline__ f32x4 unpack4(v2u w) { return (f32x4){bflo(w.x), bfhi(w.x), bflo(w.y), bfhi(w.y)}; }
__device__ __forceinline__ float sigmoidf_(float x) { return __builtin_amdgcn_rcpf(1.0f + __builtin_amdgcn_exp2f(-1.4426950408889634f * x)); }
__device__ __forceinline__ float tanhf_(float x) { return 2.0f * sigmoidf_(2.0f * x) - 1.0f; }
#define XB_TMO      128
#define XB_XCNT(j)  (256  + 64 * (j))
#define XB_XSUB(j)  (1280 + 64 * (j))
#define XB_XGEN(j)  (2304 + 64 * (j))
#define XB_TOP      3328
#define XB_TOPGEN   3392
#define XCD_BAR_WORDS 3456
#define XB_SPIN_CAP (1u << 18)

__device__ __forceinline__ unsigned xb_ld(unsigned* p)              { return __hip_atomic_load(p, __ATOMIC_RELAXED, __HIP_MEMORY_SCOPE_AGENT); }
__device__ __forceinline__ unsigned xb_add(unsigned* p, unsigned v) { return __hip_atomic_fetch_add(p, v, __ATOMIC_RELAXED, __HIP_MEMORY_SCOPE_AGENT); }
__device__ __forceinline__ unsigned xb_xcc_id() { return (unsigned)__builtin_amdgcn_s_getreg((3 << 11) | 20) & 0xFu; }
#define XB_SPIN(cond, bar) do { unsigned _sp = 0; while (cond) { __builtin_amdgcn_s_sleep(1); \
    if ((++_sp & 255u) == 0u) { if (xb_ld(&(bar)[XB_TMO])) break; if (_sp > XB_SPIN_CAP) { atomicAdd(&(bar)[XB_TMO], 1u); break; } } } } while (0)

struct XcdBarrier {
    unsigned* bar; unsigned x;
    volatile LAS unsigned* st;
};

__device__ __forceinline__ XcdBarrier xcd_barrier_post(unsigned* bar, volatile LAS unsigned* st) {
    XcdBarrier b; b.bar = bar; b.x = xb_xcc_id(); b.st = st;
    if (threadIdx.x == 0) (void)xb_add(&bar[XB_XCNT(b.x)], 1u);
    return b;
}
__device__ __forceinline__ void xcd_barrier_complete(unsigned* bar, unsigned x, unsigned& nloc, unsigned& nx) {
    const unsigned G = gridDim.x * gridDim.y * gridDim.z;
    unsigned sum, cnt, mine, sp = 0u;
    for (;;) {
        sum = 0u; cnt = 0u; mine = 0u;
#pragma unroll
        for (unsigned j = 0; j < 16; ++j) { const unsigned c = xb_ld(&bar[XB_XCNT(j)]); sum += c; cnt += (c > 0u) ? 1u : 0u; mine = (j == x) ? c : mine; }
        if (sum == G) break;
        __builtin_amdgcn_s_sleep(1);
        if ((++sp & 255u) == 0u) { if (xb_ld(&bar[XB_TMO])) break; if (sp > XB_SPIN_CAP) { atomicAdd(&bar[XB_TMO], 1u); break; } }
    }
    nloc = mine > 0u ? mine : 1u; nx = cnt > 0u ? cnt : 1u;
}

__device__ __forceinline__ void xcd_barrier(const XcdBarrier& b) {
    asm volatile("s_waitcnt vmcnt(0)" ::: "memory");
    __syncthreads();
    if (threadIdx.x == 0) {
        unsigned* bar = b.bar;
        __builtin_amdgcn_s_waitcnt(0);
        unsigned nloc = b.st[0], nx = b.st[1];
        if (nloc == 0u) { xcd_barrier_complete(bar, b.x, nloc, nx); b.st[0] = nloc; b.st[1] = nx; }
        const unsigned old = xb_add(&bar[XB_XSUB(b.x)], 1u);
        const unsigned gen = old / nloc;
        if (old + 1u == (gen + 1u) * nloc) {
            __builtin_amdgcn_fence(__ATOMIC_RELEASE, "agent");
            asm volatile("s_waitcnt vmcnt(0)" ::: "memory");
            const unsigned og = xb_add(&bar[XB_TOP], 1u);
            const unsigned tg = og / nx;
            if (og + 1u == (tg + 1u) * nx) xb_add(&bar[XB_TOPGEN], 1u);
            else XB_SPIN(xb_ld(&bar[XB_TOPGEN]) == tg, bar);
            __builtin_amdgcn_fence(__ATOMIC_ACQUIRE, "agent");
            xb_add(&bar[XB_XGEN(b.x)], 1u);
            asm volatile("s_waitcnt vmcnt(0)" ::: "memory");
        } else {
            XB_SPIN(xb_ld(&bar[XB_XGEN(b.x)]) == gen, bar);
            __builtin_amdgcn_fence(__ATOMIC_ACQUIRE, "agent");
            asm volatile("s_waitcnt vmcnt(0)" ::: "memory");
        }
    }
    __syncthreads();
}
__device__ __forceinline__ float wave_sum(float v) {
#pragma unroll
    for (int o = 1; o < 64; o <<= 1) v += __shfl_xor(v, o);
    return v;
}
__device__ __forceinline__ void p0_transpose_item(const float* W, int K, int N, bf16* WT, const float* gain, int k0, int n0, int drow0, LAS float* scr, int lane) {
#pragma unroll 8
    for (int i = 0; i < 32; ++i) { const int kk = 2 * i + (lane >> 5); float w = W[(size_t)(k0 + kk) * N + n0 + (lane & 31)]; if (gain) w *= gain[k0 + kk]; scr[kk * 33 + (lane & 31)] = w; }
    LDS_WAIT(); asm volatile("" ::: "memory");
    const int c = lane & 7;
#pragma unroll
    for (int j = 0; j < 4; ++j) { const int n = (lane >> 3) + 8 * j; const LAS float* s = scr + (8 * c) * 33 + n;
        v4u o; o.x = pk2(s[0 * 33], s[1 * 33]); o.y = pk2(s[2 * 33], s[3 * 33]); o.z = pk2(s[4 * 33], s[5 * 33]); o.w = pk2(s[6 * 33], s[7 * 33]);
        *(GAS v4u*)(WT + (size_t)(drow0 + n) * K + k0 + 8 * c) = o; }
    LDS_WAIT(); asm volatile("" ::: "memory");
}
__device__ __forceinline__ void row_to_bf16(const float* xrow, bf16* orow, float* ssq16, int lane) {
    const GAS f32x4* xr = (const GAS f32x4*)xrow + lane; f32x4 v[4]; float s = 0.f;
#pragma unroll
    for (int j = 0; j < 4; ++j) { v[j] = xr[64 * j]; s += (v[j].x * v[j].x + v[j].y * v[j].y) + (v[j].z * v[j].z + v[j].w * v[j].w); }
    s = wave_sum(s);
    GAS v2u* o8 = (GAS v2u*)orow + lane;
#pragma unroll
    for (int j = 0; j < 4; ++j) { v2u w; w.x = pk2(v[j].x, v[j].y); w.y = pk2(v[j].z, v[j].w); o8[64 * j] = w; }
    if (lane < 16) ssq16[lane] = (lane == 0) ? s : 0.f;
}
struct Ptrs {
    const float* in[27]; float* out; unsigned char* ws;
};
__device__ __forceinline__ void p0_prologue(const Ptrs& P, LAS unsigned char* lds, int vcu, int G, int wave, int lane) {
    LAS float* scr = (LAS float*)(lds + wave * 16384);
    const int gw = vcu * NWAVES + wave, NGW = G * NWAVES;
    unsigned char* ws = P.ws;
    constexpr int I_G = (DM / 64) * (FF / 32), I_D = (FF / 64) * (DM / 32), I_IN = (DM / 64) * (NIN / 32), I_O = (DM / 64) * (DM / 32);
    constexpr int NITEMS = 4 * I_G + 2 * I_D + I_IN + I_O;
    for (int it = gw; it < NITEMS; it += NGW) {
        int r = it;
        if (r < 4 * I_G) {
            const int which = r / I_G; r -= which * I_G; const int nblk = FF / 32, kb = r / nblk, nb = r % nblk, n0 = 32 * nb;
            const float* W = P.in[which == 0 ? 3 : which == 1 ? 4 : which == 2 ? 23 : 24]; const float* gain = P.in[which < 2 ? 2 : 22];
            bf16* WT = (bf16*)(ws + (which < 2 ? WS_WGU1 : WS_WGU2));
            const int drow0 = 256 * (n0 / 128) + 128 * (which & 1) + (n0 % 128);
            p0_transpose_item(W, DM, FF, WT, gain, 64 * kb, n0, drow0, scr, lane); continue; }
        r -= 4 * I_G;
        if (r < 2 * I_D) { const int which = r / I_D; r -= which * I_D; const int nblk = DM / 32, kb = r / nblk, nb = r % nblk;
            p0_transpose_item(P.in[which ? 25 : 5], FF, DM, (bf16*)(ws + (which ? WS_WD2 : WS_WD1)), nullptr, 64 * kb, 32 * nb, 32 * nb, scr, lane); continue; }
        r -= 2 * I_D;
        if (r < I_IN) { const int nblk = NIN / 32, kb = r / nblk, nb = r % nblk;
            p0_transpose_item(P.in[7], DM, NIN, (bf16*)(ws + WS_WIN), P.in[6], 64 * kb, 32 * nb, 32 * nb, scr, lane); continue; }
        r -= I_IN;
        { const int nblk = DM / 32, kb = r / nblk, nb = r % nblk;
            p0_transpose_item(P.in[21], DM, DM, (bf16*)(ws + WS_WOUT), nullptr, 64 * kb, 32 * nb, 32 * nb, scr, lane); }
    }
    { GAS v4u* z = (GAS v4u*)(ws + WS_WIN + (size_t)NIN * DM * 2); const int n16 = (NINP - NIN) * DM * 2 / 16;
      for (int i = gw * 64 + lane; i < n16; i += NGW * 64) z[i] = (v4u){0u, 0u, 0u, 0u}; }
    { bf16* LT = (bf16*)(ws + WS_LT);
      for (int i = gw * 64 + lane; i < 512 * 160; i += NGW * 64) { const int n = i / 160, j = i % 160;
          const float v = j < 32 ? P.in[11][j * 512 + n] : j < 64 ? P.in[13][(j - 32) * 512 + n] : P.in[14][(j - 64) * 512 + n];
          LT[i] = (bf16)f2bf(v); } }
    for (int m = gw; m < MR + NMETA; m += NGW) {
        if (m < MR) row_to_bf16(P.in[0] + (size_t)m * DM, (bf16*)(ws + WS_XB) + (size_t)m * DM, (float*)(ws + WS_SSQ1) + (size_t)m * 16, lane);
        else { const int i = m - MR; row_to_bf16(P.in[1] + (size_t)i * DM, (bf16*)(ws + WS_META + MO_XMB) + (size_t)i * DM, (float*)(ws + WS_META + MO_SSQM1) + i * 16, lane); }
    }
}
__device__ __forceinline__ f32x4 skinny16(const bf16* A, const bf16* Bt, int K, int n0, int lane) {
    const int fr = lane & 15, fq = lane >> 4;
    const bf16* ap = A + (size_t)fr * K + 8 * fq; const bf16* bp = Bt + (size_t)(n0 + fr) * K + 8 * fq;
    f32x4 acc = (f32x4){0.f, 0.f, 0.f, 0.f};
    for (int k = 0; k < K; k += 32) { const bf16x8 a = *(const bf16x8*)(ap + k), b = *(const bf16x8*)(bp + k); acc = __builtin_amdgcn_mfma_f32_16x16x32_bf16(a, b, acc, 0, 0, 0); }
    return acc;
}
__device__ __forceinline__ float rstd_m16(const float* ssq16) { float s = 0.f;
#pragma unroll
    for (int i = 0; i < 16; ++i) s += ssq16[i];
    return __builtin_amdgcn_rsqf(s * (1.0f / 1024.0f) + 1e-5f); }
__device__ __forceinline__ void meta_up(unsigned char* ws, int gw, int NGW, int lane) {
    const bf16* A = (const bf16*)(ws + WS_META + MO_XMB); const bf16* Bt = (const bf16*)(ws + WS_WGU1); bf16* Um = (bf16*)(ws + WS_META + MO_UM);
    const float* ssq = (const float*)(ws + WS_META + MO_SSQM1); const int fr = lane & 15, fq = lane >> 4;
    for (int t = gw; t < FF / 16; t += NGW) { const int c0 = 16 * t, nr = 256 * (c0 / 128) + (c0 % 128);
        const f32x4 g = skinny16(A, Bt, DM, nr, lane), u = skinny16(A, Bt, DM, nr + 128, lane);
#pragma unroll
        for (int r = 0; r < 4; ++r) { const int row = 4 * fq + r; const float rs = rstd_m16(ssq + row * 16); Um[(size_t)row * FF + c0 + fr] = (bf16)f2bf(pg8::silu_mul(g[r] * rs, u[r] * rs)); } }
}
__device__ __forceinline__ void meta_down(const Ptrs& P, int gw, int NGW, int lane) {
    unsigned char* ws = P.ws; const bf16* A = (const bf16*)(ws + WS_META + MO_UM); const bf16* Bt = (const bf16*)(ws + WS_WD1); bf16* H = (bf16*)(ws + WS_META + MO_H1MB);
    float* ssq = (float*)(ws + WS_META + MO_SSQM2); const int fr = lane & 15, fq = lane >> 4;
    for (int t = gw; t < DM / 16; t += NGW) { const f32x4 a = skinny16(A, Bt, FF, 16 * t, lane);
#pragma unroll
        for (int r = 0; r < 4; ++r) { const int row = 4 * fq + r; const float o = P.in[1][row * DM + 16 * t + fr] + 0.5f * a[r]; H[row * DM + 16 * t + fr] = (bf16)f2bf(o);
            float s = o * o; s += __shfl_xor(s, 1); s += __shfl_xor(s, 2); s += __shfl_xor(s, 4); s += __shfl_xor(s, 8); if (fr == 0) ssq[row * 64 + t] = s; } }
}
__device__ __forceinline__ void meta_win(const Ptrs& P, int gw, int NGW, int lane) {
    unsigned char* ws = P.ws; const bf16* A = (const bf16*)(ws + WS_META + MO_H1MB); const bf16* Bt = (const bf16*)(ws + WS_WIN); bf16* Zm = (bf16*)(ws + WS_META + MO_ZM);
    const float* ssq = (const float*)(ws + WS_META + MO_SSQM2); const int fr = lane & 15, fq = lane >> 4;
    for (int t = gw; t < NIN / 16; t += NGW) { const f32x4 a = skinny16(A, Bt, DM, 16 * t, lane); const int c = 16 * t + fr; const float bias = c >= ZC_Q ? P.in[8][c - ZC_Q] : 0.f;
#pragma unroll
        for (int r = 0; r < 4; ++r) { const int row = 4 * fq + r; float s = 0.f;
#pragma unroll 8
            for (int i = 0; i < 64; ++i) s += ssq[row * 64 + i];
            Zm[(size_t)row * NIN + c] = (bf16)f2bf(a[r] * __builtin_amdgcn_rsqf(s * (1.0f / 1024.0f) + 1e-5f) + bias); } }
}
__device__ __forceinline__ void prep_task(const Ptrs& P, int tt, int h, int lane) {
    unsigned char* ws = P.ws; const int fr = lane & 15, fq = lane >> 4;
    const bf16* Z = (const bf16*)(ws + WS_BIG); const bf16* Zm = (const bf16*)(ws + WS_META + MO_ZM); const bf16* LT = (const bf16*)(ws + WS_LT);
    const bool meta = (tt == MR / 16);
    const int m = 16 * tt + fr;
    const bf16* zc = meta ? Zm + (size_t)fr * NIN : Z + (size_t)m * NIN;
    const bool pz = meta && fr == 0;
    const bf16* zp = meta ? Zm + (size_t)(fr > 0 ? fr - 1 : 0) * NIN : ((m % TSEQ) == 0 ? Zm + (size_t)15 * NIN : Z + (size_t)(m - 1) * NIN);
    const float* mu = P.in[9];
    bf16x8 xf[5];
#pragma unroll
    for (int ks = 0; ks < 5; ++ks) { const int c0 = ZC_W + 32 * ks + 8 * fq; const v4u a = *(const v4u*)(zc + c0); v4u b = *(const v4u*)(zp + c0); if (pz) b = (v4u){0u, 0u, 0u, 0u};
        float v[8]; const f32x4 m0 = *(const f32x4*)(mu + c0), m1 = *(const f32x4*)(mu + c0 + 4);
#pragma unroll
        for (int e = 0; e < 4; ++e) { const unsigned wa = a[e], wb = b[e]; const float a0 = bflo(wa), a1 = bfhi(wa), b0 = bflo(wb), b1 = bfhi(wb);
            const float mm0 = (2 * e < 4) ? m0[2 * e] : m1[2 * e - 4], mm1 = (2 * e + 1 < 4) ? m0[2 * e + 1] : m1[2 * e + 1 - 4];
            v[2 * e] = a0 + (b0 - a0) * mm0; v[2 * e + 1] = a1 + (b1 - a1) * mm1; }
#pragma unroll
        for (int e = 0; e < 8; ++e) v[e] = (ks == 0) ? tanhf_(v[e]) : (ks == 1) ? v[e] : sigmoidf_(v[e]);
        v4u o; o.x = pk2(v[0], v[1]); o.y = pk2(v[2], v[3]); o.z = pk2(v[4], v[5]); o.w = pk2(v[6], v[7]); xf[ks] = __builtin_bit_cast(bf16x8, o); }
    f32x4 aw[4], aa[4], ag[4];
#pragma unroll
    for (int nt = 0; nt < 4; ++nt) { const bf16* lp = LT + (size_t)(h * 64 + 16 * nt + fr) * 160 + 8 * fq; const f32x4 z = (f32x4){0.f, 0.f, 0.f, 0.f};
        aw[nt] = __builtin_amdgcn_mfma_f32_16x16x32_bf16(*(const bf16x8*)(lp), xf[0], z, 0, 0, 0);
        aa[nt] = __builtin_amdgcn_mfma_f32_16x16x32_bf16(*(const bf16x8*)(lp + 32), xf[1], z, 0, 0, 0);
        ag[nt] = __builtin_amdgcn_mfma_f32_16x16x32_bf16(*(const bf16x8*)(lp + 64), xf[2], z, 0, 0, 0);
        ag[nt] = __builtin_amdgcn_mfma_f32_16x16x32_bf16(*(const bf16x8*)(lp + 96), xf[3], ag[nt], 0, 0, 0);
        ag[nt] = __builtin_amdgcn_mfma_f32_16x16x32_bf16(*(const bf16x8*)(lp + 128), xf[4], ag[nt], 0, 0, 0); }
    f32x4 kkr[4], kv[4], av[4]; float ss = 0.f;
#pragma unroll
    for (int nt = 0; nt < 4; ++nt) { const int c = h * 64 + 16 * nt + 4 * fq; const v2u a = *(const v2u*)(zc + 512 + c); v2u b = *(const v2u*)(zp + 512 + c); if (pz) b = (v2u){0u, 0u};
        const f32x4 za = unpack4(a), zb = unpack4(b), mk = *(const f32x4*)(mu + 512 + c); const f32x4 zk = za + (zb - za) * mk;
        const f32x4 a0 = *(const f32x4*)(P.in[12] + c), kkw = *(const f32x4*)(P.in[15] + c), kaw = *(const f32x4*)(P.in[16] + c);
        f32x4 a_;
#pragma unroll
        for (int r = 0; r < 4; ++r) a_[r] = sigmoidf_(a0[r] + aa[nt][r]);
        av[nt] = a_; kkr[nt] = zk * kkw; kv[nt] = zk * (1.0f + (a_ - 1.0f) * kaw);
        ss += (kkr[nt][0] * kkr[nt][0] + kkr[nt][1] * kkr[nt][1]) + (kkr[nt][2] * kkr[nt][2] + kkr[nt][3] * kkr[nt][3]); }
    ss += __shfl_xor(ss, 16); ss += __shfl_xor(ss, 32);
    const float inv = 1.0f / fmaxf(sqrtf(ss), 1e-12f);
    bf16* pr;
    if (meta) pr = (bf16*)(ws + WS_META + MO_PM) + (size_t)(h * 16 + fr) * PV;
    else { const int b = m / TSEQ, t = m % TSEQ; pr = (bf16*)(ws + WS_P) + ((size_t)(b * NHEAD + h) * TSEQ + t) * PV; }
#pragma unroll
    for (int nt = 0; nt < 4; ++nt) { const int cl = 16 * nt + 4 * fq, c = h * 64 + cl; const f32x4 w0 = *(const f32x4*)(P.in[10] + c);
        const f32x4 kk = kkr[nt] * inv, bb = kk * av[nt]; f32x4 e;
#pragma unroll
        for (int r = 0; r < 4; ++r) e[r] = 0.6065306597126334f * sigmoidf_(w0[r] + aw[nt][r]);
        v2u o;
        o.x = pk2(kk[0], kk[1]); o.y = pk2(kk[2], kk[3]); *(v2u*)(pr + cl) = o;
        o.x = pk2(e[0], e[1]); o.y = pk2(e[2], e[3]); *(v2u*)(pr + 64 + cl) = o;
        o.x = pk2(bb[0], bb[1]); o.y = pk2(bb[2], bb[3]); *(v2u*)(pr + 128 + cl) = o;
        o.x = pk2(kv[nt][0], kv[nt][1]); o.y = pk2(kv[nt][2], kv[nt][3]); *(v2u*)(pr + 192 + cl) = o;
        o.x = pk2(ag[nt][0], ag[nt][1]); o.y = pk2(ag[nt][2], ag[nt][3]); *(v2u*)(pr + 256 + cl) = o; }
}
constexpr int KS_LD = 72, VT_LD = 232, ATT_KS_BYTES = 208 * KS_LD * 2, ATT_VT_BYTES = 64 * VT_LD * 2;
__device__ __forceinline__ void attn_unit(const Ptrs& P, unsigned char* lds, int b, int g, int c, int tid, int wave, int lane) {
    unsigned char* ws = P.ws; const bf16* Z = (const bf16*)(ws + WS_BIG); const bf16* Zm = (const bf16*)(ws + WS_META + MO_ZM); bf16* Y = (bf16*)(ws + WS_XB);
    bf16* Ks = (bf16*)lds; bf16* Vt = (bf16*)(lds + ATT_KS_BYTES);
    const int fr = lane & 15, fq = lane >> 4;
    __syncthreads();
    for (int it = tid; it < 208 * 8; it += NWAVES * 64) { const int key = it >> 3, pc = it & 7; const bf16* src; bool valid = true;
        if (key < 16) src = Zm + (size_t)key * NIN; else { const int t = 64 * (c - 2) + (key - 16); valid = t >= 0; src = Z + ((size_t)b * TSEQ + (valid ? t : 0)) * NIN; }
        v4u kq = *(const v4u*)(src + ZC_K + 64 * g + 8 * pc), vq = *(const v4u*)(src + ZC_V + 64 * g + 8 * pc);
        if (!valid) { kq = (v4u){0u, 0u, 0u, 0u}; vq = kq; }
        *(v4u*)(Ks + key * KS_LD + 8 * pc) = kq;
#pragma unroll
        for (int e = 0; e < 4; ++e) { Vt[(8 * pc + 2 * e) * VT_LD + key] = (bf16)(vq[e] & 0xffffu); Vt[(8 * pc + 2 * e + 1) * VT_LD + key] = (bf16)(vq[e] >> 16); } }
    for (int it = tid; it < 64 * 16; it += NWAVES * 64) Vt[(it >> 4) * VT_LD + 208 + (it & 15)] = 0;
    __syncthreads();
    const int hq = 4 * g + (wave >> 1);
    const float slope = __builtin_amdgcn_exp2f(-(float)(hq + 1)), sink = P.in[20][hq];
#pragma unroll 1
    for (int sub = 0; sub < 2; ++sub) {
        const int i0 = 16 * (2 * (wave & 1) + sub), iq = i0 + fr;
        const size_t mrow = (size_t)b * TSEQ + 64 * c + iq;
        const bf16x8 q0 = *(const bf16x8*)(Z + mrow * NIN + ZC_Q + 64 * hq + 8 * fq), q1 = *(const bf16x8*)(Z + mrow * NIN + ZC_Q + 64 * hq + 32 + 8 * fq);
        f32x4 s[13]; float mx = sink;
#pragma unroll
        for (int kt = 0; kt < 13; ++kt) { const bf16* kp = Ks + (16 * kt + fr) * KS_LD + 8 * fq; f32x4 a = (f32x4){0.f, 0.f, 0.f, 0.f};
            a = __builtin_amdgcn_mfma_f32_16x16x32_bf16(*(const bf16x8*)(kp), q0, a, 0, 0, 0);
            a = __builtin_amdgcn_mfma_f32_16x16x32_bf16(*(const bf16x8*)(kp + 32), q1, a, 0, 0, 0);
#pragma unroll
            for (int r = 0; r < 4; ++r) { const int key = 16 * kt + 4 * fq + r; float v;
                if (kt == 0) v = a[r] * 0.125f - slope * (float)(16 + 64 * c + iq - key);
                else { const int jj = key - 16; const int d = 128 + iq - jj; v = a[r] * 0.125f - slope * (float)(d < 0 ? -d : d); if (64 * (c - 2) + jj < 0) v = -1e30f; }
                a[r] = v; mx = fmaxf(mx, v); }
            s[kt] = a; }
        mx = fmaxf(mx, __shfl_xor(mx, 16)); mx = fmaxf(mx, __shfl_xor(mx, 32));
        float sum = 0.f;
#pragma unroll
        for (int kt = 0; kt < 13; ++kt)
#pragma unroll
            for (int r = 0; r < 4; ++r) { const float p = __builtin_amdgcn_exp2f((s[kt][r] - mx) * 1.4426950408889634f); s[kt][r] = p; sum += p; }
        sum += __shfl_xor(sum, 16); sum += __shfl_xor(sum, 32);
        sum += __builtin_amdgcn_exp2f((sink - mx) * 1.4426950408889634f);
        const float rinv = 1.0f / sum;
        f32x4 o[4];
#pragma unroll
        for (int dt = 0; dt < 4; ++dt) o[dt] = (f32x4){0.f, 0.f, 0.f, 0.f};
#pragma unroll
        for (int ks = 0; ks < 7; ++ks) { const int ta = 2 * ks, tb = 2 * ks + 1; v4u pw;
            pw.x = pk2(s[ta][0], s[ta][1]); pw.y = pk2(s[ta][2], s[ta][3]);
            if (tb < 13) { pw.z = pk2(s[tb][0], s[tb][1]); pw.w = pk2(s[tb][2], s[tb][3]); } else { pw.z = 0u; pw.w = 0u; }
            const bf16x8 pf = __builtin_bit_cast(bf16x8, pw);
#pragma unroll
            for (int dt = 0; dt < 4; ++dt) { const bf16* vp = Vt + (16 * dt + fr) * VT_LD + 4 * fq; const v2u va = *(const v2u*)(vp + 16 * ta), vb = *(const v2u*)(vp + 16 * tb);
                const v4u vv = (v4u){va.x, va.y, vb.x, vb.y};
                o[dt] = __builtin_amdgcn_mfma_f32_16x16x32_bf16(__builtin_bit_cast(bf16x8, vv), pf, o[dt], 0, 0, 0); } }
#pragma unroll
        for (int dt = 0; dt < 4; ++dt) { v2u w; w.x = pk2(o[dt][0] * rinv, o[dt][1] * rinv); w.y = pk2(o[dt][2] * rinv, o[dt][3] * rinv);
            *(v2u*)(Y + mrow * DM + 512 + 64 * hq + 16 * dt + 4 * fq) = w; }
    }
}
template <int CTRL> __device__ __forceinline__ float dppf(float x) { return __builtin_bit_cast(float, __builtin_amdgcn_update_dpp(0, __builtin_bit_cast(int, x), CTRL, 0xF, 0xF, true)); }
__device__ __forceinline__ float red8(float x) { x += dppf<0xB1>(x); x += dppf<0x4E>(x); x += dppf<0x141>(x); return x; }
__device__ __forceinline__ float red16(float x) { x = red8(x); x += dppf<0x140>(x); return x; }
constexpr int NCHUNK = 257, IMG_STEP = 6 * 64, IMG_FLOATS = 16 * IMG_STEP;
struct ScanRaw { v2u pk[5]; v2u rc, rp, vc, vp; };
__device__ __forceinline__ void scan_phase(const Ptrs& P, unsigned char* lds, int sb, int tid, int wave, int lane) {
    const int b = sb >> 3, h = sb & 7;
    float* IMG = (float*)lds; float* YB = (float*)(lds + 2 * IMG_FLOATS * 4);
    if (wave < 4) {
        const int p = lane >> 3, j = lane & 7, v0 = 16 * wave + 2 * p;
        f32x2 S[8];
#pragma unroll
        for (int k = 0; k < 8; ++k) S[k] = (f32x2){0.f, 0.f};
#pragma unroll 1
        for (int n = 0; n <= NCHUNK; ++n) {
            __syncthreads();
            if (n == NCHUNK) break;
            const float* img = IMG + (n & 1) * IMG_FLOATS + 8 * j; float* yb = YB + (n & 1) * 1024 + v0;
#pragma unroll 4
            for (int s = 0; s < 16; ++s) { const float* st = img + s * IMG_STEP;
                const f32x4 kA = *(const f32x4*)(st), kB = *(const f32x4*)(st + 4), wA = *(const f32x4*)(st + 64), wB = *(const f32x4*)(st + 68), bA = *(const f32x4*)(st + 128), bB = *(const f32x4*)(st + 132);
                const f32x4 cA = *(const f32x4*)(st + 192), cB = *(const f32x4*)(st + 196), rA = *(const f32x4*)(st + 256), rB = *(const f32x4*)(st + 260);
                const f32x2 vv = *(const f32x2*)(IMG + (n & 1) * IMG_FLOATS + s * IMG_STEP + 320 + v0);
                f32x2 sa0 = S[0] * kA[0], sa1 = S[4] * kB[0];
                sa0 += S[1] * kA[1]; sa1 += S[5] * kB[1]; sa0 += S[2] * kA[2]; sa1 += S[6] * kB[2]; sa0 += S[3] * kA[3]; sa1 += S[7] * kB[3];
                f32x2 sa = sa0 + sa1; sa.x = -red8(sa.x); sa.y = -red8(sa.y);
#pragma unroll
                for (int k = 0; k < 4; ++k) { S[k] = S[k] * wA[k] + (sa * bA[k] + vv * cA[k]); S[4 + k] = S[4 + k] * wB[k] + (sa * bB[k] + vv * cB[k]); }
                f32x2 y0 = S[0] * rA[0], y1 = S[4] * rB[0];
                y0 += S[1] * rA[1]; y1 += S[5] * rB[1]; y0 += S[2] * rA[2]; y1 += S[6] * rB[2]; y0 += S[3] * rA[3]; y1 += S[7] * rB[3];
                f32x2 y = y0 + y1; y.x = red8(y.x); y.y = red8(y.y);
                if (j == 0) *(f32x2*)(yb + s * 64) = y; }
        }
    } else {
        const int ht = tid - 256, i = ht >> 4, q = ht & 15, ch = h * 64 + 4 * q;
        const bf16* Z = (const bf16*)(P.ws + WS_BIG); const bf16* Zm = (const bf16*)(P.ws + WS_META + MO_ZM);
        const bf16* Pb = (const bf16*)(P.ws + WS_P) + (size_t)(b * NHEAD + h) * TSEQ * PV; const bf16* Pm = (const bf16*)(P.ws + WS_META + MO_PM) + (size_t)h * 16 * PV;
        bf16* Y = (bf16*)(P.ws + WS_XB);
        const f32x4 mu_r = *(const f32x4*)(P.in[9] + ch), mu_v = *(const f32x4*)(P.in[9] + 1024 + ch), rk = *(const f32x4*)(P.in[17] + ch), lnw = *(const f32x4*)(P.in[18] + ch), lnb = *(const f32x4*)(P.in[19] + ch);
        ScanRaw raw;
        f32x4 sv[2], sg[2]; float sbs[2];
#pragma unroll
        for (int u = 0; u < 2; ++u) { sv[u] = (f32x4){0.f, 0.f, 0.f, 0.f}; sg[u] = sv[u]; sbs[u] = 0.f; }
#define SCAN_LOAD(n_) do { const int n__ = (n_); const bf16 *pr, *zc, *zp; \
            if (n__ == 0) { pr = Pm + (size_t)i * PV; zc = Zm + (size_t)i * NIN; zp = Zm + (size_t)(i > 0 ? i - 1 : 0) * NIN; } \
            else { const int t = 16 * (n__ - 1) + i; const size_t m = (size_t)b * TSEQ + t; pr = Pb + (size_t)t * PV; zc = Z + m * NIN; zp = (t == 0) ? Zm + (size_t)15 * NIN : Z + (m - 1) * NIN; } \
            _Pragma("unroll") for (int v_ = 0; v_ < 5; ++v_) raw.pk[v_] = *(const v2u*)(pr + 64 * v_ + 4 * q); \
            raw.rc = *(const v2u*)(zc + ch); raw.rp = *(const v2u*)(zp + ch); raw.vc = *(const v2u*)(zc + 1024 + ch); raw.vp = *(const v2u*)(zp + 1024 + ch); \
            if (n__ == 0 && i == 0) { raw.rp = (v2u){0u, 0u}; raw.vp = raw.rp; } } while (0)
#define SCAN_CONV(n_) do { float* st = IMG + ((n_) & 1) * IMG_FLOATS + i * IMG_STEP + 4 * q; \
            const f32x4 kk = unpack4(raw.pk[0]), e = unpack4(raw.pk[1]), bb = unpack4(raw.pk[2]), kx = unpack4(raw.pk[3]), g = unpack4(raw.pk[4]); \
            f32x4 w; _Pragma("unroll") for (int r_ = 0; r_ < 4; ++r_) w[r_] = __builtin_amdgcn_exp2f(-1.4426950408889634f * e[r_]); \
            const f32x4 rc = unpack4(raw.rc), rp = unpack4(raw.rp), vc = unpack4(raw.vc), vp = unpack4(raw.vp); \
            const f32x4 rr = rc + (rp - rc) * mu_r, vv = vc + (vp - vc) * mu_v; \
            *(f32x4*)(st) = kk; *(f32x4*)(st + 64) = w; *(f32x4*)(st + 128) = bb; *(f32x4*)(st + 192) = kx; *(f32x4*)(st + 256) = rr; *(f32x4*)(st + 320) = vv; \
            const f32x4 t_ = rr * kx * rk; const float bs = red16((t_[0] + t_[1]) + (t_[2] + t_[3])); \
            sv[0] = vv; sg[0] = g; sbs[0] = bs; } while (0)
        SCAN_LOAD(0); SCAN_CONV(0);
        SCAN_LOAD(1);
#pragma unroll 1
        for (int n = 0; n <= NCHUNK; ++n) {
            __syncthreads();
            if (n >= 2) { const f32x4 y = *(const f32x4*)(YB + ((n - 1) & 1) * 1024 + i * 64 + 4 * q);
                const float mean = red16((y[0] + y[1]) + (y[2] + y[3])) * (1.0f / 64.0f); const f32x4 d = y - mean;
                const float var = red16((d[0] * d[0] + d[1] * d[1]) + (d[2] * d[2] + d[3] * d[3])) * (1.0f / 64.0f);
                const float rs = __builtin_amdgcn_rsqf(var + 64e-5f);
                const f32x4 o = (d * rs * lnw + lnb + sv[1] * sbs[1]) * sg[1];
                const size_t m = (size_t)b * TSEQ + 16 * (n - 2) + i; v2u w; w.x = pk2(o[0], o[1]); w.y = pk2(o[2], o[3]);
                *(v2u*)(Y + m * DM + ch) = w; }
            sv[1] = sv[0]; sg[1] = sg[0]; sbs[1] = sbs[0];
            if (n + 1 < NCHUNK) SCAN_CONV(n + 1);
            if (n + 2 < NCHUNK) SCAN_LOAD(n + 2);
        }
#undef SCAN_LOAD
#undef SCAN_CONV
    }
}
__device__ __forceinline__ void final_norm(const Ptrs& P, int gw, int NGW, int lane) {
    const float* ssq = (const float*)(P.ws + WS_SSQ4); const GAS f32x4* g4 = (const GAS f32x4*)P.in[26] + lane;
    f32x4 g[4];
#pragma unroll
    for (int j = 0; j < 4; ++j) g[j] = g4[64 * j];
    for (int m = gw; m < MR; m += NGW) { const float rs = pg8::rstd_from16(ssq, m); GAS f32x4* o = (GAS f32x4*)(P.out + (size_t)m * DM) + lane;
#pragma unroll
        for (int j = 0; j < 4; ++j) o[64 * j] = o[64 * j] * rs * g[j]; }
}
#ifndef MK_N_LAUNCHES
#define MK_N_LAUNCHES 10
#endif
constexpr int N_PHASES = 10;
struct Args { Ptrs p; int ph_lo, ph_hi, use_cg, pad; };
__global__ void __launch_bounds__(NWAVES * 64, 2) hymba_fwd(Args args) {
    extern __shared__ __attribute__((aligned(16))) unsigned char lds[];
    LAS unsigned char* ldsl = (LAS unsigned char*)lds;
    volatile LAS unsigned* MISC = (volatile LAS unsigned*)(ldsl + MISC_OFF);
    const int tid = threadIdx.x, lane = tid & 63, wave = __builtin_amdgcn_readfirstlane(tid >> 6);
    const int G = gridDim.x, bx = blockIdx.x, vcu = (G % 8 == 0) ? (bx % 8) * (G / 8) + bx / 8 : bx;
    const Ptrs& P = args.p; unsigned char* ws = P.ws;
    if (args.use_cg) cg::this_grid().sync();
    for (int u = tid; u < (LDS_BYTES - LDSCTL_OFF) / 4; u += NWAVES * 64) ((LAS unsigned*)(ldsl + LDSCTL_OFF))[u] = 0u;
    __syncthreads();
    const int lo = args.ph_lo, hi = args.ph_hi;
    XcdBarrier bar; bar.bar = (unsigned*)(ws + WS_CTL) + CW_BAR; bar.x = 0; bar.st = nullptr;
    if (hi - lo > 1) bar = xcd_barrier_post((unsigned*)(ws + WS_CTL) + CW_BAR, MISC + 8);
#define IN(k) (lo <= (k) && (k) < hi)
#define SEAM(k) do { if (IN(k) && IN((k) + 1)) xcd_barrier(bar); } while (0)
    const int gw = vcu * NWAVES + wave, NGW = G * NWAVES;

    if (IN(0)) { p0_prologue(P, ldsl, vcu, G, wave, lane); SEAM(0); }
    if (IN(1)) {
        meta_up(ws, gw, NGW, lane);
        pg8::Gemm g{(const bf16*)(ws + WS_XB), (const bf16*)(ws + WS_WGU1), MR, NGU, DM}; pg8::StaticOrder S; S.init(MR, NGU, G, bx);
        pg8::EpiSwiglu E{(bf16*)(ws + WS_BIG), (const float*)(ws + WS_SSQ1), FF};
        pg8::gemm_phase<pg8::EpiSwiglu, pg8::StaticOrder, true, true>(ldsl, g, S, E);
        SEAM(1);
    }
    if (IN(2)) {
        meta_down(P, gw, NGW, lane);
        pg8::Gemm g{(const bf16*)(ws + WS_BIG), (const bf16*)(ws + WS_WD1), MR, DM, FF}; pg8::StaticOrder S; S.init(MR, DM, G, bx);
        pg8::EpiResid<true> E{P.in[0], P.out, (bf16*)(ws + WS_XB), (float*)(ws + WS_SSQ2), 0.5f};
        pg8::gemm_phase<pg8::EpiResid<true>, pg8::StaticOrder, true, true>(ldsl, g, S, E);
        SEAM(2);
    }
    if (IN(3)) {
        meta_win(P, gw, NGW, lane);
        pg8::Gemm g{(const bf16*)(ws + WS_XB), (const bf16*)(ws + WS_WIN), MR, NINP, DM}; pg8::StaticOrder S; S.init(MR, NINP, G, bx);
        pg8::EpiZ E{(bf16*)(ws + WS_BIG), (const float*)(ws + WS_SSQ2), P.in[8], NIN, NIN, ZC_Q};
        pg8::gemm_phase<pg8::EpiZ, pg8::StaticOrder, true, true>(ldsl, g, S, E);
        SEAM(3);
    }
    if (IN(4)) {
        constexpr int NT = (MR / 16 + 1) * NHEAD;
        for (int t = gw; t < NT; t += NGW) prep_task(P, t >> 3, t & 7, lane);
        for (int u = vcu; u < NBATCH * 2 * 64; u += G) attn_unit(P, lds, u >> 7, (u >> 6) & 1, u & 63, tid, wave, lane);
        SEAM(4);
    }
    if (IN(5)) {
        if (bx < 64) scan_phase(P, lds, bx, tid, wave, lane);
        SEAM(5);
    }
    if (IN(6)) {
        pg8::Gemm g{(const bf16*)(ws + WS_XB), (const bf16*)(ws + WS_WOUT), MR, DM, DM}; pg8::StaticOrder S; S.init(MR, DM, G, bx);
        pg8::EpiResid<true> E{P.out, P.out, (bf16*)(ws + WS_P), (float*)(ws + WS_SSQ3), 1.0f};
        pg8::gemm_phase<pg8::EpiResid<true>, pg8::StaticOrder, true, true>(ldsl, g, S, E);
        SEAM(6);
    }
    if (IN(7)) {
        pg8::Gemm g{(const bf16*)(ws + WS_P), (const bf16*)(ws + WS_WGU2), MR, NGU, DM}; pg8::StaticOrder S; S.init(MR, NGU, G, bx);
        pg8::EpiSwiglu E{(bf16*)(ws + WS_BIG), (const float*)(ws + WS_SSQ3), FF};
        pg8::gemm_phase<pg8::EpiSwiglu, pg8::StaticOrder, true, true>(ldsl, g, S, E);
        SEAM(7);
    }
    if (IN(8)) {
        pg8::Gemm g{(const bf16*)(ws + WS_BIG), (const bf16*)(ws + WS_WD2), MR, DM, FF}; pg8::StaticOrder S; S.init(MR, DM, G, bx);
        pg8::EpiResid<false> E{P.out, P.out, nullptr, (float*)(ws + WS_SSQ4), 0.5f};
        pg8::gemm_phase<pg8::EpiResid<false>, pg8::StaticOrder, true, true>(ldsl, g, S, E);
        SEAM(8);
    }
    if (IN(9)) final_norm(P, gw, NGW, lane);
#undef IN
#undef SEAM
}

extern "C" void kernel_launch(void* const* d_in, const int* in_sizes, int n_in, void* d_out, int out_size, void* d_ws, size_t ws_size, hipStream_t stream) {
    static int grid = 0;
    if (grid == 0) {
        if (n_in != 27 || in_sizes[0] != MR * DM || out_size != MR * DM || ws_size < WS_END) { fprintf(stderr, "kernel_launch: unexpected shapes (n_in %d, in0 %d, out %d, ws %zu)\n", n_in, n_in > 0 ? in_sizes[0] : -1, out_size, ws_size); grid = -1; return; }
        int dev = 0, cus = 0, per_cu = 0;
        if (hipGetDevice(&dev) != hipSuccess || hipDeviceGetAttribute(&cus, hipDeviceAttributeMultiprocessorCount, dev) != hipSuccess) { grid = -1; return; }
        if (hipFuncSetAttribute((const void*)hymba_fwd, hipFuncAttributeMaxDynamicSharedMemorySize, LDS_BYTES) != hipSuccess) { fprintf(stderr, "kernel_launch: hipFuncSetAttribute failed\n"); grid = -1; return; }
        if (hipOccupancyMaxActiveBlocksPerMultiprocessor(&per_cu, (const void*)hymba_fwd, NWAVES * 64, LDS_BYTES) != hipSuccess || per_cu < 1) fprintf(stderr, "kernel_launch: occupancy query says %d blocks per CU\n", per_cu);
        (void)hipGetLastError();
        grid = cus;
    }
    if (grid < 0) return;
    if (hipMemsetAsync((char*)d_ws + WS_CTL, 0, CTL_ZERO_BYTES, stream) != hipSuccess) { fprintf(stderr, "kernel_launch: memset failed\n"); return; }
    Args a{};
    for (int i = 0; i < 27; ++i) a.p.in[i] = (const float*)d_in[i];
    a.p.out = (float*)d_out; a.p.ws = (unsigned char*)d_ws; a.use_cg = 0; a.pad = 0;
#if MK_N_LAUNCHES == 1
    a.ph_lo = 0; a.ph_hi = N_PHASES;
    void* kargs[] = {&a};
    hipError_t e = hipLaunchCooperativeKernel((const void*)hymba_fwd, dim3(grid), dim3(NWAVES * 64), kargs, LDS_BYTES, stream);
    if (e != hipSuccess) fprintf(stderr, "kernel_launch: cooperative launch failed: %s (grid %d)\n", hipGetErrorString(e), grid);
#else
    for (int li = 0; li < N_PHASES; ++li) { a.ph_lo = li; a.ph_hi = li + 1;
        hipLaunchKernelGGL(hymba_fwd, dim3(grid), dim3(NWAVES * 64), LDS_BYTES, stream, a);
        const hipError_t le = hipPeekAtLastError(); if (le != hipSuccess) { fprintf(stderr, "kernel_launch: launch %d failed: %s\n", li, hipGetErrorName(le)); break; } }
#endif
}
```

```cpp
#include <hip/hip_runtime.h>
#include <cstdio>
#include <cstdint>
namespace pg8 {
#define PG8_LAS __attribute__((address_space(3)))
typedef unsigned short bf16_t;
typedef short bf16x8 __attribute__((ext_vector_type(8)));
typedef float f32x4 __attribute__((ext_vector_type(4)));
typedef unsigned u32x4 __attribute__((ext_vector_type(4)));
constexpr int BM = 256, BK = 64, HALF = 128, HTB = HALF * BK * 2  , STAGE_BYTES = 8 * HTB, NXCD = 8, WGM = 8;

__host__ __device__ __forceinline__ int lds_byte(int r, int c) { const int st = (r >> 4) * 2 + (c >> 5), rr = r & 15, cc = c & 31, ob = rr * 64 + cc * 2; return st * 1024 + (ob ^ (((ob >> 9) & 1) << 5)); }
__host__ __device__ __forceinline__ void stage_rc(int b, int& R, int& C) { const int st = b / 1024, sb = b % 1024, swz = sb ^ (((sb >> 9) & 1) << 5); R = (st >> 1) * 16 + swz / 64; C = (st & 1) * 32 + (swz % 64) / 2; }
__host__ __device__ __forceinline__ int perm32(int rho) { const int n = rho >> 4, i = rho & 15; return 8 * (i >> 2) + 4 * n + (i & 3); }

struct Unit { int pm, pn; };
struct Gemm { const bf16_t* A; const bf16_t* Bt; int M, N, K; };

struct StaticOrder {
    int nM, nN, nwg, G, c;
    __host__ __device__ void init(int M, int N, int G_, int c_) { nM = M / BM; nN = N / BM; nwg = nM * nN; G = G_; c = c_; }
    __host__ __device__ bool next(int i, Unit& u) const {
        const long L = (long)i * G + c; if (L >= nwg) return false;
        int wgid = (int)L; { const int q = nwg / NXCD, r = nwg % NXCD, xcd = wgid % NXCD, off = wgid / NXCD; wgid = (xcd < r ? xcd * (q + 1) : r * (q + 1) + (xcd - r) * q) + off; }
        const int nig = WGM * nN, gid = wgid / nig, fm = gid * WGM, gsz = (nM - fm) < WGM ? (nM - fm) : WGM;
        u.pm = fm + ((wgid % nig) % gsz); u.pn = (wgid % nig) / gsz; return true;
    }
    __device__ __forceinline__ void a_ready(const Unit&) const {}
    __device__ __forceinline__ void done(const Unit&) const {}
};

__device__ __forceinline__ unsigned cvt_pk_bf16(float lo, float hi) { unsigned r; asm volatile("v_cvt_pk_bf16_f32 %0, %1, %2" : "=v"(r) : "v"(lo), "v"(hi)); return r; }
typedef float f32x2 __attribute__((ext_vector_type(2)));
typedef unsigned u32x2 __attribute__((ext_vector_type(2)));
__device__ __forceinline__ float rstd_from16(const float* ssq, int row) {
    const f32x4* p = (const f32x4*)(ssq + (size_t)row * 16);
    const f32x4 a = p[0], b = p[1], c = p[2], d = p[3];
    const float s = ((a[0] + a[1]) + (a[2] + a[3])) + ((b[0] + b[1]) + (b[2] + b[3])) + ((c[0] + c[1]) + (c[2] + c[3])) + ((d[0] + d[1]) + (d[2] + d[3]));
    return __builtin_amdgcn_rsqf(s * (1.0f / 1024.0f) + 1e-5f);
}
__device__ __forceinline__ float silu_mul(float g, float u) { return g * __builtin_amdgcn_rcpf(1.0f + __builtin_amdgcn_exp2f(-1.4426950408889634f * g)) * u; }
struct EpiSwiglu {
    static constexpr bool PERM = true, AFTER_DRAIN = false;
    bf16_t* U; const float* ssq; int ldu;
    __device__ __forceinline__ void operator()(const f32x4 (&acc)[2][2][4][2], const Unit& u, int wr, int wc, int fr, int fq) const {
        const int row0 = u.pm * BM + wr * 64 + fr, col0 = u.pn * HALF + wc * 32 + 8 * fq;
#pragma unroll
        for (int ai = 0; ai < 2; ++ai)
#pragma unroll
            for (int m = 0; m < 4; ++m) { const int row = row0 + ai * HALF + m * 16; const float rs = rstd_from16(ssq, row);
                const f32x4 g0 = acc[ai][0][m][0] * rs, g1 = acc[ai][0][m][1] * rs, u0 = acc[ai][1][m][0] * rs, u1 = acc[ai][1][m][1] * rs;
                u32x4 w; w.x = cvt_pk_bf16(silu_mul(g0[0], u0[0]), silu_mul(g0[1], u0[1])); w.y = cvt_pk_bf16(silu_mul(g0[2], u0[2]), silu_mul(g0[3], u0[3]));
                w.z = cvt_pk_bf16(silu_mul(g1[0], u1[0]), silu_mul(g1[1], u1[1])); w.w = cvt_pk_bf16(silu_mul(g1[2], u1[2]), silu_mul(g1[3], u1[3]));
                *(u32x4*)(U + (size_t)row * ldu + col0) = w; }
    }
};
struct EpiZ {
    static constexpr bool PERM = true, AFTER_DRAIN = false;
    bf16_t* Z; const float* ssq; const float* bias; int ldz, ncols, bias_from;
    __device__ __forceinline__ void operator()(const f32x4 (&acc)[2][2][4][2], const Unit& u, int wr, int wc, int fr, int fq) const {
        const int row0 = u.pm * BM + wr * 64 + fr, col0 = u.pn * BM + wc * 32 + 8 * fq;
        f32x4 bv[2][2];
#pragma unroll
        for (int bj = 0; bj < 2; ++bj)
#pragma unroll
            for (int n = 0; n < 2; ++n) { const int c = col0 + bj * HALF + 4 * n; bv[bj][n] = (c >= bias_from && c < ncols) ? *(const f32x4*)(bias + (c - bias_from)) : (f32x4){0.f, 0.f, 0.f, 0.f}; }
#pragma unroll
        for (int ai = 0; ai < 2; ++ai)
#pragma unroll
            for (int m = 0; m < 4; ++m) { const int row = row0 + ai * HALF + m * 16; const float rs = rstd_from16(ssq, row);
#pragma unroll
                for (int bj = 0; bj < 2; ++bj) { const int c = col0 + bj * HALF; if (c < ncols) {
                    const f32x4 v0 = acc[ai][bj][m][0] * rs + bv[bj][0], v1 = acc[ai][bj][m][1] * rs + bv[bj][1];
                    u32x4 w; w.x = cvt_pk_bf16(v0[0], v0[1]); w.y = cvt_pk_bf16(v0[2], v0[3]); w.z = cvt_pk_bf16(v1[0], v1[1]); w.w = cvt_pk_bf16(v1[2], v1[3]);
                    *(u32x4*)(Z + (size_t)row * ldz + c) = w; } } }
    }
};
template <bool WB> struct EpiResid {
    static constexpr bool PERM = false, AFTER_DRAIN = false;
    const float* base; float* out; bf16_t* outb; float* ssq; float scale;
    __device__ __forceinline__ void operator()(const f32x4 (&acc)[2][2][4][2], const Unit& u, int wr, int wc, int fr, int fq) const {
        const int row0 = u.pm * BM + wr * 64 + fr, col0 = u.pn * BM + wc * 32 + 4 * fq;
#pragma unroll
        for (int ai = 0; ai < 2; ++ai)
#pragma unroll
            for (int m = 0; m < 4; ++m) { const int row = row0 + ai * HALF + m * 16; const size_t off = (size_t)row * 1024 + col0; float ss = 0.f;
#pragma unroll
                for (int bj = 0; bj < 2; ++bj)
#pragma unroll
                    for (int n = 0; n < 2; ++n) { const size_t o2 = off + bj * HALF + n * 16; const f32x4 bs = *(const f32x4*)(base + o2); const f32x4 o = bs + acc[ai][bj][m][n] * scale;
                        *(f32x4*)(out + o2) = o; ss += (o[0] * o[0] + o[1] * o[1]) + (o[2] * o[2] + o[3] * o[3]);
                        if (WB) { u32x2 w; w.x = cvt_pk_bf16(o[0], o[1]); w.y = cvt_pk_bf16(o[2], o[3]); *(u32x2*)(outb + o2) = w; } }
                ss += __shfl_xor(ss, 16); ss += __shfl_xor(ss, 32);
                if (fq == 0) ssq[(size_t)row * 16 + u.pn * 4 + wc] = ss; }
    }
};
template <class Epi, class Sched, bool ALIGN_EPI = false, bool SP2 = false>
__device__ __forceinline__ void gemm_phase(PG8_LAS unsigned char* lds, const Gemm g, const Sched& S, const Epi& E) {
    const int tid = threadIdx.x, wid = __builtin_amdgcn_readfirstlane(tid >> 6), lane = tid & 63, wr = wid >> 2, wc = wid & 3, fr = lane & 15, fq = lane >> 4;
    const int K = g.K, nt = K / BK;
    unsigned voffA[2], voffB[2];
#pragma unroll
    for (int i = 0; i < 2; ++i) { int R, C; stage_rc(tid * 16 + i * 8192, R, C); const int Rb = Epi::PERM ? ((R & ~31) + perm32(R & 31)) : R;
        voffA[i] = (unsigned)(R * K + C) * 2u; voffB[i] = (unsigned)(Rb * K + C) * 2u; }
    const size_t kstep = (size_t)(BK * 2);
    const size_t hstep = (size_t)HALF * K * 2;
    const size_t tstep = 2 * hstep;
    const unsigned ldsw = (unsigned)wid * 1024u;
    const int aoff = lds_byte(wr * 64 + fr, fq * 8), boff = lds_byte(wc * 32 + fr, fq * 8);
#define PG8_SA(b, h) (((b) * 2 + (h)) * HTB)
#define PG8_SB(b, h) ((4 + (b) * 2 + (h)) * HTB)
#define PG8_STAGE(bufoff, gbase, voff) do { _Pragma("unroll") for (int _i = 0; _i < 2; ++_i) \
        __builtin_amdgcn_global_load_lds((const unsigned*)((const char*)(gbase) + (voff)[_i]), (PG8_LAS unsigned*)(lds + (bufoff) + ldsw + _i * 8192), 16, 0, 0); } while (0)
#define PG8_LDA(dst, b, h) do { _Pragma("unroll") for (int m = 0; m < 4; ++m) _Pragma("unroll") for (int k = 0; k < 2; ++k) dst[m][k] = *(const PG8_LAS bf16x8*)(lds + PG8_SA(b, h) + aoff + m * 2048 + k * 1024); } while (0)
#define PG8_LDB(dst, b, h) do { _Pragma("unroll") for (int n = 0; n < 2; ++n) _Pragma("unroll") for (int k = 0; k < 2; ++k) dst[n][k] = *(const PG8_LAS bf16x8*)(lds + PG8_SB(b, h) + boff + n * 2048 + k * 1024); } while (0)
#define PG8_MMA(ai, bj, At, Bt) do { __builtin_amdgcn_s_setprio(1); _Pragma("unroll") for (int m = 0; m < 4; ++m) _Pragma("unroll") for (int n = 0; n < 2; ++n) _Pragma("unroll") for (int k = 0; k < 2; ++k) \
        acc[ai][bj][m][n] = __builtin_amdgcn_mfma_f32_16x16x32_bf16(Bt[n][k], At[m][k], acc[ai][bj][m][n], 0, 0, 0); __builtin_amdgcn_s_setprio(0); } while (0)
#define PG8_WAIT_V(n) asm volatile("s_waitcnt vmcnt(" #n ")" ::: "memory")
#define PG8_WAIT_L(n) asm volatile("s_waitcnt lgkmcnt(" #n ")" ::: "memory")
#define PG8_BAR __builtin_amdgcn_s_barrier()
#define PG8_SCHED __builtin_amdgcn_sched_barrier(0)
    Unit cur, nxt; int ui = 0;
    if (!S.next(0, cur)) return;
    f32x4 acc[2][2][4][2];
#pragma unroll
    for (int a = 0; a < 2; ++a)
#pragma unroll
        for (int b = 0; b < 2; ++b)
#pragma unroll
            for (int m = 0; m < 4; ++m)
#pragma unroll
                for (int n = 0; n < 2; ++n) acc[a][b][m][n] = (f32x4){0.f, 0.f, 0.f, 0.f};
    bf16x8 At[4][2], B0[2][2], B1[2][2];
    const char* cA = (const char*)g.A + (size_t)cur.pm * tstep; const char* cB = (const char*)g.Bt + (size_t)cur.pn * tstep;
    S.a_ready(cur);
    if constexpr (SP2) {
        PG8_STAGE(PG8_SB(0, 0), cB, voffB); PG8_STAGE(PG8_SB(0, 1), cB + hstep, voffB); PG8_STAGE(PG8_SA(0, 0), cA, voffA); PG8_STAGE(PG8_SA(0, 1), cA + hstep, voffA);
        if (wr == 1) PG8_BAR;
        PG8_WAIT_V(2); PG8_BAR;
        PG8_STAGE(PG8_SB(1, 0), cB + kstep, voffB); PG8_STAGE(PG8_SA(1, 0), cA + kstep, voffA); PG8_STAGE(PG8_SB(1, 1), cB + hstep + kstep, voffB);
        PG8_WAIT_V(6); PG8_BAR;
    } else {
        PG8_STAGE(PG8_SB(0, 0), cB, voffB); PG8_STAGE(PG8_SA(0, 0), cA, voffA); PG8_STAGE(PG8_SB(0, 1), cB + hstep, voffB); PG8_STAGE(PG8_SA(0, 1), cA + hstep, voffA);
        if (wr == 1) PG8_BAR;
        PG8_WAIT_V(4); PG8_BAR;
        PG8_STAGE(PG8_SB(1, 0), cB + kstep, voffB); PG8_STAGE(PG8_SA(1, 0), cA + kstep, voffA); PG8_STAGE(PG8_SB(1, 1), cB + hstep + kstep, voffB);
        PG8_WAIT_V(6); PG8_BAR;
    }
    for (;;) {
        const bool has_next = S.next(ui + 1, nxt);
        const char* nA = has_next ? (const char*)g.A + (size_t)nxt.pm * tstep : cA; const char* nB = has_next ? (const char*)g.Bt + (size_t)nxt.pn * tstep : cB;
        for (int t = 0; t < nt; t += 2) {
            const bool last = (t == nt - 2);
            const char* a1 = cA + (size_t)(t + 1) * kstep;
            const char* a2 = last ? nA : cA + (size_t)(t + 2) * kstep; const char* b2 = last ? nB : cB + (size_t)(t + 2) * kstep;
            const char* a3 = a2 + kstep; const char* b3 = b2 + kstep;
            if (last && has_next) S.a_ready(nxt);
            if constexpr (SP2) {
            PG8_LDB(B0, 0, 0); PG8_LDB(B1, 0, 1); PG8_SCHED; PG8_LDA(At, 0, 0); PG8_STAGE(PG8_SA(1, 1), a1 + hstep, voffA);
            PG8_WAIT_V(8); PG8_WAIT_L(0); PG8_BAR; PG8_MMA(0, 0, At, B0); PG8_MMA(0, 1, At, B1); PG8_BAR; PG8_SCHED;
            PG8_LDA(At, 0, 1); PG8_STAGE(PG8_SB(0, 0), b2, voffB); PG8_STAGE(PG8_SB(0, 1), b2 + hstep, voffB); PG8_STAGE(PG8_SA(0, 0), a2, voffA);
            PG8_WAIT_V(8); PG8_WAIT_L(0); PG8_BAR; PG8_MMA(1, 0, At, B0); PG8_MMA(1, 1, At, B1); PG8_BAR; PG8_SCHED;
            PG8_LDB(B0, 1, 0); PG8_LDB(B1, 1, 1); PG8_SCHED; PG8_LDA(At, 1, 0); PG8_STAGE(PG8_SA(0, 1), a2 + hstep, voffA);
            PG8_WAIT_V(8); PG8_WAIT_L(0); PG8_BAR; PG8_MMA(0, 0, At, B0); PG8_MMA(0, 1, At, B1); PG8_BAR; PG8_SCHED;
            PG8_LDA(At, 1, 1); PG8_STAGE(PG8_SB(1, 0), b3, voffB); PG8_STAGE(PG8_SB(1, 1), b3 + hstep, voffB); PG8_STAGE(PG8_SA(1, 0), a3, voffA);
            PG8_WAIT_V(8); PG8_WAIT_L(0); PG8_BAR; PG8_MMA(1, 0, At, B0); PG8_MMA(1, 1, At, B1); PG8_BAR; PG8_SCHED;
            } else {
            PG8_LDB(B0, 0, 0); PG8_SCHED; PG8_LDA(At, 0, 0); PG8_STAGE(PG8_SA(1, 1), a1 + hstep, voffA);
            PG8_WAIT_L(8); PG8_BAR; PG8_WAIT_L(0); PG8_MMA(0, 0, At, B0); PG8_BAR; PG8_SCHED;
            PG8_LDB(B1, 0, 1); PG8_STAGE(PG8_SB(0, 0), b2, voffB);
            PG8_BAR; PG8_WAIT_L(0); PG8_MMA(0, 1, At, B1); PG8_BAR;
            PG8_LDA(At, 0, 1); PG8_STAGE(PG8_SA(0, 0), a2, voffA);
            PG8_BAR; PG8_WAIT_L(0); PG8_MMA(1, 0, At, B0); PG8_BAR; PG8_SCHED;
            PG8_STAGE(PG8_SB(0, 1), b2 + hstep, voffB);
            PG8_WAIT_V(6); PG8_BAR; PG8_MMA(1, 1, At, B1); PG8_BAR;
            PG8_LDB(B0, 1, 0); PG8_SCHED; PG8_LDA(At, 1, 0); PG8_STAGE(PG8_SA(0, 1), a2 + hstep, voffA);
            PG8_WAIT_L(8); PG8_BAR; PG8_WAIT_L(0); PG8_MMA(0, 0, At, B0); PG8_BAR; PG8_SCHED;
            PG8_LDB(B1, 1, 1); PG8_STAGE(PG8_SB(1, 0), b3, voffB);
            PG8_BAR; PG8_WAIT_L(0); PG8_MMA(0, 1, At, B1); PG8_BAR;
            PG8_LDA(At, 1, 1); PG8_STAGE(PG8_SA(1, 0), a3, voffA);
            PG8_BAR; PG8_WAIT_L(0); PG8_MMA(1, 0, At, B0); PG8_BAR; PG8_SCHED;
            PG8_STAGE(PG8_SB(1, 1), b3 + hstep, voffB);
            PG8_WAIT_V(6); PG8_BAR; PG8_MMA(1, 1, At, B1); PG8_BAR;
            }
        }
        if constexpr (ALIGN_EPI) { if (wr == 0) PG8_BAR; }
        if constexpr (!Epi::AFTER_DRAIN) { E(acc, cur, wr, wc, fr, fq); S.done(cur); }
        if (!has_next) break;
#pragma unroll
        for (int a = 0; a < 2; ++a)
#pragma unroll
            for (int b = 0; b < 2; ++b)
#pragma unroll
                for (int m = 0; m < 4; ++m)
#pragma unroll
                    for (int n = 0; n < 2; ++n) acc[a][b][m][n] = (f32x4){0.f, 0.f, 0.f, 0.f};
        cur = nxt; cA = nA; cB = nB; ++ui;
        if constexpr (ALIGN_EPI) { if (wr == 1) PG8_BAR; }
    }
    PG8_WAIT_V(0);
    if constexpr (!ALIGN_EPI) { if (wr == 0) PG8_BAR; }
    PG8_BAR;
    if constexpr (Epi::AFTER_DRAIN) { E.fused(acc, cur, wr, wc, fr, fq, lds, wid, lane); S.done(cur); }
#undef PG8_SA
#undef PG8_SB
#undef PG8_STAGE
#undef PG8_LDA
#undef PG8_LDB
#undef PG8_MMA
#undef PG8_WAIT_V
#undef PG8_WAIT_L
#undef PG8_BAR
#undef PG8_SCHED
}
}
#include <hip/hip_cooperative_groups.h>
namespace cg = cooperative_groups;
constexpr int NWAVES = 8;
constexpr int MR = 32768, DM = 1024, FF = 2816, NGU = 5632, NIN = 2464, NINP = 2560, TSEQ = 4096, NBATCH = 8, NHEAD = 8, NMETA = 16;
constexpr int ZC_W = 1536, ZC_Q = 1696, ZC_K = 2208, ZC_V = 2336;
constexpr int PV = 320;
constexpr size_t MiB = 1u << 20;
constexpr size_t WS_CTL = 0, CTL_ZERO_BYTES = 1 * MiB;
constexpr size_t WS_WGU1 = 2 * MiB, WS_WD1 = 13 * MiB, WS_WIN = 19 * MiB, WS_WOUT = 24 * MiB, WS_WGU2 = 26 * MiB, WS_WD2 = 37 * MiB, WS_LT = 43 * MiB;
constexpr size_t WS_SSQ1 = 44 * MiB, WS_SSQ2 = 46 * MiB, WS_SSQ3 = 48 * MiB, WS_SSQ4 = 50 * MiB, WS_META = 52 * MiB;
constexpr size_t MO_XMB = 0, MO_UM = 64 * 1024, MO_H1MB = 256 * 1024, MO_SSQM1 = 320 * 1024, MO_SSQM2 = 324 * 1024, MO_ZM = 384 * 1024, MO_PM = 512 * 1024;
constexpr size_t WS_XB = 56 * MiB, WS_BIG = 120 * MiB, WS_P = 296 * MiB, WS_END = 456 * MiB;
constexpr int CW_BAR = 4096;
constexpr int RING_BYTES = 131072, LDSCTL_OFF = RING_BYTES, MISC_OFF = LDSCTL_OFF + 320, LDS_BYTES = 147456;

#define GAS __attribute__((address_space(1)))
#define LAS __attribute__((address_space(3)))
typedef unsigned short bf16;
typedef unsigned v4u __attribute__((ext_vector_type(4)));
typedef unsigned v2u __attribute__((ext_vector_type(2)));
typedef float f32x4 __attribute__((ext_vector_type(4)));
typedef float f32x2 __attribute__((ext_vector_type(2)));
typedef short bf16x8 __attribute__((ext_vector_type(8)));
typedef short bf16x4 __attribute__((ext_vector_type(4)));
typedef GAS unsigned gu32;
#define LDS_WAIT() asm volatile("s_waitcnt lgkmcnt(0)" ::: "memory")
__device__ __forceinline__ unsigned f2bf(float f) { unsigned u = __builtin_bit_cast(unsigned, f); return (u + 0x7fffu + ((u >> 16) & 1u)) >> 16; }
__device__ __forceinline__ unsigned pk2(float lo, float hi) { return pg8::cvt_pk_bf16(lo, hi); }
__device__ __forceinline__ float bflo(unsigned w) { return __builtin_bit_cast(float, w << 16); }
__device__ __forceinline__ float bfhi(unsigned w) { return __builtin_bit_cast(float, w & 0xffff0000u); }
__device__ __forceinline__ f32x4 unpack4(v2u w) { return (f32x4){bflo(w.x), bfhi(w.x), bflo(w.y), bfhi(w.y)}; }
__device__ __forceinline__ float sigmoidf_(float x) { return __builtin_amdgcn_rcpf(1.0f + __builtin_amdgcn_exp2f(-1.4426950408889634f * x)); }
__device__ __forceinline__ float tanhf_(float x) { return 2.0f * sigmoidf_(2.0f * x) - 1.0f; }
#define XB_TMO      128
#define XB_XCNT(j)  (256  + 64 * (j))
#define XB_XSUB(j)  (1280 + 64 * (j))
#define XB_XGEN(j)  (2304 + 64 * (j))
#define XB_TOP      3328
#define XB_TOPGEN   3392
#define XCD_BAR_WORDS 3456
#define XB_SPIN_CAP (1u << 18)

__device__ __forceinline__ unsigned xb_ld(unsigned* p)              { return __hip_atomic_load(p, __ATOMIC_RELAXED, __HIP_MEMORY_SCOPE_AGENT); }
__device__ __forceinline__ unsigned xb_add(unsigned* p, unsigned v) { return __hip_atomic_fetch_add(p, v, __ATOMIC_RELAXED, __HIP_MEMORY_SCOPE_AGENT); }
__device__ __forceinline__ unsigned xb_xcc_id() { return (unsigned)__builtin_amdgcn_s_getreg((3 << 11) | 20) & 0xFu; }
#define XB_SPIN(cond, bar) do { unsigned _sp = 0; while (cond) { __builtin_amdgcn_s_sleep(1); \
    if ((++_sp & 255u) == 0u) { if (xb_ld(&(bar)[XB_TMO])) break; if (_sp > XB_SPIN_CAP) { atomicAdd(&(bar)[XB_TMO], 1u); break; } } } } while (0)

struct XcdBarrier {
    unsigned* bar; unsigned x;
    volatile LAS unsigned* st;
};

__device__ __forceinline__ XcdBarrier xcd_barrier_post(unsigned* bar, volatile LAS unsigned* st) {
    XcdBarrier b; b.bar = bar; b.x = xb_xcc_id(); b.st = st;
    if (threadIdx.x == 0) (void)xb_add(&bar[XB_XCNT(b.x)], 1u);
    return b;
}
__device__ __forceinline__ void xcd_barrier_complete(unsigned* bar, unsigned x, unsigned& nloc, unsigned& nx) {
    const unsigned G = gridDim.x * gridDim.y * gridDim.z;
    unsigned sum, cnt, mine, sp = 0u;
    for (;;) {
        sum = 0u; cnt = 0u; mine = 0u;
#pragma unroll
        for (unsigned j = 0; j < 16; ++j) { const unsigned c = xb_ld(&bar[XB_XCNT(j)]); sum += c; cnt += (c > 0u) ? 1u : 0u; mine = (j == x) ? c : mine; }
        if (sum == G) break;
        __builtin_amdgcn_s_sleep(1);
        if ((++sp & 255u) == 0u) { if (xb_ld(&bar[XB_TMO])) break; if (sp > XB_SPIN_CAP) { atomicAdd(&bar[XB_TMO], 1u); break; } }
    }
    nloc = mine > 0u ? mine : 1u; nx = cnt > 0u ? cnt : 1u;
}

__device__ __forceinline__ void xcd_barrier(const XcdBarrier& b) {
    asm volatile("s_waitcnt vmcnt(0)" ::: "memory");
    __syncthreads();
    if (threadIdx.x == 0) {
        unsigned* bar = b.bar;
        __builtin_amdgcn_s_waitcnt(0);
        unsigned nloc = b.st[0], nx = b.st[1];
        if (nloc == 0u) { xcd_barrier_complete(bar, b.x, nloc, nx); b.st[0] = nloc; b.st[1] = nx; }
        const unsigned old = xb_add(&bar[XB_XSUB(b.x)], 1u);
        const unsigned gen = old / nloc;
        if (old + 1u == (gen + 1u) * nloc) {
            __builtin_amdgcn_fence(__ATOMIC_RELEASE, "agent");
            asm volatile("s_waitcnt vmcnt(0)" ::: "memory");
            const unsigned og = xb_add(&bar[XB_TOP], 1u);
            const unsigned tg = og / nx;
            if (og + 1u == (tg + 1u) * nx) xb_add(&bar[XB_TOPGEN], 1u);
            else XB_SPIN(xb_ld(&bar[XB_TOPGEN]) == tg, bar);
            __builtin_amdgcn_fence(__ATOMIC_ACQUIRE, "agent");
            xb_add(&bar[XB_XGEN(b.x)], 1u);
            asm volatile("s_waitcnt vmcnt(0)" ::: "memory");
        } else {
            XB_SPIN(xb_ld(&bar[XB_XGEN(b.x)]) == gen, bar);
            __builtin_amdgcn_fence(__ATOMIC_ACQUIRE, "agent");
            asm volatile("s_waitcnt vmcnt(0)" ::: "memory");
        }
    }
    __syncthreads();
}
__device__ __forceinline__ float wave_sum(float v) {
#pragma unroll
    for (int o = 1; o < 64; o <<= 1) v += __shfl_xor(v, o);
    return v;
}
__device__ __forceinline__ void p0_transpose_item(const float* W, int K, int N, bf16* WT, const float* gain, int k0, int n0, int drow0, LAS float* scr, int lane) {
#pragma unroll 8
    for (int i = 0; i < 32; ++i) { const int kk = 2 * i + (lane >> 5); float w = W[(size_t)(k0 + kk) * N + n0 + (lane & 31)]; if (gain) w *= gain[k0 + kk]; scr[kk * 33 + (lane & 31)] = w; }
    LDS_WAIT(); asm volatile("" ::: "memory");
    const int c = lane & 7;
#pragma unroll
    for (int j = 0; j < 4; ++j) { const int n = (lane >> 3) + 8 * j; const LAS float* s = scr + (8 * c) * 33 + n;
        v4u o; o.x = pk2(s[0 * 33], s[1 * 33]); o.y = pk2(s[2 * 33], s[3 * 33]); o.z = pk2(s[4 * 33], s[5 * 33]); o.w = pk2(s[6 * 33], s[7 * 33]);
        *(GAS v4u*)(WT + (size_t)(drow0 + n) * K + k0 + 8 * c) = o; }
    LDS_WAIT(); asm volatile("" ::: "memory");
}
__device__ __forceinline__ void row_to_bf16(const float* xrow, bf16* orow, float* ssq16, int lane) {
    const GAS f32x4* xr = (const GAS f32x4*)xrow + lane; f32x4 v[4]; float s = 0.f;
#pragma unroll
    for (int j = 0; j < 4; ++j) { v[j] = xr[64 * j]; s += (v[j].x * v[j].x + v[j].y * v[j].y) + (v[j].z * v[j].z + v[j].w * v[j].w); }
    s = wave_sum(s);
    GAS v2u* o8 = (GAS v2u*)orow + lane;
#pragma unroll
    for (int j = 0; j < 4; ++j) { v2u w; w.x = pk2(v[j].x, v[j].y); w.y = pk2(v[j].z, v[j].w); o8[64 * j] = w; }
    if (lane < 16) ssq16[lane] = (lane == 0) ? s : 0.f;
}
struct Ptrs {
    const float* in[27]; float* out; unsigned char* ws;
};
__device__ __forceinline__ void p0_prologue(const Ptrs& P, LAS unsigned char* lds, int vcu, int G, int wave, int lane) {
    LAS float* scr = (LAS float*)(lds + wave * 16384);
    const int gw = vcu * NWAVES + wave, NGW = G * NWAVES;
    unsigned char* ws = P.ws;
    constexpr int I_G = (DM / 64) * (FF / 32), I_D = (FF / 64) * (DM / 32), I_IN = (DM / 64) * (NIN / 32), I_O = (DM / 64) * (DM / 32);
    constexpr int NITEMS = 4 * I_G + 2 * I_D + I_IN + I_O;
    for (int it = gw; it < NITEMS; it += NGW) {
        int r = it;
        if (r < 4 * I_G) {
            const int which = r / I_G; r -= which * I_G; const int nblk = FF / 32, kb = r / nblk, nb = r % nblk, n0 = 32 * nb;
            const float* W = P.in[which == 0 ? 3 : which == 1 ? 4 : which == 2 ? 23 : 24]; const float* gain = P.in[which < 2 ? 2 : 22];
            bf16* WT = (bf16*)(ws + (which < 2 ? WS_WGU1 : WS_WGU2));
            const int drow0 = 256 * (n0 / 128) + 128 * (which & 1) + (n0 % 128);
            p0_transpose_item(W, DM, FF, WT, gain, 64 * kb, n0, drow0, scr, lane); continue; }
        r -= 4 * I_G;
        if (r < 2 * I_D) { const int which = r / I_D; r -= which * I_D; const int nblk = DM / 32, kb = r / nblk, nb = r % nblk;
            p0_transpose_item(P.in[which ? 25 : 5], FF, DM, (bf16*)(ws + (which ? WS_WD2 : WS_WD1)), nullptr, 64 * kb, 32 * nb, 32 * nb, scr, lane); continue; }
        r -= 2 * I_D;
        if (r < I_IN) { const int nblk = NIN / 32, kb = r / nblk, nb = r % nblk;
            p0_transpose_item(P.in[7], DM, NIN, (bf16*)(ws + WS_WIN), P.in[6], 64 * kb, 32 * nb, 32 * nb, scr, lane); continue; }
        r -= I_IN;
        { const int nblk = DM / 32, kb = r / nblk, nb = r % nblk;
            p0_transpose_item(P.in[21], DM, DM, (bf16*)(ws + WS_WOUT), nullptr, 64 * kb, 32 * nb, 32 * nb, scr, lane); }
    }
    { GAS v4u* z = (GAS v4u*)(ws + WS_WIN + (size_t)NIN * DM * 2); const int n16 = (NINP - NIN) * DM * 2 / 16;
      for (int i = gw * 64 + lane; i < n16; i += NGW * 64) z[i] = (v4u){0u, 0u, 0u, 0u}; }
    { bf16* LT = (bf16*)(ws + WS_LT);
      for (int i = gw * 64 + lane; i < 512 * 160; i += NGW * 64) { const int n = i / 160, j = i % 160;
          const float v = j < 32 ? P.in[11][j * 512 + n] : j < 64 ? P.in[13][(j - 32) * 512 + n] : P.in[14][(j - 64) * 512 + n];
          LT[i] = (bf16)f2bf(v); } }
    for (int m = gw; m < MR + NMETA; m += NGW) {
        if (m < MR) row_to_bf16(P.in[0] + (size_t)m * DM, (bf16*)(ws + WS_XB) + (size_t)m * DM, (float*)(ws + WS_SSQ1) + (size_t)m * 16, lane);
        else { const int i = m - MR; row_to_bf16(P.in[1] + (size_t)i * DM, (bf16*)(ws + WS_META + MO_XMB) + (size_t)i * DM, (float*)(ws + WS_META + MO_SSQM1) + i * 16, lane); }
    }
}
__device__ __forceinline__ f32x4 skinny16(const bf16* A, const bf16* Bt, int K, int n0, int lane) {
    const int fr = lane & 15, fq = lane >> 4;
    const bf16* ap = A + (size_t)fr * K + 8 * fq; const bf16* bp = Bt + (size_t)(n0 + fr) * K + 8 * fq;
    f32x4 acc = (f32x4){0.f, 0.f, 0.f, 0.f};
    for (int k = 0; k < K; k += 32) { const bf16x8 a = *(const bf16x8*)(ap + k), b = *(const bf16x8*)(bp + k); acc = __builtin_amdgcn_mfma_f32_16x16x32_bf16(a, b, acc, 0, 0, 0); }
    return acc;
}
__device__ __forceinline__ float rstd_m16(const float* ssq16) { float s = 0.f;
#pragma unroll
    for (int i = 0; i < 16; ++i) s += ssq16[i];
    return __builtin_amdgcn_rsqf(s * (1.0f / 1024.0f) + 1e-5f); }
__device__ __forceinline__ void meta_up(unsigned char* ws, int gw, int NGW, int lane) {
    const bf16* A = (const bf16*)(ws + WS_META + MO_XMB); const bf16* Bt = (const bf16*)(ws + WS_WGU1); bf16* Um = (bf16*)(ws + WS_META + MO_UM);
    const float* ssq = (const float*)(ws + WS_META + MO_SSQM1); const int fr = lane & 15, fq = lane >> 4;
    for (int t = gw; t < FF / 16; t += NGW) { const int c0 = 16 * t, nr = 256 * (c0 / 128) + (c0 % 128);
        const f32x4 g = skinny16(A, Bt, DM, nr, lane), u = skinny16(A, Bt, DM, nr + 128, lane);
#pragma unroll
        for (int r = 0; r < 4; ++r) { const int row = 4 * fq + r; const float rs = rstd_m16(ssq + row * 16); Um[(size_t)row * FF + c0 + fr] = (bf16)f2bf(pg8::silu_mul(g[r] * rs, u[r] * rs)); } }
}
__device__ __forceinline__ void meta_down(const Ptrs& P, int gw, int NGW, int lane) {
    unsigned char* ws = P.ws; const bf16* A = (const bf16*)(ws + WS_META + MO_UM); const bf16* Bt = (const bf16*)(ws + WS_WD1); bf16* H = (bf16*)(ws + WS_META + MO_H1MB);
    float* ssq = (float*)(ws + WS_META + MO_SSQM2); const int fr = lane & 15, fq = lane >> 4;
    for (int t = gw; t < DM / 16; t += NGW) { const f32x4 a = skinny16(A, Bt, FF, 16 * t, lane);
#pragma unroll
        for (int r = 0; r < 4; ++r) { const int row = 4 * fq + r; const float o = P.in[1][row * DM + 16 * t + fr] + 0.5f * a[r]; H[row * DM + 16 * t + fr] = (bf16)f2bf(o);
            float s = o * o; s += __shfl_xor(s, 1); s += __shfl_xor(s, 2); s += __shfl_xor(s, 4); s += __shfl_xor(s, 8); if (fr == 0) ssq[row * 64 + t] = s; } }
}
__device__ __forceinline__ void meta_win(const Ptrs& P, int gw, int NGW, int lane) {
    unsigned char* ws = P.ws; const bf16* A = (const bf16*)(ws + WS_META + MO_H1MB); const bf16* Bt = (const bf16*)(ws + WS_WIN); bf16* Zm = (bf16*)(ws + WS_META + MO_ZM);
    const float* ssq = (const float*)(ws + WS_META + MO_SSQM2); const int fr = lane & 15, fq = lane >> 4;
    for (int t = gw; t < NIN / 16; t += NGW) { const f32x4 a = skinny16(A, Bt, DM, 16 * t, lane); const int c = 16 * t + fr; const float bias = c >= ZC_Q ? P.in[8][c - ZC_Q] : 0.f;
#pragma unroll
        for (int r = 0; r < 4; ++r) { const int row = 4 * fq + r; float s = 0.f;
#pragma unroll 8
            for (int i = 0; i < 64; ++i) s += ssq[row * 64 + i];
            Zm[(size_t)row * NIN + c] = (bf16)f2bf(a[r] * __builtin_amdgcn_rsqf(s * (1.0f / 1024.0f) + 1e-5f) + bias); } }
}
__device__ __forceinline__ void prep_task(const Ptrs& P, int tt, int h, int lane) {
    unsigned char* ws = P.ws; const int fr = lane & 15, fq = lane >> 4;
    const bf16* Z = (const bf16*)(ws + WS_BIG); const bf16* Zm = (const bf16*)(ws + WS_META + MO_ZM); const bf16* LT = (const bf16*)(ws + WS_LT);
    const bool meta = (tt == MR / 16);
    const int m = 16 * tt + fr;
    const bf16* zc = meta ? Zm + (size_t)fr * NIN : Z + (size_t)m * NIN;
    const bool pz = meta && fr == 0;
    const bf16* zp = meta ? Zm + (size_t)(fr > 0 ? fr - 1 : 0) * NIN : ((m % TSEQ) == 0 ? Zm + (size_t)15 * NIN : Z + (size_t)(m - 1) * NIN);
    const float* mu = P.in[9];
    bf16x8 xf[5];
#pragma unroll
    for (int ks = 0; ks < 5; ++ks) { const int c0 = ZC_W + 32 * ks + 8 * fq; const v4u a = *(const v4u*)(zc + c0); v4u b = *(const v4u*)(zp + c0); if (pz) b = (v4u){0u, 0u, 0u, 0u};
        float v[8]; const f32x4 m0 = *(const f32x4*)(mu + c0), m1 = *(const f32x4*)(mu + c0 + 4);
#pragma unroll
        for (int e = 0; e < 4; ++e) { const unsigned wa = a[e], wb = b[e]; const float a0 = bflo(wa), a1 = bfhi(wa), b0 = bflo(wb), b1 = bfhi(wb);
            const float mm0 = (2 * e < 4) ? m0[2 * e] : m1[2 * e - 4], mm1 = (2 * e + 1 < 4) ? m0[2 * e + 1] : m1[2 * e + 1 - 4];
            v[2 * e] = a0 + (b0 - a0) * mm0; v[2 * e + 1] = a1 + (b1 - a1) * mm1; }
#pragma unroll
        for (int e = 0; e < 8; ++e) v[e] = (ks == 0) ? tanhf_(v[e]) : (ks == 1) ? v[e] : sigmoidf_(v[e]);
        v4u o; o.x = pk2(v[0], v[1]); o.y = pk2(v[2], v[3]); o.z = pk2(v[4], v[5]); o.w = pk2(v[6], v[7]); xf[ks] = __builtin_bit_cast(bf16x8, o); }
    f32x4 aw[4], aa[4], ag[4];
#pragma unroll
    for (int nt = 0; nt < 4; ++nt) { const bf16* lp = LT + (size_t)(h * 64 + 16 * nt + fr) * 160 + 8 * fq; const f32x4 z = (f32x4){0.f, 0.f, 0.f, 0.f};
        aw[nt] = __builtin_amdgcn_mfma_f32_16x16x32_bf16(*(const bf16x8*)(lp), xf[0], z, 0, 0, 0);
        aa[nt] = __builtin_amdgcn_mfma_f32_16x16x32_bf16(*(const bf16x8*)(lp + 32), xf[1], z, 0, 0, 0);
        ag[nt] = __builtin_amdgcn_mfma_f32_16x16x32_bf16(*(const bf16x8*)(lp + 64), xf[2], z, 0, 0, 0);
        ag[nt] = __builtin_amdgcn_mfma_f32_16x16x32_bf16(*(const bf16x8*)(lp + 96), xf[3], ag[nt], 0, 0, 0);
        ag[nt] = __builtin_amdgcn_mfma_f32_16x16x32_bf16(*(const bf16x8*)(lp + 128), xf[4], ag[nt], 0, 0, 0); }
    f32x4 kkr[4], kv[4], av[4]; float ss = 0.f;
#pragma unroll
    for (int nt = 0; nt < 4; ++nt) { const int c = h * 64 + 16 * nt + 4 * fq; const v2u a = *(const v2u*)(zc + 512 + c); v2u b = *(const v2u*)(zp + 512 + c); if (pz) b = (v2u){0u, 0u};
        const f32x4 za = unpack4(a), zb = unpack4(b), mk = *(const f32x4*)(mu + 512 + c); const f32x4 zk = za + (zb - za) * mk;
        const f32x4 a0 = *(const f32x4*)(P.in[12] + c), kkw = *(const f32x4*)(P.in[15] + c), kaw = *(const f32x4*)(P.in[16] + c);
        f32x4 a_;
#pragma unroll
        for (int r = 0; r < 4; ++r) a_[r] = sigmoidf_(a0[r] + aa[nt][r]);
        av[nt] = a_; kkr[nt] = zk * kkw; kv[nt] = zk * (1.0f + (a_ - 1.0f) * kaw);
        ss += (kkr[nt][0] * kkr[nt][0] + kkr[nt][1] * kkr[nt][1]) + (kkr[nt][2] * kkr[nt][2] + kkr[nt][3] * kkr[nt][3]); }
    ss += __shfl_xor(ss, 16); ss += __shfl_xor(ss, 32);
    const float inv = 1.0f / fmaxf(sqrtf(ss), 1e-12f);
    bf16* pr;
    if (meta) pr = (bf16*)(ws + WS_META + MO_PM) + (size_t)(h * 16 + fr) * PV;
    else { const int b = m / TSEQ, t = m % TSEQ; pr = (bf16*)(ws + WS_P) + ((size_t)(b * NHEAD + h) * TSEQ + t) * PV; }
#pragma unroll
    for (int nt = 0; nt < 4; ++nt) { const int cl = 16 * nt + 4 * fq, c = h * 64 + cl; const f32x4 w0 = *(const f32x4*)(P.in[10] + c);
        const f32x4 kk = kkr[nt] * inv, bb = kk * av[nt]; f32x4 e;
#pragma unroll
        for (int r = 0; r < 4; ++r) e[r] = 0.6065306597126334f * sigmoidf_(w0[r] + aw[nt][r]);
        v2u o;
        o.x = pk2(kk[0], kk[1]); o.y = pk2(kk[2], kk[3]); *(v2u*)(pr + cl) = o;
        o.x = pk2(e[0], e[1]); o.y = pk2(e[2], e[3]); *(v2u*)(pr + 64 + cl) = o;
        o.x = pk2(bb[0], bb[1]); o.y = pk2(bb[2], bb[3]); *(v2u*)(pr + 128 + cl) = o;
        o.x = pk2(kv[nt][0], kv[nt][1]); o.y = pk2(kv[nt][2], kv[nt][3]); *(v2u*)(pr + 192 + cl) = o;
        o.x = pk2(ag[nt][0], ag[nt][1]); o.y = pk2(ag[nt][2], ag[nt][3]); *(v2u*)(pr + 256 + cl) = o; }
}
constexpr int KS_LD = 72, VT_LD = 232, ATT_KS_BYTES = 208 * KS_LD * 2, ATT_VT_BYTES = 64 * VT_LD * 2;
__device__ __forceinline__ void attn_unit(const Ptrs& P, unsigned char* lds, int b, int g, int c, int tid, int wave, int lane) {
    unsigned char* ws = P.ws; const bf16* Z = (const bf16*)(ws + WS_BIG); const bf16* Zm = (const bf16*)(ws + WS_META + MO_ZM); bf16* Y = (bf16*)(ws + WS_XB);
    bf16* Ks = (bf16*)lds; bf16* Vt = (bf16*)(lds + ATT_KS_BYTES);
    const int fr = lane & 15, fq = lane >> 4;
    __syncthreads();
    for (int it = tid; it < 208 * 8; it += NWAVES * 64) { const int key = it >> 3, pc = it & 7; const bf16* src; bool valid = true;
        if (key < 16) src = Zm + (size_t)key * NIN; else { const int t = 64 * (c - 2) + (key - 16); valid = t >= 0; src = Z + ((size_t)b * TSEQ + (valid ? t : 0)) * NIN; }
        v4u kq = *(const v4u*)(src + ZC_K + 64 * g + 8 * pc), vq = *(const v4u*)(src + ZC_V + 64 * g + 8 * pc);
        if (!valid) { kq = (v4u){0u, 0u, 0u, 0u}; vq = kq; }
        *(v4u*)(Ks + key * KS_LD + 8 * pc) = kq;
#pragma unroll
        for (int e = 0; e < 4; ++e) { Vt[(8 * pc + 2 * e) * VT_LD + key] = (bf16)(vq[e] & 0xffffu); Vt[(8 * pc + 2 * e + 1) * VT_LD + key] = (bf16)(vq[e] >> 16); } }
    for (int it = tid; it < 64 * 16; it += NWAVES * 64) Vt[(it >> 4) * VT_LD + 208 + (it & 15)] = 0;
    __syncthreads();
    const int hq = 4 * g + (wave >> 1);
    const float slope = __builtin_amdgcn_exp2f(-(float)(hq + 1)), sink = P.in[20][hq];
#pragma unroll 1
    for (int sub = 0; sub < 2; ++sub) {
        const int i0 = 16 * (2 * (wave & 1) + sub), iq = i0 + fr;
        const size_t mrow = (size_t)b * TSEQ + 64 * c + iq;
        const bf16x8 q0 = *(const bf16x8*)(Z + mrow * NIN + ZC_Q + 64 * hq + 8 * fq), q1 = *(const bf16x8*)(Z + mrow * NIN + ZC_Q + 64 * hq + 32 + 8 * fq);
        f32x4 s[13]; float mx = sink;
#pragma unroll
        for (int kt = 0; kt < 13; ++kt) { const bf16* kp = Ks + (16 * kt + fr) * KS_LD + 8 * fq; f32x4 a = (f32x4){0.f, 0.f, 0.f, 0.f};
            a = __builtin_amdgcn_mfma_f32_16x16x32_bf16(*(const bf16x8*)(kp), q0, a, 0, 0, 0);
            a = __builtin_amdgcn_mfma_f32_16x16x32_bf16(*(const bf16x8*)(kp + 32), q1, a, 0, 0, 0);
#pragma unroll
            for (int r = 0; r < 4; ++r) { const int key = 16 * kt + 4 * fq + r; float v;
                if (kt == 0) v = a[r] * 0.125f - slope * (float)(16 + 64 * c + iq - key);
                else { const int jj = key - 16; const int d = 128 + iq - jj; v = a[r] * 0.125f - slope * (float)(d < 0 ? -d : d); if (64 * (c - 2) + jj < 0) v = -1e30f; }
                a[r] = v; mx = fmaxf(mx, v); }
            s[kt] = a; }
        mx = fmaxf(mx, __shfl_xor(mx, 16)); mx = fmaxf(mx, __shfl_xor(mx, 32));
        float sum = 0.f;
#pragma unroll
        for (int kt = 0; kt < 13; ++kt)
#pragma unroll
            for (int r = 0; r < 4; ++r) { const float p = __builtin_amdgcn_exp2f((s[kt][r] - mx) * 1.4426950408889634f); s[kt][r] = p; sum += p; }
        sum += __shfl_xor(sum, 16); sum += __shfl_xor(sum, 32);
        sum += __builtin_amdgcn_exp2f((sink - mx) * 1.4426950408889634f);
        const float rinv = 1.0f / sum;
        f32x4 o[4];
#pragma unroll
        for (int dt = 0; dt < 4; ++dt) o[dt] = (f32x4){0.f, 0.f, 0.f, 0.f};
#pragma unroll
        for (int ks = 0; ks < 7; ++ks) { const int ta = 2 * ks, tb = 2 * ks + 1; v4u pw;
            pw.x = pk2(s[ta][0], s[ta][1]); pw.y = pk2(s[ta][2], s[ta][3]);
            if (tb < 13) { pw.z = pk2(s[tb][0], s[tb][1]); pw.w = pk2(s[tb][2], s[tb][3]); } else { pw.z = 0u; pw.w = 0u; }
            const bf16x8 pf = __builtin_bit_cast(bf16x8, pw);
#pragma unroll
            for (int dt = 0; dt < 4; ++dt) { const bf16* vp = Vt + (16 * dt + fr) * VT_LD + 4 * fq; const v2u va = *(const v2u*)(vp + 16 * ta), vb = *(const v2u*)(vp + 16 * tb);
                const v4u vv = (v4u){va.x, va.y, vb.x, vb.y};
                o[dt] = __builtin_amdgcn_mfma_f32_16x16x32_bf16(__builtin_bit_cast(bf16x8, vv), pf, o[dt], 0, 0, 0); } }
#pragma unroll
        for (int dt = 0; dt < 4; ++dt) { v2u w; w.x = pk2(o[dt][0] * rinv, o[dt][1] * rinv); w.y = pk2(o[dt][2] * rinv, o[dt][3] * rinv);
            *(v2u*)(Y + mrow * DM + 512 + 64 * hq + 16 * dt + 4 * fq) = w; }
    }
}
template <int CTRL> __device__ __forceinline__ float dppf(float x) { return __builtin_bit_cast(float, __builtin_amdgcn_update_dpp(0, __builtin_bit_cast(int, x), CTRL, 0xF, 0xF, true)); }
__device__ __forceinline__ float red8(float x) { x += dppf<0xB1>(x); x += dppf<0x4E>(x); x += dppf<0x141>(x); return x; }
__device__ __forceinline__ float red16(float x) { x = red8(x); x += dppf<0x140>(x); return x; }
constexpr int NCHUNK = 257, IMG_STEP = 6 * 64, IMG_FLOATS = 16 * IMG_STEP;
struct ScanRaw { v2u pk[5]; v2u rc, rp, vc, vp; };
__device__ __forceinline__ void scan_phase(const Ptrs& P, unsigned char* lds, int sb, int tid, int wave, int lane) {
    const int b = sb >> 3, h = sb & 7;
    float* IMG = (float*)lds; float* YB = (float*)(lds + 2 * IMG_FLOATS * 4);
    if (wave < 4) {
        const int p = lane >> 3, j = lane & 7, v0 = 16 * wave + 2 * p;
        f32x2 S[8];
#pragma unroll
        for (int k = 0; k < 8; ++k) S[k] = (f32x2){0.f, 0.f};
#pragma unroll 1
        for (int n = 0; n <= NCHUNK; ++n) {
            __syncthreads();
            if (n == NCHUNK) break;
            const float* img = IMG + (n & 1) * IMG_FLOATS + 8 * j; float* yb = YB + (n & 1) * 1024 + v0;
#pragma unroll 4
            for (int s = 0; s < 16; ++s) { const float* st = img + s * IMG_STEP;
                const f32x4 kA = *(const f32x4*)(st), kB = *(const f32x4*)(st + 4), wA = *(const f32x4*)(st + 64), wB = *(const f32x4*)(st + 68), bA = *(const f32x4*)(st + 128), bB = *(const f32x4*)(st + 132);
                const f32x4 cA = *(const f32x4*)(st + 192), cB = *(const f32x4*)(st + 196), rA = *(const f32x4*)(st + 256), rB = *(const f32x4*)(st + 260);
                const f32x2 vv = *(const f32x2*)(IMG + (n & 1) * IMG_FLOATS + s * IMG_STEP + 320 + v0);
                f32x2 sa0 = S[0] * kA[0], sa1 = S[4] * kB[0];
                sa0 += S[1] * kA[1]; sa1 += S[5] * kB[1]; sa0 += S[2] * kA[2]; sa1 += S[6] * kB[2]; sa0 += S[3] * kA[3]; sa1 += S[7] * kB[3];
                f32x2 sa = sa0 + sa1; sa.x = -red8(sa.x); sa.y = -red8(sa.y);
#pragma unroll
                for (int k = 0; k < 4; ++k) { S[k] = S[k] * wA[k] + (sa * bA[k] + vv * cA[k]); S[4 + k] = S[4 + k] * wB[k] + (sa * bB[k] + vv * cB[k]); }
                f32x2 y0 = S[0] * rA[0], y1 = S[4] * rB[0];
                y0 += S[1] * rA[1]; y1 += S[5] * rB[1]; y0 += S[2] * rA[2]; y1 += S[6] * rB[2]; y0 += S[3] * rA[3]; y1 += S[7] * rB[3];
                f32x2 y = y0 + y1; y.x = red8(y.x); y.y = red8(y.y);
                if (j == 0) *(f32x2*)(yb + s * 64) = y; }
        }
    } else {
        const int ht = tid - 256, i = ht >> 4, q = ht & 15, ch = h * 64 + 4 * q;
        const bf16* Z = (const bf16*)(P.ws + WS_BIG); const bf16* Zm = (const bf16*)(P.ws + WS_META + MO_ZM);
        const bf16* Pb = (const bf16*)(P.ws + WS_P) + (size_t)(b * NHEAD + h) * TSEQ * PV; const bf16* Pm = (const bf16*)(P.ws + WS_META + MO_PM) + (size_t)h * 16 * PV;
        bf16* Y = (bf16*)(P.ws + WS_XB);
        const f32x4 mu_r = *(const f32x4*)(P.in[9] + ch), mu_v = *(const f32x4*)(P.in[9] + 1024 + ch), rk = *(const f32x4*)(P.in[17] + ch), lnw = *(const f32x4*)(P.in[18] + ch), lnb = *(const f32x4*)(P.in[19] + ch);
        ScanRaw raw;
        f32x4 sv[2], sg[2]; float sbs[2];
#pragma unroll
        for (int u = 0; u < 2; ++u) { sv[u] = (f32x4){0.f, 0.f, 0.f, 0.f}; sg[u] = sv[u]; sbs[u] = 0.f; }
#define SCAN_LOAD(n_) do { const int n__ = (n_); const bf16 *pr, *zc, *zp; \
            if (n__ == 0) { pr = Pm + (size_t)i * PV; zc = Zm + (size_t)i * NIN; zp = Zm + (size_t)(i > 0 ? i - 1 : 0) * NIN; } \
            else { const int t = 16 * (n__ - 1) + i; const size_t m = (size_t)b * TSEQ + t; pr = Pb + (size_t)t * PV; zc = Z + m * NIN; zp = (t == 0) ? Zm + (size_t)15 * NIN : Z + (m - 1) * NIN; } \
            _Pragma("unroll") for (int v_ = 0; v_ < 5; ++v_) raw.pk[v_] = *(const v2u*)(pr + 64 * v_ + 4 * q); \
            raw.rc = *(const v2u*)(zc + ch); raw.rp = *(const v2u*)(zp + ch); raw.vc = *(const v2u*)(zc + 1024 + ch); raw.vp = *(const v2u*)(zp + 1024 + ch); \
            if (n__ == 0 && i == 0) { raw.rp = (v2u){0u, 0u}; raw.vp = raw.rp; } } while (0)
#define SCAN_CONV(n_) do { float* st = IMG + ((n_) & 1) * IMG_FLOATS + i * IMG_STEP + 4 * q; \
            const f32x4 kk = unpack4(raw.pk[0]), e = unpack4(raw.pk[1]), bb = unpack4(raw.pk[2]), kx = unpack4(raw.pk[3]), g = unpack4(raw.pk[4]); \
            f32x4 w; _Pragma("unroll") for (int r_ = 0; r_ < 4; ++r_) w[r_] = __builtin_amdgcn_exp2f(-1.4426950408889634f * e[r_]); \
            const f32x4 rc = unpack4(raw.rc), rp = unpack4(raw.rp), vc = unpack4(raw.vc), vp = unpack4(raw.vp); \
            const f32x4 rr = rc + (rp - rc) * mu_r, vv = vc + (vp - vc) * mu_v; \
            *(f32x4*)(st) = kk; *(f32x4*)(st + 64) = w; *(f32x4*)(st + 128) = bb; *(f32x4*)(st + 192) = kx; *(f32x4*)(st + 256) = rr; *(f32x4*)(st + 320) = vv; \
            const f32x4 t_ = rr * kx * rk; const float bs = red16((t_[0] + t_[1]) + (t_[2] + t_[3])); \
            sv[0] = vv; sg[0] = g; sbs[0] = bs; } while (0)
        SCAN_LOAD(0); SCAN_CONV(0);
        SCAN_LOAD(1);
#pragma unroll 1
        for (int n = 0; n <= NCHUNK; ++n) {
            __syncthreads();
            if (n >= 2) { const f32x4 y = *(const f32x4*)(YB + ((n - 1) & 1) * 1024 + i * 64 + 4 * q);
                const float mean = red16((y[0] + y[1]) + (y[2] + y[3])) * (1.0f / 64.0f); const f32x4 d = y - mean;
                const float var = red16((d[0] * d[0] + d[1] * d[1]) + (d[2] * d[2] + d[3] * d[3])) * (1.0f / 64.0f);
                const float rs = __builtin_amdgcn_rsqf(var + 64e-5f);
                const f32x4 o = (d * rs * lnw + lnb + sv[1] * sbs[1]) * sg[1];
                const size_t m = (size_t)b * TSEQ + 16 * (n - 2) + i; v2u w; w.x = pk2(o[0], o[1]); w.y = pk2(o[2], o[3]);
                *(v2u*)(Y + m * DM + ch) = w; }
            sv[1] = sv[0]; sg[1] = sg[0]; sbs[1] = sbs[0];
            if (n + 1 < NCHUNK) SCAN_CONV(n + 1);
            if (n + 2 < NCHUNK) SCAN_LOAD(n + 2);
        }
#undef SCAN_LOAD
#undef SCAN_CONV
    }
}
__device__ __forceinline__ void final_norm(const Ptrs& P, int gw, int NGW, int lane) {
    const float* ssq = (const float*)(P.ws + WS_SSQ4); const GAS f32x4* g4 = (const GAS f32x4*)P.in[26] + lane;
    f32x4 g[4];
#pragma unroll
    for (int j = 0; j < 4; ++j) g[j] = g4[64 * j];
    for (int m = gw; m < MR; m += NGW) { const float rs = pg8::rstd_from16(ssq, m); GAS f32x4* o = (GAS f32x4*)(P.out + (size_t)m * DM) + lane;
#pragma unroll
        for (int j = 0; j < 4; ++j) o[64 * j] = o[64 * j] * rs * g[j]; }
}
#ifndef MK_N_LAUNCHES
#define MK_N_LAUNCHES 1
#endif
constexpr int N_PHASES = 10;
struct Args { Ptrs p; int ph_lo, ph_hi, use_cg, pad; };
__global__ void __launch_bounds__(NWAVES * 64, 2) hymba_fwd(Args args) {
    extern __shared__ __attribute__((aligned(16))) unsigned char lds[];
    LAS unsigned char* ldsl = (LAS unsigned char*)lds;
    volatile LAS unsigned* MISC = (volatile LAS unsigned*)(ldsl + MISC_OFF);
    const int tid = threadIdx.x, lane = tid & 63, wave = __builtin_amdgcn_readfirstlane(tid >> 6);
    const int G = gridDim.x, bx = blockIdx.x, vcu = (G % 8 == 0) ? (bx % 8) * (G / 8) + bx / 8 : bx;
    const Ptrs& P = args.p; unsigned char* ws = P.ws;
    if (args.use_cg) cg::this_grid().sync();
    for (int u = tid; u < (LDS_BYTES - LDSCTL_OFF) / 4; u += NWAVES * 64) ((LAS unsigned*)(ldsl + LDSCTL_OFF))[u] = 0u;
    __syncthreads();
    const int lo = args.ph_lo, hi = args.ph_hi;
    XcdBarrier bar; bar.bar = (unsigned*)(ws + WS_CTL) + CW_BAR; bar.x = 0; bar.st = nullptr;
    if (hi - lo > 1) bar = xcd_barrier_post((unsigned*)(ws + WS_CTL) + CW_BAR, MISC + 8);
#define IN(k) (lo <= (k) && (k) < hi)
#define SEAM(k) do { if (IN(k) && IN((k) + 1)) xcd_barrier(bar); } while (0)
    const int gw = vcu * NWAVES + wave, NGW = G * NWAVES;

    if (IN(0)) { p0_prologue(P, ldsl, vcu, G, wave, lane); SEAM(0); }
    if (IN(1)) {
        meta_up(ws, gw, NGW, lane);
        pg8::Gemm g{(const bf16*)(ws + WS_XB), (const bf16*)(ws + WS_WGU1), MR, NGU, DM}; pg8::StaticOrder S; S.init(MR, NGU, G, bx);
        pg8::EpiSwiglu E{(bf16*)(ws + WS_BIG), (const float*)(ws + WS_SSQ1), FF};
        pg8::gemm_phase<pg8::EpiSwiglu, pg8::StaticOrder, true, true>(ldsl, g, S, E);
        SEAM(1);
    }
    if (IN(2)) {
        meta_down(P, gw, NGW, lane);
        pg8::Gemm g{(const bf16*)(ws + WS_BIG), (const bf16*)(ws + WS_WD1), MR, DM, FF}; pg8::StaticOrder S; S.init(MR, DM, G, bx);
        pg8::EpiResid<true> E{P.in[0], P.out, (bf16*)(ws + WS_XB), (float*)(ws + WS_SSQ2), 0.5f};
        pg8::gemm_phase<pg8::EpiResid<true>, pg8::StaticOrder, true, true>(ldsl, g, S, E);
        SEAM(2);
    }
    if (IN(3)) {
        meta_win(P, gw, NGW, lane);
        pg8::Gemm g{(const bf16*)(ws + WS_XB), (const bf16*)(ws + WS_WIN), MR, NINP, DM}; pg8::StaticOrder S; S.init(MR, NINP, G, bx);
        pg8::EpiZ E{(bf16*)(ws + WS_BIG), (const float*)(ws + WS_SSQ2), P.in[8], NIN, NIN, ZC_Q};
        pg8::gemm_phase<pg8::EpiZ, pg8::StaticOrder, true, true>(ldsl, g, S, E);
        SEAM(3);
    }
    if (IN(4)) {
        constexpr int NT = (MR / 16 + 1) * NHEAD;
        for (int t = gw; t < NT; t += NGW) prep_task(P, t >> 3, t & 7, lane);
        for (int u = vcu; u < NBATCH * 2 * 64; u += G) attn_unit(P, lds, u >> 7, (u >> 6) & 1, u & 63, tid, wave, lane);
        SEAM(4);
    }
    if (IN(5)) {
        if (bx < 64) scan_phase(P, lds, bx, tid, wave, lane);
        SEAM(5);
    }
    if (IN(6)) {
        pg8::Gemm g{(const bf16*)(ws + WS_XB), (const bf16*)(ws + WS_WOUT), MR, DM, DM}; pg8::StaticOrder S; S.init(MR, DM, G, bx);
        pg8::EpiResid<true> E{P.out, P.out, (bf16*)(ws + WS_P), (float*)(ws + WS_SSQ3), 1.0f};
        pg8::gemm_phase<pg8::EpiResid<true>, pg8::StaticOrder, true, true>(ldsl, g, S, E);
        SEAM(6);
    }
    if (IN(7)) {
        pg8::Gemm g{(const bf16*)(ws + WS_P), (const bf16*)(ws + WS_WGU2), MR, NGU, DM}; pg8::StaticOrder S; S.init(MR, NGU, G, bx);
        pg8::EpiSwiglu E{(bf16*)(ws + WS_BIG), (const float*)(ws + WS_SSQ3), FF};
        pg8::gemm_phase<pg8::EpiSwiglu, pg8::StaticOrder, true, true>(ldsl, g, S, E);
        SEAM(7);
    }
    if (IN(8)) {
        pg8::Gemm g{(const bf16*)(ws + WS_BIG), (const bf16*)(ws + WS_WD2), MR, DM, FF}; pg8::StaticOrder S; S.init(MR, DM, G, bx);
        pg8::EpiResid<false> E{P.out, P.out, nullptr, (float*)(ws + WS_SSQ4), 0.5f};
        pg8::gemm_phase<pg8::EpiResid<false>, pg8::StaticOrder, true, true>(ldsl, g, S, E);
        SEAM(8);
    }
    if (IN(9)) final_norm(P, gw, NGW, lane);
#undef IN
#undef SEAM
}

extern "C" void kernel_launch(void* const* d_in, const int* in_sizes, int n_in, void* d_out, int out_size, void* d_ws, size_t ws_size, hipStream_t stream) {
    static int grid = 0;
    if (grid == 0) {
        if (n_in != 27 || in_sizes[0] != MR * DM || out_size != MR * DM || ws_size < WS_END) { fprintf(stderr, "kernel_launch: unexpected shapes (n_in %d, in0 %d, out %d, ws %zu)\n", n_in, n_in > 0 ? in_sizes[0] : -1, out_size, ws_size); grid = -1; return; }
        int dev = 0, cus = 0, per_cu = 0;
        if (hipGetDevice(&dev) != hipSuccess || hipDeviceGetAttribute(&cus, hipDeviceAttributeMultiprocessorCount, dev) != hipSuccess) { grid = -1; return; }
        if (hipFuncSetAttribute((const void*)hymba_fwd, hipFuncAttributeMaxDynamicSharedMemorySize, LDS_BYTES) != hipSuccess) { fprintf(stderr, "kernel_launch: hipFuncSetAttribute failed\n"); grid = -1; return; }
        if (hipOccupancyMaxActiveBlocksPerMultiprocessor(&per_cu, (const void*)hymba_fwd, NWAVES * 64, LDS_BYTES) != hipSuccess || per_cu < 1) fprintf(stderr, "kernel_launch: occupancy query says %d blocks per CU\n", per_cu);
        (void)hipGetLastError();
        grid = cus;
    }
    if (grid < 0) return;
    if (hipMemsetAsync((char*)d_ws + WS_CTL, 0, CTL_ZERO_BYTES, stream) != hipSuccess) { fprintf(stderr, "kernel_launch: memset failed\n"); return; }
    Args a{};
    for (int i = 0; i < 27; ++i) a.p.in[i] = (const float*)d_in[i];
    a.p.out = (float*)d_out; a.p.ws = (unsigned char*)d_ws; a.use_cg = 0; a.pad = 0;
#if MK_N_LAUNCHES == 1
    a.ph_lo = 0; a.ph_hi = N_PHASES;
    void* kargs[] = {&a};
    hipError_t e = hipLaunchCooperativeKernel((const void*)hymba_fwd, dim3(grid), dim3(NWAVES * 64), kargs, LDS_BYTES, stream);
    if (e != hipSuccess) fprintf(stderr, "kernel_launch: cooperative launch failed: %s (grid %d)\n", hipGetErrorString(e), grid);
#else
    for (int li = 0; li < N_PHASES; ++li) { a.ph_lo = li; a.ph_hi = li + 1;
        hipLaunchKernelGGL(hymba_fwd, dim3(grid), dim3(NWAVES * 64), LDS_BYTES, stream, a);
        const hipError_t le = hipPeekAtLastError(); if (le != hipSuccess) { fprintf(stderr, "kernel_launch: launch %d failed: %s\n", li, hipGetErrorName(le)); break; } }
#endif
}
```

```cpp
#include <hip/hip_runtime.h>
#include <cstdio>
#include <cstdint>
namespace pg8 {
#define PG8_LAS __attribute__((address_space(3)))
typedef unsigned short bf16_t;
typedef short bf16x8 __attribute__((ext_vector_type(8)));
typedef float f32x4 __attribute__((ext_vector_type(4)));
typedef unsigned u32x4 __attribute__((ext_vector_type(4)));
constexpr int BM = 256, BK = 64, HALF = 128, HTB = HALF * BK * 2  , STAGE_BYTES = 8 * HTB, NXCD = 8, WGM = 8;

__host__ __device__ __forceinline__ int lds_byte(int r, int c) { const int st = (r >> 4) * 2 + (c >> 5), rr = r & 15, cc = c & 31, ob = rr * 64 + cc * 2; return st * 1024 + (ob ^ (((ob >> 9) & 1) << 5)); }
__host__ __device__ __forceinline__ void stage_rc(int b, int& R, int& C) { const int st = b / 1024, sb = b % 1024, swz = sb ^ (((sb >> 9) & 1) << 5); R = (st >> 1) * 16 + swz / 64; C = (st & 1) * 32 + (swz % 64) / 2; }
__host__ __device__ __forceinline__ int perm32(int rho) { const int n = rho >> 4, i = rho & 15; return 8 * (i >> 2) + 4 * n + (i & 3); }

struct Unit { int pm, pn; };
struct Gemm { const bf16_t* A; const bf16_t* Bt; int M, N, K; };

struct StaticOrder {
    int nM, nN, nwg, G, c;
    __host__ __device__ void init(int M, int N, int G_, int c_) { nM = M / BM; nN = N / BM; nwg = nM * nN; G = G_; c = c_; }
    __host__ __device__ bool next(int i, Unit& u) const {
        const long L = (long)i * G + c; if (L >= nwg) return false;
        int wgid = (int)L; { const int q = nwg / NXCD, r = nwg % NXCD, xcd = wgid % NXCD, off = wgid / NXCD; wgid = (xcd < r ? xcd * (q + 1) : r * (q + 1) + (xcd - r) * q) + off; }
        const int nig = WGM * nN, gid = wgid / nig, fm = gid * WGM, gsz = (nM - fm) < WGM ? (nM - fm) : WGM;
        u.pm = fm + ((wgid % nig) % gsz); u.pn = (wgid % nig) / gsz; return true;
    }
    __device__ __forceinline__ void a_ready(const Unit&) const {}
    __device__ __forceinline__ void done(const Unit&) const {}
};

__device__ __forceinline__ unsigned cvt_pk_bf16(float lo, float hi) { unsigned r; asm volatile("v_cvt_pk_bf16_f32 %0, %1, %2" : "=v"(r) : "v"(lo), "v"(hi)); return r; }
typedef float f32x2 __attribute__((ext_vector_type(2)));
typedef unsigned u32x2 __attribute__((ext_vector_type(2)));
__device__ __forceinline__ float rstd_from16(const float* ssq, int row) {
    const f32x4* p = (const f32x4*)(ssq + (size_t)row * 16);
    const f32x4 a = p[0], b = p[1], c = p[2], d = p[3];
    const float s = ((a[0] + a[1]) + (a[2] + a[3])) + ((b[0] + b[1]) + (b[2] + b[3])) + ((c[0] + c[1]) + (c[2] + c[3])) + ((d[0] + d[1]) + (d[2] + d[3]));
    return __builtin_amdgcn_rsqf(s * (1.0f / 1024.0f) + 1e-5f);
}
__device__ __forceinline__ float silu_mul(float g, float u) { return g * __builtin_amdgcn_rcpf(1.0f + __builtin_amdgcn_exp2f(-1.4426950408889634f * g)) * u; }
struct EpiSwiglu {
    static constexpr bool PERM = true, AFTER_DRAIN = false;
    bf16_t* U; const float* ssq; int ldu;
    __device__ __forceinline__ void operator()(const f32x4 (&acc)[2][2][4][2], const Unit& u, int wr, int wc, int fr, int fq) const {
        const int row0 = u.pm * BM + wr * 64 + fr, col0 = u.pn * HALF + wc * 32 + 8 * fq;
#pragma unroll
        for (int ai = 0; ai < 2; ++ai)
#pragma unroll
            for (int m = 0; m < 4; ++m) { const int row = row0 + ai * HALF + m * 16; const float rs = rstd_from16(ssq, row);
                const f32x4 g0 = acc[ai][0][m][0] * rs, g1 = acc[ai][0][m][1] * rs, u0 = acc[ai][1][m][0] * rs, u1 = acc[ai][1][m][1] * rs;
                u32x4 w; w.x = cvt_pk_bf16(silu_mul(g0[0], u0[0]), silu_mul(g0[1], u0[1])); w.y = cvt_pk_bf16(silu_mul(g0[2], u0[2]), silu_mul(g0[3], u0[3]));
                w.z = cvt_pk_bf16(silu_mul(g1[0], u1[0]), silu_mul(g1[1], u1[1])); w.w = cvt_pk_bf16(silu_mul(g1[2], u1[2]), silu_mul(g1[3], u1[3]));
                *(u32x4*)(U + (size_t)row * ldu + col0) = w; }
    }
};
struct EpiZ {
    static constexpr bool PERM = true, AFTER_DRAIN = false;
    bf16_t* Z; const float* ssq; const float* bias; int ldz, ncols, bias_from;
    __device__ __forceinline__ void operator()(const f32x4 (&acc)[2][2][4][2], const Unit& u, int wr, int wc, int fr, int fq) const {
        const int row0 = u.pm * BM + wr * 64 + fr, col0 = u.pn * BM + wc * 32 + 8 * fq;
        f32x4 bv[2][2];
#pragma unroll
        for (int bj = 0; bj < 2; ++bj)
#pragma unroll
            for (int n = 0; n < 2; ++n) { const int c = col0 + bj * HALF + 4 * n; bv[bj][n] = (c >= bias_from && c < ncols) ? *(const f32x4*)(bias + (c - bias_from)) : (f32x4){0.f, 0.f, 0.f, 0.f}; }
#pragma unroll
        for (int ai = 0; ai < 2; ++ai)
#pragma unroll
            for (int m = 0; m < 4; ++m) { const int row = row0 + ai * HALF + m * 16; const float rs = rstd_from16(ssq, row);
#pragma unroll
                for (int bj = 0; bj < 2; ++bj) { const int c = col0 + bj * HALF; if (c < ncols) {
                    const f32x4 v0 = acc[ai][bj][m][0] * rs + bv[bj][0], v1 = acc[ai][bj][m][1] * rs + bv[bj][1];
                    u32x4 w; w.x = cvt_pk_bf16(v0[0], v0[1]); w.y = cvt_pk_bf16(v0[2], v0[3]); w.z = cvt_pk_bf16(v1[0], v1[1]); w.w = cvt_pk_bf16(v1[2], v1[3]);
                    *(u32x4*)(Z + (size_t)row * ldz + c) = w; } } }
    }
};
template <bool WB> struct EpiResid {
    static constexpr bool PERM = false, AFTER_DRAIN = false;
    const float* base; float* out; bf16_t* outb; float* ssq; float scale;
    __device__ __forceinline__ void operator()(const f32x4 (&acc)[2][2][4][2], const Unit& u, int wr, int wc, int fr, int fq) const {
        const int row0 = u.pm * BM + wr * 64 + fr, col0 = u.pn * BM + wc * 32 + 4 * fq;
#pragma unroll
        for (int ai = 0; ai < 2; ++ai)
#pragma unroll
            for (int m = 0; m < 4; ++m) { const int row = row0 + ai * HALF + m * 16; const size_t off = (size_t)row * 1024 + col0; float ss = 0.f;
#pragma unroll
                for (int bj = 0; bj < 2; ++bj)
#pragma unroll
                    for (int n = 0; n < 2; ++n) { const size_t o2 = off + bj * HALF + n * 16; const f32x4 bs = *(const f32x4*)(base + o2); const f32x4 o = bs + acc[ai][bj][m][n] * scale;
                        *(f32x4*)(out + o2) = o; ss += (o[0] * o[0] + o[1] * o[1]) + (o[2] * o[2] + o[3] * o[3]);
                        if (WB) { u32x2 w; w.x = cvt_pk_bf16(o[0], o[1]); w.y = cvt_pk_bf16(o[2], o[3]); *(u32x2*)(outb + o2) = w; } }
                ss += __shfl_xor(ss, 16); ss += __shfl_xor(ss, 32);
                if (fq == 0) ssq[(size_t)row * 16 + u.pn * 4 + wc] = ss; }
    }
};
template <class Epi, class Sched, bool ALIGN_EPI = false, bool SP2 = false>
__device__ __forceinline__ void gemm_phase(PG8_LAS unsigned char* lds, const Gemm g, const Sched& S, const Epi& E) {
    const int tid = threadIdx.x, wid = __builtin_amdgcn_readfirstlane(tid >> 6), lane = tid & 63, wr = wid >> 2, wc = wid & 3, fr = lane & 15, fq = lane >> 4;
    const int K = g.K, nt = K / BK;
    unsigned voffA[2], voffB[2];
#pragma unroll
    for (int i = 0; i < 2; ++i) { int R, C; stage_rc(tid * 16 + i * 8192, R, C); const int Rb = Epi::PERM ? ((R & ~31) + perm32(R & 31)) : R;
        voffA[i] = (unsigned)(R * K + C) * 2u; voffB[i] = (unsigned)(Rb * K + C) * 2u; }
    const size_t kstep = (size_t)(BK * 2);
    const size_t hstep = (size_t)HALF * K * 2;
    const size_t tstep = 2 * hstep;
    const unsigned ldsw = (unsigned)wid * 1024u;
    const int aoff = lds_byte(wr * 64 + fr, fq * 8), boff = lds_byte(wc * 32 + fr, fq * 8);
#define PG8_SA(b, h) (((b) * 2 + (h)) * HTB)
#define PG8_SB(b, h) ((4 + (b) * 2 + (h)) * HTB)
#define PG8_STAGE(bufoff, gbase, voff) do { _Pragma("unroll") for (int _i = 0; _i < 2; ++_i) \
        __builtin_amdgcn_global_load_lds((const unsigned*)((const char*)(gbase) + (voff)[_i]), (PG8_LAS unsigned*)(lds + (bufoff) + ldsw + _i * 8192), 16, 0, 0); } while (0)
#define PG8_LDA(dst, b, h) do { _Pragma("unroll") for (int m = 0; m < 4; ++m) _Pragma("unroll") for (int k = 0; k < 2; ++k) dst[m][k] = *(const PG8_LAS bf16x8*)(lds + PG8_SA(b, h) + aoff + m * 2048 + k * 1024); } while (0)
#define PG8_LDB(dst, b, h) do { _Pragma("unroll") for (int n = 0; n < 2; ++n) _Pragma("unroll") for (int k = 0; k < 2; ++k) dst[n][k] = *(const PG8_LAS bf16x8*)(lds + PG8_SB(b, h) + boff + n * 2048 + k * 1024); } while (0)
#define PG8_MMA(ai, bj, At, Bt) do { __builtin_amdgcn_s_setprio(1); _Pragma("unroll") for (int m = 0; m < 4; ++m) _Pragma("unroll") for (int n = 0; n < 2; ++n) _Pragma("unroll") for (int k = 0; k < 2; ++k) \
        acc[ai][bj][m][n] = __builtin_amdgcn_mfma_f32_16x16x32_bf16(Bt[n][k], At[m][k], acc[ai][bj][m][n], 0, 0, 0); __builtin_amdgcn_s_setprio(0); } while (0)
#define PG8_WAIT_V(n) asm volatile("s_waitcnt vmcnt(" #n ")" ::: "memory")
#define PG8_WAIT_L(n) asm volatile("s_waitcnt lgkmcnt(" #n ")" ::: "memory")
#define PG8_BAR __builtin_amdgcn_s_barrier()
#define PG8_SCHED __builtin_amdgcn_sched_barrier(0)
    Unit cur, nxt; int ui = 0;
    if (!S.next(0, cur)) return;
    f32x4 acc[2][2][4][2];
#pragma unroll
    for (int a = 0; a < 2; ++a)
#pragma unroll
        for (int b = 0; b < 2; ++b)
#pragma unroll
            for (int m = 0; m < 4; ++m)
#pragma unroll
                for (int n = 0; n < 2; ++n) acc[a][b][m][n] = (f32x4){0.f, 0.f, 0.f, 0.f};
    bf16x8 At[4][2], B0[2][2], B1[2][2];
    const char* cA = (const char*)g.A + (size_t)cur.pm * tstep; const char* cB = (const char*)g.Bt + (size_t)cur.pn * tstep;
    S.a_ready(cur);
    if constexpr (SP2) {
        PG8_STAGE(PG8_SB(0, 0), cB, voffB); PG8_STAGE(PG8_SB(0, 1), cB + hstep, voffB); PG8_STAGE(PG8_SA(0, 0), cA, voffA); PG8_STAGE(PG8_SA(0, 1), cA + hstep, voffA);
        if (wr == 1) PG8_BAR;
        PG8_WAIT_V(2); PG8_BAR;
        PG8_STAGE(PG8_SB(1, 0), cB + kstep, voffB); PG8_STAGE(PG8_SA(1, 0), cA + kstep, voffA); PG8_STAGE(PG8_SB(1, 1), cB + hstep + kstep, voffB);
        PG8_WAIT_V(6); PG8_BAR;
    } else {
        PG8_STAGE(PG8_SB(0, 0), cB, voffB); PG8_STAGE(PG8_SA(0, 0), cA, voffA); PG8_STAGE(PG8_SB(0, 1), cB + hstep, voffB); PG8_STAGE(PG8_SA(0, 1), cA + hstep, voffA);
        if (wr == 1) PG8_BAR;
        PG8_WAIT_V(4); PG8_BAR;
        PG8_STAGE(PG8_SB(1, 0), cB + kstep, voffB); PG8_STAGE(PG8_SA(1, 0), cA + kstep, voffA); PG8_STAGE(PG8_SB(1, 1), cB + hstep + kstep, voffB);
        PG8_WAIT_V(6); PG8_BAR;
    }
    for (;;) {
        const bool has_next = S.next(ui + 1, nxt);
        const char* nA = has_next ? (const char*)g.A + (size_t)nxt.pm * tstep : cA; const char* nB = has_next ? (const char*)g.Bt + (size_t)nxt.pn * tstep : cB;
        for (int t = 0; t < nt; t += 2) {
            const bool last = (t == nt - 2);
            const char* a1 = cA + (size_t)(t + 1) * kstep;
            const char* a2 = last ? nA : cA + (size_t)(t + 2) * kstep; const char* b2 = last ? nB : cB + (size_t)(t + 2) * kstep;
            const char* a3 = a2 + kstep; const char* b3 = b2 + kstep;
            if (last && has_next) S.a_ready(nxt);
            if constexpr (SP2) {
            PG8_LDB(B0, 0, 0); PG8_LDB(B1, 0, 1); PG8_SCHED; PG8_LDA(At, 0, 0); PG8_STAGE(PG8_SA(1, 1), a1 + hstep, voffA);
            PG8_WAIT_V(8); PG8_WAIT_L(0); PG8_BAR; PG8_MMA(0, 0, At, B0); PG8_MMA(0, 1, At, B1); PG8_BAR; PG8_SCHED;
            PG8_LDA(At, 0, 1); PG8_STAGE(PG8_SB(0, 0), b2, voffB); PG8_STAGE(PG8_SB(0, 1), b2 + hstep, voffB); PG8_STAGE(PG8_SA(0, 0), a2, voffA);
            PG8_WAIT_V(8); PG8_WAIT_L(0); PG8_BAR; PG8_MMA(1, 0, At, B0); PG8_MMA(1, 1, At, B1); PG8_BAR; PG8_SCHED;
            PG8_LDB(B0, 1, 0); PG8_LDB(B1, 1, 1); PG8_SCHED; PG8_LDA(At, 1, 0); PG8_STAGE(PG8_SA(0, 1), a2 + hstep, voffA);
            PG8_WAIT_V(8); PG8_WAIT_L(0); PG8_BAR; PG8_MMA(0, 0, At, B0); PG8_MMA(0, 1, At, B1); PG8_BAR; PG8_SCHED;
            PG8_LDA(At, 1, 1); PG8_STAGE(PG8_SB(1, 0), b3, voffB); PG8_STAGE(PG8_SB(1, 1), b3 + hstep, voffB); PG8_STAGE(PG8_SA(1, 0), a3, voffA);
            PG8_WAIT_V(8); PG8_WAIT_L(0); PG8_BAR; PG8_MMA(1, 0, At, B0); PG8_MMA(1, 1, At, B1); PG8_BAR; PG8_SCHED;
            } else {
            PG8_LDB(B0, 0, 0); PG8_SCHED; PG8_LDA(At, 0, 0); PG8_STAGE(PG8_SA(1, 1), a1 + hstep, voffA);
            PG8_WAIT_L(8); PG8_BAR; PG8_WAIT_L(0); PG8_MMA(0, 0, At, B0); PG8_BAR; PG8_SCHED;
            PG8_LDB(B1, 0, 1); PG8_STAGE(PG8_SB(0, 0), b2, voffB);
            PG8_BAR; PG8_WAIT_L(0); PG8_MMA(0, 1, At, B1); PG8_BAR;
            PG8_LDA(At, 0, 1); PG8_STAGE(PG8_SA(0, 0), a2, voffA);
            PG8_BAR; PG8_WAIT_L(0); PG8_MMA(1, 0, At, B0); PG8_BAR; PG8_SCHED;
            PG8_STAGE(PG8_SB(0, 1), b2 + hstep, voffB);
            PG8_WAIT_V(6); PG8_BAR; PG8_MMA(1, 1, At, B1); PG8_BAR;
            PG8_LDB(B0, 1, 0); PG8_SCHED; PG8_LDA(At, 1, 0); PG8_STAGE(PG8_SA(0, 1), a2 + hstep, voffA);
            PG8_WAIT_L(8); PG8_BAR; PG8_WAIT_L(0); PG8_MMA(0, 0, At, B0); PG8_BAR; PG8_SCHED;
            PG8_LDB(B1, 1, 1); PG8_STAGE(PG8_SB(1, 0), b3, voffB);
            PG8_BAR; PG8_WAIT_L(0); PG8_MMA(0, 1, At, B1); PG8_BAR;
            PG8_LDA(At, 1, 1); PG8_STAGE(PG8_SA(1, 0), a3, voffA);
            PG8_BAR; PG8_WAIT_L(0); PG8_MMA(1, 0, At, B0); PG8_BAR; PG8_SCHED;
            PG8_STAGE(PG8_SB(1, 1), b3 + hstep, voffB);
            PG8_WAIT_V(6); PG8_BAR; PG8_MMA(1, 1, At, B1); PG8_BAR;
            }
        }
        if constexpr (ALIGN_EPI) { if (wr == 0) PG8_BAR; }
        if constexpr (!Epi::AFTER_DRAIN) { E(acc, cur, wr, wc, fr, fq); S.done(cur); }
        if (!has_next) break;
#pragma unroll
        for (int a = 0; a < 2; ++a)
#pragma unroll
            for (int b = 0; b < 2; ++b)
#pragma unroll
                for (int m = 0; m < 4; ++m)
#pragma unroll
                    for (int n = 0; n < 2; ++n) acc[a][b][m][n] = (f32x4){0.f, 0.f, 0.f, 0.f};
        cur = nxt; cA = nA; cB = nB; ++ui;
        if constexpr (ALIGN_EPI) { if (wr == 1) PG8_BAR; }
    }
    PG8_WAIT_V(0);
    if constexpr (!ALIGN_EPI) { if (wr == 0) PG8_BAR; }
    PG8_BAR;
    if constexpr (Epi::AFTER_DRAIN) { E.fused(acc, cur, wr, wc, fr, fq, lds, wid, lane); S.done(cur); }
#undef PG8_SA
#undef PG8_SB
#undef PG8_STAGE
#undef PG8_LDA
#undef PG8_LDB
#undef PG8_MMA
#undef PG8_WAIT_V
#undef PG8_WAIT_L
#undef PG8_BAR
#undef PG8_SCHED
}
}
#include <hip/hip_cooperative_groups.h>
namespace cg = cooperative_groups;
constexpr int NWAVES = 8;
constexpr int MR = 32768, DM = 1024, FF = 2816, NGU = 5632, NIN = 2464, NINP = 2560, TSEQ = 4096, NBATCH = 8, NHEAD = 8, NMETA = 16;
constexpr int ZC_W = 1536, ZC_Q = 1696, ZC_K = 2208, ZC_V = 2336;
constexpr int PV = 320;
constexpr size_t MiB = 1u << 20;
constexpr size_t WS_CTL = 0, CTL_ZERO_BYTES = 1 * MiB;
constexpr size_t WS_WGU1 = 2 * MiB, WS_WD1 = 13 * MiB, WS_WIN = 19 * MiB, WS_WOUT = 24 * MiB, WS_WGU2 = 26 * MiB, WS_WD2 = 37 * MiB, WS_LT = 43 * MiB;
constexpr size_t WS_SSQ1 = 44 * MiB, WS_SSQ2 = 46 * MiB, WS_SSQ3 = 48 * MiB, WS_SSQ4 = 50 * MiB, WS_META = 52 * MiB;
constexpr size_t MO_XMB = 0, MO_UM = 64 * 1024, MO_H1MB = 256 * 1024, MO_SSQM1 = 320 * 1024, MO_SSQM2 = 324 * 1024, MO_ZM = 384 * 1024, MO_PM = 512 * 1024;
constexpr size_t WS_XB = 56 * MiB, WS_BIG = 120 * MiB, WS_P = 296 * MiB, WS_END = 456 * MiB;
constexpr int CW_BAR = 4096;
constexpr int RING_BYTES = 131072, LDSCTL_OFF = 143360, MISC_OFF = LDSCTL_OFF + 320, LDS_BYTES = 147456;

#define GAS __attribute__((address_space(1)))
#define LAS __attribute__((address_space(3)))
typedef unsigned short bf16;
typedef unsigned v4u __attribute__((ext_vector_type(4)));
typedef unsigned v2u __attribute__((ext_vector_type(2)));
typedef float f32x4 __attribute__((ext_vector_type(4)));
typedef float f32x2 __attribute__((ext_vector_type(2)));
typedef short bf16x8 __attribute__((ext_vector_type(8)));
typedef short bf16x4 __attribute__((ext_vector_type(4)));
typedef GAS unsigned gu32;
#define LDS_WAIT() asm volatile("s_waitcnt lgkmcnt(0)" ::: "memory")
__device__ __forceinline__ unsigned f2bf(float f) { unsigned u = __builtin_bit_cast(unsigned, f); return (u + 0x7fffu + ((u >> 16) & 1u)) >> 16; }
typedef __bf16 bf16x2_t __attribute__((ext_vector_type(2)));
__device__ __forceinline__ unsigned pk2m(float lo, float hi) { f32x2 v = {lo, hi}; bf16x2_t b = __builtin_convertvector(v, bf16x2_t); return __builtin_bit_cast(unsigned, b); }
__device__ __forceinline__ unsigned pk2(float lo, float hi) { return pg8::cvt_pk_bf16(lo, hi); }
__device__ __forceinline__ float bflo(unsigned w) { return __builtin_bit_cast(float, w << 16); }
__device__ __forceinline__ float bfhi(unsigned w) { return __builtin_bit_cast(float, w & 0xffff0000u); }
__device__ __forceinline__ f32x4 unpack4(v2u w) { return (f32x4){bflo(w.x), bfhi(w.x), bflo(w.y), bfhi(w.y)}; }
__device__ __forceinline__ float sigmoidf_(float x) { return __builtin_amdgcn_rcpf(1.0f + __builtin_amdgcn_exp2f(-1.4426950408889634f * x)); }
__device__ __forceinline__ float tanhf_(float x) { return 2.0f * sigmoidf_(2.0f * x) - 1.0f; }
#define XB_TMO      128
#define XB_XCNT(j)  (256  + 64 * (j))
#define XB_XSUB(j)  (1280 + 64 * (j))
#define XB_XGEN(j)  (2304 + 64 * (j))
#define XB_TOP      3328
#define XB_TOPGEN   3392
#define XCD_BAR_WORDS 3456
#define XB_SPIN_CAP (1u << 18)

__device__ __forceinline__ unsigned xb_ld(unsigned* p)              { return __hip_atomic_load(p, __ATOMIC_RELAXED, __HIP_MEMORY_SCOPE_AGENT); }
__device__ __forceinline__ unsigned xb_add(unsigned* p, unsigned v) { return __hip_atomic_fetch_add(p, v, __ATOMIC_RELAXED, __HIP_MEMORY_SCOPE_AGENT); }
__device__ __forceinline__ unsigned xb_xcc_id() { return (unsigned)__builtin_amdgcn_s_getreg((3 << 11) | 20) & 0xFu; }
#define XB_SPIN(cond, bar) do { unsigned _sp = 0; while (cond) { __builtin_amdgcn_s_sleep(1); \
    if ((++_sp & 255u) == 0u) { if (xb_ld(&(bar)[XB_TMO])) break; if (_sp > XB_SPIN_CAP) { atomicAdd(&(bar)[XB_TMO], 1u); break; } } } } while (0)

struct XcdBarrier {
    unsigned* bar; unsigned x;
    volatile LAS unsigned* st;
};

__device__ __forceinline__ XcdBarrier xcd_barrier_post(unsigned* bar, volatile LAS unsigned* st) {
    XcdBarrier b; b.bar = bar; b.x = xb_xcc_id(); b.st = st;
    if (threadIdx.x == 0) (void)xb_add(&bar[XB_XCNT(b.x)], 1u);
    return b;
}
__device__ __forceinline__ void xcd_barrier_complete(unsigned* bar, unsigned x, unsigned& nloc, unsigned& nx) {
    const unsigned G = gridDim.x * gridDim.y * gridDim.z;
    unsigned sum, cnt, mine, sp = 0u;
    for (;;) {
        sum = 0u; cnt = 0u; mine = 0u;
#pragma unroll
        for (unsigned j = 0; j < 16; ++j) { const unsigned c = xb_ld(&bar[XB_XCNT(j)]); sum += c; cnt += (c > 0u) ? 1u : 0u; mine = (j == x) ? c : mine; }
        if (sum == G) break;
        __builtin_amdgcn_s_sleep(1);
        if ((++sp & 255u) == 0u) { if (xb_ld(&bar[XB_TMO])) break; if (sp > XB_SPIN_CAP) { atomicAdd(&bar[XB_TMO], 1u); break; } }
    }
    nloc = mine > 0u ? mine : 1u; nx = cnt > 0u ? cnt : 1u;
}

__device__ __forceinline__ void xcd_barrier(const XcdBarrier& b) {
    asm volatile("s_waitcnt vmcnt(0)" ::: "memory");
    __syncthreads();
    if (threadIdx.x == 0) {
        unsigned* bar = b.bar;
        __builtin_amdgcn_s_waitcnt(0);
        unsigned nloc = b.st[0], nx = b.st[1];
        if (nloc == 0u) { xcd_barrier_complete(bar, b.x, nloc, nx); b.st[0] = nloc; b.st[1] = nx; }
        const unsigned old = xb_add(&bar[XB_XSUB(b.x)], 1u);
        const unsigned gen = old / nloc;
        if (old + 1u == (gen + 1u) * nloc) {
            __builtin_amdgcn_fence(__ATOMIC_RELEASE, "agent");
            asm volatile("s_waitcnt vmcnt(0)" ::: "memory");
            const unsigned og = xb_add(&bar[XB_TOP], 1u);
            const unsigned tg = og / nx;
            if (og + 1u == (tg + 1u) * nx) xb_add(&bar[XB_TOPGEN], 1u);
            else XB_SPIN(xb_ld(&bar[XB_TOPGEN]) == tg, bar);
            __builtin_amdgcn_fence(__ATOMIC_ACQUIRE, "agent");
            xb_add(&bar[XB_XGEN(b.x)], 1u);
            asm volatile("s_waitcnt vmcnt(0)" ::: "memory");
        } else {
            XB_SPIN(xb_ld(&bar[XB_XGEN(b.x)]) == gen, bar);
            __builtin_amdgcn_fence(__ATOMIC_ACQUIRE, "agent");
            asm volatile("s_waitcnt vmcnt(0)" ::: "memory");
        }
    }
    __syncthreads();
}
__device__ __forceinline__ float wave_sum(float v) {
#pragma unroll
    for (int o = 1; o < 64; o <<= 1) v += __shfl_xor(v, o);
    return v;
}
__device__ __forceinline__ void p0_transpose_item(const float* W, int K, int N, bf16* WT, const float* gain, int k0, int n0, int drow0, LAS float* scr, int lane) {
#pragma unroll 8
    for (int i = 0; i < 32; ++i) { const int kk = 2 * i + (lane >> 5); float w = W[(size_t)(k0 + kk) * N + n0 + (lane & 31)]; if (gain) w *= gain[k0 + kk]; scr[kk * 33 + (lane & 31)] = w; }
    LDS_WAIT(); asm volatile("" ::: "memory");
    const int c = lane & 7;
#pragma unroll
    for (int j = 0; j < 4; ++j) { const int n = (lane >> 3) + 8 * j; const LAS float* s = scr + (8 * c) * 33 + n;
        v4u o; o.x = pk2(s[0 * 33], s[1 * 33]); o.y = pk2(s[2 * 33], s[3 * 33]); o.z = pk2(s[4 * 33], s[5 * 33]); o.w = pk2(s[6 * 33], s[7 * 33]);
        *(GAS v4u*)(WT + (size_t)(drow0 + n) * K + k0 + 8 * c) = o; }
    LDS_WAIT(); asm volatile("" ::: "memory");
}
__device__ __forceinline__ void row_to_bf16(const float* xrow, bf16* orow, float* ssq16, int lane) {
    const GAS f32x4* xr = (const GAS f32x4*)xrow + lane; f32x4 v[4]; float s = 0.f;
#pragma unroll
    for (int j = 0; j < 4; ++j) { v[j] = xr[64 * j]; s += (v[j].x * v[j].x + v[j].y * v[j].y) + (v[j].z * v[j].z + v[j].w * v[j].w); }
    s = wave_sum(s);
    GAS v2u* o8 = (GAS v2u*)orow + lane;
#pragma unroll
    for (int j = 0; j < 4; ++j) { v2u w; w.x = pk2(v[j].x, v[j].y); w.y = pk2(v[j].z, v[j].w); o8[64 * j] = w; }
    if (lane < 16) ssq16[lane] = (lane == 0) ? s : 0.f;
}
struct Ptrs {
    const float* in[27]; float* out; unsigned char* ws;
};
__device__ __forceinline__ void p0_prologue(const Ptrs& P, LAS unsigned char* lds, int vcu, int G, int wave, int lane) {
    LAS float* scr = (LAS float*)(lds + wave * 16384);
    const int gw = vcu * NWAVES + wave, NGW = G * NWAVES;
    unsigned char* ws = P.ws;
    constexpr int I_G = (DM / 64) * (FF / 32), I_D = (FF / 64) * (DM / 32), I_IN = (DM / 64) * (NIN / 32), I_O = (DM / 64) * (DM / 32);
    constexpr int NITEMS = 4 * I_G + 2 * I_D + I_IN + I_O;
    for (int it = gw; it < NITEMS; it += NGW) {
        int r = it;
        if (r < 4 * I_G) {
            const int which = r / I_G; r -= which * I_G; const int nblk = FF / 32, kb = r / nblk, nb = r % nblk, n0 = 32 * nb;
            const float* W = P.in[which == 0 ? 3 : which == 1 ? 4 : which == 2 ? 23 : 24]; const float* gain = P.in[which < 2 ? 2 : 22];
            bf16* WT = (bf16*)(ws + (which < 2 ? WS_WGU1 : WS_WGU2));
            const int drow0 = 256 * (n0 / 128) + 128 * (which & 1) + (n0 % 128);
            p0_transpose_item(W, DM, FF, WT, gain, 64 * kb, n0, drow0, scr, lane); continue; }
        r -= 4 * I_G;
        if (r < 2 * I_D) { const int which = r / I_D; r -= which * I_D; const int nblk = DM / 32, kb = r / nblk, nb = r % nblk;
            p0_transpose_item(P.in[which ? 25 : 5], FF, DM, (bf16*)(ws + (which ? WS_WD2 : WS_WD1)), nullptr, 64 * kb, 32 * nb, 32 * nb, scr, lane); continue; }
        r -= 2 * I_D;
        if (r < I_IN) { const int nblk = NIN / 32, kb = r / nblk, nb = r % nblk;
            p0_transpose_item(P.in[7], DM, NIN, (bf16*)(ws + WS_WIN), P.in[6], 64 * kb, 32 * nb, 32 * nb, scr, lane); continue; }
        r -= I_IN;
        { const int nblk = DM / 32, kb = r / nblk, nb = r % nblk;
            p0_transpose_item(P.in[21], DM, DM, (bf16*)(ws + WS_WOUT), nullptr, 64 * kb, 32 * nb, 32 * nb, scr, lane); }
    }
    { GAS v4u* z = (GAS v4u*)(ws + WS_WIN + (size_t)NIN * DM * 2); const int n16 = (NINP - NIN) * DM * 2 / 16;
      for (int i = gw * 64 + lane; i < n16; i += NGW * 64) z[i] = (v4u){0u, 0u, 0u, 0u}; }
    { bf16* LT = (bf16*)(ws + WS_LT);
      for (int i = gw * 64 + lane; i < 512 * 160; i += NGW * 64) { const int n = i / 160, j = i % 160;
          const float v = j < 32 ? P.in[11][j * 512 + n] : j < 64 ? P.in[13][(j - 32) * 512 + n] : P.in[14][(j - 64) * 512 + n];
          LT[i] = (bf16)f2bf(v); } }
    for (int m = gw; m < MR + NMETA; m += NGW) {
        if (m < MR) row_to_bf16(P.in[0] + (size_t)m * DM, (bf16*)(ws + WS_XB) + (size_t)m * DM, (float*)(ws + WS_SSQ1) + (size_t)m * 16, lane);
        else { const int i = m - MR; row_to_bf16(P.in[1] + (size_t)i * DM, (bf16*)(ws + WS_META + MO_XMB) + (size_t)i * DM, (float*)(ws + WS_META + MO_SSQM1) + i * 16, lane); }
    }
}
__device__ __forceinline__ f32x4 skinny16(const bf16* A, const bf16* Bt, int K, int n0, int lane) {
    const int fr = lane & 15, fq = lane >> 4;
    const bf16* ap = A + (size_t)fr * K + 8 * fq; const bf16* bp = Bt + (size_t)(n0 + fr) * K + 8 * fq;
    f32x4 acc = (f32x4){0.f, 0.f, 0.f, 0.f};
    for (int k = 0; k < K; k += 32) { const bf16x8 a = *(const bf16x8*)(ap + k), b = *(const bf16x8*)(bp + k); acc = __builtin_amdgcn_mfma_f32_16x16x32_bf16(a, b, acc, 0, 0, 0); }
    return acc;
}
__device__ __forceinline__ float rstd_m16(const float* ssq16) { float s = 0.f;
#pragma unroll
    for (int i = 0; i < 16; ++i) s += ssq16[i];
    return __builtin_amdgcn_rsqf(s * (1.0f / 1024.0f) + 1e-5f); }
__device__ __forceinline__ void meta_up(unsigned char* ws, int gw, int NGW, int lane) {
    const bf16* A = (const bf16*)(ws + WS_META + MO_XMB); const bf16* Bt = (const bf16*)(ws + WS_WGU1); bf16* Um = (bf16*)(ws + WS_META + MO_UM);
    const float* ssq = (const float*)(ws + WS_META + MO_SSQM1); const int fr = lane & 15, fq = lane >> 4;
    for (int t = gw; t < FF / 16; t += NGW) { const int c0 = 16 * t, nr = 256 * (c0 / 128) + (c0 % 128);
        const f32x4 g = skinny16(A, Bt, DM, nr, lane), u = skinny16(A, Bt, DM, nr + 128, lane);
#pragma unroll
        for (int r = 0; r < 4; ++r) { const int row = 4 * fq + r; const float rs = rstd_m16(ssq + row * 16); Um[(size_t)row * FF + c0 + fr] = (bf16)f2bf(pg8::silu_mul(g[r] * rs, u[r] * rs)); } }
}
__device__ __forceinline__ void meta_down(const Ptrs& P, int gw, int NGW, int lane) {
    unsigned char* ws = P.ws; const bf16* A = (const bf16*)(ws + WS_META + MO_UM); const bf16* Bt = (const bf16*)(ws + WS_WD1); bf16* H = (bf16*)(ws + WS_META + MO_H1MB);
    float* ssq = (float*)(ws + WS_META + MO_SSQM2); const int fr = lane & 15, fq = lane >> 4;
    for (int t = gw; t < DM / 16; t += NGW) { const f32x4 a = skinny16(A, Bt, FF, 16 * t, lane);
#pragma unroll
        for (int r = 0; r < 4; ++r) { const int row = 4 * fq + r; const float o = P.in[1][row * DM + 16 * t + fr] + 0.5f * a[r]; H[row * DM + 16 * t + fr] = (bf16)f2bf(o);
            float s = o * o; s += __shfl_xor(s, 1); s += __shfl_xor(s, 2); s += __shfl_xor(s, 4); s += __shfl_xor(s, 8); if (fr == 0) ssq[row * 64 + t] = s; } }
}
__device__ __forceinline__ void meta_win(const Ptrs& P, int gw, int NGW, int lane) {
    unsigned char* ws = P.ws; const bf16* A = (const bf16*)(ws + WS_META + MO_H1MB); const bf16* Bt = (const bf16*)(ws + WS_WIN); bf16* Zm = (bf16*)(ws + WS_META + MO_ZM);
    const float* ssq = (const float*)(ws + WS_META + MO_SSQM2); const int fr = lane & 15, fq = lane >> 4;
    for (int t = gw; t < NIN / 16; t += NGW) { const f32x4 a = skinny16(A, Bt, DM, 16 * t, lane); const int c = 16 * t + fr; const float bias = c >= ZC_Q ? P.in[8][c - ZC_Q] : 0.f;
#pragma unroll
        for (int r = 0; r < 4; ++r) { const int row = 4 * fq + r; float s = 0.f;
#pragma unroll 8
            for (int i = 0; i < 64; ++i) s += ssq[row * 64 + i];
            Zm[(size_t)row * NIN + c] = (bf16)f2bf(a[r] * __builtin_amdgcn_rsqf(s * (1.0f / 1024.0f) + 1e-5f) + bias); } }
}
__device__ __forceinline__ void prep_task(const Ptrs& P, int tt, int h, int lane) {
    unsigned char* ws = P.ws; const int fr = lane & 15, fq = lane >> 4;
    const bf16* Z = (const bf16*)(ws + WS_BIG); const bf16* Zm = (const bf16*)(ws + WS_META + MO_ZM); const bf16* LT = (const bf16*)(ws + WS_LT);
    const bool meta = (tt == MR / 16);
    const int m = 16 * tt + fr;
    const bf16* zc = meta ? Zm + (size_t)fr * NIN : Z + (size_t)m * NIN;
    const bool pz = meta && fr == 0;
    const bf16* zp = meta ? Zm + (size_t)(fr > 0 ? fr - 1 : 0) * NIN : ((m % TSEQ) == 0 ? Zm + (size_t)15 * NIN : Z + (size_t)(m - 1) * NIN);
    const float* mu = P.in[9];
    bf16x8 xf[5];
#pragma unroll
    for (int ks = 0; ks < 5; ++ks) { const int c0 = ZC_W + 32 * ks + 8 * fq; const v4u a = *(const v4u*)(zc + c0); v4u b = *(const v4u*)(zp + c0); if (pz) b = (v4u){0u, 0u, 0u, 0u};
        float v[8]; const f32x4 m0 = *(const f32x4*)(mu + c0), m1 = *(const f32x4*)(mu + c0 + 4);
#pragma unroll
        for (int e = 0; e < 4; ++e) { const unsigned wa = a[e], wb = b[e]; const float a0 = bflo(wa), a1 = bfhi(wa), b0 = bflo(wb), b1 = bfhi(wb);
            const float mm0 = (2 * e < 4) ? m0[2 * e] : m1[2 * e - 4], mm1 = (2 * e + 1 < 4) ? m0[2 * e + 1] : m1[2 * e + 1 - 4];
            v[2 * e] = a0 + (b0 - a0) * mm0; v[2 * e + 1] = a1 + (b1 - a1) * mm1; }
#pragma unroll
        for (int e = 0; e < 8; ++e) v[e] = (ks == 0) ? tanhf_(v[e]) : (ks == 1) ? v[e] : sigmoidf_(v[e]);
        v4u o; o.x = pk2(v[0], v[1]); o.y = pk2(v[2], v[3]); o.z = pk2(v[4], v[5]); o.w = pk2(v[6], v[7]); xf[ks] = __builtin_bit_cast(bf16x8, o); }
    f32x4 aw[4], aa[4], ag[4];
#pragma unroll
    for (int nt = 0; nt < 4; ++nt) { const bf16* lp = LT + (size_t)(h * 64 + 16 * nt + fr) * 160 + 8 * fq; const f32x4 z = (f32x4){0.f, 0.f, 0.f, 0.f};
        aw[nt] = __builtin_amdgcn_mfma_f32_16x16x32_bf16(*(const bf16x8*)(lp), xf[0], z, 0, 0, 0);
        aa[nt] = __builtin_amdgcn_mfma_f32_16x16x32_bf16(*(const bf16x8*)(lp + 32), xf[1], z, 0, 0, 0);
        ag[nt] = __builtin_amdgcn_mfma_f32_16x16x32_bf16(*(const bf16x8*)(lp + 64), xf[2], z, 0, 0, 0);
        ag[nt] = __builtin_amdgcn_mfma_f32_16x16x32_bf16(*(const bf16x8*)(lp + 96), xf[3], ag[nt], 0, 0, 0);
        ag[nt] = __builtin_amdgcn_mfma_f32_16x16x32_bf16(*(const bf16x8*)(lp + 128), xf[4], ag[nt], 0, 0, 0); }
    f32x4 kkr[4], kv[4], av[4]; float ss = 0.f;
#pragma unroll
    for (int nt = 0; nt < 4; ++nt) { const int c = h * 64 + 16 * nt + 4 * fq; const v2u a = *(const v2u*)(zc + 512 + c); v2u b = *(const v2u*)(zp + 512 + c); if (pz) b = (v2u){0u, 0u};
        const f32x4 za = unpack4(a), zb = unpack4(b), mk = *(const f32x4*)(mu + 512 + c); const f32x4 zk = za + (zb - za) * mk;
        const f32x4 a0 = *(const f32x4*)(P.in[12] + c), kkw = *(const f32x4*)(P.in[15] + c), kaw = *(const f32x4*)(P.in[16] + c);
        f32x4 a_;
#pragma unroll
        for (int r = 0; r < 4; ++r) a_[r] = sigmoidf_(a0[r] + aa[nt][r]);
        av[nt] = a_; kkr[nt] = zk * kkw; kv[nt] = zk * (1.0f + (a_ - 1.0f) * kaw);
        ss += (kkr[nt][0] * kkr[nt][0] + kkr[nt][1] * kkr[nt][1]) + (kkr[nt][2] * kkr[nt][2] + kkr[nt][3] * kkr[nt][3]); }
    ss += __shfl_xor(ss, 16); ss += __shfl_xor(ss, 32);
    const float inv = 1.0f / fmaxf(sqrtf(ss), 1e-12f);
    bf16* pr;
    if (meta) pr = (bf16*)(ws + WS_META + MO_PM) + (size_t)(h * 16 + fr) * PV;
    else { const int b = m / TSEQ, t = m % TSEQ; pr = (bf16*)(ws + WS_P) + ((size_t)(b * NHEAD + h) * TSEQ + t) * PV; }
#pragma unroll
    for (int nt = 0; nt < 4; ++nt) { const int cl = 16 * nt + 4 * fq, c = h * 64 + cl; const f32x4 w0 = *(const f32x4*)(P.in[10] + c);
        const f32x4 kk = kkr[nt] * inv, bb = kk * av[nt]; f32x4 e;
#pragma unroll
        for (int r = 0; r < 4; ++r) e[r] = 0.6065306597126334f * sigmoidf_(w0[r] + aw[nt][r]);
        v2u o;
        o.x = pk2(kk[0], kk[1]); o.y = pk2(kk[2], kk[3]); *(v2u*)(pr + cl) = o;
        o.x = pk2(e[0], e[1]); o.y = pk2(e[2], e[3]); *(v2u*)(pr + 64 + cl) = o;
        o.x = pk2(bb[0], bb[1]); o.y = pk2(bb[2], bb[3]); *(v2u*)(pr + 128 + cl) = o;
        o.x = pk2(kv[nt][0], kv[nt][1]); o.y = pk2(kv[nt][2], kv[nt][3]); *(v2u*)(pr + 192 + cl) = o;
        o.x = pk2(ag[nt][0], ag[nt][1]); o.y = pk2(ag[nt][2], ag[nt][3]); *(v2u*)(pr + 256 + cl) = o; }
}
constexpr int KS_LD = 72, VT_LD = 232, ATT_KS_BYTES = 208 * KS_LD * 2, ATT_VT_BYTES = 64 * VT_LD * 2;
__device__ __forceinline__ void attn_unit(const Ptrs& P, unsigned char* lds, int b, int g, int c, int tid, int wave, int lane) {
    unsigned char* ws = P.ws; const bf16* Z = (const bf16*)(ws + WS_BIG); const bf16* Zm = (const bf16*)(ws + WS_META + MO_ZM); bf16* Y = (bf16*)(ws + WS_XB);
    bf16* Ks = (bf16*)lds; bf16* Vt = (bf16*)(lds + ATT_KS_BYTES);
    const int fr = lane & 15, fq = lane >> 4;
    __syncthreads();
    for (int it = tid; it < 208 * 8; it += NWAVES * 64) { const int key = it >> 3, pc = it & 7; const bf16* src; bool valid = true;
        if (key < 16) src = Zm + (size_t)key * NIN; else { const int t = 64 * (c - 2) + (key - 16); valid = t >= 0; src = Z + ((size_t)b * TSEQ + (valid ? t : 0)) * NIN; }
        v4u kq = *(const v4u*)(src + ZC_K + 64 * g + 8 * pc), vq = *(const v4u*)(src + ZC_V + 64 * g + 8 * pc);
        if (!valid) { kq = (v4u){0u, 0u, 0u, 0u}; vq = kq; }
        *(v4u*)(Ks + key * KS_LD + 8 * pc) = kq;
#pragma unroll
        for (int e = 0; e < 4; ++e) { Vt[(8 * pc + 2 * e) * VT_LD + key] = (bf16)(vq[e] & 0xffffu); Vt[(8 * pc + 2 * e + 1) * VT_LD + key] = (bf16)(vq[e] >> 16); } }
    for (int it = tid; it < 64 * 16; it += NWAVES * 64) Vt[(it >> 4) * VT_LD + 208 + (it & 15)] = 0;
    __syncthreads();
    const int hq = 4 * g + (wave >> 1);
    const float slope = __builtin_amdgcn_exp2f(-(float)(hq + 1)), sink = P.in[20][hq];
#pragma unroll 1
    for (int sub = 0; sub < 2; ++sub) {
        const int i0 = 16 * (2 * (wave & 1) + sub), iq = i0 + fr;
        const size_t mrow = (size_t)b * TSEQ + 64 * c + iq;
        const bf16x8 q0 = *(const bf16x8*)(Z + mrow * NIN + ZC_Q + 64 * hq + 8 * fq), q1 = *(const bf16x8*)(Z + mrow * NIN + ZC_Q + 64 * hq + 32 + 8 * fq);
        f32x4 s[13]; float mx = sink;
#pragma unroll
        for (int kt = 0; kt < 13; ++kt) { const bf16* kp = Ks + (16 * kt + fr) * KS_LD + 8 * fq; f32x4 a = (f32x4){0.f, 0.f, 0.f, 0.f};
            a = __builtin_amdgcn_mfma_f32_16x16x32_bf16(*(const bf16x8*)(kp), q0, a, 0, 0, 0);
            a = __builtin_amdgcn_mfma_f32_16x16x32_bf16(*(const bf16x8*)(kp + 32), q1, a, 0, 0, 0);
#pragma unroll
            for (int r = 0; r < 4; ++r) { const int key = 16 * kt + 4 * fq + r; float v;
                if (kt == 0) v = a[r] * 0.125f - slope * (float)(16 + 64 * c + iq - key);
                else { const int jj = key - 16; const int d = 128 + iq - jj; v = a[r] * 0.125f - slope * (float)(d < 0 ? -d : d); if (64 * (c - 2) + jj < 0) v = -1e30f; }
                a[r] = v; mx = fmaxf(mx, v); }
            s[kt] = a; }
        mx = fmaxf(mx, __shfl_xor(mx, 16)); mx = fmaxf(mx, __shfl_xor(mx, 32));
        float sum = 0.f;
#pragma unroll
        for (int kt = 0; kt < 13; ++kt)
#pragma unroll
            for (int r = 0; r < 4; ++r) { const float p = __builtin_amdgcn_exp2f((s[kt][r] - mx) * 1.4426950408889634f); s[kt][r] = p; sum += p; }
        sum += __shfl_xor(sum, 16); sum += __shfl_xor(sum, 32);
        sum += __builtin_amdgcn_exp2f((sink - mx) * 1.4426950408889634f);
        const float rinv = 1.0f / sum;
        f32x4 o[4];
#pragma unroll
        for (int dt = 0; dt < 4; ++dt) o[dt] = (f32x4){0.f, 0.f, 0.f, 0.f};
#pragma unroll
        for (int ks = 0; ks < 7; ++ks) { const int ta = 2 * ks, tb = 2 * ks + 1; v4u pw;
            pw.x = pk2(s[ta][0], s[ta][1]); pw.y = pk2(s[ta][2], s[ta][3]);
            if (tb < 13) { pw.z = pk2(s[tb][0], s[tb][1]); pw.w = pk2(s[tb][2], s[tb][3]); } else { pw.z = 0u; pw.w = 0u; }
            const bf16x8 pf = __builtin_bit_cast(bf16x8, pw);
#pragma unroll
            for (int dt = 0; dt < 4; ++dt) { const bf16* vp = Vt + (16 * dt + fr) * VT_LD + 4 * fq; const v2u va = *(const v2u*)(vp + 16 * ta), vb = *(const v2u*)(vp + 16 * tb);
                const v4u vv = (v4u){va.x, va.y, vb.x, vb.y};
                o[dt] = __builtin_amdgcn_mfma_f32_16x16x32_bf16(__builtin_bit_cast(bf16x8, vv), pf, o[dt], 0, 0, 0); } }
#pragma unroll
        for (int dt = 0; dt < 4; ++dt) { v2u w; w.x = pk2(o[dt][0] * rinv, o[dt][1] * rinv); w.y = pk2(o[dt][2] * rinv, o[dt][3] * rinv);
            *(v2u*)(Y + mrow * DM + 512 + 64 * hq + 16 * dt + 4 * fq) = w; }
    }
}
template <int CTRL> __device__ __forceinline__ float dppf(float x) { return __builtin_bit_cast(float, __builtin_amdgcn_update_dpp(0, __builtin_bit_cast(int, x), CTRL, 0xF, 0xF, true)); }
template <int CTRL> __device__ __forceinline__ float dppf_old(float old, float x) { return __builtin_bit_cast(float, __builtin_amdgcn_update_dpp(__builtin_bit_cast(int, old), __builtin_bit_cast(int, x), CTRL, 0xF, 0xF, false)); }
__device__ __forceinline__ float red8(float x) { x += dppf<0xB1>(x); x += dppf<0x4E>(x); x += dppf<0x141>(x); return x; }
__device__ __forceinline__ float red16(float x) { x = red8(x); x += dppf<0x140>(x); return x; }
__device__ __forceinline__ float scan16(float x) { x += dppf<0x111>(x); x += dppf<0x112>(x); x += dppf<0x114>(x); x += dppf<0x118>(x); return x; }
constexpr int NCHUNK = 257, NSUPER = 65;
constexpr int CB_A = 0, CB_R = 2048, CB_BK = 4096, CB_VT = 8192, CB_TT = 10240, CB_AR = 11264, CB_G = 12288, CB_BON = 12544, CB_SIZE = 12800;
constexpr int SC_YB = 8 * CB_SIZE, SC_HS = SC_YB + 8 * 4096, SC_END = SC_HS + 4 * 2048;
static_assert(SC_END <= LDSCTL_OFF, "scan LDS map");
__device__ __forceinline__ bf16x8 pack8(const float* v) { v4u o; o.x = pk2(v[0], v[1]); o.y = pk2(v[2], v[3]); o.z = pk2(v[4], v[5]); o.w = pk2(v[6], v[7]); return __builtin_bit_cast(bf16x8, o); }
__device__ __forceinline__ void unpack8(v4u w, float* v) { v[0] = bflo(w.x); v[1] = bfhi(w.x); v[2] = bflo(w.y); v[3] = bfhi(w.y); v[4] = bflo(w.z); v[5] = bfhi(w.z); v[6] = bflo(w.w); v[7] = bfhi(w.w); }

__device__ __forceinline__ void scan_phase(const Ptrs& P, unsigned char* lds, int sb, int tid, int wave, int lane) {
    const int b = sb >> 3, h = sb & 7, fr = lane & 15, fq = lane >> 4;
    if (wave < 4) {
        f32x4 H[4];
#pragma unroll
        for (int kt = 0; kt < 4; ++kt) H[kt] = (f32x4){0.f, 0.f, 0.f, 0.f};
        const int vcol = 16 * wave + fr;
#pragma unroll 1
        for (int s = 0; s <= NSUPER + 1; ++s) {
            __syncthreads();
            if (s < 1 || s > NSUPER) continue;
            const int set = (s - 1) & 1;
#pragma unroll 1
            for (int j = 0; j < 4; ++j) { const int ch = 4 * (s - 1) + j; if (ch >= NCHUNK) break;
                const unsigned char* cb = lds + (set * 4 + j) * CB_SIZE; float* yb = (float*)(lds + SC_YB + (set * 4 + j) * 4096);
                v4u hb0, hb1;
                hb0.x = pk2m(H[0][0], H[0][1]); hb0.y = pk2m(H[0][2], H[0][3]); hb0.z = pk2m(H[1][0], H[1][1]); hb0.w = pk2m(H[1][2], H[1][3]);
                hb1.x = pk2m(H[2][0], H[2][1]); hb1.y = pk2m(H[2][2], H[2][3]); hb1.z = pk2m(H[3][0], H[3][1]); hb1.w = pk2m(H[3][2], H[3][3]);
                const bf16x8 h0 = __builtin_bit_cast(bf16x8, hb0), h1 = __builtin_bit_cast(bf16x8, hb1);
                const bf16x8 a0 = *(const bf16x8*)(cb + CB_A + ((fr * 2 + 0) * 4 + fq) * 16), a1 = *(const bf16x8*)(cb + CB_A + ((fr * 2 + 1) * 4 + fq) * 16);
                const bf16x8 r0 = *(const bf16x8*)(cb + CB_R + ((fr * 2 + 0) * 4 + fq) * 16), r1 = *(const bf16x8*)(cb + CB_R + ((fr * 2 + 1) * 4 + fq) * 16);
                const bf16x8 tt = *(const bf16x8*)(cb + CB_TT + (fr * 4 + fq) * 16), ar = *(const bf16x8*)(cb + CB_AR + (fr * 4 + fq) * 16);
                const v2u vt = *(const v2u*)(cb + CB_VT + (vcol * 16 + 4 * fq) * 2);
                const f32x4 z4 = (f32x4){0.f, 0.f, 0.f, 0.f};
                f32x4 X = __builtin_amdgcn_mfma_f32_16x16x32_bf16(a0, h0, z4, 0, 0, 0); X = __builtin_amdgcn_mfma_f32_16x16x32_bf16(a1, h1, X, 0, 0, 0);
                f32x4 Y = __builtin_amdgcn_mfma_f32_16x16x32_bf16(r0, h0, z4, 0, 0, 0); Y = __builtin_amdgcn_mfma_f32_16x16x32_bf16(r1, h1, Y, 0, 0, 0);
                v4u xb; xb.x = pk2m(X[0], X[1]); xb.y = pk2m(X[2], X[3]); xb.z = vt.x; xb.w = vt.y;
                const f32x4 U = __builtin_amdgcn_mfma_f32_16x16x32_bf16(tt, __builtin_bit_cast(bf16x8, xb), z4, 0, 0, 0);
                v4u ub; ub.x = pk2m(U[0], U[1]); ub.y = pk2m(U[2], U[3]); ub.z = vt.x; ub.w = vt.y;
                const bf16x8 uf = __builtin_bit_cast(bf16x8, ub);
                Y = __builtin_amdgcn_mfma_f32_16x16x32_bf16(ar, uf, Y, 0, 0, 0);
#pragma unroll
                for (int kt = 0; kt < 4; ++kt) { const f32x4 g = *(const f32x4*)(cb + CB_G + (16 * kt + 4 * fq) * 4); const bf16x8 bk = *(const bf16x8*)(cb + CB_BK + ((16 * kt + fr) * 4 + fq) * 16);
                    H[kt] = __builtin_amdgcn_mfma_f32_16x16x32_bf16(bk, uf, H[kt] * g, 0, 0, 0); }
#pragma unroll
                for (int r = 0; r < 4; ++r) yb[(4 * fq + r) * 64 + vcol] = Y[r];
            }
        }
    } else {
        const int hw = wave - 4, t = fr;
        const bf16* Z = (const bf16*)(P.ws + WS_BIG); const bf16* Zm = (const bf16*)(P.ws + WS_META + MO_ZM);
        const bf16* Pb = (const bf16*)(P.ws + WS_P) + (size_t)(b * NHEAD + h) * TSEQ * PV; const bf16* Pm = (const bf16*)(P.ws + WS_META + MO_PM) + (size_t)h * 16 * PV;
        bf16* Yo = (bf16*)(P.ws + WS_XB);
        float* hs = (float*)(lds + SC_HS + hw * 2048);
        const int cbase = h * 64 + 8 * fq;
#pragma unroll 1
        for (int s = 0; s <= NSUPER + 1; ++s) {
            __syncthreads();
            { const int ch = 4 * (s - 2) + hw;
              if (s >= 2 && ch >= 1 && ch < NCHUNK) { const int set = s & 1; const unsigned char* cb = lds + (set * 4 + hw) * CB_SIZE; const float* yb = (const float*)(lds + SC_YB + (set * 4 + hw) * 4096);
                const int tok = 16 * (ch - 1) + t; const size_t m = (size_t)b * TSEQ + tok;
                const bf16* zc = Z + m * NIN; const bf16* zp = (tok == 0) ? Zm + (size_t)15 * NIN : Z + (m - 1) * NIN; const bf16* pr = Pb + (size_t)tok * PV;
                float y[16]; float sm = 0.f;
#pragma unroll
                for (int ks = 0; ks < 2; ++ks) { const f32x4 y0 = *(const f32x4*)(yb + t * 64 + 32 * ks + 8 * fq), y1 = *(const f32x4*)(yb + t * 64 + 32 * ks + 8 * fq + 4);
#pragma unroll
                    for (int e = 0; e < 4; ++e) { y[8 * ks + e] = y0[e]; y[8 * ks + 4 + e] = y1[e]; sm += y0[e] + y1[e]; } }
                sm += __shfl_xor(sm, 16); sm += __shfl_xor(sm, 32); const float mean = sm * (1.0f / 64.0f); float sq = 0.f;
#pragma unroll
                for (int i = 0; i < 16; ++i) { y[i] -= mean; sq += y[i] * y[i]; }
                sq += __shfl_xor(sq, 16); sq += __shfl_xor(sq, 32); const float rs = __builtin_amdgcn_rsqf(sq * (1.0f / 64.0f) + 64e-5f);
                const float bon = *(const float*)(cb + CB_BON + t * 4);
#pragma unroll
                for (int ks = 0; ks < 2; ++ks) { const int c = cbase + 32 * ks;
                    float vc[8], vp[8], g[8]; unpack8(*(const v4u*)(zc + 1024 + c), vc); unpack8(*(const v4u*)(zp + 1024 + c), vp); unpack8(*(const v4u*)(pr + 256 + 32 * ks + 8 * fq), g);
                    float o[8]; float muv[8], lw[8], lb[8];
                    { const f32x4 a0 = *(const f32x4*)(P.in[9] + 1024 + c), a1 = *(const f32x4*)(P.in[9] + 1024 + c + 4), b0 = *(const f32x4*)(P.in[18] + c), b1 = *(const f32x4*)(P.in[18] + c + 4), c0 = *(const f32x4*)(P.in[19] + c), c1 = *(const f32x4*)(P.in[19] + c + 4);
#pragma unroll
                      for (int e = 0; e < 4; ++e) { muv[e] = a0[e]; muv[4 + e] = a1[e]; lw[e] = b0[e]; lw[4 + e] = b1[e]; lb[e] = c0[e]; lb[4 + e] = c1[e]; } }
#pragma unroll
                    for (int e = 0; e < 8; ++e) { const float vv = vc[e] + (vp[e] - vc[e]) * muv[e];
                        o[e] = (y[8 * ks + e] * rs * lw[e] + lb[e] + bon * vv) * g[e]; }
                    *(bf16x8*)(Yo + m * DM + c) = pack8(o); } } }
            { const int ch = 4 * s + hw;
              if (ch < NCHUNK) { unsigned char* cb = lds + ((s & 1) * 4 + hw) * CB_SIZE;
                const bf16 *pr, *zc, *zp; bool pz = false;
                if (ch == 0) { pr = Pm + (size_t)t * PV; zc = Zm + (size_t)t * NIN; zp = Zm + (size_t)(t > 0 ? t - 1 : 0) * NIN; pz = (t == 0); }
                else { const int tok = 16 * (ch - 1) + t; const size_t m = (size_t)b * TSEQ + tok; pr = Pb + (size_t)tok * PV; zc = Z + m * NIN; zp = (tok == 0) ? Zm + (size_t)15 * NIN : Z + (m - 1) * NIN; }
                bf16x8 Af[2], Rf[2], Bf[2], Kf[2]; float bonp = 0.f;
#pragma unroll
                for (int ks = 0; ks < 2; ++ks) { const int c = cbase + 32 * ks, cl = 32 * ks + 8 * fq;
                    asm volatile("" ::: "memory"); __builtin_amdgcn_sched_barrier(0);
                    float kk[8], e_[8], bb[8], kx[8], rc[8], rp[8], vc[8], vp[8];
                    unpack8(*(const v4u*)(pr + cl), kk); unpack8(*(const v4u*)(pr + 64 + cl), e_); unpack8(*(const v4u*)(pr + 128 + cl), bb); unpack8(*(const v4u*)(pr + 192 + cl), kx);
                    unpack8(*(const v4u*)(zc + c), rc); unpack8(*(const v4u*)(zc + 1024 + c), vc);
                    { v4u a = *(const v4u*)(zp + c), d = *(const v4u*)(zp + 1024 + c); if (pz) { a = (v4u){0u, 0u, 0u, 0u}; d = a; } unpack8(a, rp); unpack8(d, vp); }
                    float At[8], Rt[8], Bt[8], Kt[8]; float mur[8], muv[8], rkk[8];
                    { const f32x4 a0 = *(const f32x4*)(P.in[9] + c), a1 = *(const f32x4*)(P.in[9] + c + 4), b0 = *(const f32x4*)(P.in[9] + 1024 + c), b1 = *(const f32x4*)(P.in[9] + 1024 + c + 4), c0 = *(const f32x4*)(P.in[17] + c), c1 = *(const f32x4*)(P.in[17] + c + 4);
#pragma unroll
                      for (int e = 0; e < 4; ++e) { mur[e] = a0[e]; mur[4 + e] = a1[e]; muv[e] = b0[e]; muv[4 + e] = b1[e]; rkk[e] = c0[e]; rkk[4 + e] = c1[e]; } }
#pragma unroll
                    for (int e = 0; e < 8; ++e) { const float rr = rc[e] + (rp[e] - rc[e]) * mur[e]; const float vv = vc[e] + (vp[e] - vc[e]) * muv[e];
                        bonp += rr * kx[e] * rkk[e];
                        const float ec = scan16(e_[e]), etot = red16(e_[e]);
                        const float g1 = __builtin_amdgcn_exp2f(-1.4426950408889634f * ec);
                        const float gi = __builtin_amdgcn_exp2f(1.4426950408889634f * ec);
                        const float gC = __builtin_amdgcn_exp2f(-1.4426950408889634f * etot);
                        const float g0 = dppf_old<0x111>(1.0f, g1);
                        At[e] = -kk[e] * g0; Rt[e] = rr * g1; Bt[e] = bb[e] * gi; Kt[e] = kx[e] * gi;
                        const int kap = cl + e;
                        *(bf16*)(cb + CB_BK + ((kap * 4 + (t >> 2)) * 8 + (t & 3)) * 2) = (bf16)f2bf(Bt[e] * gC);
                        *(bf16*)(cb + CB_BK + ((kap * 4 + (t >> 2)) * 8 + 4 + (t & 3)) * 2) = (bf16)f2bf(Kt[e] * gC);
                        *(bf16*)(cb + CB_VT + (kap * 16 + t) * 2) = (bf16)f2bf(vv);
                        if (t == 15) *(float*)(cb + CB_G + kap * 4) = gC; }
                    Af[ks] = pack8(At); Rf[ks] = pack8(Rt); Bf[ks] = pack8(Bt); Kf[ks] = pack8(Kt);
                    { const int fqs = 2 * (fq & 1), bo = (fq >> 1) * 8; const v4u aw = __builtin_bit_cast(v4u, Af[ks]), rw = __builtin_bit_cast(v4u, Rf[ks]);
                      *(v2u*)(cb + CB_A + ((t * 2 + ks) * 4 + fqs) * 16 + bo) = (v2u){aw.x, aw.y}; *(v2u*)(cb + CB_A + ((t * 2 + ks) * 4 + fqs + 1) * 16 + bo) = (v2u){aw.z, aw.w};
                      *(v2u*)(cb + CB_R + ((t * 2 + ks) * 4 + fqs) * 16 + bo) = (v2u){rw.x, rw.y}; *(v2u*)(cb + CB_R + ((t * 2 + ks) * 4 + fqs + 1) * 16 + bo) = (v2u){rw.z, rw.w}; } }
                asm volatile("" ::: "memory"); __builtin_amdgcn_sched_barrier(0);
                bonp += __shfl_xor(bonp, 16); bonp += __shfl_xor(bonp, 32);
                if (fq == 0) *(float*)(cb + CB_BON + t * 4) = bonp;
                const f32x4 z4 = (f32x4){0.f, 0.f, 0.f, 0.f};
                f32x4 Mab = __builtin_amdgcn_mfma_f32_16x16x32_bf16(Af[0], Bf[0], z4, 0, 0, 0); Mab = __builtin_amdgcn_mfma_f32_16x16x32_bf16(Af[1], Bf[1], Mab, 0, 0, 0);
                f32x4 Mak = __builtin_amdgcn_mfma_f32_16x16x32_bf16(Af[0], Kf[0], z4, 0, 0, 0); Mak = __builtin_amdgcn_mfma_f32_16x16x32_bf16(Af[1], Kf[1], Mak, 0, 0, 0);
                f32x4 Mrb = __builtin_amdgcn_mfma_f32_16x16x32_bf16(Rf[0], Bf[0], z4, 0, 0, 0); Mrb = __builtin_amdgcn_mfma_f32_16x16x32_bf16(Rf[1], Bf[1], Mrb, 0, 0, 0);
                f32x4 Mrk = __builtin_amdgcn_mfma_f32_16x16x32_bf16(Rf[0], Kf[0], z4, 0, 0, 0); Mrk = __builtin_amdgcn_mfma_f32_16x16x32_bf16(Rf[1], Kf[1], Mrk, 0, 0, 0);
#pragma unroll
                for (int r = 0; r < 4; ++r) { const int tt = 4 * fq + r, i = fr;
                    hs[tt * 16 + i] = (tt > i) ? Mab[r] : 0.f; hs[256 + tt * 16 + i] = (tt > i) ? Mak[r] : 0.f;
                    *(bf16*)(cb + CB_AR + ((tt * 4 + (i >> 2)) * 8 + (i & 3)) * 2) = (bf16)f2bf((tt >= i) ? Mrb[r] : 0.f);
                    *(bf16*)(cb + CB_AR + ((tt * 4 + (i >> 2)) * 8 + 4 + (i & 3)) * 2) = (bf16)f2bf((tt >= i) ? Mrk[r] : 0.f); }
                asm volatile("s_waitcnt lgkmcnt(0)" ::: "memory");
                { const int c = lane & 31, cc = c & 15; const bool isT = c < 16; float out[16];
#pragma unroll
                  for (int tt = 0; tt < 16; ++tt) { float acc = isT ? (tt == cc ? 1.0f : 0.0f) : hs[256 + tt * 16 + cc];
#pragma unroll
                      for (int i4 = 0; i4 < (tt + 3) / 4; ++i4) { const f32x4 l = *(const f32x4*)(hs + tt * 16 + 4 * i4);
#pragma unroll
                          for (int e = 0; e < 4; ++e) if (4 * i4 + e < tt) acc += l[e] * out[4 * i4 + e]; }
                      out[tt] = acc;
                      if (lane < 32) *(bf16*)(cb + CB_TT + ((tt * 4 + (cc >> 2)) * 8 + (isT ? 0 : 4) + (cc & 3)) * 2) = (bf16)f2bf(acc); } }
              } }
        }
    }
}
__device__ __forceinline__ void final_norm(const Ptrs& P, int gw, int NGW, int lane) {
    const float* ssq = (const float*)(P.ws + WS_SSQ4); const GAS f32x4* g4 = (const GAS f32x4*)P.in[26] + lane;
    f32x4 g[4];
#pragma unroll
    for (int j = 0; j < 4; ++j) g[j] = g4[64 * j];
    for (int m = gw; m < MR; m += NGW) { const float rs = pg8::rstd_from16(ssq, m); GAS f32x4* o = (GAS f32x4*)(P.out + (size_t)m * DM) + lane;
#pragma unroll
        for (int j = 0; j < 4; ++j) o[64 * j] = o[64 * j] * rs * g[j]; }
}
#ifndef MK_N_LAUNCHES
#define MK_N_LAUNCHES 1
#endif
constexpr int N_PHASES = 10;
struct Args { Ptrs p; int ph_lo, ph_hi, use_cg, pad; };
__global__ void __launch_bounds__(NWAVES * 64, 2) hymba_fwd(Args args) {
    extern __shared__ __attribute__((aligned(16))) unsigned char lds[];
    LAS unsigned char* ldsl = (LAS unsigned char*)lds;
    volatile LAS unsigned* MISC = (volatile LAS unsigned*)(ldsl + MISC_OFF);
    const int tid = threadIdx.x, lane = tid & 63, wave = __builtin_amdgcn_readfirstlane(tid >> 6);
    const int G = gridDim.x, bx = blockIdx.x, vcu = (G % 8 == 0) ? (bx % 8) * (G / 8) + bx / 8 : bx;
    const Ptrs& P = args.p; unsigned char* ws = P.ws;
    if (args.use_cg) cg::this_grid().sync();
    for (int u = tid; u < (LDS_BYTES - LDSCTL_OFF) / 4; u += NWAVES * 64) ((LAS unsigned*)(ldsl + LDSCTL_OFF))[u] = 0u;
    __syncthreads();
    const int lo = args.ph_lo, hi = args.ph_hi;
    XcdBarrier bar; bar.bar = (unsigned*)(ws + WS_CTL) + CW_BAR; bar.x = 0; bar.st = nullptr;
    if (hi - lo > 1) bar = xcd_barrier_post((unsigned*)(ws + WS_CTL) + CW_BAR, MISC + 8);
#define IN(k) (lo <= (k) && (k) < hi)
#define SEAM(k) do { if (IN(k) && IN((k) + 1)) xcd_barrier(bar); } while (0)
    const int gw = vcu * NWAVES + wave, NGW = G * NWAVES;

    if (IN(0)) { p0_prologue(P, ldsl, vcu, G, wave, lane); SEAM(0); }
    if (IN(1)) {
        meta_up(ws, gw, NGW, lane);
        pg8::Gemm g{(const bf16*)(ws + WS_XB), (const bf16*)(ws + WS_WGU1), MR, NGU, DM}; pg8::StaticOrder S; S.init(MR, NGU, G, bx);
        pg8::EpiSwiglu E{(bf16*)(ws + WS_BIG), (const float*)(ws + WS_SSQ1), FF};
        pg8::gemm_phase<pg8::EpiSwiglu, pg8::StaticOrder, true, true>(ldsl, g, S, E);
        SEAM(1);
    }
    if (IN(2)) {
        meta_down(P, gw, NGW, lane);
        pg8::Gemm g{(const bf16*)(ws + WS_BIG), (const bf16*)(ws + WS_WD1), MR, DM, FF}; pg8::StaticOrder S; S.init(MR, DM, G, bx);
        pg8::EpiResid<true> E{P.in[0], P.out, (bf16*)(ws + WS_XB), (float*)(ws + WS_SSQ2), 0.5f};
        pg8::gemm_phase<pg8::EpiResid<true>, pg8::StaticOrder, true, true>(ldsl, g, S, E);
        SEAM(2);
    }
    if (IN(3)) {
        meta_win(P, gw, NGW, lane);
        pg8::Gemm g{(const bf16*)(ws + WS_XB), (const bf16*)(ws + WS_WIN), MR, NINP, DM}; pg8::StaticOrder S; S.init(MR, NINP, G, bx);
        pg8::EpiZ E{(bf16*)(ws + WS_BIG), (const float*)(ws + WS_SSQ2), P.in[8], NIN, NIN, ZC_Q};
        pg8::gemm_phase<pg8::EpiZ, pg8::StaticOrder, true, true>(ldsl, g, S, E);
        SEAM(3);
    }
    if (IN(4)) {
        constexpr int NT = (MR / 16 + 1) * NHEAD;
#ifndef REP_PREP
#define REP_PREP 1
#endif
#ifndef REP_ATTN
#define REP_ATTN 1
#endif
        for (int rep = 0; rep < REP_PREP; ++rep) for (int t = gw; t < NT; t += NGW) prep_task(P, t >> 3, t & 7, lane);
        for (int rep = 0; rep < REP_ATTN; ++rep) for (int u = vcu; u < NBATCH * 2 * 64; u += G) attn_unit(P, lds, u >> 7, (u >> 6) & 1, u & 63, tid, wave, lane);
        SEAM(4);
    }
    if (IN(5)) {
#ifndef REP_SCAN
#define REP_SCAN 1
#endif
        for (int rep = 0; rep < REP_SCAN; ++rep) { if (bx < 64) scan_phase(P, lds, bx, tid, wave, lane); __syncthreads(); }
        SEAM(5);
    }
    if (IN(6)) {
        pg8::Gemm g{(const bf16*)(ws + WS_XB), (const bf16*)(ws + WS_WOUT), MR, DM, DM}; pg8::StaticOrder S; S.init(MR, DM, G, bx);
        pg8::EpiResid<true> E{P.out, P.out, (bf16*)(ws + WS_P), (float*)(ws + WS_SSQ3), 1.0f};
        pg8::gemm_phase<pg8::EpiResid<true>, pg8::StaticOrder, true, true>(ldsl, g, S, E);
        SEAM(6);
    }
    if (IN(7)) {
        pg8::Gemm g{(const bf16*)(ws + WS_P), (const bf16*)(ws + WS_WGU2), MR, NGU, DM}; pg8::StaticOrder S; S.init(MR, NGU, G, bx);
        pg8::EpiSwiglu E{(bf16*)(ws + WS_BIG), (const float*)(ws + WS_SSQ3), FF};
        pg8::gemm_phase<pg8::EpiSwiglu, pg8::StaticOrder, true, true>(ldsl, g, S, E);
        SEAM(7);
    }
    if (IN(8)) {
        pg8::Gemm g{(const bf16*)(ws + WS_BIG), (const bf16*)(ws + WS_WD2), MR, DM, FF}; pg8::StaticOrder S; S.init(MR, DM, G, bx);
        pg8::EpiResid<false> E{P.out, P.out, nullptr, (float*)(ws + WS_SSQ4), 0.5f};
        pg8::gemm_phase<pg8::EpiResid<false>, pg8::StaticOrder, true, true>(ldsl, g, S, E);
        SEAM(8);
    }
    if (IN(9)) final_norm(P, gw, NGW, lane);
#undef IN
#undef SEAM
}

extern "C" void kernel_launch(void* const* d_in, const int* in_sizes, int n_in, void* d_out, int out_size, void* d_ws, size_t ws_size, hipStream_t stream) {
    static int grid = 0;
    if (grid == 0) {
        if (n_in != 27 || in_sizes[0] != MR * DM || out_size != MR * DM || ws_size < WS_END) { fprintf(stderr, "kernel_launch: unexpected shapes (n_in %d, in0 %d, out %d, ws %zu)\n", n_in, n_in > 0 ? in_sizes[0] : -1, out_size, ws_size); grid = -1; return; }
        int dev = 0, cus = 0, per_cu = 0;
        if (hipGetDevice(&dev) != hipSuccess || hipDeviceGetAttribute(&cus, hipDeviceAttributeMultiprocessorCount, dev) != hipSuccess) { grid = -1; return; }
        if (hipFuncSetAttribute((const void*)hymba_fwd, hipFuncAttributeMaxDynamicSharedMemorySize, LDS_BYTES) != hipSuccess) { fprintf(stderr, "kernel_launch: hipFuncSetAttribute failed\n"); grid = -1; return; }
        if (hipOccupancyMaxActiveBlocksPerMultiprocessor(&per_cu, (const void*)hymba_fwd, NWAVES * 64, LDS_BYTES) != hipSuccess || per_cu < 1) fprintf(stderr, "kernel_launch: occupancy query says %d blocks per CU\n", per_cu);
        (void)hipGetLastError();
        grid = cus;
    }
    if (grid < 0) return;
    if (hipMemsetAsync((char*)d_ws + WS_CTL, 0, CTL_ZERO_BYTES, stream) != hipSuccess) { fprintf(stderr, "kernel_launch: memset failed\n"); return; }
    Args a{};
    for (int i = 0; i < 27; ++i) a.p.in[i] = (const float*)d_in[i];
    a.p.out = (float*)d_out; a.p.ws = (unsigned char*)d_ws; a.use_cg = 0; a.pad = 0;
#if MK_N_LAUNCHES == 1
    a.ph_lo = 0; a.ph_hi = N_PHASES;
    void* kargs[] = {&a};
    hipError_t e = hipLaunchCooperativeKernel((const void*)hymba_fwd, dim3(grid), dim3(NWAVES * 64), kargs, LDS_BYTES, stream);
    if (e != hipSuccess) fprintf(stderr, "kernel_launch: cooperative launch failed: %s (grid %d)\n", hipGetErrorString(e), grid);
#else
    for (int li = 0; li < N_PHASES; ++li) { a.ph_lo = li; a.ph_hi = li + 1;
        hipLaunchKernelGGL(hymba_fwd, dim3(grid), dim3(NWAVES * 64), LDS_BYTES, stream, a);
        const hipError_t le = hipPeekAtLastError(); if (le != hipSuccess) { fprintf(stderr, "kernel_launch: launch %d failed: %s\n", li, hipGetErrorName(le)); break; } }
#endif
}
```

```cpp
#include <hip/hip_runtime.h>
#include <cstdio>
#include <cstdint>
namespace pg8 {
#define PG8_LAS __attribute__((address_space(3)))
typedef unsigned short bf16_t;
typedef short bf16x8 __attribute__((ext_vector_type(8)));
typedef float f32x4 __attribute__((ext_vector_type(4)));
typedef unsigned u32x4 __attribute__((ext_vector_type(4)));
constexpr int BM = 256, BK = 64, HALF = 128, HTB = HALF * BK * 2  , STAGE_BYTES = 8 * HTB, NXCD = 8, WGM = 8;

__host__ __device__ __forceinline__ int lds_byte(int r, int c) { const int st = (r >> 4) * 2 + (c >> 5), rr = r & 15, cc = c & 31, ob = rr * 64 + cc * 2; return st * 1024 + (ob ^ (((ob >> 9) & 1) << 5)); }
__host__ __device__ __forceinline__ void stage_rc(int b, int& R, int& C) { const int st = b / 1024, sb = b % 1024, swz = sb ^ (((sb >> 9) & 1) << 5); R = (st >> 1) * 16 + swz / 64; C = (st & 1) * 32 + (swz % 64) / 2; }
__host__ __device__ __forceinline__ int perm32(int rho) { const int n = rho >> 4, i = rho & 15; return 8 * (i >> 2) + 4 * n + (i & 3); }

struct Unit { int pm, pn; };
struct Gemm { const bf16_t* A; const bf16_t* Bt; int M, N, K; };

struct StaticOrder {
    int nM, nN, nwg, G, c;
    __host__ __device__ void init(int M, int N, int G_, int c_) { nM = M / BM; nN = N / BM; nwg = nM * nN; G = G_; c = c_; }
    __host__ __device__ bool next(int i, Unit& u) const {
        const long L = (long)i * G + c; if (L >= nwg) return false;
        int wgid = (int)L; { const int q = nwg / NXCD, r = nwg % NXCD, xcd = wgid % NXCD, off = wgid / NXCD; wgid = (xcd < r ? xcd * (q + 1) : r * (q + 1) + (xcd - r) * q) + off; }
        const int nig = WGM * nN, gid = wgid / nig, fm = gid * WGM, gsz = (nM - fm) < WGM ? (nM - fm) : WGM;
        u.pm = fm + ((wgid % nig) % gsz); u.pn = (wgid % nig) / gsz; return true;
    }
    __device__ __forceinline__ void a_ready(const Unit&) const {}
    __device__ __forceinline__ void done(const Unit&) const {}
};

__device__ __forceinline__ unsigned cvt_pk_bf16(float lo, float hi) { unsigned r; asm volatile("v_cvt_pk_bf16_f32 %0, %1, %2" : "=v"(r) : "v"(lo), "v"(hi)); return r; }
typedef float f32x2 __attribute__((ext_vector_type(2)));
typedef unsigned u32x2 __attribute__((ext_vector_type(2)));
__device__ __forceinline__ float rstd_from16(const float* ssq, int row) {
    const f32x4* p = (const f32x4*)(ssq + (size_t)row * 16);
    const f32x4 a = p[0], b = p[1], c = p[2], d = p[3];
    const float s = ((a[0] + a[1]) + (a[2] + a[3])) + ((b[0] + b[1]) + (b[2] + b[3])) + ((c[0] + c[1]) + (c[2] + c[3])) + ((d[0] + d[1]) + (d[2] + d[3]));
    return __builtin_amdgcn_rsqf(s * (1.0f / 1024.0f) + 1e-5f);
}
__device__ __forceinline__ float silu_mul(float g, float u) { return g * __builtin_amdgcn_rcpf(1.0f + __builtin_amdgcn_exp2f(-1.4426950408889634f * g)) * u; }
struct EpiSwiglu {
    static constexpr bool PERM = true, AFTER_DRAIN = false;
    bf16_t* U; const float* ssq; int ldu;
    __device__ __forceinline__ void operator()(const f32x4 (&acc)[2][2][4][2], const Unit& u, int wr, int wc, int fr, int fq) const {
        const int row0 = u.pm * BM + wr * 64 + fr, col0 = u.pn * HALF + wc * 32 + 8 * fq;
#pragma unroll
        for (int ai = 0; ai < 2; ++ai)
#pragma unroll
            for (int m = 0; m < 4; ++m) { const int row = row0 + ai * HALF + m * 16; const float rs = rstd_from16(ssq, row);
                const f32x4 g0 = acc[ai][0][m][0] * rs, g1 = acc[ai][0][m][1] * rs, u0 = acc[ai][1][m][0] * rs, u1 = acc[ai][1][m][1] * rs;
                u32x4 w; w.x = cvt_pk_bf16(silu_mul(g0[0], u0[0]), silu_mul(g0[1], u0[1])); w.y = cvt_pk_bf16(silu_mul(g0[2], u0[2]), silu_mul(g0[3], u0[3]));
                w.z = cvt_pk_bf16(silu_mul(g1[0], u1[0]), silu_mul(g1[1], u1[1])); w.w = cvt_pk_bf16(silu_mul(g1[2], u1[2]), silu_mul(g1[3], u1[3]));
                *(u32x4*)(U + (size_t)row * ldu + col0) = w; }
    }
};
struct EpiZ {
    static constexpr bool PERM = true, AFTER_DRAIN = false;
    bf16_t* Z; const float* ssq; const float* bias; int ldz, ncols, bias_from;
    __device__ __forceinline__ void operator()(const f32x4 (&acc)[2][2][4][2], const Unit& u, int wr, int wc, int fr, int fq) const {
        const int row0 = u.pm * BM + wr * 64 + fr, col0 = u.pn * BM + wc * 32 + 8 * fq;
        f32x4 bv[2][2];
#pragma unroll
        for (int bj = 0; bj < 2; ++bj)
#pragma unroll
            for (int n = 0; n < 2; ++n) { const int c = col0 + bj * HALF + 4 * n; bv[bj][n] = (c >= bias_from && c < ncols) ? *(const f32x4*)(bias + (c - bias_from)) : (f32x4){0.f, 0.f, 0.f, 0.f}; }
#pragma unroll
        for (int ai = 0; ai < 2; ++ai)
#pragma unroll
            for (int m = 0; m < 4; ++m) { const int row = row0 + ai * HALF + m * 16; const float rs = rstd_from16(ssq, row);
#pragma unroll
                for (int bj = 0; bj < 2; ++bj) { const int c = col0 + bj * HALF; if (c < ncols) {
                    const f32x4 v0 = acc[ai][bj][m][0] * rs + bv[bj][0], v1 = acc[ai][bj][m][1] * rs + bv[bj][1];
                    u32x4 w; w.x = cvt_pk_bf16(v0[0], v0[1]); w.y = cvt_pk_bf16(v0[2], v0[3]); w.z = cvt_pk_bf16(v1[0], v1[1]); w.w = cvt_pk_bf16(v1[2], v1[3]);
                    *(u32x4*)(Z + (size_t)row * ldz + c) = w; } } }
    }
};
template <bool WB> struct EpiResid {
    static constexpr bool PERM = false, AFTER_DRAIN = false;
    const float* base; float* out; bf16_t* outb; float* ssq; float scale;
    __device__ __forceinline__ void operator()(const f32x4 (&acc)[2][2][4][2], const Unit& u, int wr, int wc, int fr, int fq) const {
        const int row0 = u.pm * BM + wr * 64 + fr, col0 = u.pn * BM + wc * 32 + 4 * fq;
#pragma unroll
        for (int ai = 0; ai < 2; ++ai)
#pragma unroll
            for (int m = 0; m < 4; ++m) { const int row = row0 + ai * HALF + m * 16; const size_t off = (size_t)row * 1024 + col0; float ss = 0.f;
#pragma unroll
                for (int bj = 0; bj < 2; ++bj)
#pragma unroll
                    for (int n = 0; n < 2; ++n) { const size_t o2 = off + bj * HALF + n * 16; const f32x4 bs = *(const f32x4*)(base + o2); const f32x4 o = bs + acc[ai][bj][m][n] * scale;
                        *(f32x4*)(out + o2) = o; ss += (o[0] * o[0] + o[1] * o[1]) + (o[2] * o[2] + o[3] * o[3]);
                        if (WB) { u32x2 w; w.x = cvt_pk_bf16(o[0], o[1]); w.y = cvt_pk_bf16(o[2], o[3]); *(u32x2*)(outb + o2) = w; } }
                ss += __shfl_xor(ss, 16); ss += __shfl_xor(ss, 32);
                if (fq == 0) ssq[(size_t)row * 16 + u.pn * 4 + wc] = ss; }
    }
};
template <class Epi, class Sched, bool ALIGN_EPI = false, bool SP2 = false>
__device__ __forceinline__ void gemm_phase(PG8_LAS unsigned char* lds, const Gemm g, const Sched& S, const Epi& E) {
    const int tid = threadIdx.x, wid = __builtin_amdgcn_readfirstlane(tid >> 6), lane = tid & 63, wr = wid >> 2, wc = wid & 3, fr = lane & 15, fq = lane >> 4;
    const int K = g.K, nt = K / BK;
    unsigned voffA[2], voffB[2];
#pragma unroll
    for (int i = 0; i < 2; ++i) { int R, C; stage_rc(tid * 16 + i * 8192, R, C); const int Rb = Epi::PERM ? ((R & ~31) + perm32(R & 31)) : R;
        voffA[i] = (unsigned)(R * K + C) * 2u; voffB[i] = (unsigned)(Rb * K + C) * 2u; }
    const size_t kstep = (size_t)(BK * 2);
    const size_t hstep = (size_t)HALF * K * 2;
    const size_t tstep = 2 * hstep;
    const unsigned ldsw = (unsigned)wid * 1024u;
    const int aoff = lds_byte(wr * 64 + fr, fq * 8), boff = lds_byte(wc * 32 + fr, fq * 8);
#define PG8_SA(b, h) (((b) * 2 + (h)) * HTB)
#define PG8_SB(b, h) ((4 + (b) * 2 + (h)) * HTB)
#define PG8_STAGE(bufoff, gbase, voff) do { _Pragma("unroll") for (int _i = 0; _i < 2; ++_i) \
        __builtin_amdgcn_global_load_lds((const unsigned*)((const char*)(gbase) + (voff)[_i]), (PG8_LAS unsigned*)(lds + (bufoff) + ldsw + _i * 8192), 16, 0, 0); } while (0)
#define PG8_LDA(dst, b, h) do { _Pragma("unroll") for (int m = 0; m < 4; ++m) _Pragma("unroll") for (int k = 0; k < 2; ++k) dst[m][k] = *(const PG8_LAS bf16x8*)(lds + PG8_SA(b, h) + aoff + m * 2048 + k * 1024); } while (0)
#define PG8_LDB(dst, b, h) do { _Pragma("unroll") for (int n = 0; n < 2; ++n) _Pragma("unroll") for (int k = 0; k < 2; ++k) dst[n][k] = *(const PG8_LAS bf16x8*)(lds + PG8_SB(b, h) + boff + n * 2048 + k * 1024); } while (0)
#define PG8_MMA(ai, bj, At, Bt) do { __builtin_amdgcn_s_setprio(1); _Pragma("unroll") for (int m = 0; m < 4; ++m) _Pragma("unroll") for (int n = 0; n < 2; ++n) _Pragma("unroll") for (int k = 0; k < 2; ++k) \
        acc[ai][bj][m][n] = __builtin_amdgcn_mfma_f32_16x16x32_bf16(Bt[n][k], At[m][k], acc[ai][bj][m][n], 0, 0, 0); __builtin_amdgcn_s_setprio(0); } while (0)
#define PG8_WAIT_V(n) asm volatile("s_waitcnt vmcnt(" #n ")" ::: "memory")
#define PG8_WAIT_L(n) asm volatile("s_waitcnt lgkmcnt(" #n ")" ::: "memory")
#define PG8_BAR __builtin_amdgcn_s_barrier()
#define PG8_SCHED __builtin_amdgcn_sched_barrier(0)
    Unit cur, nxt; int ui = 0;
    if (!S.next(0, cur)) return;
    f32x4 acc[2][2][4][2];
#pragma unroll
    for (int a = 0; a < 2; ++a)
#pragma unroll
        for (int b = 0; b < 2; ++b)
#pragma unroll
            for (int m = 0; m < 4; ++m)
#pragma unroll
                for (int n = 0; n < 2; ++n) acc[a][b][m][n] = (f32x4){0.f, 0.f, 0.f, 0.f};
    bf16x8 At[4][2], B0[2][2], B1[2][2];
    const char* cA = (const char*)g.A + (size_t)cur.pm * tstep; const char* cB = (const char*)g.Bt + (size_t)cur.pn * tstep;
    S.a_ready(cur);
    if constexpr (SP2) {
        PG8_STAGE(PG8_SB(0, 0), cB, voffB); PG8_STAGE(PG8_SB(0, 1), cB + hstep, voffB); PG8_STAGE(PG8_SA(0, 0), cA, voffA); PG8_STAGE(PG8_SA(0, 1), cA + hstep, voffA);
        if (wr == 1) PG8_BAR;
        PG8_WAIT_V(2); PG8_BAR;
        PG8_STAGE(PG8_SB(1, 0), cB + kstep, voffB); PG8_STAGE(PG8_SA(1, 0), cA + kstep, voffA); PG8_STAGE(PG8_SB(1, 1), cB + hstep + kstep, voffB);
        PG8_WAIT_V(6); PG8_BAR;
    } else {
        PG8_STAGE(PG8_SB(0, 0), cB, voffB); PG8_STAGE(PG8_SA(0, 0), cA, voffA); PG8_STAGE(PG8_SB(0, 1), cB + hstep, voffB); PG8_STAGE(PG8_SA(0, 1), cA + hstep, voffA);
        if (wr == 1) PG8_BAR;
        PG8_WAIT_V(4); PG8_BAR;
        PG8_STAGE(PG8_SB(1, 0), cB + kstep, voffB); PG8_STAGE(PG8_SA(1, 0), cA + kstep, voffA); PG8_STAGE(PG8_SB(1, 1), cB + hstep + kstep, voffB);
        PG8_WAIT_V(6); PG8_BAR;
    }
    for (;;) {
        const bool has_next = S.next(ui + 1, nxt);
        const char* nA = has_next ? (const char*)g.A + (size_t)nxt.pm * tstep : cA; const char* nB = has_next ? (const char*)g.Bt + (size_t)nxt.pn * tstep : cB;
        for (int t = 0; t < nt; t += 2) {
            const bool last = (t == nt - 2);
            const char* a1 = cA + (size_t)(t + 1) * kstep;
            const char* a2 = last ? nA : cA + (size_t)(t + 2) * kstep; const char* b2 = last ? nB : cB + (size_t)(t + 2) * kstep;
            const char* a3 = a2 + kstep; const char* b3 = b2 + kstep;
            if (last && has_next) S.a_ready(nxt);
            if constexpr (SP2) {
            PG8_LDB(B0, 0, 0); PG8_LDB(B1, 0, 1); PG8_SCHED; PG8_LDA(At, 0, 0); PG8_STAGE(PG8_SA(1, 1), a1 + hstep, voffA);
            PG8_WAIT_V(8); PG8_WAIT_L(0); PG8_BAR; PG8_MMA(0, 0, At, B0); PG8_MMA(0, 1, At, B1); PG8_BAR; PG8_SCHED;
            PG8_LDA(At, 0, 1); PG8_STAGE(PG8_SB(0, 0), b2, voffB); PG8_STAGE(PG8_SB(0, 1), b2 + hstep, voffB); PG8_STAGE(PG8_SA(0, 0), a2, voffA);
            PG8_WAIT_V(8); PG8_WAIT_L(0); PG8_BAR; PG8_MMA(1, 0, At, B0); PG8_MMA(1, 1, At, B1); PG8_BAR; PG8_SCHED;
            PG8_LDB(B0, 1, 0); PG8_LDB(B1, 1, 1); PG8_SCHED; PG8_LDA(At, 1, 0); PG8_STAGE(PG8_SA(0, 1), a2 + hstep, voffA);
            PG8_WAIT_V(8); PG8_WAIT_L(0); PG8_BAR; PG8_MMA(0, 0, At, B0); PG8_MMA(0, 1, At, B1); PG8_BAR; PG8_SCHED;
            PG8_LDA(At, 1, 1); PG8_STAGE(PG8_SB(1, 0), b3, voffB); PG8_STAGE(PG8_SB(1, 1), b3 + hstep, voffB); PG8_STAGE(PG8_SA(1, 0), a3, voffA);
            PG8_WAIT_V(8); PG8_WAIT_L(0); PG8_BAR; PG8_MMA(1, 0, At, B0); PG8_MMA(1, 1, At, B1); PG8_BAR; PG8_SCHED;
            } else {
            PG8_LDB(B0, 0, 0); PG8_SCHED; PG8_LDA(At, 0, 0); PG8_STAGE(PG8_SA(1, 1), a1 + hstep, voffA);
            PG8_WAIT_L(8); PG8_BAR; PG8_WAIT_L(0); PG8_MMA(0, 0, At, B0); PG8_BAR; PG8_SCHED;
            PG8_LDB(B1, 0, 1); PG8_STAGE(PG8_SB(0, 0), b2, voffB);
            PG8_BAR; PG8_WAIT_L(0); PG8_MMA(0, 1, At, B1); PG8_BAR;
            PG8_LDA(At, 0, 1); PG8_STAGE(PG8_SA(0, 0), a2, voffA);
            PG8_BAR; PG8_WAIT_L(0); PG8_MMA(1, 0, At, B0); PG8_BAR; PG8_SCHED;
            PG8_STAGE(PG8_SB(0, 1), b2 + hstep, voffB);
            PG8_WAIT_V(6); PG8_BAR; PG8_MMA(1, 1, At, B1); PG8_BAR;
            PG8_LDB(B0, 1, 0); PG8_SCHED; PG8_LDA(At, 1, 0); PG8_STAGE(PG8_SA(0, 1), a2 + hstep, voffA);
            PG8_WAIT_L(8); PG8_BAR; PG8_WAIT_L(0); PG8_MMA(0, 0, At, B0); PG8_BAR; PG8_SCHED;
            PG8_LDB(B1, 1, 1); PG8_STAGE(PG8_SB(1, 0), b3, voffB);
            PG8_BAR; PG8_WAIT_L(0); PG8_MMA(0, 1, At, B1); PG8_BAR;
            PG8_LDA(At, 1, 1); PG8_STAGE(PG8_SA(1, 0), a3, voffA);
            PG8_BAR; PG8_WAIT_L(0); PG8_MMA(1, 0, At, B0); PG8_BAR; PG8_SCHED;
            PG8_STAGE(PG8_SB(1, 1), b3 + hstep, voffB);
            PG8_WAIT_V(6); PG8_BAR; PG8_MMA(1, 1, At, B1); PG8_BAR;
            }
        }
        if constexpr (ALIGN_EPI) { if (wr == 0) PG8_BAR; }
        if constexpr (!Epi::AFTER_DRAIN) { E(acc, cur, wr, wc, fr, fq); S.done(cur); }
        if (!has_next) break;
#pragma unroll
        for (int a = 0; a < 2; ++a)
#pragma unroll
            for (int b = 0; b < 2; ++b)
#pragma unroll
                for (int m = 0; m < 4; ++m)
#pragma unroll
                    for (int n = 0; n < 2; ++n) acc[a][b][m][n] = (f32x4){0.f, 0.f, 0.f, 0.f};
        cur = nxt; cA = nA; cB = nB; ++ui;
        if constexpr (ALIGN_EPI) { if (wr == 1) PG8_BAR; }
    }
    PG8_WAIT_V(0);
    if constexpr (!ALIGN_EPI) { if (wr == 0) PG8_BAR; }
    PG8_BAR;
    if constexpr (Epi::AFTER_DRAIN) { E.fused(acc, cur, wr, wc, fr, fq, lds, wid, lane); S.done(cur); }
#undef PG8_SA
#undef PG8_SB
#undef PG8_STAGE
#undef PG8_LDA
#undef PG8_LDB
#undef PG8_MMA
#undef PG8_WAIT_V
#undef PG8_WAIT_L
#undef PG8_BAR
#undef PG8_SCHED
}
}
#include <hip/hip_cooperative_groups.h>
namespace cg = cooperative_groups;
constexpr int NWAVES = 8;
constexpr int MR = 32768, DM = 1024, FF = 2816, NGU = 5632, NIN = 2464, NINP = 2560, TSEQ = 4096, NBATCH = 8, NHEAD = 8, NMETA = 16;
constexpr int ZC_W = 1536, ZC_Q = 1696, ZC_K = 2208, ZC_V = 2336;
constexpr int PV = 320;
constexpr size_t MiB = 1u << 20;
constexpr size_t WS_CTL = 0, CTL_ZERO_BYTES = 1 * MiB;
constexpr size_t WS_WGU1 = 2 * MiB, WS_WD1 = 13 * MiB, WS_WIN = 19 * MiB, WS_WOUT = 24 * MiB, WS_WGU2 = 26 * MiB, WS_WD2 = 37 * MiB, WS_LT = 43 * MiB;
constexpr size_t WS_SSQ1 = 44 * MiB, WS_SSQ2 = 46 * MiB, WS_SSQ3 = 48 * MiB, WS_SSQ4 = 50 * MiB, WS_META = 52 * MiB;
constexpr size_t MO_XMB = 0, MO_UM = 64 * 1024, MO_H1MB = 256 * 1024, MO_SSQM1 = 320 * 1024, MO_SSQM2 = 324 * 1024, MO_ZM = 384 * 1024, MO_PM = 512 * 1024;
constexpr size_t WS_XB = 56 * MiB, WS_BIG = 120 * MiB, WS_IMG = 274 * MiB, WS_P = 296 * MiB, WS_END = 507 * MiB;
constexpr int CW_BAR = 4096;
constexpr int RING_BYTES = 131072, LDSCTL_OFF = 143360, MISC_OFF = LDSCTL_OFF + 320, LDS_BYTES = 147456;

#define GAS __attribute__((address_space(1)))
#define LAS __attribute__((address_space(3)))
typedef unsigned short bf16;
typedef unsigned v4u __attribute__((ext_vector_type(4)));
typedef unsigned v2u __attribute__((ext_vector_type(2)));
typedef float f32x4 __attribute__((ext_vector_type(4)));
typedef float f32x2 __attribute__((ext_vector_type(2)));
typedef short bf16x8 __attribute__((ext_vector_type(8)));
typedef short bf16x4 __attribute__((ext_vector_type(4)));
typedef GAS unsigned gu32;
#define LDS_WAIT() asm volatile("s_waitcnt lgkmcnt(0)" ::: "memory")
__device__ __forceinline__ unsigned f2bf(float f) { unsigned u = __builtin_bit_cast(unsigned, f); return (u + 0x7fffu + ((u >> 16) & 1u)) >> 16; }
typedef __bf16 bf16x2_t __attribute__((ext_vector_type(2)));
__device__ __forceinline__ unsigned pk2m(float lo, float hi) { f32x2 v = {lo, hi}; bf16x2_t b = __builtin_convertvector(v, bf16x2_t); return __builtin_bit_cast(unsigned, b); }
__device__ __forceinline__ unsigned pk2(float lo, float hi) { return pg8::cvt_pk_bf16(lo, hi); }
__device__ __forceinline__ float bflo(unsigned w) { return __builtin_bit_cast(float, w << 16); }
__device__ __forceinline__ float bfhi(unsigned w) { return __builtin_bit_cast(float, w & 0xffff0000u); }
__device__ __forceinline__ f32x4 unpack4(v2u w) { return (f32x4){bflo(w.x), bfhi(w.x), bflo(w.y), bfhi(w.y)}; }
__device__ __forceinline__ float sigmoidf_(float x) { return __builtin_amdgcn_rcpf(1.0f + __builtin_amdgcn_exp2f(-1.4426950408889634f * x)); }
__device__ __forceinline__ float tanhf_(float x) { return 2.0f * sigmoidf_(2.0f * x) - 1.0f; }
#define XB_TMO      128
#define XB_XCNT(j)  (256  + 64 * (j))
#define XB_XSUB(j)  (1280 + 64 * (j))
#define XB_XGEN(j)  (2304 + 64 * (j))
#define XB_TOP      3328
#define XB_TOPGEN   3392
#define XCD_BAR_WORDS 3456
#define XB_SPIN_CAP (1u << 18)

__device__ __forceinline__ unsigned xb_ld(unsigned* p)              { return __hip_atomic_load(p, __ATOMIC_RELAXED, __HIP_MEMORY_SCOPE_AGENT); }
__device__ __forceinline__ unsigned xb_add(unsigned* p, unsigned v) { return __hip_atomic_fetch_add(p, v, __ATOMIC_RELAXED, __HIP_MEMORY_SCOPE_AGENT); }
__device__ __forceinline__ unsigned xb_xcc_id() { return (unsigned)__builtin_amdgcn_s_getreg((3 << 11) | 20) & 0xFu; }
#define XB_SPIN(cond, bar) do { unsigned _sp = 0; while (cond) { __builtin_amdgcn_s_sleep(1); \
    if ((++_sp & 255u) == 0u) { if (xb_ld(&(bar)[XB_TMO])) break; if (_sp > XB_SPIN_CAP) { atomicAdd(&(bar)[XB_TMO], 1u); break; } } } } while (0)

struct XcdBarrier {
    unsigned* bar; unsigned x;
    volatile LAS unsigned* st;
};

__device__ __forceinline__ XcdBarrier xcd_barrier_post(unsigned* bar, volatile LAS unsigned* st) {
    XcdBarrier b; b.bar = bar; b.x = xb_xcc_id(); b.st = st;
    if (threadIdx.x == 0) (void)xb_add(&bar[XB_XCNT(b.x)], 1u);
    return b;
}
__device__ __forceinline__ void xcd_barrier_complete(unsigned* bar, unsigned x, unsigned& nloc, unsigned& nx) {
    const unsigned G = gridDim.x * gridDim.y * gridDim.z;
    unsigned sum, cnt, mine, sp = 0u;
    for (;;) {
        sum = 0u; cnt = 0u; mine = 0u;
#pragma unroll
        for (unsigned j = 0; j < 16; ++j) { const unsigned c = xb_ld(&bar[XB_XCNT(j)]); sum += c; cnt += (c > 0u) ? 1u : 0u; mine = (j == x) ? c : mine; }
        if (sum == G) break;
        __builtin_amdgcn_s_sleep(1);
        if ((++sp & 255u) == 0u) { if (xb_ld(&bar[XB_TMO])) break; if (sp > XB_SPIN_CAP) { atomicAdd(&bar[XB_TMO], 1u); break; } }
    }
    nloc = mine > 0u ? mine : 1u; nx = cnt > 0u ? cnt : 1u;
}

__device__ __forceinline__ void xcd_barrier(const XcdBarrier& b) {
    asm volatile("s_waitcnt vmcnt(0)" ::: "memory");
    __syncthreads();
    if (threadIdx.x == 0) {
        unsigned* bar = b.bar;
        __builtin_amdgcn_s_waitcnt(0);
        unsigned nloc = b.st[0], nx = b.st[1];
        if (nloc == 0u) { xcd_barrier_complete(bar, b.x, nloc, nx); b.st[0] = nloc; b.st[1] = nx; }
        const unsigned old = xb_add(&bar[XB_XSUB(b.x)], 1u);
        const unsigned gen = old / nloc;
        if (old + 1u == (gen + 1u) * nloc) {
            __builtin_amdgcn_fence(__ATOMIC_RELEASE, "agent");
            asm volatile("s_waitcnt vmcnt(0)" ::: "memory");
            const unsigned og = xb_add(&bar[XB_TOP], 1u);
            const unsigned tg = og / nx;
            if (og + 1u == (tg + 1u) * nx) xb_add(&bar[XB_TOPGEN], 1u);
            else XB_SPIN(xb_ld(&bar[XB_TOPGEN]) == tg, bar);
            __builtin_amdgcn_fence(__ATOMIC_ACQUIRE, "agent");
            xb_add(&bar[XB_XGEN(b.x)], 1u);
            asm volatile("s_waitcnt vmcnt(0)" ::: "memory");
        } else {
            XB_SPIN(xb_ld(&bar[XB_XGEN(b.x)]) == gen, bar);
            __builtin_amdgcn_fence(__ATOMIC_ACQUIRE, "agent");
            asm volatile("s_waitcnt vmcnt(0)" ::: "memory");
        }
    }
    __syncthreads();
}
__device__ __forceinline__ float wave_sum(float v) {
#pragma unroll
    for (int o = 1; o < 64; o <<= 1) v += __shfl_xor(v, o);
    return v;
}
__device__ __forceinline__ void p0_transpose_item(const float* W, int K, int N, bf16* WT, const float* gain, int k0, int n0, int drow0, LAS float* scr, int lane) {
#pragma unroll 8
    for (int i = 0; i < 32; ++i) { const int kk = 2 * i + (lane >> 5); float w = W[(size_t)(k0 + kk) * N + n0 + (lane & 31)]; if (gain) w *= gain[k0 + kk]; scr[kk * 33 + (lane & 31)] = w; }
    LDS_WAIT(); asm volatile("" ::: "memory");
    const int c = lane & 7;
#pragma unroll
    for (int j = 0; j < 4; ++j) { const int n = (lane >> 3) + 8 * j; const LAS float* s = scr + (8 * c) * 33 + n;
        v4u o; o.x = pk2(s[0 * 33], s[1 * 33]); o.y = pk2(s[2 * 33], s[3 * 33]); o.z = pk2(s[4 * 33], s[5 * 33]); o.w = pk2(s[6 * 33], s[7 * 33]);
        *(GAS v4u*)(WT + (size_t)(drow0 + n) * K + k0 + 8 * c) = o; }
    LDS_WAIT(); asm volatile("" ::: "memory");
}
__device__ __forceinline__ void row_to_bf16(const float* xrow, bf16* orow, float* ssq16, int lane) {
    const GAS f32x4* xr = (const GAS f32x4*)xrow + lane; f32x4 v[4]; float s = 0.f;
#pragma unroll
    for (int j = 0; j < 4; ++j) { v[j] = xr[64 * j]; s += (v[j].x * v[j].x + v[j].y * v[j].y) + (v[j].z * v[j].z + v[j].w * v[j].w); }
    s = wave_sum(s);
    GAS v2u* o8 = (GAS v2u*)orow + lane;
#pragma unroll
    for (int j = 0; j < 4; ++j) { v2u w; w.x = pk2(v[j].x, v[j].y); w.y = pk2(v[j].z, v[j].w); o8[64 * j] = w; }
    if (lane < 16) ssq16[lane] = (lane == 0) ? s : 0.f;
}
struct Ptrs {
    const float* in[27]; float* out; unsigned char* ws;
};
__device__ __forceinline__ void p0_prologue(const Ptrs& P, LAS unsigned char* lds, int vcu, int G, int wave, int lane) {
    LAS float* scr = (LAS float*)(lds + wave * 16384);
    const int gw = vcu * NWAVES + wave, NGW = G * NWAVES;
    unsigned char* ws = P.ws;
    constexpr int I_G = (DM / 64) * (FF / 32), I_D = (FF / 64) * (DM / 32), I_IN = (DM / 64) * (NIN / 32), I_O = (DM / 64) * (DM / 32);
    constexpr int NITEMS = 4 * I_G + 2 * I_D + I_IN + I_O;
    for (int it = gw; it < NITEMS; it += NGW) {
        int r = it;
        if (r < 4 * I_G) {
            const int which = r / I_G; r -= which * I_G; const int nblk = FF / 32, kb = r / nblk, nb = r % nblk, n0 = 32 * nb;
            const float* W = P.in[which == 0 ? 3 : which == 1 ? 4 : which == 2 ? 23 : 24]; const float* gain = P.in[which < 2 ? 2 : 22];
            bf16* WT = (bf16*)(ws + (which < 2 ? WS_WGU1 : WS_WGU2));
            const int drow0 = 256 * (n0 / 128) + 128 * (which & 1) + (n0 % 128);
            p0_transpose_item(W, DM, FF, WT, gain, 64 * kb, n0, drow0, scr, lane); continue; }
        r -= 4 * I_G;
        if (r < 2 * I_D) { const int which = r / I_D; r -= which * I_D; const int nblk = DM / 32, kb = r / nblk, nb = r % nblk;
            p0_transpose_item(P.in[which ? 25 : 5], FF, DM, (bf16*)(ws + (which ? WS_WD2 : WS_WD1)), nullptr, 64 * kb, 32 * nb, 32 * nb, scr, lane); continue; }
        r -= 2 * I_D;
        if (r < I_IN) { const int nblk = NIN / 32, kb = r / nblk, nb = r % nblk;
            p0_transpose_item(P.in[7], DM, NIN, (bf16*)(ws + WS_WIN), P.in[6], 64 * kb, 32 * nb, 32 * nb, scr, lane); continue; }
        r -= I_IN;
        { const int nblk = DM / 32, kb = r / nblk, nb = r % nblk;
            p0_transpose_item(P.in[21], DM, DM, (bf16*)(ws + WS_WOUT), nullptr, 64 * kb, 32 * nb, 32 * nb, scr, lane); }
    }
    { GAS v4u* z = (GAS v4u*)(ws + WS_WIN + (size_t)NIN * DM * 2); const int n16 = (NINP - NIN) * DM * 2 / 16;
      for (int i = gw * 64 + lane; i < n16; i += NGW * 64) z[i] = (v4u){0u, 0u, 0u, 0u}; }
    { bf16* LT = (bf16*)(ws + WS_LT);
      for (int i = gw * 64 + lane; i < 512 * 160; i += NGW * 64) { const int n = i / 160, j = i % 160;
          const float v = j < 32 ? P.in[11][j * 512 + n] : j < 64 ? P.in[13][(j - 32) * 512 + n] : P.in[14][(j - 64) * 512 + n];
          LT[i] = (bf16)f2bf(v); } }
    for (int m = gw; m < MR + NMETA; m += NGW) {
        if (m < MR) row_to_bf16(P.in[0] + (size_t)m * DM, (bf16*)(ws + WS_XB) + (size_t)m * DM, (float*)(ws + WS_SSQ1) + (size_t)m * 16, lane);
        else { const int i = m - MR; row_to_bf16(P.in[1] + (size_t)i * DM, (bf16*)(ws + WS_META + MO_XMB) + (size_t)i * DM, (float*)(ws + WS_META + MO_SSQM1) + i * 16, lane); }
    }
}
__device__ __forceinline__ f32x4 skinny16(const bf16* A, const bf16* Bt, int K, int n0, int lane) {
    const int fr = lane & 15, fq = lane >> 4;
    const bf16* ap = A + (size_t)fr * K + 8 * fq; const bf16* bp = Bt + (size_t)(n0 + fr) * K + 8 * fq;
    f32x4 acc = (f32x4){0.f, 0.f, 0.f, 0.f};
    for (int k = 0; k < K; k += 32) { const bf16x8 a = *(const bf16x8*)(ap + k), b = *(const bf16x8*)(bp + k); acc = __builtin_amdgcn_mfma_f32_16x16x32_bf16(a, b, acc, 0, 0, 0); }
    return acc;
}
__device__ __forceinline__ float rstd_m16(const float* ssq16) { float s = 0.f;
#pragma unroll
    for (int i = 0; i < 16; ++i) s += ssq16[i];
    return __builtin_amdgcn_rsqf(s * (1.0f / 1024.0f) + 1e-5f); }
__device__ __forceinline__ void meta_up(unsigned char* ws, int gw, int NGW, int lane) {
    const bf16* A = (const bf16*)(ws + WS_META + MO_XMB); const bf16* Bt = (const bf16*)(ws + WS_WGU1); bf16* Um = (bf16*)(ws + WS_META + MO_UM);
    const float* ssq = (const float*)(ws + WS_META + MO_SSQM1); const int fr = lane & 15, fq = lane >> 4;
    for (int t = gw; t < FF / 16; t += NGW) { const int c0 = 16 * t, nr = 256 * (c0 / 128) + (c0 % 128);
        const f32x4 g = skinny16(A, Bt, DM, nr, lane), u = skinny16(A, Bt, DM, nr + 128, lane);
#pragma unroll
        for (int r = 0; r < 4; ++r) { const int row = 4 * fq + r; const float rs = rstd_m16(ssq + row * 16); Um[(size_t)row * FF + c0 + fr] = (bf16)f2bf(pg8::silu_mul(g[r] * rs, u[r] * rs)); } }
}
__device__ __forceinline__ void meta_down(const Ptrs& P, int gw, int NGW, int lane) {
    unsigned char* ws = P.ws; const bf16* A = (const bf16*)(ws + WS_META + MO_UM); const bf16* Bt = (const bf16*)(ws + WS_WD1); bf16* H = (bf16*)(ws + WS_META + MO_H1MB);
    float* ssq = (float*)(ws + WS_META + MO_SSQM2); const int fr = lane & 15, fq = lane >> 4;
    for (int t = gw; t < DM / 16; t += NGW) { const f32x4 a = skinny16(A, Bt, FF, 16 * t, lane);
#pragma unroll
        for (int r = 0; r < 4; ++r) { const int row = 4 * fq + r; const float o = P.in[1][row * DM + 16 * t + fr] + 0.5f * a[r]; H[row * DM + 16 * t + fr] = (bf16)f2bf(o);
            float s = o * o; s += __shfl_xor(s, 1); s += __shfl_xor(s, 2); s += __shfl_xor(s, 4); s += __shfl_xor(s, 8); if (fr == 0) ssq[row * 64 + t] = s; } }
}
__device__ __forceinline__ void meta_win(const Ptrs& P, int gw, int NGW, int lane) {
    unsigned char* ws = P.ws; const bf16* A = (const bf16*)(ws + WS_META + MO_H1MB); const bf16* Bt = (const bf16*)(ws + WS_WIN); bf16* Zm = (bf16*)(ws + WS_META + MO_ZM);
    const float* ssq = (const float*)(ws + WS_META + MO_SSQM2); const int fr = lane & 15, fq = lane >> 4;
    for (int t = gw; t < NIN / 16; t += NGW) { const f32x4 a = skinny16(A, Bt, DM, 16 * t, lane); const int c = 16 * t + fr; const float bias = c >= ZC_Q ? P.in[8][c - ZC_Q] : 0.f;
#pragma unroll
        for (int r = 0; r < 4; ++r) { const int row = 4 * fq + r; float s = 0.f;
#pragma unroll 8
            for (int i = 0; i < 64; ++i) s += ssq[row * 64 + i];
            Zm[(size_t)row * NIN + c] = (bf16)f2bf(a[r] * __builtin_amdgcn_rsqf(s * (1.0f / 1024.0f) + 1e-5f) + bias); } }
}
constexpr int KS_LD = 72, VT_LD = 232, ATT_KS_BYTES = 208 * KS_LD * 2, ATT_VT_BYTES = 64 * VT_LD * 2;
__device__ __forceinline__ void attn_unit(const Ptrs& P, unsigned char* lds, int b, int g, int c, int tid, int wave, int lane) {
    unsigned char* ws = P.ws; const bf16* Z = (const bf16*)(ws + WS_BIG); const bf16* Zm = (const bf16*)(ws + WS_META + MO_ZM); bf16* Y = (bf16*)(ws + WS_XB);
    bf16* Ks = (bf16*)lds; bf16* Vt = (bf16*)(lds + ATT_KS_BYTES);
    const int fr = lane & 15, fq = lane >> 4;
    __syncthreads();
    for (int it = tid; it < 208 * 8; it += NWAVES * 64) { const int key = it >> 3, pc = it & 7; const bf16* src; bool valid = true;
        if (key < 16) src = Zm + (size_t)key * NIN; else { const int t = 64 * (c - 2) + (key - 16); valid = t >= 0; src = Z + ((size_t)b * TSEQ + (valid ? t : 0)) * NIN; }
        v4u kq = *(const v4u*)(src + ZC_K + 64 * g + 8 * pc), vq = *(const v4u*)(src + ZC_V + 64 * g + 8 * pc);
        if (!valid) { kq = (v4u){0u, 0u, 0u, 0u}; vq = kq; }
        *(v4u*)(Ks + key * KS_LD + 8 * pc) = kq;
#pragma unroll
        for (int e = 0; e < 4; ++e) { Vt[(8 * pc + 2 * e) * VT_LD + key] = (bf16)(vq[e] & 0xffffu); Vt[(8 * pc + 2 * e + 1) * VT_LD + key] = (bf16)(vq[e] >> 16); } }
    for (int it = tid; it < 64 * 16; it += NWAVES * 64) Vt[(it >> 4) * VT_LD + 208 + (it & 15)] = 0;
    __syncthreads();
    const int hq = 4 * g + (wave >> 1);
    const float slope = __builtin_amdgcn_exp2f(-(float)(hq + 1)), sink = P.in[20][hq];
#pragma unroll 1
    for (int sub = 0; sub < 2; ++sub) {
        const int i0 = 16 * (2 * (wave & 1) + sub), iq = i0 + fr;
        const size_t mrow = (size_t)b * TSEQ + 64 * c + iq;
        const bf16x8 q0 = *(const bf16x8*)(Z + mrow * NIN + ZC_Q + 64 * hq + 8 * fq), q1 = *(const bf16x8*)(Z + mrow * NIN + ZC_Q + 64 * hq + 32 + 8 * fq);
        f32x4 s[13]; float mx = sink;
#pragma unroll
        for (int kt = 0; kt < 13; ++kt) { const bf16* kp = Ks + (16 * kt + fr) * KS_LD + 8 * fq; f32x4 a = (f32x4){0.f, 0.f, 0.f, 0.f};
            a = __builtin_amdgcn_mfma_f32_16x16x32_bf16(*(const bf16x8*)(kp), q0, a, 0, 0, 0);
            a = __builtin_amdgcn_mfma_f32_16x16x32_bf16(*(const bf16x8*)(kp + 32), q1, a, 0, 0, 0);
#pragma unroll
            for (int r = 0; r < 4; ++r) { const int key = 16 * kt + 4 * fq + r; float v;
                if (kt == 0) v = a[r] * 0.125f - slope * (float)(16 + 64 * c + iq - key);
                else { const int jj = key - 16; const int d = 128 + iq - jj; v = a[r] * 0.125f - slope * (float)(d < 0 ? -d : d); if (64 * (c - 2) + jj < 0) v = -1e30f; }
                a[r] = v; mx = fmaxf(mx, v); }
            s[kt] = a; }
        mx = fmaxf(mx, __shfl_xor(mx, 16)); mx = fmaxf(mx, __shfl_xor(mx, 32));
        float sum = 0.f;
#pragma unroll
        for (int kt = 0; kt < 13; ++kt)
#pragma unroll
            for (int r = 0; r < 4; ++r) { const float p = __builtin_amdgcn_exp2f((s[kt][r] - mx) * 1.4426950408889634f); s[kt][r] = p; sum += p; }
        sum += __shfl_xor(sum, 16); sum += __shfl_xor(sum, 32);
        sum += __builtin_amdgcn_exp2f((sink - mx) * 1.4426950408889634f);
        const float rinv = 1.0f / sum;
        f32x4 o[4];
#pragma unroll
        for (int dt = 0; dt < 4; ++dt) o[dt] = (f32x4){0.f, 0.f, 0.f, 0.f};
#pragma unroll
        for (int ks = 0; ks < 7; ++ks) { const int ta = 2 * ks, tb = 2 * ks + 1; v4u pw;
            pw.x = pk2(s[ta][0], s[ta][1]); pw.y = pk2(s[ta][2], s[ta][3]);
            if (tb < 13) { pw.z = pk2(s[tb][0], s[tb][1]); pw.w = pk2(s[tb][2], s[tb][3]); } else { pw.z = 0u; pw.w = 0u; }
            const bf16x8 pf = __builtin_bit_cast(bf16x8, pw);
#pragma unroll
            for (int dt = 0; dt < 4; ++dt) { const bf16* vp = Vt + (16 * dt + fr) * VT_LD + 4 * fq; const v2u va = *(const v2u*)(vp + 16 * ta), vb = *(const v2u*)(vp + 16 * tb);
                const v4u vv = (v4u){va.x, va.y, vb.x, vb.y};
                o[dt] = __builtin_amdgcn_mfma_f32_16x16x32_bf16(__builtin_bit_cast(bf16x8, vv), pf, o[dt], 0, 0, 0); } }
#pragma unroll
        for (int dt = 0; dt < 4; ++dt) { v2u w; w.x = pk2(o[dt][0] * rinv, o[dt][1] * rinv); w.y = pk2(o[dt][2] * rinv, o[dt][3] * rinv);
            *(v2u*)(Y + mrow * DM + 512 + 64 * hq + 16 * dt + 4 * fq) = w; }
    }
}
template <int CTRL> __device__ __forceinline__ float dppf(float x) { return __builtin_bit_cast(float, __builtin_amdgcn_update_dpp(0, __builtin_bit_cast(int, x), CTRL, 0xF, 0xF, true)); }
template <int CTRL> __device__ __forceinline__ float dppf_old(float old, float x) { return __builtin_bit_cast(float, __builtin_amdgcn_update_dpp(__builtin_bit_cast(int, old), __builtin_bit_cast(int, x), CTRL, 0xF, 0xF, false)); }
__device__ __forceinline__ float red8(float x) { x += dppf<0xB1>(x); x += dppf<0x4E>(x); x += dppf<0x141>(x); return x; }
__device__ __forceinline__ float red16(float x) { x = red8(x); x += dppf<0x140>(x); return x; }
__device__ __forceinline__ float scan16(float x) { x += dppf<0x111>(x); x += dppf<0x112>(x); x += dppf<0x114>(x); x += dppf<0x118>(x); return x; }
constexpr int NCHUNK = 257, NSUPER = 65;
constexpr int CB_A = 0, CB_R = 2048, CB_BK = 4096, CB_VT = 8192, CB_TT = 10240, CB_AR = 11264, CB_G = 12288, CB_BON = 12544, CB_SIZE = 12800;
constexpr int CB_GATE = 12800, IMG_SIZE = 14848;
constexpr int WL_HS = IMG_SIZE, WL_SIZE = IMG_SIZE + 2048;
constexpr int SC_YB = 8 * CB_SIZE, SC_END = SC_YB + 8 * 4096;
static_assert(8 * WL_SIZE <= LDSCTL_OFF && SC_END <= LDSCTL_OFF, "LDS map");
__device__ __forceinline__ bf16x8 pack8(const float* v) { v4u o; o.x = pk2(v[0], v[1]); o.y = pk2(v[2], v[3]); o.z = pk2(v[4], v[5]); o.w = pk2(v[6], v[7]); return __builtin_bit_cast(bf16x8, o); }
__device__ __forceinline__ void unpack8(v4u w, float* v) { v[0] = bflo(w.x); v[1] = bfhi(w.x); v[2] = bflo(w.y); v[3] = bfhi(w.y); v[4] = bflo(w.z); v[5] = bfhi(w.z); v[6] = bflo(w.w); v[7] = bfhi(w.w); }


__device__ __forceinline__ void chunk_task(const Ptrs& P, unsigned char* ldsb, int woff, int b, int h, int ch, int lane) {
    int wo_ = woff; asm volatile("" : "+v"(wo_));
    unsigned char* wl = ldsb + wo_;
    unsigned char* ws = P.ws; const int fr = lane & 15, fq = lane >> 4, t = fr;
    const bf16* Z = (const bf16*)(ws + WS_BIG); const bf16* Zm = (const bf16*)(ws + WS_META + MO_ZM); const bf16* LT = (const bf16*)(ws + WS_LT);
    const bool meta = (ch == 0);
    const int tok = 16 * (ch - 1) + fr; const size_t m = (size_t)b * TSEQ + tok;
    const bf16* zc = meta ? Zm + (size_t)fr * NIN : Z + m * NIN;
    const bool pz = meta && fr == 0;
    const bf16* zp = meta ? Zm + (size_t)(fr > 0 ? fr - 1 : 0) * NIN : (tok == 0 ? Zm + (size_t)15 * NIN : Z + (m - 1) * NIN);
    const float* mu = P.in[9];
    bf16* sx = (bf16*)wl;
    {
    bf16x8 xf[5];
#pragma unroll
    for (int ks = 0; ks < 5; ++ks) { const int c0 = ZC_W + 32 * ks + 8 * fq; const v4u a = *(const v4u*)(zc + c0); v4u bq = *(const v4u*)(zp + c0); if (pz) bq = (v4u){0u, 0u, 0u, 0u};
        float va[8], vb[8], v[8]; unpack8(a, va); unpack8(bq, vb); const f32x4 m0 = *(const f32x4*)(mu + c0), m1 = *(const f32x4*)(mu + c0 + 4);
#pragma unroll
        for (int e = 0; e < 8; ++e) { const float mm = e < 4 ? m0[e & 3] : m1[e & 3]; const float z = va[e] + (vb[e] - va[e]) * mm; v[e] = (ks == 0) ? tanhf_(z) : (ks == 1) ? z : sigmoidf_(z); }
        xf[ks] = pack8(v); }
    f32x4 aw[4], aa[4], ag[4];
#pragma unroll
    for (int nt = 0; nt < 4; ++nt) { const bf16* lp = LT + (size_t)(h * 64 + 16 * nt + fr) * 160 + 8 * fq; const f32x4 z = (f32x4){0.f, 0.f, 0.f, 0.f};
        aw[nt] = __builtin_amdgcn_mfma_f32_16x16x32_bf16(*(const bf16x8*)(lp), xf[0], z, 0, 0, 0);
        aa[nt] = __builtin_amdgcn_mfma_f32_16x16x32_bf16(*(const bf16x8*)(lp + 32), xf[1], z, 0, 0, 0);
        ag[nt] = __builtin_amdgcn_mfma_f32_16x16x32_bf16(*(const bf16x8*)(lp + 64), xf[2], z, 0, 0, 0);
        ag[nt] = __builtin_amdgcn_mfma_f32_16x16x32_bf16(*(const bf16x8*)(lp + 96), xf[3], ag[nt], 0, 0, 0);
        ag[nt] = __builtin_amdgcn_mfma_f32_16x16x32_bf16(*(const bf16x8*)(lp + 128), xf[4], ag[nt], 0, 0, 0); }
    f32x4 kkr[4], kv[4], av[4]; float ss = 0.f;
#pragma unroll
    for (int nt = 0; nt < 4; ++nt) { const int c = h * 64 + 16 * nt + 4 * fq; const v2u a = *(const v2u*)(zc + 512 + c); v2u bq = *(const v2u*)(zp + 512 + c); if (pz) bq = (v2u){0u, 0u};
        const f32x4 za = unpack4(a), zb = unpack4(bq), mk = *(const f32x4*)(mu + 512 + c); const f32x4 zk = za + (zb - za) * mk;
        const f32x4 a0 = *(const f32x4*)(P.in[12] + c), kkw = *(const f32x4*)(P.in[15] + c), kaw = *(const f32x4*)(P.in[16] + c);
        f32x4 a_;
#pragma unroll
        for (int r = 0; r < 4; ++r) a_[r] = sigmoidf_(a0[r] + aa[nt][r]);
        av[nt] = a_; kkr[nt] = zk * kkw; kv[nt] = zk * (1.0f + (a_ - 1.0f) * kaw);
        ss += (kkr[nt][0] * kkr[nt][0] + kkr[nt][1] * kkr[nt][1]) + (kkr[nt][2] * kkr[nt][2] + kkr[nt][3] * kkr[nt][3]); }
    ss += __shfl_xor(ss, 16); ss += __shfl_xor(ss, 32);
    const float inv = 1.0f / fmaxf(sqrtf(ss), 1e-12f);
#pragma unroll
    for (int nt = 0; nt < 4; ++nt) { const int cl = 16 * nt + 4 * fq, c = h * 64 + cl; const f32x4 w0 = *(const f32x4*)(P.in[10] + c);
        const f32x4 kk = kkr[nt] * inv, bb = kk * av[nt]; f32x4 e;
#pragma unroll
        for (int r = 0; r < 4; ++r) e[r] = 0.6065306597126334f * sigmoidf_(w0[r] + aw[nt][r]);
        bf16* px = sx + t * 64 + cl; v2u o;
        o.x = pk2(kk[0], kk[1]); o.y = pk2(kk[2], kk[3]); *(v2u*)(px) = o;
        o.x = pk2(e[0], e[1]); o.y = pk2(e[2], e[3]); *(v2u*)(px + 1024) = o;
        o.x = pk2(bb[0], bb[1]); o.y = pk2(bb[2], bb[3]); *(v2u*)(px + 2048) = o;
        o.x = pk2(kv[nt][0], kv[nt][1]); o.y = pk2(kv[nt][2], kv[nt][3]); *(v2u*)(px + 3072) = o;
        o.x = pk2m(ag[nt][0], ag[nt][1]); o.y = pk2m(ag[nt][2], ag[nt][3]); *(v2u*)(px + 4096) = o; }
    }
    asm volatile("s_waitcnt lgkmcnt(0)" ::: "memory"); __builtin_amdgcn_sched_barrier(0);
    v4u xk[2], xe[2], xb[2], xx[2], xg[2];
#pragma unroll
    for (int ks = 0; ks < 2; ++ks) { const bf16* px = sx + t * 64 + 32 * ks + 8 * fq; xk[ks] = *(const v4u*)(px); xe[ks] = *(const v4u*)(px + 1024); xb[ks] = *(const v4u*)(px + 2048); xx[ks] = *(const v4u*)(px + 3072); xg[ks] = *(const v4u*)(px + 4096); }
    asm volatile("s_waitcnt lgkmcnt(0)" ::: "memory"); __builtin_amdgcn_sched_barrier(0);
    unsigned char* cb = wl; float* hs = (float*)(wl + WL_HS);
    const int cbase = h * 64 + 8 * fq;
    unsigned char* pbk = cb + CB_BK + ((8 * fq * 4 + (t >> 2)) * 8 + (t & 3)) * 2; unsigned char* pvt = cb + CB_VT + (8 * fq * 16 + t) * 2; unsigned char* pgc = cb + CB_G + 8 * fq * 4;
    bf16x8 Af[2], Rf[2], Bf[2], Kf[2]; float bonp = 0.f;
#pragma unroll
    for (int ks = 0; ks < 2; ++ks) { const int c = cbase + 32 * ks, cl = 32 * ks + 8 * fq;
        asm volatile("" ::: "memory"); __builtin_amdgcn_sched_barrier(0);
        float kk[8], e_[8], bb[8], kx[8], rc[8], rp[8], vc[8], vp[8];
        unpack8(xk[ks], kk); unpack8(xe[ks], e_); unpack8(xb[ks], bb); unpack8(xx[ks], kx);
        unpack8(*(const v4u*)(zc + c), rc); unpack8(*(const v4u*)(zc + 1024 + c), vc);
        { v4u a = *(const v4u*)(zp + c), d = *(const v4u*)(zp + 1024 + c); if (pz) { a = (v4u){0u, 0u, 0u, 0u}; d = a; } unpack8(a, rp); unpack8(d, vp); }
        float At[8], Rt[8], Bt[8], Kt[8]; float mur[8], muv[8], rkk[8];
        { const f32x4 a0 = *(const f32x4*)(P.in[9] + c), a1 = *(const f32x4*)(P.in[9] + c + 4), b0 = *(const f32x4*)(P.in[9] + 1024 + c), b1 = *(const f32x4*)(P.in[9] + 1024 + c + 4), c0 = *(const f32x4*)(P.in[17] + c), c1 = *(const f32x4*)(P.in[17] + c + 4);
#pragma unroll
          for (int e = 0; e < 4; ++e) { mur[e] = a0[e]; mur[4 + e] = a1[e]; muv[e] = b0[e]; muv[4 + e] = b1[e]; rkk[e] = c0[e]; rkk[4 + e] = c1[e]; } }
#pragma unroll
        for (int e = 0; e < 8; ++e) { const float rr = rc[e] + (rp[e] - rc[e]) * mur[e]; const float vv = vc[e] + (vp[e] - vc[e]) * muv[e];
            bonp += rr * kx[e] * rkk[e];
            const float ec = scan16(e_[e]), etot = red16(e_[e]);
            const float g1 = __builtin_amdgcn_exp2f(-1.4426950408889634f * ec);
            const float gi = __builtin_amdgcn_exp2f(1.4426950408889634f * ec);
            const float gC = __builtin_amdgcn_exp2f(-1.4426950408889634f * etot);
            const float g0 = dppf_old<0x111>(1.0f, g1);
            At[e] = -kk[e] * g0; Rt[e] = rr * g1; Bt[e] = bb[e] * gi; Kt[e] = kx[e] * gi;
            const int ke = 32 * ks + e;
            *(bf16*)(pbk + ke * 64) = (bf16)f2bf(Bt[e] * gC);
            *(bf16*)(pbk + ke * 64 + 8) = (bf16)f2bf(Kt[e] * gC);
            *(bf16*)(pvt + ke * 32) = (bf16)f2bf(vv);
            if (t == 15) *(float*)(pgc + ke * 4) = gC; }
        Af[ks] = pack8(At); Rf[ks] = pack8(Rt); Bf[ks] = pack8(Bt); Kf[ks] = pack8(Kt);
        { const int fqs = 2 * (fq & 1), bo = (fq >> 1) * 8; const v4u aw = __builtin_bit_cast(v4u, Af[ks]), rw = __builtin_bit_cast(v4u, Rf[ks]);
          *(v2u*)(cb + CB_A + ((t * 2 + ks) * 4 + fqs) * 16 + bo) = (v2u){aw.x, aw.y}; *(v2u*)(cb + CB_A + ((t * 2 + ks) * 4 + fqs + 1) * 16 + bo) = (v2u){aw.z, aw.w};
          *(v2u*)(cb + CB_R + ((t * 2 + ks) * 4 + fqs) * 16 + bo) = (v2u){rw.x, rw.y}; *(v2u*)(cb + CB_R + ((t * 2 + ks) * 4 + fqs + 1) * 16 + bo) = (v2u){rw.z, rw.w}; }
        *(v4u*)(cb + CB_GATE + (t * 64 + cl) * 2) = xg[ks]; }
    asm volatile("" ::: "memory"); __builtin_amdgcn_sched_barrier(0);
    bonp += __shfl_xor(bonp, 16); bonp += __shfl_xor(bonp, 32);
    if (fq == 0) *(float*)(cb + CB_BON + t * 4) = bonp;
    const f32x4 z4 = (f32x4){0.f, 0.f, 0.f, 0.f};
    f32x4 Mab = __builtin_amdgcn_mfma_f32_16x16x32_bf16(Af[0], Bf[0], z4, 0, 0, 0); Mab = __builtin_amdgcn_mfma_f32_16x16x32_bf16(Af[1], Bf[1], Mab, 0, 0, 0);
    f32x4 Mak = __builtin_amdgcn_mfma_f32_16x16x32_bf16(Af[0], Kf[0], z4, 0, 0, 0); Mak = __builtin_amdgcn_mfma_f32_16x16x32_bf16(Af[1], Kf[1], Mak, 0, 0, 0);
    f32x4 Mrb = __builtin_amdgcn_mfma_f32_16x16x32_bf16(Rf[0], Bf[0], z4, 0, 0, 0); Mrb = __builtin_amdgcn_mfma_f32_16x16x32_bf16(Rf[1], Bf[1], Mrb, 0, 0, 0);
    f32x4 Mrk = __builtin_amdgcn_mfma_f32_16x16x32_bf16(Rf[0], Kf[0], z4, 0, 0, 0); Mrk = __builtin_amdgcn_mfma_f32_16x16x32_bf16(Rf[1], Kf[1], Mrk, 0, 0, 0);
#pragma unroll
    for (int r = 0; r < 4; ++r) { const int tt = 4 * fq + r, i = fr;
        const float mab = (tt > i) ? Mab[r] : 0.f, mak = (tt > i) ? Mak[r] : 0.f, mrb = (tt >= i) ? Mrb[r] : 0.f, mrk = (tt >= i) ? Mrk[r] : 0.f;
        hs[tt * 16 + i] = mab; hs[256 + tt * 16 + i] = mak;
        const unsigned w = pk2m(mrb, mrk);
        *(bf16*)(cb + CB_AR + ((tt * 4 + (i >> 2)) * 8 + (i & 3)) * 2) = (bf16)(w & 0xffffu);
        *(bf16*)(cb + CB_AR + ((tt * 4 + (i >> 2)) * 8 + 4 + (i & 3)) * 2) = (bf16)(w >> 16); }
    asm volatile("s_waitcnt lgkmcnt(0)" ::: "memory");
    { const int c = lane & 31, cc = c & 15; const bool isT = c < 16; float out[16];
#pragma unroll
      for (int tt = 0; tt < 16; ++tt) { float acc = isT ? (tt == cc ? 1.0f : 0.0f) : hs[256 + tt * 16 + cc];
#pragma unroll
          for (int i4 = 0; i4 < (tt + 3) / 4; ++i4) { const f32x4 l = *(const f32x4*)(hs + tt * 16 + 4 * i4);
#pragma unroll
              for (int e = 0; e < 4; ++e) if (4 * i4 + e < tt) acc += l[e] * out[4 * i4 + e]; }
          out[tt] = acc;
          if (lane < 32) *(bf16*)(cb + CB_TT + ((tt * 4 + (cc >> 2)) * 8 + (isT ? 0 : 4) + (cc & 3)) * 2) = (bf16)f2bf(acc); } }
    asm volatile("s_waitcnt lgkmcnt(0)" ::: "memory");
    { unsigned char* gi = ws + WS_IMG + ((size_t)(b * NHEAD + h) * NCHUNK + ch) * IMG_SIZE;
      for (int i = lane; i < IMG_SIZE / 16; i += 64) *(v4u*)(gi + i * 16) = *(const v4u*)(cb + i * 16); }
    asm volatile("s_waitcnt lgkmcnt(0)" ::: "memory"); __builtin_amdgcn_sched_barrier(0);
}

struct ScanOps { bf16x8 a0, a1, r0, r1, tt, ar, bk[4]; v2u vt; f32x4 g[4]; };
__device__ __forceinline__ void scan_load(ScanOps& o, const unsigned char* ib, int fr, int fq, int vcol) {
    o.a0 = *(const bf16x8*)(ib + CB_A + ((fr * 2 + 0) * 4 + fq) * 16); o.a1 = *(const bf16x8*)(ib + CB_A + ((fr * 2 + 1) * 4 + fq) * 16);
    o.r0 = *(const bf16x8*)(ib + CB_R + ((fr * 2 + 0) * 4 + fq) * 16); o.r1 = *(const bf16x8*)(ib + CB_R + ((fr * 2 + 1) * 4 + fq) * 16);
    o.tt = *(const bf16x8*)(ib + CB_TT + (fr * 4 + fq) * 16); o.ar = *(const bf16x8*)(ib + CB_AR + (fr * 4 + fq) * 16);
    o.vt = *(const v2u*)(ib + CB_VT + (vcol * 16 + 4 * fq) * 2);
#pragma unroll
    for (int kt = 0; kt < 4; ++kt) { o.g[kt] = *(const f32x4*)(ib + CB_G + (16 * kt + 4 * fq) * 4); o.bk[kt] = *(const bf16x8*)(ib + CB_BK + ((16 * kt + fr) * 4 + fq) * 16); }
}
__device__ __forceinline__ void scan_step(f32x4 (&H)[4], const ScanOps& o, float* yb, int fq, int vcol) {
    v4u hb0, hb1;
    hb0.x = pk2m(H[0][0], H[0][1]); hb0.y = pk2m(H[0][2], H[0][3]); hb0.z = pk2m(H[1][0], H[1][1]); hb0.w = pk2m(H[1][2], H[1][3]);
    hb1.x = pk2m(H[2][0], H[2][1]); hb1.y = pk2m(H[2][2], H[2][3]); hb1.z = pk2m(H[3][0], H[3][1]); hb1.w = pk2m(H[3][2], H[3][3]);
    const bf16x8 h0 = __builtin_bit_cast(bf16x8, hb0), h1 = __builtin_bit_cast(bf16x8, hb1);
    const f32x4 z4 = (f32x4){0.f, 0.f, 0.f, 0.f};
    f32x4 X = __builtin_amdgcn_mfma_f32_16x16x32_bf16(o.a0, h0, z4, 0, 0, 0); X = __builtin_amdgcn_mfma_f32_16x16x32_bf16(o.a1, h1, X, 0, 0, 0);
    f32x4 Y = __builtin_amdgcn_mfma_f32_16x16x32_bf16(o.r0, h0, z4, 0, 0, 0); Y = __builtin_amdgcn_mfma_f32_16x16x32_bf16(o.r1, h1, Y, 0, 0, 0);
    v4u xb; xb.x = pk2m(X[0], X[1]); xb.y = pk2m(X[2], X[3]); xb.z = o.vt.x; xb.w = o.vt.y;
    const f32x4 U = __builtin_amdgcn_mfma_f32_16x16x32_bf16(o.tt, __builtin_bit_cast(bf16x8, xb), z4, 0, 0, 0);
    v4u ub; ub.x = pk2m(U[0], U[1]); ub.y = pk2m(U[2], U[3]); ub.z = o.vt.x; ub.w = o.vt.y;
    const bf16x8 uf = __builtin_bit_cast(bf16x8, ub);
    Y = __builtin_amdgcn_mfma_f32_16x16x32_bf16(o.ar, uf, Y, 0, 0, 0);
#pragma unroll
    for (int kt = 0; kt < 4; ++kt) H[kt] = __builtin_amdgcn_mfma_f32_16x16x32_bf16(o.bk[kt], uf, H[kt] * o.g[kt], 0, 0, 0);
#pragma unroll
    for (int r = 0; r < 4; ++r) yb[(4 * fq + r) * 64 + vcol] = Y[r];
}
__device__ __forceinline__ void scan_phase(const Ptrs& P, unsigned char* lds, int sb, int tid, int wave, int lane, int never) {
    const int b = sb >> 3, h = sb & 7, fr = lane & 15, fq = lane >> 4;
    const unsigned char* img = P.ws + WS_IMG + (size_t)(b * NHEAD + h) * NCHUNK * IMG_SIZE;
    if (wave < 4) {
        f32x4 H[4];
#pragma unroll
        for (int kt = 0; kt < 4; ++kt) H[kt] = (f32x4){0.f, 0.f, 0.f, 0.f};
        const int vcol = 16 * wave + fr;
#pragma unroll 1
        for (int s = 0; s <= NSUPER + 1; ++s) {
            __syncthreads();
            if (s < 1 || s > NSUPER) continue;
            const int set = (s - 1) & 1;
#pragma unroll 1
            for (int j = 0; j < 4; ++j) { const int ch = 4 * (s - 1) + j; if (ch >= NCHUNK) break;
                ScanOps o; scan_load(o, lds + (set * 4 + j) * CB_SIZE, fr, fq, vcol);
                scan_step(H, o, (float*)(lds + SC_YB + (set * 4 + j) * 4096), fq, vcol); }
        }
    } else {
        const int hw = wave - 4, t = fr;
        const bf16* Z = (const bf16*)(P.ws + WS_BIG); const bf16* Zm = (const bf16*)(P.ws + WS_META + MO_ZM);
        bf16* Yo = (bf16*)(P.ws + WS_XB);
        const int cbase = h * 64 + 8 * fq;
        float muv[16], lw[16], lb[16];
#pragma unroll
        for (int ks = 0; ks < 2; ++ks) { const int c = cbase + 32 * ks;
            const f32x4 a0 = *(const f32x4*)(P.in[9] + 1024 + c), a1 = *(const f32x4*)(P.in[9] + 1024 + c + 4), b0 = *(const f32x4*)(P.in[18] + c), b1 = *(const f32x4*)(P.in[18] + c + 4), c0 = *(const f32x4*)(P.in[19] + c), c1 = *(const f32x4*)(P.in[19] + c + 4);
#pragma unroll
            for (int e = 0; e < 4; ++e) { muv[8 * ks + e] = a0[e]; muv[8 * ks + 4 + e] = a1[e]; lw[8 * ks + e] = b0[e]; lw[8 * ks + 4 + e] = b1[e]; lb[8 * ks + e] = c0[e]; lb[8 * ks + 4 + e] = c1[e]; } }
        v4u cvc[2], cvp[2], cg[2], nvc[2], nvp[2], ng[2]; float cbon = 0.f, nbon = 0.f;
        v4u im[13];
#define IMG_LOAD(chx) do { const unsigned char* ip_ = img + (size_t)(chx) * IMG_SIZE; _Pragma("unroll") for (int i_ = 0; i_ < 13; ++i_) if (i_ < 12 || lane < 32) im[i_] = *(const v4u*)(ip_ + (i_ * 64 + lane) * 16); } while (0)
        if (hw < NCHUNK) IMG_LOAD(hw);
#pragma unroll
        for (int ks = 0; ks < 2; ++ks) { cvc[ks] = (v4u){0u, 0u, 0u, 0u}; cvp[ks] = cvc[ks]; cg[ks] = cvc[ks]; nvc[ks] = cvc[ks]; nvp[ks] = cvc[ks]; ng[ks] = cvc[ks]; }
#pragma unroll 1
        for (int s = 0; s <= NSUPER + 1; ++s) {
            __syncthreads();
            if (4 * s + hw < NCHUNK) { unsigned char* cbw = lds + ((s & 1) * 4 + hw) * CB_SIZE;
#pragma unroll
                for (int i_ = 0; i_ < 13; ++i_) if (i_ < 12 || lane < 32) *(v4u*)(cbw + (i_ * 64 + lane) * 16) = im[i_]; }
            if (4 * (s + 1) + hw < NCHUNK) IMG_LOAD(4 * (s + 1) + hw);
            { const int chn = 4 * (s - 1) + hw;
              if (s >= 1 && chn >= 1 && chn < NCHUNK) { const unsigned char* ib = img + (size_t)chn * IMG_SIZE; const int tok = 16 * (chn - 1) + t; const size_t m = (size_t)b * TSEQ + tok;
                const bf16* zc = Z + m * NIN; const bf16* zp = (tok == 0) ? Zm + (size_t)15 * NIN : Z + (m - 1) * NIN;
#pragma unroll
                for (int ks = 0; ks < 2; ++ks) { const int c = cbase + 32 * ks; nvc[ks] = *(const v4u*)(zc + 1024 + c); nvp[ks] = *(const v4u*)(zp + 1024 + c); ng[ks] = *(const v4u*)(ib + CB_GATE + (t * 64 + 32 * ks + 8 * fq) * 2); }
                nbon = *(const float*)(ib + CB_BON + t * 4); } }
            const int ch = 4 * (s - 2) + hw;
            if (s >= 2 && ch >= 1 && ch < NCHUNK) { const int set = s & 1; const float* yb = (const float*)(lds + SC_YB + (set * 4 + hw) * 4096);
                const int tok = 16 * (ch - 1) + t; const size_t m = (size_t)b * TSEQ + tok;
                float y[16]; float sm = 0.f;
#pragma unroll
                for (int ks = 0; ks < 2; ++ks) { const f32x4 y0 = *(const f32x4*)(yb + t * 64 + 32 * ks + 8 * fq), y1 = *(const f32x4*)(yb + t * 64 + 32 * ks + 8 * fq + 4);
#pragma unroll
                    for (int e = 0; e < 4; ++e) { y[8 * ks + e] = y0[e]; y[8 * ks + 4 + e] = y1[e]; sm += y0[e] + y1[e]; } }
                sm += __shfl_xor(sm, 16); sm += __shfl_xor(sm, 32); const float mean = sm * (1.0f / 64.0f); float sq = 0.f;
#pragma unroll
                for (int i = 0; i < 16; ++i) { y[i] -= mean; sq += y[i] * y[i]; }
                sq += __shfl_xor(sq, 16); sq += __shfl_xor(sq, 32); const float rs = __builtin_amdgcn_rsqf(sq * (1.0f / 64.0f) + 64e-5f);
#pragma unroll
                for (int ks = 0; ks < 2; ++ks) { const int c = cbase + 32 * ks;
                    float vc[8], vp[8], g[8], o[8]; unpack8(cvc[ks], vc); unpack8(cvp[ks], vp); unpack8(cg[ks], g);
#pragma unroll
                    for (int e = 0; e < 8; ++e) { const float vv = vc[e] + (vp[e] - vc[e]) * muv[8 * ks + e];
                        o[e] = (y[8 * ks + e] * rs * lw[8 * ks + e] + lb[8 * ks + e] + cbon * vv) * g[e]; }
                    *(bf16x8*)(Yo + m * DM + c) = pack8(o); } }
#pragma unroll
            for (int ks = 0; ks < 2; ++ks) { cvc[ks] = nvc[ks]; cvp[ks] = nvp[ks]; cg[ks] = ng[ks]; }
            cbon = nbon;
        }
#undef IMG_LOAD
    }
}
__device__ __forceinline__ void final_norm(const Ptrs& P, int gw, int NGW, int lane) {
    const float* ssq = (const float*)(P.ws + WS_SSQ4); const GAS f32x4* g4 = (const GAS f32x4*)P.in[26] + lane;
    f32x4 g[4];
#pragma unroll
    for (int j = 0; j < 4; ++j) g[j] = g4[64 * j];
    for (int m = gw; m < MR; m += NGW) { const float rs = pg8::rstd_from16(ssq, m); GAS f32x4* o = (GAS f32x4*)(P.out + (size_t)m * DM) + lane;
#pragma unroll
        for (int j = 0; j < 4; ++j) o[64 * j] = o[64 * j] * rs * g[j]; }
}
#ifndef MK_N_LAUNCHES
#define MK_N_LAUNCHES 1
#endif
constexpr int N_PHASES = 10;
struct Args { Ptrs p; int ph_lo, ph_hi, use_cg, pad; };
__global__ void __launch_bounds__(NWAVES * 64, 2) hymba_fwd(Args args) {
    extern __shared__ __attribute__((aligned(16))) unsigned char lds[];
    LAS unsigned char* ldsl = (LAS unsigned char*)lds;
    volatile LAS unsigned* MISC = (volatile LAS unsigned*)(ldsl + MISC_OFF);
    const int tid = threadIdx.x, lane = tid & 63, wave = __builtin_amdgcn_readfirstlane(tid >> 6);
    const int G = gridDim.x, bx = blockIdx.x, vcu = (G % 8 == 0) ? (bx % 8) * (G / 8) + bx / 8 : bx;
    const Ptrs& P = args.p; unsigned char* ws = P.ws;
    if (args.use_cg) cg::this_grid().sync();
    for (int u = tid; u < (LDS_BYTES - LDSCTL_OFF) / 4; u += NWAVES * 64) ((LAS unsigned*)(ldsl + LDSCTL_OFF))[u] = 0u;
    __syncthreads();
    const int lo = args.ph_lo, hi = args.ph_hi;
    XcdBarrier bar; bar.bar = (unsigned*)(ws + WS_CTL) + CW_BAR; bar.x = 0; bar.st = nullptr;
    if (hi - lo > 1) bar = xcd_barrier_post((unsigned*)(ws + WS_CTL) + CW_BAR, MISC + 8);
#define IN(k) (lo <= (k) && (k) < hi)
#define SEAM(k) do { if (IN(k) && IN((k) + 1)) xcd_barrier(bar); } while (0)
    const int gw = vcu * NWAVES + wave, NGW = G * NWAVES;

    if (IN(0)) { p0_prologue(P, ldsl, vcu, G, wave, lane); SEAM(0); }
    if (IN(1)) {
        meta_up(ws, gw, NGW, lane);
        pg8::Gemm g{(const bf16*)(ws + WS_XB), (const bf16*)(ws + WS_WGU1), MR, NGU, DM}; pg8::StaticOrder S; S.init(MR, NGU, G, bx);
        pg8::EpiSwiglu E{(bf16*)(ws + WS_BIG), (const float*)(ws + WS_SSQ1), FF};
        pg8::gemm_phase<pg8::EpiSwiglu, pg8::StaticOrder, true, true>(ldsl, g, S, E);
        SEAM(1);
    }
    if (IN(2)) {
        meta_down(P, gw, NGW, lane);
        pg8::Gemm g{(const bf16*)(ws + WS_BIG), (const bf16*)(ws + WS_WD1), MR, DM, FF}; pg8::StaticOrder S; S.init(MR, DM, G, bx);
        pg8::EpiResid<true> E{P.in[0], P.out, (bf16*)(ws + WS_XB), (float*)(ws + WS_SSQ2), 0.5f};
        pg8::gemm_phase<pg8::EpiResid<true>, pg8::StaticOrder, true, true>(ldsl, g, S, E);
        SEAM(2);
    }
    if (IN(3)) {
        meta_win(P, gw, NGW, lane);
        pg8::Gemm g{(const bf16*)(ws + WS_XB), (const bf16*)(ws + WS_WIN), MR, NINP, DM}; pg8::StaticOrder S; S.init(MR, NINP, G, bx);
        pg8::EpiZ E{(bf16*)(ws + WS_BIG), (const float*)(ws + WS_SSQ2), P.in[8], NIN, NIN, ZC_Q};
        pg8::gemm_phase<pg8::EpiZ, pg8::StaticOrder, true, true>(ldsl, g, S, E);
        SEAM(3);
    }
    if (IN(4)) {
        for (int u = vcu; u < NBATCH * 2 * 64; u += G) attn_unit(P, lds, u >> 7, (u >> 6) & 1, u & 63, tid, wave, lane);
        __syncthreads();
        for (int task = gw; task < NBATCH * NHEAD * NCHUNK; task += NGW) { const int bc = task >> 3; chunk_task(P, lds, wave * WL_SIZE, bc / NCHUNK, task & 7, bc % NCHUNK, lane); }
        SEAM(4);
    }
    if (IN(5)) {
#ifndef REP_SCAN
#define REP_SCAN 1
#endif
        for (int rep = 0; rep < REP_SCAN; ++rep) { if (bx < 64) scan_phase(P, lds, bx, tid, wave, lane, args.use_cg); __syncthreads(); }
        SEAM(5);
    }
    if (IN(6)) {
        pg8::Gemm g{(const bf16*)(ws + WS_XB), (const bf16*)(ws + WS_WOUT), MR, DM, DM}; pg8::StaticOrder S; S.init(MR, DM, G, bx);
        pg8::EpiResid<true> E{P.out, P.out, (bf16*)(ws + WS_P), (float*)(ws + WS_SSQ3), 1.0f};
        pg8::gemm_phase<pg8::EpiResid<true>, pg8::StaticOrder, true, true>(ldsl, g, S, E);
        SEAM(6);
    }
    if (IN(7)) {
        pg8::Gemm g{(const bf16*)(ws + WS_P), (const bf16*)(ws + WS_WGU2), MR, NGU, DM}; pg8::StaticOrder S; S.init(MR, NGU, G, bx);
        pg8::EpiSwiglu E{(bf16*)(ws + WS_BIG), (const float*)(ws + WS_SSQ3), FF};
        pg8::gemm_phase<pg8::EpiSwiglu, pg8::StaticOrder, true, true>(ldsl, g, S, E);
        SEAM(7);
    }
    if (IN(8)) {
        pg8::Gemm g{(const bf16*)(ws + WS_BIG), (const bf16*)(ws + WS_WD2), MR, DM, FF}; pg8::StaticOrder S; S.init(MR, DM, G, bx);
        pg8::EpiResid<false> E{P.out, P.out, nullptr, (float*)(ws + WS_SSQ4), 0.5f};
        pg8::gemm_phase<pg8::EpiResid<false>, pg8::StaticOrder, true, true>(ldsl, g, S, E);
        SEAM(8);
    }
    if (IN(9)) final_norm(P, gw, NGW, lane);
#undef IN
#undef SEAM
}

extern "C" void kernel_launch(void* const* d_in, const int* in_sizes, int n_in, void* d_out, int out_size, void* d_ws, size_t ws_size, hipStream_t stream) {
    static int grid = 0;
    if (grid == 0) {
        if (n_in != 27 || in_sizes[0] != MR * DM || out_size != MR * DM || ws_size < WS_END) { fprintf(stderr, "kernel_launch: unexpected shapes (n_in %d, in0 %d, out %d, ws %zu)\n", n_in, n_in > 0 ? in_sizes[0] : -1, out_size, ws_size); grid = -1; return; }
        int dev = 0, cus = 0, per_cu = 0;
        if (hipGetDevice(&dev) != hipSuccess || hipDeviceGetAttribute(&cus, hipDeviceAttributeMultiprocessorCount, dev) != hipSuccess) { grid = -1; return; }
        if (hipFuncSetAttribute((const void*)hymba_fwd, hipFuncAttributeMaxDynamicSharedMemorySize, LDS_BYTES) != hipSuccess) { fprintf(stderr, "kernel_launch: hipFuncSetAttribute failed\n"); grid = -1; return; }
        if (hipOccupancyMaxActiveBlocksPerMultiprocessor(&per_cu, (const void*)hymba_fwd, NWAVES * 64, LDS_BYTES) != hipSuccess || per_cu < 1) fprintf(stderr, "kernel_launch: occupancy query says %d blocks per CU\n", per_cu);
        (void)hipGetLastError();
        grid = cus;
    }
    if (grid < 0) return;
    if (hipMemsetAsync((char*)d_ws + WS_CTL, 0, CTL_ZERO_BYTES, stream) != hipSuccess) { fprintf(stderr, "kernel_launch: memset failed\n"); return; }
    Args a{};
    for (int i = 0; i < 27; ++i) a.p.in[i] = (const float*)d_in[i];
    a.p.out = (float*)d_out; a.p.ws = (unsigned char*)d_ws; a.use_cg = 0; a.pad = 0;
#if MK_N_LAUNCHES == 1
    a.ph_lo = 0; a.ph_hi = N_PHASES;
    void* kargs[] = {&a};
    hipError_t e = hipLaunchCooperativeKernel((const void*)hymba_fwd, dim3(grid), dim3(NWAVES * 64), kargs, LDS_BYTES, stream);
    if (e != hipSuccess) fprintf(stderr, "kernel_launch: cooperative launch failed: %s (grid %d)\n", hipGetErrorString(e), grid);
#else
    for (int li = 0; li < N_PHASES; ++li) { a.ph_lo = li; a.ph_hi = li + 1;
        hipLaunchKernelGGL(hymba_fwd, dim3(grid), dim3(NWAVES * 64), LDS_BYTES, stream, a);
        const hipError_t le = hipPeekAtLastError(); if (le != hipSuccess) { fprintf(stderr, "kernel_launch: launch %d failed: %s\n", li, hipGetErrorName(le)); break; } }
#endif
}
```

```cpp
#include <hip/hip_runtime.h>
#include <cstdio>
#include <cstdint>
namespace pg8 {
#define PG8_LAS __attribute__((address_space(3)))
typedef unsigned short bf16_t;
typedef short bf16x8 __attribute__((ext_vector_type(8)));
typedef float f32x4 __attribute__((ext_vector_type(4)));
typedef unsigned u32x4 __attribute__((ext_vector_type(4)));
constexpr int BM = 256, BK = 64, HALF = 128, HTB = HALF * BK * 2  , STAGE_BYTES = 8 * HTB, NXCD = 8, WGM = 8;

__host__ __device__ __forceinline__ int lds_byte(int r, int c) { const int st = (r >> 4) * 2 + (c >> 5), rr = r & 15, cc = c & 31, ob = rr * 64 + cc * 2; return st * 1024 + (ob ^ (((ob >> 9) & 1) << 5)); }
__host__ __device__ __forceinline__ void stage_rc(int b, int& R, int& C) { const int st = b / 1024, sb = b % 1024, swz = sb ^ (((sb >> 9) & 1) << 5); R = (st >> 1) * 16 + swz / 64; C = (st & 1) * 32 + (swz % 64) / 2; }
__host__ __device__ __forceinline__ int perm32(int rho) { const int n = rho >> 4, i = rho & 15; return 8 * (i >> 2) + 4 * n + (i & 3); }

struct Unit { int pm, pn; };
struct Gemm { const bf16_t* A; const bf16_t* Bt; int M, N, K; };

struct StaticOrder {
    int nM, nN, nwg, G, c;
    __host__ __device__ void init(int M, int N, int G_, int c_) { nM = M / BM; nN = N / BM; nwg = nM * nN; G = G_; c = c_; }
    __host__ __device__ bool next(int i, Unit& u) const {
        const long L = (long)i * G + c; if (L >= nwg) return false;
        int wgid = (int)L; { const int q = nwg / NXCD, r = nwg % NXCD, xcd = wgid % NXCD, off = wgid / NXCD; wgid = (xcd < r ? xcd * (q + 1) : r * (q + 1) + (xcd - r) * q) + off; }
        const int nig = WGM * nN, gid = wgid / nig, fm = gid * WGM, gsz = (nM - fm) < WGM ? (nM - fm) : WGM;
        u.pm = fm + ((wgid % nig) % gsz); u.pn = (wgid % nig) / gsz; return true;
    }
    __device__ __forceinline__ void a_ready(const Unit&) const {}
    __device__ __forceinline__ void done(const Unit&) const {}
};

__device__ __forceinline__ unsigned cvt_pk_bf16(float lo, float hi) { unsigned r; asm volatile("v_cvt_pk_bf16_f32 %0, %1, %2" : "=v"(r) : "v"(lo), "v"(hi)); return r; }
typedef float f32x2 __attribute__((ext_vector_type(2)));
typedef unsigned u32x2 __attribute__((ext_vector_type(2)));
__device__ __forceinline__ float rstd_from16(const float* ssq, int row) {
    const f32x4* p = (const f32x4*)(ssq + (size_t)row * 16);
    const f32x4 a = p[0], b = p[1], c = p[2], d = p[3];
    const float s = ((a[0] + a[1]) + (a[2] + a[3])) + ((b[0] + b[1]) + (b[2] + b[3])) + ((c[0] + c[1]) + (c[2] + c[3])) + ((d[0] + d[1]) + (d[2] + d[3]));
    return __builtin_amdgcn_rsqf(s * (1.0f / 1024.0f) + 1e-5f);
}
__device__ __forceinline__ float silu_mul(float g, float u) { return g * __builtin_amdgcn_rcpf(1.0f + __builtin_amdgcn_exp2f(-1.4426950408889634f * g)) * u; }
struct EpiSwiglu {
    static constexpr bool PERM = true, AFTER_DRAIN = false;
    bf16_t* U; const float* ssq; int ldu;
    __device__ __forceinline__ void operator()(const f32x4 (&acc)[2][2][4][2], const Unit& u, int wr, int wc, int fr, int fq) const {
        const int row0 = u.pm * BM + wr * 64 + fr, col0 = u.pn * HALF + wc * 32 + 8 * fq;
#pragma unroll
        for (int ai = 0; ai < 2; ++ai)
#pragma unroll
            for (int m = 0; m < 4; ++m) { const int row = row0 + ai * HALF + m * 16; const float rs = rstd_from16(ssq, row);
                const f32x4 g0 = acc[ai][0][m][0] * rs, g1 = acc[ai][0][m][1] * rs, u0 = acc[ai][1][m][0] * rs, u1 = acc[ai][1][m][1] * rs;
                u32x4 w; w.x = cvt_pk_bf16(silu_mul(g0[0], u0[0]), silu_mul(g0[1], u0[1])); w.y = cvt_pk_bf16(silu_mul(g0[2], u0[2]), silu_mul(g0[3], u0[3]));
                w.z = cvt_pk_bf16(silu_mul(g1[0], u1[0]), silu_mul(g1[1], u1[1])); w.w = cvt_pk_bf16(silu_mul(g1[2], u1[2]), silu_mul(g1[3], u1[3]));
                *(u32x4*)(U + (size_t)row * ldu + col0) = w; }
    }
};
struct EpiZ {
    static constexpr bool PERM = true, AFTER_DRAIN = false;
    bf16_t* Z; const float* ssq; const float* bias; int ldz, ncols, bias_from;
    __device__ __forceinline__ void operator()(const f32x4 (&acc)[2][2][4][2], const Unit& u, int wr, int wc, int fr, int fq) const {
        const int row0 = u.pm * BM + wr * 64 + fr, col0 = u.pn * BM + wc * 32 + 8 * fq;
        f32x4 bv[2][2];
#pragma unroll
        for (int bj = 0; bj < 2; ++bj)
#pragma unroll
            for (int n = 0; n < 2; ++n) { const int c = col0 + bj * HALF + 4 * n; bv[bj][n] = (c >= bias_from && c < ncols) ? *(const f32x4*)(bias + (c - bias_from)) : (f32x4){0.f, 0.f, 0.f, 0.f}; }
#pragma unroll
        for (int ai = 0; ai < 2; ++ai)
#pragma unroll
            for (int m = 0; m < 4; ++m) { const int row = row0 + ai * HALF + m * 16; const float rs = rstd_from16(ssq, row);
#pragma unroll
                for (int bj = 0; bj < 2; ++bj) { const int c = col0 + bj * HALF; if (c < ncols) {
                    const f32x4 v0 = acc[ai][bj][m][0] * rs + bv[bj][0], v1 = acc[ai][bj][m][1] * rs + bv[bj][1];
                    u32x4 w; w.x = cvt_pk_bf16(v0[0], v0[1]); w.y = cvt_pk_bf16(v0[2], v0[3]); w.z = cvt_pk_bf16(v1[0], v1[1]); w.w = cvt_pk_bf16(v1[2], v1[3]);
                    *(u32x4*)(Z + (size_t)row * ldz + c) = w; } } }
    }
};
template <bool WB> struct EpiResid {
    static constexpr bool PERM = false, AFTER_DRAIN = false;
    const float* base; float* out; bf16_t* outb; float* ssq; float scale;
    __device__ __forceinline__ void operator()(const f32x4 (&acc)[2][2][4][2], const Unit& u, int wr, int wc, int fr, int fq) const {
        const int row0 = u.pm * BM + wr * 64 + fr, col0 = u.pn * BM + wc * 32 + 4 * fq;
#pragma unroll
        for (int ai = 0; ai < 2; ++ai)
#pragma unroll
            for (int m = 0; m < 4; ++m) { const int row = row0 + ai * HALF + m * 16; const size_t off = (size_t)row * 1024 + col0; float ss = 0.f;
#pragma unroll
                for (int bj = 0; bj < 2; ++bj)
#pragma unroll
                    for (int n = 0; n < 2; ++n) { const size_t o2 = off + bj * HALF + n * 16; const f32x4 bs = *(const f32x4*)(base + o2); const f32x4 o = bs + acc[ai][bj][m][n] * scale;
                        *(f32x4*)(out + o2) = o; ss += (o[0] * o[0] + o[1] * o[1]) + (o[2] * o[2] + o[3] * o[3]);
                        if (WB) { u32x2 w; w.x = cvt_pk_bf16(o[0], o[1]); w.y = cvt_pk_bf16(o[2], o[3]); *(u32x2*)(outb + o2) = w; } }
                ss += __shfl_xor(ss, 16); ss += __shfl_xor(ss, 32);
                if (fq == 0) ssq[(size_t)row * 16 + u.pn * 4 + wc] = ss; }
    }
};
template <class Epi, class Sched, bool ALIGN_EPI = false, bool SP2 = false>
__device__ __forceinline__ void gemm_phase(PG8_LAS unsigned char* lds, const Gemm g, const Sched& S, const Epi& E) {
    const int tid = threadIdx.x, wid = __builtin_amdgcn_readfirstlane(tid >> 6), lane = tid & 63, wr = wid >> 2, wc = wid & 3, fr = lane & 15, fq = lane >> 4;
    const int K = g.K, nt = K / BK;
    unsigned voffA[2], voffB[2];
#pragma unroll
    for (int i = 0; i < 2; ++i) { int R, C; stage_rc(tid * 16 + i * 8192, R, C); const int Rb = Epi::PERM ? ((R & ~31) + perm32(R & 31)) : R;
        voffA[i] = (unsigned)(R * K + C) * 2u; voffB[i] = (unsigned)(Rb * K + C) * 2u; }
    const size_t kstep = (size_t)(BK * 2);
    const size_t hstep = (size_t)HALF * K * 2;
    const size_t tstep = 2 * hstep;
    const unsigned ldsw = (unsigned)wid * 1024u;
    const int aoff = lds_byte(wr * 64 + fr, fq * 8), boff = lds_byte(wc * 32 + fr, fq * 8);
#define PG8_SA(b, h) (((b) * 2 + (h)) * HTB)
#define PG8_SB(b, h) ((4 + (b) * 2 + (h)) * HTB)
#define PG8_STAGE(bufoff, gbase, voff) do { _Pragma("unroll") for (int _i = 0; _i < 2; ++_i) \
        __builtin_amdgcn_global_load_lds((const unsigned*)((const char*)(gbase) + (voff)[_i]), (PG8_LAS unsigned*)(lds + (bufoff) + ldsw + _i * 8192), 16, 0, 0); } while (0)
#define PG8_LDA(dst, b, h) do { _Pragma("unroll") for (int m = 0; m < 4; ++m) _Pragma("unroll") for (int k = 0; k < 2; ++k) dst[m][k] = *(const PG8_LAS bf16x8*)(lds + PG8_SA(b, h) + aoff + m * 2048 + k * 1024); } while (0)
#define PG8_LDB(dst, b, h) do { _Pragma("unroll") for (int n = 0; n < 2; ++n) _Pragma("unroll") for (int k = 0; k < 2; ++k) dst[n][k] = *(const PG8_LAS bf16x8*)(lds + PG8_SB(b, h) + boff + n * 2048 + k * 1024); } while (0)
#define PG8_MMA(ai, bj, At, Bt) do { __builtin_amdgcn_s_setprio(1); _Pragma("unroll") for (int m = 0; m < 4; ++m) _Pragma("unroll") for (int n = 0; n < 2; ++n) _Pragma("unroll") for (int k = 0; k < 2; ++k) \
        acc[ai][bj][m][n] = __builtin_amdgcn_mfma_f32_16x16x32_bf16(Bt[n][k], At[m][k], acc[ai][bj][m][n], 0, 0, 0); __builtin_amdgcn_s_setprio(0); } while (0)
#define PG8_WAIT_V(n) asm volatile("s_waitcnt vmcnt(" #n ")" ::: "memory")
#define PG8_WAIT_L(n) asm volatile("s_waitcnt lgkmcnt(" #n ")" ::: "memory")
#define PG8_BAR __builtin_amdgcn_s_barrier()
#define PG8_SCHED __builtin_amdgcn_sched_barrier(0)
    Unit cur, nxt; int ui = 0;
    if (!S.next(0, cur)) return;
    f32x4 acc[2][2][4][2];
#pragma unroll
    for (int a = 0; a < 2; ++a)
#pragma unroll
        for (int b = 0; b < 2; ++b)
#pragma unroll
            for (int m = 0; m < 4; ++m)
#pragma unroll
                for (int n = 0; n < 2; ++n) acc[a][b][m][n] = (f32x4){0.f, 0.f, 0.f, 0.f};
    bf16x8 At[4][2], B0[2][2], B1[2][2];
    const char* cA = (const char*)g.A + (size_t)cur.pm * tstep; const char* cB = (const char*)g.Bt + (size_t)cur.pn * tstep;
    S.a_ready(cur);
    if constexpr (SP2) {
        PG8_STAGE(PG8_SB(0, 0), cB, voffB); PG8_STAGE(PG8_SB(0, 1), cB + hstep, voffB); PG8_STAGE(PG8_SA(0, 0), cA, voffA); PG8_STAGE(PG8_SA(0, 1), cA + hstep, voffA);
        if (wr == 1) PG8_BAR;
        PG8_WAIT_V(2); PG8_BAR;
        PG8_STAGE(PG8_SB(1, 0), cB + kstep, voffB); PG8_STAGE(PG8_SA(1, 0), cA + kstep, voffA); PG8_STAGE(PG8_SB(1, 1), cB + hstep + kstep, voffB);
        PG8_WAIT_V(6); PG8_BAR;
    } else {
        PG8_STAGE(PG8_SB(0, 0), cB, voffB); PG8_STAGE(PG8_SA(0, 0), cA, voffA); PG8_STAGE(PG8_SB(0, 1), cB + hstep, voffB); PG8_STAGE(PG8_SA(0, 1), cA + hstep, voffA);
        if (wr == 1) PG8_BAR;
        PG8_WAIT_V(4); PG8_BAR;
        PG8_STAGE(PG8_SB(1, 0), cB + kstep, voffB); PG8_STAGE(PG8_SA(1, 0), cA + kstep, voffA); PG8_STAGE(PG8_SB(1, 1), cB + hstep + kstep, voffB);
        PG8_WAIT_V(6); PG8_BAR;
    }
    for (;;) {
        const bool has_next = S.next(ui + 1, nxt);
        const char* nA = has_next ? (const char*)g.A + (size_t)nxt.pm * tstep : cA; const char* nB = has_next ? (const char*)g.Bt + (size_t)nxt.pn * tstep : cB;
        for (int t = 0; t < nt; t += 2) {
            const bool last = (t == nt - 2);
            const char* a1 = cA + (size_t)(t + 1) * kstep;
            const char* a2 = last ? nA : cA + (size_t)(t + 2) * kstep; const char* b2 = last ? nB : cB + (size_t)(t + 2) * kstep;
            const char* a3 = a2 + kstep; const char* b3 = b2 + kstep;
            if (last && has_next) S.a_ready(nxt);
            if constexpr (SP2) {
            PG8_LDB(B0, 0, 0); PG8_LDB(B1, 0, 1); PG8_SCHED; PG8_LDA(At, 0, 0); PG8_STAGE(PG8_SA(1, 1), a1 + hstep, voffA);
            PG8_WAIT_V(8); PG8_WAIT_L(0); PG8_BAR; PG8_MMA(0, 0, At, B0); PG8_MMA(0, 1, At, B1); PG8_BAR; PG8_SCHED;
            PG8_LDA(At, 0, 1); PG8_STAGE(PG8_SB(0, 0), b2, voffB); PG8_STAGE(PG8_SB(0, 1), b2 + hstep, voffB); PG8_STAGE(PG8_SA(0, 0), a2, voffA);
            PG8_WAIT_V(8); PG8_WAIT_L(0); PG8_BAR; PG8_MMA(1, 0, At, B0); PG8_MMA(1, 1, At, B1); PG8_BAR; PG8_SCHED;
            PG8_LDB(B0, 1, 0); PG8_LDB(B1, 1, 1); PG8_SCHED; PG8_LDA(At, 1, 0); PG8_STAGE(PG8_SA(0, 1), a2 + hstep, voffA);
            PG8_WAIT_V(8); PG8_WAIT_L(0); PG8_BAR; PG8_MMA(0, 0, At, B0); PG8_MMA(0, 1, At, B1); PG8_BAR; PG8_SCHED;
            PG8_LDA(At, 1, 1); PG8_STAGE(PG8_SB(1, 0), b3, voffB); PG8_STAGE(PG8_SB(1, 1), b3 + hstep, voffB); PG8_STAGE(PG8_SA(1, 0), a3, voffA);
            PG8_WAIT_V(8); PG8_WAIT_L(0); PG8_BAR; PG8_MMA(1, 0, At, B0); PG8_MMA(1, 1, At, B1); PG8_BAR; PG8_SCHED;
            } else {
            PG8_LDB(B0, 0, 0); PG8_SCHED; PG8_LDA(At, 0, 0); PG8_STAGE(PG8_SA(1, 1), a1 + hstep, voffA);
            PG8_WAIT_L(8); PG8_BAR; PG8_WAIT_L(0); PG8_MMA(0, 0, At, B0); PG8_BAR; PG8_SCHED;
            PG8_LDB(B1, 0, 1); PG8_STAGE(PG8_SB(0, 0), b2, voffB);
            PG8_BAR; PG8_WAIT_L(0); PG8_MMA(0, 1, At, B1); PG8_BAR;
            PG8_LDA(At, 0, 1); PG8_STAGE(PG8_SA(0, 0), a2, voffA);
            PG8_BAR; PG8_WAIT_L(0); PG8_MMA(1, 0, At, B0); PG8_BAR; PG8_SCHED;
            PG8_STAGE(PG8_SB(0, 1), b2 + hstep, voffB);
            PG8_WAIT_V(6); PG8_BAR; PG8_MMA(1, 1, At, B1); PG8_BAR;
            PG8_LDB(B0, 1, 0); PG8_SCHED; PG8_LDA(At, 1, 0); PG8_STAGE(PG8_SA(0, 1), a2 + hstep, voffA);
            PG8_WAIT_L(8); PG8_BAR; PG8_WAIT_L(0); PG8_MMA(0, 0, At, B0); PG8_BAR; PG8_SCHED;
            PG8_LDB(B1, 1, 1); PG8_STAGE(PG8_SB(1, 0), b3, voffB);
            PG8_BAR; PG8_WAIT_L(0); PG8_MMA(0, 1, At, B1); PG8_BAR;
            PG8_LDA(At, 1, 1); PG8_STAGE(PG8_SA(1, 0), a3, voffA);
            PG8_BAR; PG8_WAIT_L(0); PG8_MMA(1, 0, At, B0); PG8_BAR; PG8_SCHED;
            PG8_STAGE(PG8_SB(1, 1), b3 + hstep, voffB);
            PG8_WAIT_V(6); PG8_BAR; PG8_MMA(1, 1, At, B1); PG8_BAR;
            }
        }
        if constexpr (ALIGN_EPI) { if (wr == 0) PG8_BAR; }
        if constexpr (!Epi::AFTER_DRAIN) { E(acc, cur, wr, wc, fr, fq); S.done(cur); }
        if (!has_next) break;
#pragma unroll
        for (int a = 0; a < 2; ++a)
#pragma unroll
            for (int b = 0; b < 2; ++b)
#pragma unroll
                for (int m = 0; m < 4; ++m)
#pragma unroll
                    for (int n = 0; n < 2; ++n) acc[a][b][m][n] = (f32x4){0.f, 0.f, 0.f, 0.f};
        cur = nxt; cA = nA; cB = nB; ++ui;
        if constexpr (ALIGN_EPI) { if (wr == 1) PG8_BAR; }
    }
    PG8_WAIT_V(0);
    if constexpr (!ALIGN_EPI) { if (wr == 0) PG8_BAR; }
    PG8_BAR;
    if constexpr (Epi::AFTER_DRAIN) { E.fused(acc, cur, wr, wc, fr, fq, lds, wid, lane); S.done(cur); }
#undef PG8_SA
#undef PG8_SB
#undef PG8_STAGE
#undef PG8_LDA
#undef PG8_LDB
#undef PG8_MMA
#undef PG8_WAIT_V
#undef PG8_WAIT_L
#undef PG8_BAR
#undef PG8_SCHED
}
}
#include <hip/hip_cooperative_groups.h>
namespace cg = cooperative_groups;
constexpr int NWAVES = 8;
constexpr int MR = 32768, DM = 1024, FF = 2816, NGU = 5632, NIN = 2464, NINP = 2560, TSEQ = 4096, NBATCH = 8, NHEAD = 8, NMETA = 16;
constexpr int ZC_W = 1536, ZC_Q = 1696, ZC_K = 2208, ZC_V = 2336;
constexpr int PV = 320;
constexpr size_t MiB = 1u << 20;
constexpr size_t WS_CTL = 0, CTL_ZERO_BYTES = 1 * MiB;
constexpr size_t WS_WGU1 = 2 * MiB, WS_WD1 = 13 * MiB, WS_WIN = 19 * MiB, WS_WOUT = 24 * MiB, WS_WGU2 = 26 * MiB, WS_WD2 = 37 * MiB, WS_LT = 43 * MiB;
constexpr size_t WS_SSQ1 = 44 * MiB, WS_SSQ2 = 46 * MiB, WS_SSQ3 = 48 * MiB, WS_SSQ4 = 50 * MiB, WS_META = 52 * MiB;
constexpr size_t MO_XMB = 0, MO_UM = 64 * 1024, MO_H1MB = 256 * 1024, MO_SSQM1 = 320 * 1024, MO_SSQM2 = 324 * 1024, MO_ZM = 384 * 1024, MO_PM = 512 * 1024;
constexpr size_t WS_XB = 56 * MiB, WS_BIG = 120 * MiB, WS_IMG = 274 * MiB, WS_P = 296 * MiB, WS_END = 507 * MiB;
constexpr int CW_BAR = 4096;
constexpr int RING_BYTES = 131072, LDSCTL_OFF = 143360, MISC_OFF = LDSCTL_OFF + 320, LDS_BYTES = 147456;

#define GAS __attribute__((address_space(1)))
#define LAS __attribute__((address_space(3)))
typedef unsigned short bf16;
typedef unsigned v4u __attribute__((ext_vector_type(4)));
typedef unsigned v2u __attribute__((ext_vector_type(2)));
typedef float f32x4 __attribute__((ext_vector_type(4)));
typedef float f32x2 __attribute__((ext_vector_type(2)));
typedef short bf16x8 __attribute__((ext_vector_type(8)));
typedef short bf16x4 __attribute__((ext_vector_type(4)));
typedef GAS unsigned gu32;
#define LDS_WAIT() asm volatile("s_waitcnt lgkmcnt(0)" ::: "memory")
__device__ __forceinline__ unsigned f2bf(float f) { unsigned u = __builtin_bit_cast(unsigned, f); return (u + 0x7fffu + ((u >> 16) & 1u)) >> 16; }
typedef __bf16 bf16x2_t __attribute__((ext_vector_type(2)));
__device__ __forceinline__ unsigned pk2m(float lo, float hi) { f32x2 v = {lo, hi}; bf16x2_t b = __builtin_convertvector(v, bf16x2_t); return __builtin_bit_cast(unsigned, b); }
__device__ __forceinline__ unsigned pk2(float lo, float hi) { return pg8::cvt_pk_bf16(lo, hi); }
__device__ __forceinline__ float bflo(unsigned w) { return __builtin_bit_cast(float, w << 16); }
__device__ __forceinline__ float bfhi(unsigned w) { return __builtin_bit_cast(float, w & 0xffff0000u); }
__device__ __forceinline__ f32x4 unpack4(v2u w) { return (f32x4){bflo(w.x), bfhi(w.x), bflo(w.y), bfhi(w.y)}; }
__device__ __forceinline__ float sigmoidf_(float x) { return __builtin_amdgcn_rcpf(1.0f + __builtin_amdgcn_exp2f(-1.4426950408889634f * x)); }
__device__ __forceinline__ float tanhf_(float x) { return 2.0f * sigmoidf_(2.0f * x) - 1.0f; }
#define XB_TMO      128
#define XB_XCNT(j)  (256  + 64 * (j))
#define XB_XSUB(j)  (1280 + 64 * (j))
#define XB_XGEN(j)  (2304 + 64 * (j))
#define XB_TOP      3328
#define XB_TOPGEN   3392
#define XCD_BAR_WORDS 3456
#define XB_SPIN_CAP (1u << 18)

__device__ __forceinline__ unsigned xb_ld(unsigned* p)              { return __hip_atomic_load(p, __ATOMIC_RELAXED, __HIP_MEMORY_SCOPE_AGENT); }
__device__ __forceinline__ unsigned xb_add(unsigned* p, unsigned v) { return __hip_atomic_fetch_add(p, v, __ATOMIC_RELAXED, __HIP_MEMORY_SCOPE_AGENT); }
__device__ __forceinline__ unsigned xb_xcc_id() { return (unsigned)__builtin_amdgcn_s_getreg((3 << 11) | 20) & 0xFu; }
#define XB_SPIN(cond, bar) do { unsigned _sp = 0; while (cond) { __builtin_amdgcn_s_sleep(1); \
    if ((++_sp & 255u) == 0u) { if (xb_ld(&(bar)[XB_TMO])) break; if (_sp > XB_SPIN_CAP) { atomicAdd(&(bar)[XB_TMO], 1u); break; } } } } while (0)

struct XcdBarrier {
    unsigned* bar; unsigned x;
    volatile LAS unsigned* st;
};

__device__ __forceinline__ XcdBarrier xcd_barrier_post(unsigned* bar, volatile LAS unsigned* st) {
    XcdBarrier b; b.bar = bar; b.x = xb_xcc_id(); b.st = st;
    if (threadIdx.x == 0) (void)xb_add(&bar[XB_XCNT(b.x)], 1u);
    return b;
}
__device__ __forceinline__ void xcd_barrier_complete(unsigned* bar, unsigned x, unsigned& nloc, unsigned& nx) {
    const unsigned G = gridDim.x * gridDim.y * gridDim.z;
    unsigned sum, cnt, mine, sp = 0u;
    for (;;) {
        sum = 0u; cnt = 0u; mine = 0u;
#pragma unroll
        for (unsigned j = 0; j < 16; ++j) { const unsigned c = xb_ld(&bar[XB_XCNT(j)]); sum += c; cnt += (c > 0u) ? 1u : 0u; mine = (j == x) ? c : mine; }
        if (sum == G) break;
        __builtin_amdgcn_s_sleep(1);
        if ((++sp & 255u) == 0u) { if (xb_ld(&bar[XB_TMO])) break; if (sp > XB_SPIN_CAP) { atomicAdd(&bar[XB_TMO], 1u); break; } }
    }
    nloc = mine > 0u ? mine : 1u; nx = cnt > 0u ? cnt : 1u;
}

__device__ __forceinline__ void xcd_barrier(const XcdBarrier& b) {
    asm volatile("s_waitcnt vmcnt(0)" ::: "memory");
    __syncthreads();
    if (threadIdx.x == 0) {
        unsigned* bar = b.bar;
        __builtin_amdgcn_s_waitcnt(0);
        unsigned nloc = b.st[0], nx = b.st[1];
        if (nloc == 0u) { xcd_barrier_complete(bar, b.x, nloc, nx); b.st[0] = nloc; b.st[1] = nx; }
        const unsigned old = xb_add(&bar[XB_XSUB(b.x)], 1u);
        const unsigned gen = old / nloc;
        if (old + 1u == (gen + 1u) * nloc) {
            __builtin_amdgcn_fence(__ATOMIC_RELEASE, "agent");
            asm volatile("s_waitcnt vmcnt(0)" ::: "memory");
            const unsigned og = xb_add(&bar[XB_TOP], 1u);
            const unsigned tg = og / nx;
            if (og + 1u == (tg + 1u) * nx) xb_add(&bar[XB_TOPGEN], 1u);
            else XB_SPIN(xb_ld(&bar[XB_TOPGEN]) == tg, bar);
            __builtin_amdgcn_fence(__ATOMIC_ACQUIRE, "agent");
            xb_add(&bar[XB_XGEN(b.x)], 1u);
            asm volatile("s_waitcnt vmcnt(0)" ::: "memory");
        } else {
            XB_SPIN(xb_ld(&bar[XB_XGEN(b.x)]) == gen, bar);
            __builtin_amdgcn_fence(__ATOMIC_ACQUIRE, "agent");
            asm volatile("s_waitcnt vmcnt(0)" ::: "memory");
        }
    }
    __syncthreads();
}
__device__ __forceinline__ float wave_sum(float v) {
#pragma unroll
    for (int o = 1; o < 64; o <<= 1) v += __shfl_xor(v, o);
    return v;
}
__device__ __forceinline__ void p0_transpose_item(const float* W, int K, int N, bf16* WT, const float* gain, int k0, int n0, int drow0, LAS float* scr, int lane) {
#pragma unroll 8
    for (int i = 0; i < 32; ++i) { const int kk = 2 * i + (lane >> 5); float w = W[(size_t)(k0 + kk) * N + n0 + (lane & 31)]; if (gain) w *= gain[k0 + kk]; scr[kk * 33 + (lane & 31)] = w; }
    LDS_WAIT(); asm volatile("" ::: "memory");
    const int c = lane & 7;
#pragma unroll
    for (int j = 0; j < 4; ++j) { const int n = (lane >> 3) + 8 * j; const LAS float* s = scr + (8 * c) * 33 + n;
        v4u o; o.x = pk2(s[0 * 33], s[1 * 33]); o.y = pk2(s[2 * 33], s[3 * 33]); o.z = pk2(s[4 * 33], s[5 * 33]); o.w = pk2(s[6 * 33], s[7 * 33]);
        *(GAS v4u*)(WT + (size_t)(drow0 + n) * K + k0 + 8 * c) = o; }
    LDS_WAIT(); asm volatile("" ::: "memory");
}
__device__ __forceinline__ void row_to_bf16(const float* xrow, bf16* orow, float* ssq16, int lane) {
    const GAS f32x4* xr = (const GAS f32x4*)xrow + lane; f32x4 v[4]; float s = 0.f;
#pragma unroll
    for (int j = 0; j < 4; ++j) { v[j] = xr[64 * j]; s += (v[j].x * v[j].x + v[j].y * v[j].y) + (v[j].z * v[j].z + v[j].w * v[j].w); }
    s = wave_sum(s);
    GAS v2u* o8 = (GAS v2u*)orow + lane;
#pragma unroll
    for (int j = 0; j < 4; ++j) { v2u w; w.x = pk2(v[j].x, v[j].y); w.y = pk2(v[j].z, v[j].w); o8[64 * j] = w; }
    if (lane < 16) ssq16[lane] = (lane == 0) ? s : 0.f;
}
struct Ptrs {
    const float* in[27]; float* out; unsigned char* ws;
};
__device__ __forceinline__ void p0_prologue(const Ptrs& P, LAS unsigned char* lds, int vcu, int G, int wave, int lane) {
    LAS float* scr = (LAS float*)(lds + wave * 16384);
    const int gw = vcu * NWAVES + wave, NGW = G * NWAVES;
    unsigned char* ws = P.ws;
    constexpr int I_G = (DM / 64) * (FF / 32), I_D = (FF / 64) * (DM / 32), I_IN = (DM / 64) * (NIN / 32), I_O = (DM / 64) * (DM / 32);
    constexpr int NITEMS = 4 * I_G + 2 * I_D + I_IN + I_O;
    for (int it = gw; it < NITEMS; it += NGW) {
        int r = it;
        if (r < 4 * I_G) {
            const int which = r / I_G; r -= which * I_G; const int nblk = FF / 32, kb = r / nblk, nb = r % nblk, n0 = 32 * nb;
            const float* W = P.in[which == 0 ? 3 : which == 1 ? 4 : which == 2 ? 23 : 24]; const float* gain = P.in[which < 2 ? 2 : 22];
            bf16* WT = (bf16*)(ws + (which < 2 ? WS_WGU1 : WS_WGU2));
            const int drow0 = 256 * (n0 / 128) + 128 * (which & 1) + (n0 % 128);
            p0_transpose_item(W, DM, FF, WT, gain, 64 * kb, n0, drow0, scr, lane); continue; }
        r -= 4 * I_G;
        if (r < 2 * I_D) { const int which = r / I_D; r -= which * I_D; const int nblk = DM / 32, kb = r / nblk, nb = r % nblk;
            p0_transpose_item(P.in[which ? 25 : 5], FF, DM, (bf16*)(ws + (which ? WS_WD2 : WS_WD1)), nullptr, 64 * kb, 32 * nb, 32 * nb, scr, lane); continue; }
        r -= 2 * I_D;
        if (r < I_IN) { const int nblk = NIN / 32, kb = r / nblk, nb = r % nblk;
            p0_transpose_item(P.in[7], DM, NIN, (bf16*)(ws + WS_WIN), P.in[6], 64 * kb, 32 * nb, 32 * nb, scr, lane); continue; }
        r -= I_IN;
        { const int nblk = DM / 32, kb = r / nblk, nb = r % nblk;
            p0_transpose_item(P.in[21], DM, DM, (bf16*)(ws + WS_WOUT), nullptr, 64 * kb, 32 * nb, 32 * nb, scr, lane); }
    }
    { GAS v4u* z = (GAS v4u*)(ws + WS_WIN + (size_t)NIN * DM * 2); const int n16 = (NINP - NIN) * DM * 2 / 16;
      for (int i = gw * 64 + lane; i < n16; i += NGW * 64) z[i] = (v4u){0u, 0u, 0u, 0u}; }
    { bf16* LT = (bf16*)(ws + WS_LT);
      for (int i = gw * 64 + lane; i < 512 * 160; i += NGW * 64) { const int n = i / 160, j = i % 160;
          const float v = j < 32 ? P.in[11][j * 512 + n] : j < 64 ? P.in[13][(j - 32) * 512 + n] : P.in[14][(j - 64) * 512 + n];
          LT[i] = (bf16)f2bf(v); } }
    for (int m = gw; m < MR + NMETA; m += NGW) {
        if (m < MR) row_to_bf16(P.in[0] + (size_t)m * DM, (bf16*)(ws + WS_XB) + (size_t)m * DM, (float*)(ws + WS_SSQ1) + (size_t)m * 16, lane);
        else { const int i = m - MR; row_to_bf16(P.in[1] + (size_t)i * DM, (bf16*)(ws + WS_META + MO_XMB) + (size_t)i * DM, (float*)(ws + WS_META + MO_SSQM1) + i * 16, lane); }
    }
}
__device__ __forceinline__ f32x4 skinny16(const bf16* A, const bf16* Bt, int K, int n0, int lane) {
    const int fr = lane & 15, fq = lane >> 4;
    const bf16* ap = A + (size_t)fr * K + 8 * fq; const bf16* bp = Bt + (size_t)(n0 + fr) * K + 8 * fq;
    f32x4 acc = (f32x4){0.f, 0.f, 0.f, 0.f};
    for (int k = 0; k < K; k += 256) {
        bf16x8 a[8], b[8];
#pragma unroll
        for (int j = 0; j < 8; ++j) { a[j] = *(const bf16x8*)(ap + k + 32 * j); b[j] = *(const bf16x8*)(bp + k + 32 * j); }
#pragma unroll
        for (int j = 0; j < 8; ++j) acc = __builtin_amdgcn_mfma_f32_16x16x32_bf16(a[j], b[j], acc, 0, 0, 0); }
    return acc;
}
__device__ __forceinline__ float rstd_m16(const float* ssq16) { float s = 0.f;
#pragma unroll
    for (int i = 0; i < 16; ++i) s += ssq16[i];
    return __builtin_amdgcn_rsqf(s * (1.0f / 1024.0f) + 1e-5f); }
__device__ __forceinline__ void meta_up(unsigned char* ws, int gw, int NGW, int lane) {
    const bf16* A = (const bf16*)(ws + WS_META + MO_XMB); const bf16* Bt = (const bf16*)(ws + WS_WGU1); bf16* Um = (bf16*)(ws + WS_META + MO_UM);
    const float* ssq = (const float*)(ws + WS_META + MO_SSQM1); const int fr = lane & 15, fq = lane >> 4;
    for (int t = gw; t < FF / 16; t += NGW) { const int c0 = 16 * t, nr = 256 * (c0 / 128) + (c0 % 128);
        const f32x4 g = skinny16(A, Bt, DM, nr, lane), u = skinny16(A, Bt, DM, nr + 128, lane);
#pragma unroll
        for (int r = 0; r < 4; ++r) { const int row = 4 * fq + r; const float rs = rstd_m16(ssq + row * 16); Um[(size_t)row * FF + c0 + fr] = (bf16)f2bf(pg8::silu_mul(g[r] * rs, u[r] * rs)); } }
}
__device__ __forceinline__ void meta_down(const Ptrs& P, int gw, int NGW, int lane) {
    unsigned char* ws = P.ws; const bf16* A = (const bf16*)(ws + WS_META + MO_UM); const bf16* Bt = (const bf16*)(ws + WS_WD1); bf16* H = (bf16*)(ws + WS_META + MO_H1MB);
    float* ssq = (float*)(ws + WS_META + MO_SSQM2); const int fr = lane & 15, fq = lane >> 4;
    for (int t = gw; t < DM / 16; t += NGW) { const f32x4 a = skinny16(A, Bt, FF, 16 * t, lane);
#pragma unroll
        for (int r = 0; r < 4; ++r) { const int row = 4 * fq + r; const float o = P.in[1][row * DM + 16 * t + fr] + 0.5f * a[r]; H[row * DM + 16 * t + fr] = (bf16)f2bf(o);
            float s = o * o; s += __shfl_xor(s, 1); s += __shfl_xor(s, 2); s += __shfl_xor(s, 4); s += __shfl_xor(s, 8); if (fr == 0) ssq[row * 64 + t] = s; } }
}
__device__ __forceinline__ void meta_win(const Ptrs& P, int gw, int NGW, int lane) {
    unsigned char* ws = P.ws; const bf16* A = (const bf16*)(ws + WS_META + MO_H1MB); const bf16* Bt = (const bf16*)(ws + WS_WIN); bf16* Zm = (bf16*)(ws + WS_META + MO_ZM);
    const float* ssq = (const float*)(ws + WS_META + MO_SSQM2); const int fr = lane & 15, fq = lane >> 4;
    for (int t = gw; t < NIN / 16; t += NGW) { const f32x4 a = skinny16(A, Bt, DM, 16 * t, lane); const int c = 16 * t + fr; const float bias = c >= ZC_Q ? P.in[8][c - ZC_Q] : 0.f;
#pragma unroll
        for (int r = 0; r < 4; ++r) { const int row = 4 * fq + r; float s = 0.f;
#pragma unroll 8
            for (int i = 0; i < 64; ++i) s += ssq[row * 64 + i];
            Zm[(size_t)row * NIN + c] = (bf16)f2bf(a[r] * __builtin_amdgcn_rsqf(s * (1.0f / 1024.0f) + 1e-5f) + bias); } }
}
constexpr int KS_LD = 72, VT_LD = 232, ATT_KS_BYTES = 208 * KS_LD * 2, ATT_VT_BYTES = 64 * VT_LD * 2;
__device__ __forceinline__ void attn_unit(const Ptrs& P, unsigned char* lds, int b, int g, int c, int tid, int wave, int lane) {
    unsigned char* ws = P.ws; const bf16* Z = (const bf16*)(ws + WS_BIG); const bf16* Zm = (const bf16*)(ws + WS_META + MO_ZM); bf16* Y = (bf16*)(ws + WS_XB);
    bf16* Ks = (bf16*)lds; bf16* Vt = (bf16*)(lds + ATT_KS_BYTES);
    const int fr = lane & 15, fq = lane >> 4;
    __syncthreads();
    for (int it = tid; it < 208 * 8; it += NWAVES * 64) { const int key = it >> 3, pc = it & 7; const bf16* src; bool valid = true;
        if (key < 16) src = Zm + (size_t)key * NIN; else { const int t = 64 * (c - 2) + (key - 16); valid = t >= 0; src = Z + ((size_t)b * TSEQ + (valid ? t : 0)) * NIN; }
        v4u kq = *(const v4u*)(src + ZC_K + 64 * g + 8 * pc), vq = *(const v4u*)(src + ZC_V + 64 * g + 8 * pc);
        if (!valid) { kq = (v4u){0u, 0u, 0u, 0u}; vq = kq; }
        *(v4u*)(Ks + key * KS_LD + 8 * pc) = kq;
#pragma unroll
        for (int e = 0; e < 4; ++e) { Vt[(8 * pc + 2 * e) * VT_LD + key] = (bf16)(vq[e] & 0xffffu); Vt[(8 * pc + 2 * e + 1) * VT_LD + key] = (bf16)(vq[e] >> 16); } }
    for (int it = tid; it < 64 * 16; it += NWAVES * 64) Vt[(it >> 4) * VT_LD + 208 + (it & 15)] = 0;
    __syncthreads();
    const int hq = 4 * g + (wave >> 1);
    const float slope = __builtin_amdgcn_exp2f(-(float)(hq + 1)), sink = P.in[20][hq];
#pragma unroll 1
    for (int sub = 0; sub < 2; ++sub) {
        const int i0 = 16 * (2 * (wave & 1) + sub), iq = i0 + fr;
        const size_t mrow = (size_t)b * TSEQ + 64 * c + iq;
        const bf16x8 q0 = *(const bf16x8*)(Z + mrow * NIN + ZC_Q + 64 * hq + 8 * fq), q1 = *(const bf16x8*)(Z + mrow * NIN + ZC_Q + 64 * hq + 32 + 8 * fq);
        f32x4 s[13]; float mx = sink;
#pragma unroll
        for (int kt = 0; kt < 13; ++kt) { const bf16* kp = Ks + (16 * kt + fr) * KS_LD + 8 * fq; f32x4 a = (f32x4){0.f, 0.f, 0.f, 0.f};
            a = __builtin_amdgcn_mfma_f32_16x16x32_bf16(*(const bf16x8*)(kp), q0, a, 0, 0, 0);
            a = __builtin_amdgcn_mfma_f32_16x16x32_bf16(*(const bf16x8*)(kp + 32), q1, a, 0, 0, 0);
#pragma unroll
            for (int r = 0; r < 4; ++r) { const int key = 16 * kt + 4 * fq + r; float v;
                if (kt == 0) v = a[r] * 0.125f - slope * (float)(16 + 64 * c + iq - key);
                else { const int jj = key - 16; const int d = 128 + iq - jj; v = a[r] * 0.125f - slope * (float)(d < 0 ? -d : d); if (64 * (c - 2) + jj < 0) v = -1e30f; }
                a[r] = v; mx = fmaxf(mx, v); }
            s[kt] = a; }
        mx = fmaxf(mx, __shfl_xor(mx, 16)); mx = fmaxf(mx, __shfl_xor(mx, 32));
        float sum = 0.f;
#pragma unroll
        for (int kt = 0; kt < 13; ++kt)
#pragma unroll
            for (int r = 0; r < 4; ++r) { const float p = __builtin_amdgcn_exp2f((s[kt][r] - mx) * 1.4426950408889634f); s[kt][r] = p; sum += p; }
        sum += __shfl_xor(sum, 16); sum += __shfl_xor(sum, 32);
        sum += __builtin_amdgcn_exp2f((sink - mx) * 1.4426950408889634f);
        const float rinv = 1.0f / sum;
        f32x4 o[4];
#pragma unroll
        for (int dt = 0; dt < 4; ++dt) o[dt] = (f32x4){0.f, 0.f, 0.f, 0.f};
#pragma unroll
        for (int ks = 0; ks < 7; ++ks) { const int ta = 2 * ks, tb = 2 * ks + 1; v4u pw;
            pw.x = pk2(s[ta][0], s[ta][1]); pw.y = pk2(s[ta][2], s[ta][3]);
            if (tb < 13) { pw.z = pk2(s[tb][0], s[tb][1]); pw.w = pk2(s[tb][2], s[tb][3]); } else { pw.z = 0u; pw.w = 0u; }
            const bf16x8 pf = __builtin_bit_cast(bf16x8, pw);
#pragma unroll
            for (int dt = 0; dt < 4; ++dt) { const bf16* vp = Vt + (16 * dt + fr) * VT_LD + 4 * fq; const v2u va = *(const v2u*)(vp + 16 * ta), vb = *(const v2u*)(vp + 16 * tb);
                const v4u vv = (v4u){va.x, va.y, vb.x, vb.y};
                o[dt] = __builtin_amdgcn_mfma_f32_16x16x32_bf16(__builtin_bit_cast(bf16x8, vv), pf, o[dt], 0, 0, 0); } }
#pragma unroll
        for (int dt = 0; dt < 4; ++dt) { v2u w; w.x = pk2(o[dt][0] * rinv, o[dt][1] * rinv); w.y = pk2(o[dt][2] * rinv, o[dt][3] * rinv);
            *(v2u*)(Y + mrow * DM + 512 + 64 * hq + 16 * dt + 4 * fq) = w; }
    }
}
template <int CTRL> __device__ __forceinline__ float dppf(float x) { return __builtin_bit_cast(float, __builtin_amdgcn_update_dpp(0, __builtin_bit_cast(int, x), CTRL, 0xF, 0xF, true)); }
template <int CTRL> __device__ __forceinline__ float dppf_old(float old, float x) { return __builtin_bit_cast(float, __builtin_amdgcn_update_dpp(__builtin_bit_cast(int, old), __builtin_bit_cast(int, x), CTRL, 0xF, 0xF, false)); }
__device__ __forceinline__ float red8(float x) { x += dppf<0xB1>(x); x += dppf<0x4E>(x); x += dppf<0x141>(x); return x; }
__device__ __forceinline__ float red16(float x) { x = red8(x); x += dppf<0x140>(x); return x; }
__device__ __forceinline__ float scan16(float x) { x += dppf<0x111>(x); x += dppf<0x112>(x); x += dppf<0x114>(x); x += dppf<0x118>(x); return x; }
constexpr int NCHUNK = 257, NSUPER = 65;
constexpr int CB_A = 0, CB_R = 2048, CB_BK = 4096, CB_VT = 8192, CB_TT = 10240, CB_AR = 11264, CB_G = 12288, CB_BON = 12544, CB_SIZE = 12800;
constexpr int CB_GATE = 12800, IMG_SIZE = 14848;
constexpr int WL_HS = IMG_SIZE, WL_SIZE = IMG_SIZE + 2048;
constexpr int SC_YB = 8 * CB_SIZE, SC_END = SC_YB + 8 * 4096;
static_assert(8 * WL_SIZE <= LDSCTL_OFF && SC_END <= LDSCTL_OFF, "LDS map");
__device__ __forceinline__ bf16x8 pack8(const float* v) { v4u o; o.x = pk2(v[0], v[1]); o.y = pk2(v[2], v[3]); o.z = pk2(v[4], v[5]); o.w = pk2(v[6], v[7]); return __builtin_bit_cast(bf16x8, o); }
__device__ __forceinline__ void unpack8(v4u w, float* v) { v[0] = bflo(w.x); v[1] = bfhi(w.x); v[2] = bflo(w.y); v[3] = bfhi(w.y); v[4] = bflo(w.z); v[5] = bfhi(w.z); v[6] = bflo(w.w); v[7] = bfhi(w.w); }


__device__ __forceinline__ void chunk_task(const Ptrs& P, unsigned char* ldsb, int woff, int b, int h, int ch, int lane) {
    int wo_ = woff; asm volatile("" : "+v"(wo_));
    unsigned char* wl = ldsb + wo_;
    unsigned char* ws = P.ws; const int fr = lane & 15, fq = lane >> 4, t = fr;
    const bf16* Z = (const bf16*)(ws + WS_BIG); const bf16* Zm = (const bf16*)(ws + WS_META + MO_ZM); const bf16* LT = (const bf16*)(ws + WS_LT);
    const bool meta = (ch == 0);
    const int tok = 16 * (ch - 1) + fr; const size_t m = (size_t)b * TSEQ + tok;
    const bf16* zc = meta ? Zm + (size_t)fr * NIN : Z + m * NIN;
    const bool pz = meta && fr == 0;
    const bf16* zp = meta ? Zm + (size_t)(fr > 0 ? fr - 1 : 0) * NIN : (tok == 0 ? Zm + (size_t)15 * NIN : Z + (m - 1) * NIN);
    const float* mu = P.in[9];
    bf16* sx = (bf16*)wl;
    {
    bf16x8 xf[5];
#pragma unroll
    for (int ks = 0; ks < 5; ++ks) { const int c0 = ZC_W + 32 * ks + 8 * fq; const v4u a = *(const v4u*)(zc + c0); v4u bq = *(const v4u*)(zp + c0); if (pz) bq = (v4u){0u, 0u, 0u, 0u};
        float va[8], vb[8], v[8]; unpack8(a, va); unpack8(bq, vb); const f32x4 m0 = *(const f32x4*)(mu + c0), m1 = *(const f32x4*)(mu + c0 + 4);
#pragma unroll
        for (int e = 0; e < 8; ++e) { const float mm = e < 4 ? m0[e & 3] : m1[e & 3]; const float z = va[e] + (vb[e] - va[e]) * mm; v[e] = (ks == 0) ? tanhf_(z) : (ks == 1) ? z : sigmoidf_(z); }
        xf[ks] = pack8(v); }
    f32x4 aw[4], aa[4], ag[4];
#pragma unroll
    for (int nt = 0; nt < 4; ++nt) { const bf16* lp = LT + (size_t)(h * 64 + 16 * nt + fr) * 160 + 8 * fq; const f32x4 z = (f32x4){0.f, 0.f, 0.f, 0.f};
        aw[nt] = __builtin_amdgcn_mfma_f32_16x16x32_bf16(*(const bf16x8*)(lp), xf[0], z, 0, 0, 0);
        aa[nt] = __builtin_amdgcn_mfma_f32_16x16x32_bf16(*(const bf16x8*)(lp + 32), xf[1], z, 0, 0, 0);
        ag[nt] = __builtin_amdgcn_mfma_f32_16x16x32_bf16(*(const bf16x8*)(lp + 64), xf[2], z, 0, 0, 0);
        ag[nt] = __builtin_amdgcn_mfma_f32_16x16x32_bf16(*(const bf16x8*)(lp + 96), xf[3], ag[nt], 0, 0, 0);
        ag[nt] = __builtin_amdgcn_mfma_f32_16x16x32_bf16(*(const bf16x8*)(lp + 128), xf[4], ag[nt], 0, 0, 0); }
    f32x4 kkr[4], kv[4], av[4]; float ss = 0.f;
#pragma unroll
    for (int nt = 0; nt < 4; ++nt) { const int c = h * 64 + 16 * nt + 4 * fq; const v2u a = *(const v2u*)(zc + 512 + c); v2u bq = *(const v2u*)(zp + 512 + c); if (pz) bq = (v2u){0u, 0u};
        const f32x4 za = unpack4(a), zb = unpack4(bq), mk = *(const f32x4*)(mu + 512 + c); const f32x4 zk = za + (zb - za) * mk;
        const f32x4 a0 = *(const f32x4*)(P.in[12] + c), kkw = *(const f32x4*)(P.in[15] + c), kaw = *(const f32x4*)(P.in[16] + c);
        f32x4 a_;
#pragma unroll
        for (int r = 0; r < 4; ++r) a_[r] = sigmoidf_(a0[r] + aa[nt][r]);
        av[nt] = a_; kkr[nt] = zk * kkw; kv[nt] = zk * (1.0f + (a_ - 1.0f) * kaw);
        ss += (kkr[nt][0] * kkr[nt][0] + kkr[nt][1] * kkr[nt][1]) + (kkr[nt][2] * kkr[nt][2] + kkr[nt][3] * kkr[nt][3]); }
    ss += __shfl_xor(ss, 16); ss += __shfl_xor(ss, 32);
    const float inv = 1.0f / fmaxf(sqrtf(ss), 1e-12f);
#pragma unroll
    for (int nt = 0; nt < 4; ++nt) { const int cl = 16 * nt + 4 * fq, c = h * 64 + cl; const f32x4 w0 = *(const f32x4*)(P.in[10] + c);
        const f32x4 kk = kkr[nt] * inv, bb = kk * av[nt]; f32x4 e;
#pragma unroll
        for (int r = 0; r < 4; ++r) e[r] = 0.6065306597126334f * sigmoidf_(w0[r] + aw[nt][r]);
        bf16* px = sx + t * 64 + cl; v2u o;
        o.x = pk2(kk[0], kk[1]); o.y = pk2(kk[2], kk[3]); *(v2u*)(px) = o;
        o.x = pk2(e[0], e[1]); o.y = pk2(e[2], e[3]); *(v2u*)(px + 1024) = o;
        o.x = pk2(bb[0], bb[1]); o.y = pk2(bb[2], bb[3]); *(v2u*)(px + 2048) = o;
        o.x = pk2(kv[nt][0], kv[nt][1]); o.y = pk2(kv[nt][2], kv[nt][3]); *(v2u*)(px + 3072) = o;
        o.x = pk2m(ag[nt][0], ag[nt][1]); o.y = pk2m(ag[nt][2], ag[nt][3]); *(v2u*)(px + 4096) = o; }
    }
    asm volatile("s_waitcnt lgkmcnt(0)" ::: "memory"); __builtin_amdgcn_sched_barrier(0);
    v4u xk[2], xe[2], xb[2], xx[2], xg[2];
#pragma unroll
    for (int ks = 0; ks < 2; ++ks) { const bf16* px = sx + t * 64 + 32 * ks + 8 * fq; xk[ks] = *(const v4u*)(px); xe[ks] = *(const v4u*)(px + 1024); xb[ks] = *(const v4u*)(px + 2048); xx[ks] = *(const v4u*)(px + 3072); xg[ks] = *(const v4u*)(px + 4096); }
    asm volatile("s_waitcnt lgkmcnt(0)" ::: "memory"); __builtin_amdgcn_sched_barrier(0);
    unsigned char* cb = wl; float* hs = (float*)(wl + WL_HS);
    const int cbase = h * 64 + 8 * fq;
    unsigned char* pbk = cb + CB_BK + ((((fq >> 1) * 4 + (t >> 2)) * 16 + 8 * (fq & 1)) * 8 + (t & 3)) * 2;
    unsigned char* pvt = cb + CB_VT + (((fq >> 1) * 4 + (t >> 2)) * 16 + 8 * (fq & 1)) * 8 + (t & 3) * 2;
    unsigned char* pgc = cb + CB_G + 8 * fq * 4;
    bf16x8 Af[2], Rf[2], Bf[2], Kf[2]; float bonp = 0.f;
#pragma unroll
    for (int ks = 0; ks < 2; ++ks) { const int c = cbase + 32 * ks, cl = 32 * ks + 8 * fq;
        asm volatile("" ::: "memory"); __builtin_amdgcn_sched_barrier(0);
        float kk[8], e_[8], bb[8], kx[8], rc[8], rp[8], vc[8], vp[8];
        unpack8(xk[ks], kk); unpack8(xe[ks], e_); unpack8(xb[ks], bb); unpack8(xx[ks], kx);
        unpack8(*(const v4u*)(zc + c), rc); unpack8(*(const v4u*)(zc + 1024 + c), vc);
        { v4u a = *(const v4u*)(zp + c), d = *(const v4u*)(zp + 1024 + c); if (pz) { a = (v4u){0u, 0u, 0u, 0u}; d = a; } unpack8(a, rp); unpack8(d, vp); }
        float At[8], Rt[8], Bt[8], Kt[8]; float mur[8], muv[8], rkk[8];
        { const f32x4 a0 = *(const f32x4*)(P.in[9] + c), a1 = *(const f32x4*)(P.in[9] + c + 4), b0 = *(const f32x4*)(P.in[9] + 1024 + c), b1 = *(const f32x4*)(P.in[9] + 1024 + c + 4), c0 = *(const f32x4*)(P.in[17] + c), c1 = *(const f32x4*)(P.in[17] + c + 4);
#pragma unroll
          for (int e = 0; e < 4; ++e) { mur[e] = a0[e]; mur[4 + e] = a1[e]; muv[e] = b0[e]; muv[4 + e] = b1[e]; rkk[e] = c0[e]; rkk[4 + e] = c1[e]; } }
#pragma unroll
        for (int e = 0; e < 8; ++e) { const float rr = rc[e] + (rp[e] - rc[e]) * mur[e]; const float vv = vc[e] + (vp[e] - vc[e]) * muv[e];
            bonp += rr * kx[e] * rkk[e];
            const float ec = scan16(e_[e]), etot = red16(e_[e]);
            const float g1 = __builtin_amdgcn_exp2f(-1.4426950408889634f * ec);
            const float gi = __builtin_amdgcn_exp2f(1.4426950408889634f * ec);
            const float gC = __builtin_amdgcn_exp2f(-1.4426950408889634f * etot);
            const float g0 = dppf_old<0x111>(1.0f, g1);
            At[e] = -kk[e] * g0; Rt[e] = rr * g1; Bt[e] = bb[e] * gi; Kt[e] = kx[e] * gi;
            const int ke = 32 * ks + e;
            *(bf16*)(pbk + ks * 2048 + e * 16) = (bf16)f2bf(Bt[e] * gC);
            *(bf16*)(pbk + ks * 2048 + e * 16 + 8) = (bf16)f2bf(Kt[e] * gC);
            *(bf16*)(pvt + ks * 1024 + e * 8) = (bf16)f2bf(vv);
            if (t == 15) *(float*)(pgc + ke * 4) = gC; }
        Af[ks] = pack8(At); Rf[ks] = pack8(Rt); Bf[ks] = pack8(Bt); Kf[ks] = pack8(Kt);
        { const int fqs = 2 * (fq & 1), bo = (fq >> 1) * 8; const v4u aw = __builtin_bit_cast(v4u, Af[ks]), rw = __builtin_bit_cast(v4u, Rf[ks]);
          *(v2u*)(cb + CB_A + ((ks * 4 + fqs) * 16 + t) * 16 + bo) = (v2u){aw.x, aw.y}; *(v2u*)(cb + CB_A + ((ks * 4 + fqs + 1) * 16 + t) * 16 + bo) = (v2u){aw.z, aw.w};
          *(v2u*)(cb + CB_R + ((ks * 4 + fqs) * 16 + t) * 16 + bo) = (v2u){rw.x, rw.y}; *(v2u*)(cb + CB_R + ((ks * 4 + fqs + 1) * 16 + t) * 16 + bo) = (v2u){rw.z, rw.w}; }
        *(v4u*)(cb + CB_GATE + (t * 64 + cl) * 2) = xg[ks]; }
    asm volatile("" ::: "memory"); __builtin_amdgcn_sched_barrier(0);
    bonp += __shfl_xor(bonp, 16); bonp += __shfl_xor(bonp, 32);
    if (fq == 0) *(float*)(cb + CB_BON + t * 4) = bonp;
    const f32x4 z4 = (f32x4){0.f, 0.f, 0.f, 0.f};
    f32x4 Mab = __builtin_amdgcn_mfma_f32_16x16x32_bf16(Af[0], Bf[0], z4, 0, 0, 0); Mab = __builtin_amdgcn_mfma_f32_16x16x32_bf16(Af[1], Bf[1], Mab, 0, 0, 0);
    f32x4 Mak = __builtin_amdgcn_mfma_f32_16x16x32_bf16(Af[0], Kf[0], z4, 0, 0, 0); Mak = __builtin_amdgcn_mfma_f32_16x16x32_bf16(Af[1], Kf[1], Mak, 0, 0, 0);
    f32x4 Mrb = __builtin_amdgcn_mfma_f32_16x16x32_bf16(Rf[0], Bf[0], z4, 0, 0, 0); Mrb = __builtin_amdgcn_mfma_f32_16x16x32_bf16(Rf[1], Bf[1], Mrb, 0, 0, 0);
    f32x4 Mrk = __builtin_amdgcn_mfma_f32_16x16x32_bf16(Rf[0], Kf[0], z4, 0, 0, 0); Mrk = __builtin_amdgcn_mfma_f32_16x16x32_bf16(Rf[1], Kf[1], Mrk, 0, 0, 0);
#pragma unroll
    for (int r = 0; r < 4; ++r) { const int tt = 4 * fq + r, i = fr;
        const float mab = (tt > i) ? Mab[r] : 0.f, mak = (tt > i) ? Mak[r] : 0.f, mrb = (tt >= i) ? Mrb[r] : 0.f, mrk = (tt >= i) ? Mrk[r] : 0.f;
        hs[tt * 16 + i] = mab; hs[256 + tt * 16 + i] = mak;
        const unsigned w = pk2m(mrb, mrk);
        *(bf16*)(cb + CB_AR + (((i >> 2) * 16 + tt) * 8 + (i & 3)) * 2) = (bf16)(w & 0xffffu);
        *(bf16*)(cb + CB_AR + (((i >> 2) * 16 + tt) * 8 + 4 + (i & 3)) * 2) = (bf16)(w >> 16); }
    asm volatile("s_waitcnt lgkmcnt(0)" ::: "memory");
    { const int c = lane & 31, cc = c & 15; const bool isT = c < 16; float out[16];
#pragma unroll
      for (int tt = 0; tt < 16; ++tt) { float acc = isT ? (tt == cc ? 1.0f : 0.0f) : hs[256 + tt * 16 + cc];
#pragma unroll
          for (int i4 = 0; i4 < (tt + 3) / 4; ++i4) { const f32x4 l = *(const f32x4*)(hs + tt * 16 + 4 * i4);
#pragma unroll
              for (int e = 0; e < 4; ++e) if (4 * i4 + e < tt) acc += l[e] * out[4 * i4 + e]; }
          out[tt] = acc;
          if (lane < 32) *(bf16*)(cb + CB_TT + (((cc >> 2) * 16 + tt) * 8 + (isT ? 0 : 4) + (cc & 3)) * 2) = (bf16)f2bf(acc); } }
    asm volatile("s_waitcnt lgkmcnt(0)" ::: "memory");
    { unsigned char* gi = ws + WS_IMG + ((size_t)(b * NHEAD + h) * NCHUNK + ch) * IMG_SIZE;
      for (int i = lane; i < IMG_SIZE / 16; i += 64) *(v4u*)(gi + i * 16) = *(const v4u*)(cb + i * 16); }
    asm volatile("s_waitcnt lgkmcnt(0)" ::: "memory"); __builtin_amdgcn_sched_barrier(0);
}

struct ScanOps { bf16x8 a0, a1, r0, r1, tt, ar, bk[4]; v2u vt; f32x4 g[4]; };
__device__ __forceinline__ void scan_load(ScanOps& o, const unsigned char* ib, int fr, int fq, int vcol) {
    const int ln = (fq * 16 + fr) * 16;
    o.a0 = *(const bf16x8*)(ib + CB_A + ln); o.a1 = *(const bf16x8*)(ib + CB_A + 1024 + ln);
    o.r0 = *(const bf16x8*)(ib + CB_R + ln); o.r1 = *(const bf16x8*)(ib + CB_R + 1024 + ln);
    o.tt = *(const bf16x8*)(ib + CB_TT + ln); o.ar = *(const bf16x8*)(ib + CB_AR + ln);
    o.vt = *(const v2u*)(ib + CB_VT + (((vcol >> 4) * 4 + fq) * 16 + fr) * 8);
#pragma unroll
    for (int kt = 0; kt < 4; ++kt) { o.g[kt] = *(const f32x4*)(ib + CB_G + (16 * kt + 4 * fq) * 4); o.bk[kt] = *(const bf16x8*)(ib + CB_BK + kt * 1024 + ln); }
}
__device__ __forceinline__ void scan_step(f32x4 (&H)[4], const ScanOps& o, float* yb, int fq, int vcol) {
    v4u hb0, hb1;
    hb0.x = pk2m(H[0][0], H[0][1]); hb0.y = pk2m(H[0][2], H[0][3]); hb0.z = pk2m(H[1][0], H[1][1]); hb0.w = pk2m(H[1][2], H[1][3]);
    hb1.x = pk2m(H[2][0], H[2][1]); hb1.y = pk2m(H[2][2], H[2][3]); hb1.z = pk2m(H[3][0], H[3][1]); hb1.w = pk2m(H[3][2], H[3][3]);
    const bf16x8 h0 = __builtin_bit_cast(bf16x8, hb0), h1 = __builtin_bit_cast(bf16x8, hb1);
    const f32x4 z4 = (f32x4){0.f, 0.f, 0.f, 0.f};
    f32x4 X = __builtin_amdgcn_mfma_f32_16x16x32_bf16(o.a0, h0, z4, 0, 0, 0); X = __builtin_amdgcn_mfma_f32_16x16x32_bf16(o.a1, h1, X, 0, 0, 0);
    f32x4 Y = __builtin_amdgcn_mfma_f32_16x16x32_bf16(o.r0, h0, z4, 0, 0, 0); Y = __builtin_amdgcn_mfma_f32_16x16x32_bf16(o.r1, h1, Y, 0, 0, 0);
    v4u xb; xb.x = pk2m(X[0], X[1]); xb.y = pk2m(X[2], X[3]); xb.z = o.vt.x; xb.w = o.vt.y;
    const f32x4 U = __builtin_amdgcn_mfma_f32_16x16x32_bf16(o.tt, __builtin_bit_cast(bf16x8, xb), z4, 0, 0, 0);
    v4u ub; ub.x = pk2m(U[0], U[1]); ub.y = pk2m(U[2], U[3]); ub.z = o.vt.x; ub.w = o.vt.y;
    const bf16x8 uf = __builtin_bit_cast(bf16x8, ub);
    Y = __builtin_amdgcn_mfma_f32_16x16x32_bf16(o.ar, uf, Y, 0, 0, 0);
#pragma unroll
    for (int kt = 0; kt < 4; ++kt) H[kt] = __builtin_amdgcn_mfma_f32_16x16x32_bf16(o.bk[kt], uf, H[kt] * o.g[kt], 0, 0, 0);
#pragma unroll
    for (int r = 0; r < 4; ++r) yb[(4 * fq + r) * 64 + vcol] = Y[r];
}
__device__ __forceinline__ void scan_phase(const Ptrs& P, unsigned char* lds, int sb, int tid, int wave, int lane, int never) {
    const int b = sb >> 3, h = sb & 7, fr = lane & 15, fq = lane >> 4;
    const unsigned char* img = P.ws + WS_IMG + (size_t)(b * NHEAD + h) * NCHUNK * IMG_SIZE;
    if (wave < 4) {
        f32x4 H[4];
#pragma unroll
        for (int kt = 0; kt < 4; ++kt) H[kt] = (f32x4){0.f, 0.f, 0.f, 0.f};
        const int vcol = 16 * wave + fr;
#pragma unroll 1
        for (int s = 0; s <= NSUPER + 1; ++s) {
            __syncthreads();
            if (s < 1 || s > NSUPER) continue;
            const int set = (s - 1) & 1;
#pragma unroll 1
            for (int j = 0; j < 4; ++j) { const int ch = 4 * (s - 1) + j; if (ch >= NCHUNK) break;
                ScanOps o; scan_load(o, lds + (set * 4 + j) * CB_SIZE, fr, fq, vcol);
                scan_step(H, o, (float*)(lds + SC_YB + (set * 4 + j) * 4096), fq, vcol); }
        }
    } else {
        const int hw = wave - 4, t = fr;
        const bf16* Z = (const bf16*)(P.ws + WS_BIG); const bf16* Zm = (const bf16*)(P.ws + WS_META + MO_ZM);
        bf16* Yo = (bf16*)(P.ws + WS_XB);
        const int cbase = h * 64 + 8 * fq;
        float muv[16], lw[16], lb[16];
#pragma unroll
        for (int ks = 0; ks < 2; ++ks) { const int c = cbase + 32 * ks;
            const f32x4 a0 = *(const f32x4*)(P.in[9] + 1024 + c), a1 = *(const f32x4*)(P.in[9] + 1024 + c + 4), b0 = *(const f32x4*)(P.in[18] + c), b1 = *(const f32x4*)(P.in[18] + c + 4), c0 = *(const f32x4*)(P.in[19] + c), c1 = *(const f32x4*)(P.in[19] + c + 4);
#pragma unroll
            for (int e = 0; e < 4; ++e) { muv[8 * ks + e] = a0[e]; muv[8 * ks + 4 + e] = a1[e]; lw[8 * ks + e] = b0[e]; lw[8 * ks + 4 + e] = b1[e]; lb[8 * ks + e] = c0[e]; lb[8 * ks + 4 + e] = c1[e]; } }
        v4u cvc[2], cvp[2], cg[2]; float cbon = 0.f;
        v4u im0[13], im1[13];
#define IMG_LOAD(IM, chx) do { const unsigned char* ip_ = img + (size_t)(chx) * IMG_SIZE; _Pragma("unroll") for (int i_ = 0; i_ < 13; ++i_) if (i_ < 12 || lane < 32) IM[i_] = *(const v4u*)(ip_ + (i_ * 64 + lane) * 16); } while (0)
        if (hw < NCHUNK) IMG_LOAD(im0, hw);
        if (4 + hw < NCHUNK) IMG_LOAD(im1, 4 + hw);
#pragma unroll
        for (int ks = 0; ks < 2; ++ks) { cvc[ks] = (v4u){0u, 0u, 0u, 0u}; cvp[ks] = cvc[ks]; cg[ks] = cvc[ks]; }
#pragma unroll 1
        for (int s2 = 0; s2 <= NSUPER + 1; s2 += 2) {
            { const int s = s2;
            __syncthreads();
            if (4 * s + hw < NCHUNK) { unsigned char* cbw = lds + ((s & 1) * 4 + hw) * CB_SIZE;
#pragma unroll
                for (int i_ = 0; i_ < 13; ++i_) if (i_ < 12 || lane < 32) *(v4u*)(cbw + (i_ * 64 + lane) * 16) = im0[i_]; }
            if (4 * (s + 2) + hw < NCHUNK) IMG_LOAD(im0, 4 * (s + 2) + hw);
            const int ch = 4 * (s - 2) + hw;
            if (s >= 2 && ch >= 1 && ch < NCHUNK) { const int set = s & 1; const float* yb = (const float*)(lds + SC_YB + (set * 4 + hw) * 4096);
                const int tok = 16 * (ch - 1) + t; const size_t m = (size_t)b * TSEQ + tok;
                float y[16]; float sm = 0.f;
#pragma unroll
                for (int ks = 0; ks < 2; ++ks) { const f32x4 y0 = *(const f32x4*)(yb + t * 64 + 32 * ks + 8 * fq), y1 = *(const f32x4*)(yb + t * 64 + 32 * ks + 8 * fq + 4);
#pragma unroll
                    for (int e = 0; e < 4; ++e) { y[8 * ks + e] = y0[e]; y[8 * ks + 4 + e] = y1[e]; sm += y0[e] + y1[e]; } }
                sm += __shfl_xor(sm, 16); sm += __shfl_xor(sm, 32); const float mean = sm * (1.0f / 64.0f); float sq = 0.f;
#pragma unroll
                for (int i = 0; i < 16; ++i) { y[i] -= mean; sq += y[i] * y[i]; }
                sq += __shfl_xor(sq, 16); sq += __shfl_xor(sq, 32); const float rs = __builtin_amdgcn_rsqf(sq * (1.0f / 64.0f) + 64e-5f);
#pragma unroll
                for (int ks = 0; ks < 2; ++ks) { const int c = cbase + 32 * ks;
                    float vc[8], vp[8], g[8], o[8]; unpack8(cvc[ks], vc); unpack8(cvp[ks], vp); unpack8(cg[ks], g);
#pragma unroll
                    for (int e = 0; e < 8; ++e) { const float vv = vc[e] + (vp[e] - vc[e]) * muv[8 * ks + e];
                        o[e] = (y[8 * ks + e] * rs * lw[8 * ks + e] + lb[8 * ks + e] + cbon * vv) * g[e]; }
                    *(bf16x8*)(Yo + m * DM + c) = pack8(o); } }
            { const int chn = 4 * (s - 1) + hw;
              if (s >= 1 && chn >= 1 && chn < NCHUNK) { const unsigned char* ib = img + (size_t)chn * IMG_SIZE; const int tok = 16 * (chn - 1) + t; const size_t m = (size_t)b * TSEQ + tok;
                const bf16* zc = Z + m * NIN; const bf16* zp = (tok == 0) ? Zm + (size_t)15 * NIN : Z + (m - 1) * NIN;
#pragma unroll
                for (int ks = 0; ks < 2; ++ks) { const int c = cbase + 32 * ks; cvc[ks] = *(const v4u*)(zc + 1024 + c); cvp[ks] = *(const v4u*)(zp + 1024 + c); cg[ks] = *(const v4u*)(ib + CB_GATE + (t * 64 + 32 * ks + 8 * fq) * 2); }
                cbon = *(const float*)(ib + CB_BON + t * 4); } }
            }
            if (s2 + 1 <= NSUPER + 1) { const int s = s2 + 1;
            __syncthreads();
            if (4 * s + hw < NCHUNK) { unsigned char* cbw = lds + ((s & 1) * 4 + hw) * CB_SIZE;
#pragma unroll
                for (int i_ = 0; i_ < 13; ++i_) if (i_ < 12 || lane < 32) *(v4u*)(cbw + (i_ * 64 + lane) * 16) = im1[i_]; }
            if (4 * (s + 2) + hw < NCHUNK) IMG_LOAD(im1, 4 * (s + 2) + hw);
            const int ch = 4 * (s - 2) + hw;
            if (s >= 2 && ch >= 1 && ch < NCHUNK) { const int set = s & 1; const float* yb = (const float*)(lds + SC_YB + (set * 4 + hw) * 4096);
                const int tok = 16 * (ch - 1) + t; const size_t m = (size_t)b * TSEQ + tok;
                float y[16]; float sm = 0.f;
#pragma unroll
                for (int ks = 0; ks < 2; ++ks) { const f32x4 y0 = *(const f32x4*)(yb + t * 64 + 32 * ks + 8 * fq), y1 = *(const f32x4*)(yb + t * 64 + 32 * ks + 8 * fq + 4);
#pragma unroll
                    for (int e = 0; e < 4; ++e) { y[8 * ks + e] = y0[e]; y[8 * ks + 4 + e] = y1[e]; sm += y0[e] + y1[e]; } }
                sm += __shfl_xor(sm, 16); sm += __shfl_xor(sm, 32); const float mean = sm * (1.0f / 64.0f); float sq = 0.f;
#pragma unroll
                for (int i = 0; i < 16; ++i) { y[i] -= mean; sq += y[i] * y[i]; }
                sq += __shfl_xor(sq, 16); sq += __shfl_xor(sq, 32); const float rs = __builtin_amdgcn_rsqf(sq * (1.0f / 64.0f) + 64e-5f);
#pragma unroll
                for (int ks = 0; ks < 2; ++ks) { const int c = cbase + 32 * ks;
                    float vc[8], vp[8], g[8], o[8]; unpack8(cvc[ks], vc); unpack8(cvp[ks], vp); unpack8(cg[ks], g);
#pragma unroll
                    for (int e = 0; e < 8; ++e) { const float vv = vc[e] + (vp[e] - vc[e]) * muv[8 * ks + e];
                        o[e] = (y[8 * ks + e] * rs * lw[8 * ks + e] + lb[8 * ks + e] + cbon * vv) * g[e]; }
                    *(bf16x8*)(Yo + m * DM + c) = pack8(o); } }
            { const int chn = 4 * (s - 1) + hw;
              if (s >= 1 && chn >= 1 && chn < NCHUNK) { const unsigned char* ib = img + (size_t)chn * IMG_SIZE; const int tok = 16 * (chn - 1) + t; const size_t m = (size_t)b * TSEQ + tok;
                const bf16* zc = Z + m * NIN; const bf16* zp = (tok == 0) ? Zm + (size_t)15 * NIN : Z + (m - 1) * NIN;
#pragma unroll
                for (int ks = 0; ks < 2; ++ks) { const int c = cbase + 32 * ks; cvc[ks] = *(const v4u*)(zc + 1024 + c); cvp[ks] = *(const v4u*)(zp + 1024 + c); cg[ks] = *(const v4u*)(ib + CB_GATE + (t * 64 + 32 * ks + 8 * fq) * 2); }
                cbon = *(const float*)(ib + CB_BON + t * 4); } }
            }
        }
#undef IMG_LOAD
    }
}
__device__ __forceinline__ void final_norm(const Ptrs& P, int gw, int NGW, int lane) {
    const float* ssq = (const float*)(P.ws + WS_SSQ4); const GAS f32x4* g4 = (const GAS f32x4*)P.in[26] + lane;
    f32x4 g[4];
#pragma unroll
    for (int j = 0; j < 4; ++j) g[j] = g4[64 * j];
    for (int m = gw; m < MR; m += NGW) { const float rs = pg8::rstd_from16(ssq, m); GAS f32x4* o = (GAS f32x4*)(P.out + (size_t)m * DM) + lane;
#pragma unroll
        for (int j = 0; j < 4; ++j) o[64 * j] = o[64 * j] * rs * g[j]; }
}
#ifndef MK_N_LAUNCHES
#define MK_N_LAUNCHES 1
#endif
constexpr int N_PHASES = 10;
struct Args { Ptrs p; int ph_lo, ph_hi, use_cg, pad; };
__global__ void __launch_bounds__(NWAVES * 64, 2) hymba_fwd(Args args) {
    extern __shared__ __attribute__((aligned(16))) unsigned char lds[];
    LAS unsigned char* ldsl = (LAS unsigned char*)lds;
    volatile LAS unsigned* MISC = (volatile LAS unsigned*)(ldsl + MISC_OFF);
    const int tid = threadIdx.x, lane = tid & 63, wave = __builtin_amdgcn_readfirstlane(tid >> 6);
    const int G = gridDim.x, bx = blockIdx.x, vcu = (G % 8 == 0) ? (bx % 8) * (G / 8) + bx / 8 : bx;
    const Ptrs& P = args.p; unsigned char* ws = P.ws;
    if (args.use_cg) cg::this_grid().sync();
    for (int u = tid; u < (LDS_BYTES - LDSCTL_OFF) / 4; u += NWAVES * 64) ((LAS unsigned*)(ldsl + LDSCTL_OFF))[u] = 0u;
    __syncthreads();
    const int lo = args.ph_lo, hi = args.ph_hi;
    XcdBarrier bar; bar.bar = (unsigned*)(ws + WS_CTL) + CW_BAR; bar.x = 0; bar.st = nullptr;
    if (hi - lo > 1) bar = xcd_barrier_post((unsigned*)(ws + WS_CTL) + CW_BAR, MISC + 8);
#define IN(k) (lo <= (k) && (k) < hi)
#define SEAM(k) do { if (IN(k) && IN((k) + 1)) xcd_barrier(bar); } while (0)
    const int gw = vcu * NWAVES + wave, NGW = G * NWAVES;
    const int gwm = bx + G * wave;

    if (IN(0)) { p0_prologue(P, ldsl, vcu, G, wave, lane); SEAM(0); }
    if (IN(1)) {
        meta_up(ws, gwm, NGW, lane);
        pg8::Gemm g{(const bf16*)(ws + WS_XB), (const bf16*)(ws + WS_WGU1), MR, NGU, DM}; pg8::StaticOrder S; S.init(MR, NGU, G, bx);
        pg8::EpiSwiglu E{(bf16*)(ws + WS_BIG), (const float*)(ws + WS_SSQ1), FF};
#ifndef REP_P1
#define REP_P1 1
#endif
        for (int rep = 0; rep < REP_P1; ++rep) pg8::gemm_phase<pg8::EpiSwiglu, pg8::StaticOrder, true, true>(ldsl, g, S, E);
        SEAM(1);
    }
    if (IN(2)) {
        meta_down(P, gwm, NGW, lane);
        pg8::Gemm g{(const bf16*)(ws + WS_BIG), (const bf16*)(ws + WS_WD1), MR, DM, FF}; pg8::StaticOrder S; S.init(MR, DM, G, bx);
        pg8::EpiResid<true> E{P.in[0], P.out, (bf16*)(ws + WS_XB), (float*)(ws + WS_SSQ2), 0.5f};
#ifndef REP_P2
#define REP_P2 1
#endif
        for (int rep = 0; rep < REP_P2; ++rep) pg8::gemm_phase<pg8::EpiResid<true>, pg8::StaticOrder, true, true>(ldsl, g, S, E);
        SEAM(2);
    }
    if (IN(3)) {
        meta_win(P, gwm, NGW, lane);
        pg8::Gemm g{(const bf16*)(ws + WS_XB), (const bf16*)(ws + WS_WIN), MR, NINP, DM}; pg8::StaticOrder S; S.init(MR, NINP, G, bx);
        pg8::EpiZ E{(bf16*)(ws + WS_BIG), (const float*)(ws + WS_SSQ2), P.in[8], NIN, NIN, ZC_Q};
        pg8::gemm_phase<pg8::EpiZ, pg8::StaticOrder, true, true>(ldsl, g, S, E);
        SEAM(3);
    }
    if (IN(4)) {
#ifndef REP_PREP
#define REP_PREP 1
#endif
        for (int rep = 0; rep < REP_PREP; ++rep) for (int task = gw; task < NBATCH * NHEAD * NCHUNK; task += NGW) { const int bc = task >> 3; chunk_task(P, lds, wave * WL_SIZE, bc / NCHUNK, task & 7, bc % NCHUNK, lane); }
        SEAM(4);
    }
    if (IN(5)) {
#ifndef REP_SCAN
#define REP_SCAN 1
#endif
#ifndef REP_ATTN
#define REP_ATTN 1
#endif
        if (bx < 64) { for (int rep = 0; rep < REP_SCAN; ++rep) { scan_phase(P, lds, bx, tid, wave, lane, args.use_cg); __syncthreads(); } }
        else for (int rep = 0; rep < REP_ATTN; ++rep) for (int u = bx - 64; u < NBATCH * 2 * 64; u += G - 64) attn_unit(P, lds, u >> 7, (u >> 6) & 1, u & 63, tid, wave, lane);
        __syncthreads();
        SEAM(5);
    }
    if (IN(6)) {
        pg8::Gemm g{(const bf16*)(ws + WS_XB), (const bf16*)(ws + WS_WOUT), MR, DM, DM}; pg8::StaticOrder S; S.init(MR, DM, G, bx);
        pg8::EpiResid<true> E{P.out, P.out, (bf16*)(ws + WS_P), (float*)(ws + WS_SSQ3), 1.0f};
        pg8::gemm_phase<pg8::EpiResid<true>, pg8::StaticOrder, true, true>(ldsl, g, S, E);
        SEAM(6);
    }
    if (IN(7)) {
        pg8::Gemm g{(const bf16*)(ws + WS_P), (const bf16*)(ws + WS_WGU2), MR, NGU, DM}; pg8::StaticOrder S; S.init(MR, NGU, G, bx);
        pg8::EpiSwiglu E{(bf16*)(ws + WS_BIG), (const float*)(ws + WS_SSQ3), FF};
        pg8::gemm_phase<pg8::EpiSwiglu, pg8::StaticOrder, true, true>(ldsl, g, S, E);
        SEAM(7);
    }
    if (IN(8)) {
        pg8::Gemm g{(const bf16*)(ws + WS_BIG), (const bf16*)(ws + WS_WD2), MR, DM, FF}; pg8::StaticOrder S; S.init(MR, DM, G, bx);
        pg8::EpiResid<false> E{P.out, P.out, nullptr, (float*)(ws + WS_SSQ4), 0.5f};
        pg8::gemm_phase<pg8::EpiResid<false>, pg8::StaticOrder, true, true>(ldsl, g, S, E);
        SEAM(8);
    }
    if (IN(9)) final_norm(P, gw, NGW, lane);
#undef IN
#undef SEAM
}

extern "C" void kernel_launch(void* const* d_in, const int* in_sizes, int n_in, void* d_out, int out_size, void* d_ws, size_t ws_size, hipStream_t stream) {
    static int grid = 0;
    if (grid == 0) {
        if (n_in != 27 || in_sizes[0] != MR * DM || out_size != MR * DM || ws_size < WS_END) { fprintf(stderr, "kernel_launch: unexpected shapes (n_in %d, in0 %d, out %d, ws %zu)\n", n_in, n_in > 0 ? in_sizes[0] : -1, out_size, ws_size); grid = -1; return; }
        int dev = 0, cus = 0, per_cu = 0;
        if (hipGetDevice(&dev) != hipSuccess || hipDeviceGetAttribute(&cus, hipDeviceAttributeMultiprocessorCount, dev) != hipSuccess) { grid = -1; return; }
        if (hipFuncSetAttribute((const void*)hymba_fwd, hipFuncAttributeMaxDynamicSharedMemorySize, LDS_BYTES) != hipSuccess) { fprintf(stderr, "kernel_launch: hipFuncSetAttribute failed\n"); grid = -1; return; }
        if (hipOccupancyMaxActiveBlocksPerMultiprocessor(&per_cu, (const void*)hymba_fwd, NWAVES * 64, LDS_BYTES) != hipSuccess || per_cu < 1) fprintf(stderr, "kernel_launch: occupancy query says %d blocks per CU\n", per_cu);
        (void)hipGetLastError();
        grid = cus;
    }
    if (grid < 0) return;
    if (hipMemsetAsync((char*)d_ws + WS_CTL, 0, CTL_ZERO_BYTES, stream) != hipSuccess) { fprintf(stderr, "kernel_launch: memset failed\n"); return; }
    Args a{};
    for (int i = 0; i < 27; ++i) a.p.in[i] = (const float*)d_in[i];
    a.p.out = (float*)d_out; a.p.ws = (unsigned char*)d_ws; a.use_cg = 0; a.pad = 0;
#if MK_N_LAUNCHES == 1
    a.ph_lo = 0; a.ph_hi = N_PHASES;
    void* kargs[] = {&a};
    hipError_t e = hipLaunchCooperativeKernel((const void*)hymba_fwd, dim3(grid), dim3(NWAVES * 64), kargs, LDS_BYTES, stream);
    if (e != hipSuccess) fprintf(stderr, "kernel_launch: cooperative launch failed: %s (grid %d)\n", hipGetErrorString(e), grid);
#else
    for (int li = 0; li < N_PHASES; ++li) { a.ph_lo = li; a.ph_hi = li + 1;
        hipLaunchKernelGGL(hymba_fwd, dim3(grid), dim3(NWAVES * 64), LDS_BYTES, stream, a);
        const hipError_t le = hipPeekAtLastError(); if (le != hipSuccess) { fprintf(stderr, "kernel_launch: launch %d failed: %s\n", li, hipGetErrorName(le)); break; } }
#endif
}
```

```cpp
#include <hip/hip_runtime.h>
#include <cstdio>
#include <cstdint>
namespace pg8 {
#define PG8_LAS __attribute__((address_space(3)))
typedef unsigned short bf16_t;
typedef short bf16x8 __attribute__((ext_vector_type(8)));
typedef float f32x4 __attribute__((ext_vector_type(4)));
typedef unsigned u32x4 __attribute__((ext_vector_type(4)));
constexpr int BM = 256, BK = 64, HALF = 128, HTB = HALF * BK * 2  , STAGE_BYTES = 8 * HTB, NXCD = 8, WGM = 8;

__host__ __device__ __forceinline__ int lds_byte(int r, int c) { const int st = (r >> 4) * 2 + (c >> 5), rr = r & 15, cc = c & 31, ob = rr * 64 + cc * 2; return st * 1024 + (ob ^ (((ob >> 9) & 1) << 5)); }
__host__ __device__ __forceinline__ void stage_rc(int b, int& R, int& C) { const int st = b / 1024, sb = b % 1024, swz = sb ^ (((sb >> 9) & 1) << 5); R = (st >> 1) * 16 + swz / 64; C = (st & 1) * 32 + (swz % 64) / 2; }
__host__ __device__ __forceinline__ int perm32(int rho) { const int n = rho >> 4, i = rho & 15; return 8 * (i >> 2) + 4 * n + (i & 3); }

struct Unit { int pm, pn; };
struct Gemm { const bf16_t* A; const bf16_t* Bt; int M, N, K; };

struct StaticOrder {
    int nM, nN, nwg, G, c;
    __host__ __device__ void init(int M, int N, int G_, int c_) { nM = M / BM; nN = N / BM; nwg = nM * nN; G = G_; c = c_; }
    __host__ __device__ bool next(int i, Unit& u) const {
        const long L = (long)i * G + c; if (L >= nwg) return false;
        int wgid = (int)L; { const int q = nwg / NXCD, r = nwg % NXCD, xcd = wgid % NXCD, off = wgid / NXCD; wgid = (xcd < r ? xcd * (q + 1) : r * (q + 1) + (xcd - r) * q) + off; }
        const int nig = WGM * nN, gid = wgid / nig, fm = gid * WGM, gsz = (nM - fm) < WGM ? (nM - fm) : WGM;
        u.pm = fm + ((wgid % nig) % gsz); u.pn = (wgid % nig) / gsz; return true;
    }
    __device__ __forceinline__ void a_ready(const Unit&) const {}
    __device__ __forceinline__ void done(const Unit&) const {}
};

__device__ __forceinline__ unsigned cvt_pk_bf16(float lo, float hi) { unsigned r; asm volatile("v_cvt_pk_bf16_f32 %0, %1, %2" : "=v"(r) : "v"(lo), "v"(hi)); return r; }
typedef float f32x2 __attribute__((ext_vector_type(2)));
typedef unsigned u32x2 __attribute__((ext_vector_type(2)));
__device__ __forceinline__ float rstd_from16(const float* ssq, int row) {
    const f32x4* p = (const f32x4*)(ssq + (size_t)row * 16);
    const f32x4 a = p[0], b = p[1], c = p[2], d = p[3];
    const float s = ((a[0] + a[1]) + (a[2] + a[3])) + ((b[0] + b[1]) + (b[2] + b[3])) + ((c[0] + c[1]) + (c[2] + c[3])) + ((d[0] + d[1]) + (d[2] + d[3]));
    return __builtin_amdgcn_rsqf(s * (1.0f / 1024.0f) + 1e-5f);
}
__device__ __forceinline__ float silu_mul(float g, float u) { return g * __builtin_amdgcn_rcpf(1.0f + __builtin_amdgcn_exp2f(-1.4426950408889634f * g)) * u; }
struct EpiSwiglu {
    static constexpr bool PERM = true, AFTER_DRAIN = false;
    bf16_t* U; const float* ssq; int ldu;
    __device__ __forceinline__ void operator()(const f32x4 (&acc)[2][2][4][2], const Unit& u, int wr, int wc, int fr, int fq) const {
        const int row0 = u.pm * BM + wr * 64 + fr, col0 = u.pn * HALF + wc * 32 + 8 * fq;
#pragma unroll
        for (int ai = 0; ai < 2; ++ai)
#pragma unroll
            for (int m = 0; m < 4; ++m) { const int row = row0 + ai * HALF + m * 16; const float rs = rstd_from16(ssq, row);
                const f32x4 g0 = acc[ai][0][m][0] * rs, g1 = acc[ai][0][m][1] * rs, u0 = acc[ai][1][m][0] * rs, u1 = acc[ai][1][m][1] * rs;
                u32x4 w; w.x = cvt_pk_bf16(silu_mul(g0[0], u0[0]), silu_mul(g0[1], u0[1])); w.y = cvt_pk_bf16(silu_mul(g0[2], u0[2]), silu_mul(g0[3], u0[3]));
                w.z = cvt_pk_bf16(silu_mul(g1[0], u1[0]), silu_mul(g1[1], u1[1])); w.w = cvt_pk_bf16(silu_mul(g1[2], u1[2]), silu_mul(g1[3], u1[3]));
                *(u32x4*)(U + (size_t)row * ldu + col0) = w; }
    }
};
struct EpiZ {
    static constexpr bool PERM = true, AFTER_DRAIN = false;
    bf16_t* Z; const float* ssq; const float* bias; int ldz, ncols, bias_from;
    __device__ __forceinline__ void operator()(const f32x4 (&acc)[2][2][4][2], const Unit& u, int wr, int wc, int fr, int fq) const {
        const int row0 = u.pm * BM + wr * 64 + fr, col0 = u.pn * BM + wc * 32 + 8 * fq;
        f32x4 bv[2][2];
#pragma unroll
        for (int bj = 0; bj < 2; ++bj)
#pragma unroll
            for (int n = 0; n < 2; ++n) { const int c = col0 + bj * HALF + 4 * n; bv[bj][n] = (c >= bias_from && c < ncols) ? *(const f32x4*)(bias + (c - bias_from)) : (f32x4){0.f, 0.f, 0.f, 0.f}; }
#pragma unroll
        for (int ai = 0; ai < 2; ++ai)
#pragma unroll
            for (int m = 0; m < 4; ++m) { const int row = row0 + ai * HALF + m * 16; const float rs = rstd_from16(ssq, row);
#pragma unroll
                for (int bj = 0; bj < 2; ++bj) { const int c = col0 + bj * HALF; if (c < ncols) {
                    const f32x4 v0 = acc[ai][bj][m][0] * rs + bv[bj][0], v1 = acc[ai][bj][m][1] * rs + bv[bj][1];
                    u32x4 w; w.x = cvt_pk_bf16(v0[0], v0[1]); w.y = cvt_pk_bf16(v0[2], v0[3]); w.z = cvt_pk_bf16(v1[0], v1[1]); w.w = cvt_pk_bf16(v1[2], v1[3]);
                    *(u32x4*)(Z + (size_t)row * ldz + c) = w; } } }
    }
};
template <bool WB> struct EpiResid {
    static constexpr bool PERM = false, AFTER_DRAIN = false;
    const float* base; float* out; bf16_t* outb; float* ssq; float scale;
    __device__ __forceinline__ void operator()(const f32x4 (&acc)[2][2][4][2], const Unit& u, int wr, int wc, int fr, int fq) const {
        const int row0 = u.pm * BM + wr * 64 + fr, col0 = u.pn * BM + wc * 32 + 4 * fq;
#pragma unroll
        for (int ai = 0; ai < 2; ++ai)
#pragma unroll
            for (int m = 0; m < 4; ++m) { const int row = row0 + ai * HALF + m * 16; const size_t off = (size_t)row * 1024 + col0; float ss = 0.f;
#pragma unroll
                for (int bj = 0; bj < 2; ++bj)
#pragma unroll
                    for (int n = 0; n < 2; ++n) { const size_t o2 = off + bj * HALF + n * 16; const f32x4 bs = *(const f32x4*)(base + o2); const f32x4 o = bs + acc[ai][bj][m][n] * scale;
                        *(f32x4*)(out + o2) = o; ss += (o[0] * o[0] + o[1] * o[1]) + (o[2] * o[2] + o[3] * o[3]);
                        if (WB) { u32x2 w; w.x = cvt_pk_bf16(o[0], o[1]); w.y = cvt_pk_bf16(o[2], o[3]); *(u32x2*)(outb + o2) = w; } }
                ss += __shfl_xor(ss, 16); ss += __shfl_xor(ss, 32);
                if (fq == 0) ssq[(size_t)row * 16 + u.pn * 4 + wc] = ss; }
    }
};
template <class Epi, class Sched, bool ALIGN_EPI = false, bool SP2 = false>
__device__ __forceinline__ void gemm_phase(PG8_LAS unsigned char* lds, const Gemm g, const Sched& S, const Epi& E) {
    const int tid = threadIdx.x, wid = __builtin_amdgcn_readfirstlane(tid >> 6), lane = tid & 63, wr = wid >> 2, wc = wid & 3, fr = lane & 15, fq = lane >> 4;
    const int K = g.K, nt = K / BK;
    unsigned voffA[2], voffB[2];
#pragma unroll
    for (int i = 0; i < 2; ++i) { int R, C; stage_rc(tid * 16 + i * 8192, R, C); const int Rb = Epi::PERM ? ((R & ~31) + perm32(R & 31)) : R;
        voffA[i] = (unsigned)(R * K + C) * 2u; voffB[i] = (unsigned)(Rb * K + C) * 2u; }
    const size_t kstep = (size_t)(BK * 2);
    const size_t hstep = (size_t)HALF * K * 2;
    const size_t tstep = 2 * hstep;
    const unsigned ldsw = (unsigned)wid * 1024u;
    const int aoff = lds_byte(wr * 64 + fr, fq * 8), boff = lds_byte(wc * 32 + fr, fq * 8);
#define PG8_SA(b, h) (((b) * 2 + (h)) * HTB)
#define PG8_SB(b, h) ((4 + (b) * 2 + (h)) * HTB)
#define PG8_STAGE(bufoff, gbase, voff) do { _Pragma("unroll") for (int _i = 0; _i < 2; ++_i) \
        __builtin_amdgcn_global_load_lds((const unsigned*)((const char*)(gbase) + (voff)[_i]), (PG8_LAS unsigned*)(lds + (bufoff) + ldsw + _i * 8192), 16, 0, 0); } while (0)
#define PG8_LDA(dst, b, h) do { _Pragma("unroll") for (int m = 0; m < 4; ++m) _Pragma("unroll") for (int k = 0; k < 2; ++k) dst[m][k] = *(const PG8_LAS bf16x8*)(lds + PG8_SA(b, h) + aoff + m * 2048 + k * 1024); } while (0)
#define PG8_LDB(dst, b, h) do { _Pragma("unroll") for (int n = 0; n < 2; ++n) _Pragma("unroll") for (int k = 0; k < 2; ++k) dst[n][k] = *(const PG8_LAS bf16x8*)(lds + PG8_SB(b, h) + boff + n * 2048 + k * 1024); } while (0)
#define PG8_MMA(ai, bj, At, Bt) do { __builtin_amdgcn_s_setprio(1); _Pragma("unroll") for (int m = 0; m < 4; ++m) _Pragma("unroll") for (int n = 0; n < 2; ++n) _Pragma("unroll") for (int k = 0; k < 2; ++k) \
        acc[ai][bj][m][n] = __builtin_amdgcn_mfma_f32_16x16x32_bf16(Bt[n][k], At[m][k], acc[ai][bj][m][n], 0, 0, 0); __builtin_amdgcn_s_setprio(0); } while (0)
#define PG8_WAIT_V(n) asm volatile("s_waitcnt vmcnt(" #n ")" ::: "memory")
#define PG8_WAIT_L(n) asm volatile("s_waitcnt lgkmcnt(" #n ")" ::: "memory")
#define PG8_BAR __builtin_amdgcn_s_barrier()
#define PG8_SCHED __builtin_amdgcn_sched_barrier(0)
    Unit cur, nxt; int ui = 0;
    if (!S.next(0, cur)) return;
    f32x4 acc[2][2][4][2];
#pragma unroll
    for (int a = 0; a < 2; ++a)
#pragma unroll
        for (int b = 0; b < 2; ++b)
#pragma unroll
            for (int m = 0; m < 4; ++m)
#pragma unroll
                for (int n = 0; n < 2; ++n) acc[a][b][m][n] = (f32x4){0.f, 0.f, 0.f, 0.f};
    bf16x8 At[4][2], B0[2][2], B1[2][2];
    const char* cA = (const char*)g.A + (size_t)cur.pm * tstep; const char* cB = (const char*)g.Bt + (size_t)cur.pn * tstep;
    S.a_ready(cur);
    if constexpr (SP2) {
        PG8_STAGE(PG8_SB(0, 0), cB, voffB); PG8_STAGE(PG8_SB(0, 1), cB + hstep, voffB); PG8_STAGE(PG8_SA(0, 0), cA, voffA); PG8_STAGE(PG8_SA(0, 1), cA + hstep, voffA);
        if (wr == 1) PG8_BAR;
        PG8_WAIT_V(2); PG8_BAR;
        PG8_STAGE(PG8_SB(1, 0), cB + kstep, voffB); PG8_STAGE(PG8_SA(1, 0), cA + kstep, voffA); PG8_STAGE(PG8_SB(1, 1), cB + hstep + kstep, voffB);
        PG8_WAIT_V(6); PG8_BAR;
    } else {
        PG8_STAGE(PG8_SB(0, 0), cB, voffB); PG8_STAGE(PG8_SA(0, 0), cA, voffA); PG8_STAGE(PG8_SB(0, 1), cB + hstep, voffB); PG8_STAGE(PG8_SA(0, 1), cA + hstep, voffA);
        if (wr == 1) PG8_BAR;
        PG8_WAIT_V(4); PG8_BAR;
        PG8_STAGE(PG8_SB(1, 0), cB + kstep, voffB); PG8_STAGE(PG8_SA(1, 0), cA + kstep, voffA); PG8_STAGE(PG8_SB(1, 1), cB + hstep + kstep, voffB);
        PG8_WAIT_V(6); PG8_BAR;
    }
    for (;;) {
        const bool has_next = S.next(ui + 1, nxt);
        const char* nA = has_next ? (const char*)g.A + (size_t)nxt.pm * tstep : cA; const char* nB = has_next ? (const char*)g.Bt + (size_t)nxt.pn * tstep : cB;
        for (int t = 0; t < nt; t += 2) {
            const bool last = (t == nt - 2);
            const char* a1 = cA + (size_t)(t + 1) * kstep;
            const char* a2 = last ? nA : cA + (size_t)(t + 2) * kstep; const char* b2 = last ? nB : cB + (size_t)(t + 2) * kstep;
            const char* a3 = a2 + kstep; const char* b3 = b2 + kstep;
            if (last && has_next) S.a_ready(nxt);
            if constexpr (SP2) {
            PG8_LDB(B0, 0, 0); PG8_LDB(B1, 0, 1); PG8_SCHED; PG8_LDA(At, 0, 0); PG8_STAGE(PG8_SA(1, 1), a1 + hstep, voffA);
            PG8_WAIT_V(8); PG8_WAIT_L(0); PG8_BAR; PG8_MMA(0, 0, At, B0); PG8_MMA(0, 1, At, B1); PG8_BAR; PG8_SCHED;
            PG8_LDA(At, 0, 1); PG8_STAGE(PG8_SB(0, 0), b2, voffB); PG8_STAGE(PG8_SB(0, 1), b2 + hstep, voffB); PG8_STAGE(PG8_SA(0, 0), a2, voffA);
            PG8_WAIT_V(8); PG8_WAIT_L(0); PG8_BAR; PG8_MMA(1, 0, At, B0); PG8_MMA(1, 1, At, B1); PG8_BAR; PG8_SCHED;
            PG8_LDB(B0, 1, 0); PG8_LDB(B1, 1, 1); PG8_SCHED; PG8_LDA(At, 1, 0); PG8_STAGE(PG8_SA(0, 1), a2 + hstep, voffA);
            PG8_WAIT_V(8); PG8_WAIT_L(0); PG8_BAR; PG8_MMA(0, 0, At, B0); PG8_MMA(0, 1, At, B1); PG8_BAR; PG8_SCHED;
            PG8_LDA(At, 1, 1); PG8_STAGE(PG8_SB(1, 0), b3, voffB); PG8_STAGE(PG8_SB(1, 1), b3 + hstep, voffB); PG8_STAGE(PG8_SA(1, 0), a3, voffA);
            PG8_WAIT_V(8); PG8_WAIT_L(0); PG8_BAR; PG8_MMA(1, 0, At, B0); PG8_MMA(1, 1, At, B1); PG8_BAR; PG8_SCHED;
            } else {
            PG8_LDB(B0, 0, 0); PG8_SCHED; PG8_LDA(At, 0, 0); PG8_STAGE(PG8_SA(1, 1), a1 + hstep, voffA);
            PG8_WAIT_L(8); PG8_BAR; PG8_WAIT_L(0); PG8_MMA(0, 0, At, B0); PG8_BAR; PG8_SCHED;
            PG8_LDB(B1, 0, 1); PG8_STAGE(PG8_SB(0, 0), b2, voffB);
            PG8_BAR; PG8_WAIT_L(0); PG8_MMA(0, 1, At, B1); PG8_BAR;
            PG8_LDA(At, 0, 1); PG8_STAGE(PG8_SA(0, 0), a2, voffA);
            PG8_BAR; PG8_WAIT_L(0); PG8_MMA(1, 0, At, B0); PG8_BAR; PG8_SCHED;
            PG8_STAGE(PG8_SB(0, 1), b2 + hstep, voffB);
            PG8_WAIT_V(6); PG8_BAR; PG8_MMA(1, 1, At, B1); PG8_BAR;
            PG8_LDB(B0, 1, 0); PG8_SCHED; PG8_LDA(At, 1, 0); PG8_STAGE(PG8_SA(0, 1), a2 + hstep, voffA);
            PG8_WAIT_L(8); PG8_BAR; PG8_WAIT_L(0); PG8_MMA(0, 0, At, B0); PG8_BAR; PG8_SCHED;
            PG8_LDB(B1, 1, 1); PG8_STAGE(PG8_SB(1, 0), b3, voffB);
            PG8_BAR; PG8_WAIT_L(0); PG8_MMA(0, 1, At, B1); PG8_BAR;
            PG8_LDA(At, 1, 1); PG8_STAGE(PG8_SA(1, 0), a3, voffA);
            PG8_BAR; PG8_WAIT_L(0); PG8_MMA(1, 0, At, B0); PG8_BAR; PG8_SCHED;
            PG8_STAGE(PG8_SB(1, 1), b3 + hstep, voffB);
            PG8_WAIT_V(6); PG8_BAR; PG8_MMA(1, 1, At, B1); PG8_BAR;
            }
        }
        if constexpr (ALIGN_EPI) { if (wr == 0) PG8_BAR; }
        if constexpr (!Epi::AFTER_DRAIN) { E(acc, cur, wr, wc, fr, fq); S.done(cur); }
        if (!has_next) break;
#pragma unroll
        for (int a = 0; a < 2; ++a)
#pragma unroll
            for (int b = 0; b < 2; ++b)
#pragma unroll
                for (int m = 0; m < 4; ++m)
#pragma unroll
                    for (int n = 0; n < 2; ++n) acc[a][b][m][n] = (f32x4){0.f, 0.f, 0.f, 0.f};
        cur = nxt; cA = nA; cB = nB; ++ui;
        if constexpr (ALIGN_EPI) { if (wr == 1) PG8_BAR; }
    }
    PG8_WAIT_V(0);
    if constexpr (!ALIGN_EPI) { if (wr == 0) PG8_BAR; }
    PG8_BAR;
    if constexpr (Epi::AFTER_DRAIN) { E.fused(acc, cur, wr, wc, fr, fq, lds, wid, lane); S.done(cur); }
#undef PG8_SA
#undef PG8_SB
#undef PG8_STAGE
#undef PG8_LDA
#undef PG8_LDB
#undef PG8_MMA
#undef PG8_WAIT_V
#undef PG8_WAIT_L
#undef PG8_BAR
#undef PG8_SCHED
}
}
#include <hip/hip_cooperative_groups.h>
namespace cg = cooperative_groups;
constexpr int NWAVES = 8;
constexpr int MR = 32768, DM = 1024, FF = 2816, NGU = 5632, NIN = 2464, NINP = 2560, TSEQ = 4096, NBATCH = 8, NHEAD = 8, NMETA = 16;
constexpr int ZC_W = 1536, ZC_Q = 1696, ZC_K = 2208, ZC_V = 2336;
constexpr int PV = 320;
constexpr size_t MiB = 1u << 20;
constexpr size_t WS_CTL = 0, CTL_ZERO_BYTES = 1 * MiB;
constexpr size_t WS_WGU1 = 2 * MiB, WS_WD1 = 13 * MiB, WS_WIN = 19 * MiB, WS_WOUT = 24 * MiB, WS_WGU2 = 26 * MiB, WS_WD2 = 37 * MiB, WS_LT = 43 * MiB;
constexpr size_t WS_SSQ1 = 44 * MiB, WS_SSQ2 = 46 * MiB, WS_SSQ3 = 48 * MiB, WS_SSQ4 = 50 * MiB, WS_META = 52 * MiB;
constexpr size_t MO_XMB = 0, MO_UM = 64 * 1024, MO_H1MB = 256 * 1024, MO_SSQM1 = 320 * 1024, MO_SSQM2 = 324 * 1024, MO_ZM = 384 * 1024, MO_PM = 512 * 1024;
constexpr size_t WS_XB = 56 * MiB, WS_BIG = 120 * MiB, WS_IMG = 274 * MiB, WS_P = 296 * MiB, WS_END = 507 * MiB;
constexpr int CW_BAR = 4096;
constexpr int RING_BYTES = 131072, LDSCTL_OFF = 143360, MISC_OFF = LDSCTL_OFF + 320, LDS_BYTES = 147456;

#define GAS __attribute__((address_space(1)))
#define LAS __attribute__((address_space(3)))
typedef unsigned short bf16;
typedef unsigned v4u __attribute__((ext_vector_type(4)));
typedef unsigned v2u __attribute__((ext_vector_type(2)));
typedef float f32x4 __attribute__((ext_vector_type(4)));
typedef float f32x2 __attribute__((ext_vector_type(2)));
typedef short bf16x8 __attribute__((ext_vector_type(8)));
typedef short bf16x4 __attribute__((ext_vector_type(4)));
typedef GAS unsigned gu32;
#define LDS_WAIT() asm volatile("s_waitcnt lgkmcnt(0)" ::: "memory")
__device__ __forceinline__ unsigned f2bf(float f) { unsigned u = __builtin_bit_cast(unsigned, f); return (u + 0x7fffu + ((u >> 16) & 1u)) >> 16; }
typedef __bf16 bf16x2_t __attribute__((ext_vector_type(2)));
__device__ __forceinline__ unsigned pk2m(float lo, float hi) { f32x2 v = {lo, hi}; bf16x2_t b = __builtin_convertvector(v, bf16x2_t); return __builtin_bit_cast(unsigned, b); }
__device__ __forceinline__ unsigned pk2(float lo, float hi) { return pg8::cvt_pk_bf16(lo, hi); }
__device__ __forceinline__ float bflo(unsigned w) { return __builtin_bit_cast(float, w << 16); }
__device__ __forceinline__ float bfhi(unsigned w) { return __builtin_bit_cast(float, w & 0xffff0000u); }
__device__ __forceinline__ f32x4 unpack4(v2u w) { return (f32x4){bflo(w.x), bfhi(w.x), bflo(w.y), bfhi(w.y)}; }
__device__ __forceinline__ float sigmoidf_(float x) { return __builtin_amdgcn_rcpf(1.0f + __builtin_amdgcn_exp2f(-1.4426950408889634f * x)); }
__device__ __forceinline__ float tanhf_(float x) { return 2.0f * sigmoidf_(2.0f * x) - 1.0f; }
#define XB_TMO      128
#define XB_XCNT(j)  (256  + 64 * (j))
#define XB_XSUB(j)  (1280 + 64 * (j))
#define XB_XGEN(j)  (2304 + 64 * (j))
#define XB_TOP      3328
#define XB_TOPGEN   3392
#define XCD_BAR_WORDS 3456
#define XB_SPIN_CAP (1u << 18)

__device__ __forceinline__ unsigned xb_ld(unsigned* p)              { return __hip_atomic_load(p, __ATOMIC_RELAXED, __HIP_MEMORY_SCOPE_AGENT); }
__device__ __forceinline__ unsigned xb_add(unsigned* p, unsigned v) { return __hip_atomic_fetch_add(p, v, __ATOMIC_RELAXED, __HIP_MEMORY_SCOPE_AGENT); }
__device__ __forceinline__ unsigned xb_xcc_id() { return (unsigned)__builtin_amdgcn_s_getreg((3 << 11) | 20) & 0xFu; }
#define XB_SPIN(cond, bar) do { unsigned _sp = 0; while (cond) { __builtin_amdgcn_s_sleep(1); \
    if ((++_sp & 255u) == 0u) { if (xb_ld(&(bar)[XB_TMO])) break; if (_sp > XB_SPIN_CAP) { atomicAdd(&(bar)[XB_TMO], 1u); break; } } } } while (0)

struct XcdBarrier {
    unsigned* bar; unsigned x;
    volatile LAS unsigned* st;
};

__device__ __forceinline__ XcdBarrier xcd_barrier_post(unsigned* bar, volatile LAS unsigned* st) {
    XcdBarrier b; b.bar = bar; b.x = xb_xcc_id(); b.st = st;
    if (threadIdx.x == 0) (void)xb_add(&bar[XB_XCNT(b.x)], 1u);
    return b;
}
__device__ __forceinline__ void xcd_barrier_complete(unsigned* bar, unsigned x, unsigned& nloc, unsigned& nx) {
    const unsigned G = gridDim.x * gridDim.y * gridDim.z;
    unsigned sum, cnt, mine, sp = 0u;
    for (;;) {
        sum = 0u; cnt = 0u; mine = 0u;
#pragma unroll
        for (unsigned j = 0; j < 16; ++j) { const unsigned c = xb_ld(&bar[XB_XCNT(j)]); sum += c; cnt += (c > 0u) ? 1u : 0u; mine = (j == x) ? c : mine; }
        if (sum == G) break;
        __builtin_amdgcn_s_sleep(1);
        if ((++sp & 255u) == 0u) { if (xb_ld(&bar[XB_TMO])) break; if (sp > XB_SPIN_CAP) { atomicAdd(&bar[XB_TMO], 1u); break; } }
    }
    nloc = mine > 0u ? mine : 1u; nx = cnt > 0u ? cnt : 1u;
}

__device__ __forceinline__ void xcd_barrier(const XcdBarrier& b) {
    asm volatile("s_waitcnt vmcnt(0)" ::: "memory");
    __syncthreads();
    if (threadIdx.x == 0) {
        unsigned* bar = b.bar;
        __builtin_amdgcn_s_waitcnt(0);
        unsigned nloc = b.st[0], nx = b.st[1];
        if (nloc == 0u) { xcd_barrier_complete(bar, b.x, nloc, nx); b.st[0] = nloc; b.st[1] = nx; }
        const unsigned old = xb_add(&bar[XB_XSUB(b.x)], 1u);
        const unsigned gen = old / nloc;
        if (old + 1u == (gen + 1u) * nloc) {
            __builtin_amdgcn_fence(__ATOMIC_RELEASE, "agent");
            asm volatile("s_waitcnt vmcnt(0)" ::: "memory");
            const unsigned og = xb_add(&bar[XB_TOP], 1u);
            const unsigned tg = og / nx;
            if (og + 1u == (tg + 1u) * nx) xb_add(&bar[XB_TOPGEN], 1u);
            else XB_SPIN(xb_ld(&bar[XB_TOPGEN]) == tg, bar);
            __builtin_amdgcn_fence(__ATOMIC_ACQUIRE, "agent");
            xb_add(&bar[XB_XGEN(b.x)], 1u);
            asm volatile("s_waitcnt vmcnt(0)" ::: "memory");
        } else {
            XB_SPIN(xb_ld(&bar[XB_XGEN(b.x)]) == gen, bar);
            __builtin_amdgcn_fence(__ATOMIC_ACQUIRE, "agent");
            asm volatile("s_waitcnt vmcnt(0)" ::: "memory");
        }
    }
    __syncthreads();
}
__device__ __forceinline__ float wave_sum(float v) {
#pragma unroll
    for (int o = 1; o < 64; o <<= 1) v += __shfl_xor(v, o);
    return v;
}
__device__ __forceinline__ void p0_transpose_item(const float* W, int K, int N, bf16* WT, const float* gain, int k0, int n0, int drow0, LAS float* scr, int lane) {
#pragma unroll
    for (int i = 0; i < 32; ++i) { const int kk = 2 * i + (lane >> 5); float w = W[(size_t)(k0 + kk) * N + n0 + (lane & 31)]; if (gain) w *= gain[k0 + kk]; scr[kk * 33 + (lane & 31)] = w; }
    LDS_WAIT(); asm volatile("" ::: "memory");
    const int c = lane & 7;
#pragma unroll
    for (int j = 0; j < 4; ++j) { const int n = (lane >> 3) + 8 * j; const LAS float* s = scr + (8 * c) * 33 + n;
        v4u o; o.x = pk2(s[0 * 33], s[1 * 33]); o.y = pk2(s[2 * 33], s[3 * 33]); o.z = pk2(s[4 * 33], s[5 * 33]); o.w = pk2(s[6 * 33], s[7 * 33]);
        *(GAS v4u*)(WT + (size_t)(drow0 + n) * K + k0 + 8 * c) = o; }
    LDS_WAIT(); asm volatile("" ::: "memory");
}
__device__ __forceinline__ void rows4_to_bf16(const float* const (&xrow)[4], bf16* const (&orow)[4], float* const (&ssq16)[4], int lane) {
    f32x4 v[4][4]; float s[4];
#pragma unroll
    for (int r = 0; r < 4; ++r) { const GAS f32x4* xr = (const GAS f32x4*)xrow[r] + lane;
#pragma unroll
        for (int j = 0; j < 4; ++j) v[r][j] = xr[64 * j]; }
#pragma unroll
    for (int r = 0; r < 4; ++r) { float a = 0.f;
#pragma unroll
        for (int j = 0; j < 4; ++j) a += (v[r][j].x * v[r][j].x + v[r][j].y * v[r][j].y) + (v[r][j].z * v[r][j].z + v[r][j].w * v[r][j].w);
        s[r] = a; }
#pragma unroll
    for (int o = 1; o < 64; o <<= 1) {
#pragma unroll
        for (int r = 0; r < 4; ++r) s[r] += __shfl_xor(s[r], o); }
#pragma unroll
    for (int r = 0; r < 4; ++r) { GAS v2u* o8 = (GAS v2u*)orow[r] + lane;
#pragma unroll
        for (int j = 0; j < 4; ++j) { v2u w; w.x = pk2(v[r][j].x, v[r][j].y); w.y = pk2(v[r][j].z, v[r][j].w); o8[64 * j] = w; }
        if (lane < 16) ssq16[r][lane] = (lane == 0) ? s[r] : 0.f; }
}
struct Ptrs {
    const float* in[27]; float* out; unsigned char* ws;
};
__device__ __forceinline__ void p0_transposes(const Ptrs& P, LAS unsigned char* lds, int part, int gw, int NGW, int wave, int lane) {
    unsigned char* ws = P.ws; LAS float* scr = (LAS float*)(lds + wave * 16384);
    constexpr int I_G = (DM / 64) * (FF / 32), I_D = (FF / 64) * (DM / 32), I_IN = (DM / 64) * (NIN / 32), I_O = (DM / 64) * (DM / 32);
    const int nitems = 2 * I_G + I_D + (part ? I_O : I_IN);
    for (int it = gw; it < nitems; it += NGW) {
        int r = it;
        if (r < 2 * I_G) { const int isup = r / I_G; r -= isup * I_G; const int nblk = FF / 32, kb = r / nblk, nb = r % nblk, n0 = 32 * nb;
            const float* W = P.in[part ? (isup ? 24 : 23) : (isup ? 4 : 3)]; const float* gain = P.in[part ? 22 : 2];
            bf16* WT = (bf16*)(ws + (part ? WS_WGU2 : WS_WGU1));
            const int drow0 = 256 * (n0 / 128) + 128 * isup + (n0 % 128);
            p0_transpose_item(W, DM, FF, WT, gain, 64 * kb, n0, drow0, scr, lane); continue; }
        r -= 2 * I_G;
        if (r < I_D) { const int nblk = DM / 32, kb = r / nblk, nb = r % nblk;
            p0_transpose_item(P.in[part ? 25 : 5], FF, DM, (bf16*)(ws + (part ? WS_WD2 : WS_WD1)), nullptr, 64 * kb, 32 * nb, 32 * nb, scr, lane); continue; }
        r -= I_D;
        if (!part) { const int nblk = NIN / 32, kb = r / nblk, nb = r % nblk;
            p0_transpose_item(P.in[7], DM, NIN, (bf16*)(ws + WS_WIN), P.in[6], 64 * kb, 32 * nb, 32 * nb, scr, lane); }
        else { const int nblk = DM / 32, kb = r / nblk, nb = r % nblk;
            p0_transpose_item(P.in[21], DM, DM, (bf16*)(ws + WS_WOUT), nullptr, 64 * kb, 32 * nb, 32 * nb, scr, lane); }
    }
}
__device__ __forceinline__ void p0_prologue(const Ptrs& P, LAS unsigned char* lds, int vcu, int G, int wave, int lane) {
    const int gw = vcu * NWAVES + wave, NGW = G * NWAVES;
    unsigned char* ws = P.ws;
    p0_transposes(P, lds, 0, gw, NGW, wave, lane);
    { GAS v4u* z = (GAS v4u*)(ws + WS_WIN + (size_t)NIN * DM * 2); const int n16 = (NINP - NIN) * DM * 2 / 16;
      for (int i = gw * 64 + lane; i < n16; i += NGW * 64) z[i] = (v4u){0u, 0u, 0u, 0u}; }
    { bf16* LT = (bf16*)(ws + WS_LT);
      for (int i = gw * 64 + lane; i < 512 * 160; i += NGW * 64) { const int n = i / 160, j = i % 160;
          const float v = j < 32 ? P.in[11][j * 512 + n] : j < 64 ? P.in[13][(j - 32) * 512 + n] : P.in[14][(j - 64) * 512 + n];
          LT[i] = (bf16)f2bf(v); } }
#ifndef REP_ROWS
#define REP_ROWS 1
#endif
    for (int rep_ = 0; rep_ < REP_ROWS; ++rep_)
    for (int m4 = gw; m4 < (MR + NMETA) / 4; m4 += NGW) { const float* xr[4]; bf16* orow[4]; float* sq[4];
#pragma unroll
        for (int r = 0; r < 4; ++r) { const int m = 4 * m4 + r;
            if (m < MR) { xr[r] = P.in[0] + (size_t)m * DM; orow[r] = (bf16*)(ws + WS_XB) + (size_t)m * DM; sq[r] = (float*)(ws + WS_SSQ1) + (size_t)m * 16; }
            else { const int i = m - MR; xr[r] = P.in[1] + (size_t)i * DM; orow[r] = (bf16*)(ws + WS_META + MO_XMB) + (size_t)i * DM; sq[r] = (float*)(ws + WS_META + MO_SSQM1) + i * 16; } }
        rows4_to_bf16(xr, orow, sq, lane); }
}
__device__ __forceinline__ f32x4 skinny16(const bf16* A, const bf16* Bt, int K, int n0, int lane) {
    const int fr = lane & 15, fq = lane >> 4;
    const bf16* ap = A + (size_t)fr * K + 8 * fq; const bf16* bp = Bt + (size_t)(n0 + fr) * K + 8 * fq;
    f32x4 acc = (f32x4){0.f, 0.f, 0.f, 0.f};
    for (int k = 0; k < K; k += 256) {
        bf16x8 a[8], b[8];
#pragma unroll
        for (int j = 0; j < 8; ++j) { a[j] = *(const bf16x8*)(ap + k + 32 * j); b[j] = *(const bf16x8*)(bp + k + 32 * j); }
#pragma unroll
        for (int j = 0; j < 8; ++j) acc = __builtin_amdgcn_mfma_f32_16x16x32_bf16(a[j], b[j], acc, 0, 0, 0); }
    return acc;
}
__device__ __forceinline__ float rstd_m16(const float* ssq16) { float s = 0.f;
#pragma unroll
    for (int i = 0; i < 16; ++i) s += ssq16[i];
    return __builtin_amdgcn_rsqf(s * (1.0f / 1024.0f) + 1e-5f); }
__device__ __forceinline__ void meta_up(unsigned char* ws, int gw, int NGW, int lane) {
    const bf16* A = (const bf16*)(ws + WS_META + MO_XMB); const bf16* Bt = (const bf16*)(ws + WS_WGU1); bf16* Um = (bf16*)(ws + WS_META + MO_UM);
    const float* ssq = (const float*)(ws + WS_META + MO_SSQM1); const int fr = lane & 15, fq = lane >> 4;
    for (int t = gw; t < FF / 16; t += NGW) { const int c0 = 16 * t, nr = 256 * (c0 / 128) + (c0 % 128);
        const f32x4 g = skinny16(A, Bt, DM, nr, lane), u = skinny16(A, Bt, DM, nr + 128, lane);
#pragma unroll
        for (int r = 0; r < 4; ++r) { const int row = 4 * fq + r; const float rs = rstd_m16(ssq + row * 16); Um[(size_t)row * FF + c0 + fr] = (bf16)f2bf(pg8::silu_mul(g[r] * rs, u[r] * rs)); } }
}
__device__ __forceinline__ void meta_down(const Ptrs& P, int gw, int NGW, int lane) {
    unsigned char* ws = P.ws; const bf16* A = (const bf16*)(ws + WS_META + MO_UM); const bf16* Bt = (const bf16*)(ws + WS_WD1); bf16* H = (bf16*)(ws + WS_META + MO_H1MB);
    float* ssq = (float*)(ws + WS_META + MO_SSQM2); const int fr = lane & 15, fq = lane >> 4;
    for (int t = gw; t < DM / 16; t += NGW) { const f32x4 a = skinny16(A, Bt, FF, 16 * t, lane);
#pragma unroll
        for (int r = 0; r < 4; ++r) { const int row = 4 * fq + r; const float o = P.in[1][row * DM + 16 * t + fr] + 0.5f * a[r]; H[row * DM + 16 * t + fr] = (bf16)f2bf(o);
            float s = o * o; s += __shfl_xor(s, 1); s += __shfl_xor(s, 2); s += __shfl_xor(s, 4); s += __shfl_xor(s, 8); if (fr == 0) ssq[row * 64 + t] = s; } }
}
__device__ __forceinline__ void meta_win(const Ptrs& P, int gw, int NGW, int lane) {
    unsigned char* ws = P.ws; const bf16* A = (const bf16*)(ws + WS_META + MO_H1MB); const bf16* Bt = (const bf16*)(ws + WS_WIN); bf16* Zm = (bf16*)(ws + WS_META + MO_ZM);
    const float* ssq = (const float*)(ws + WS_META + MO_SSQM2); const int fr = lane & 15, fq = lane >> 4;
    for (int t = gw; t < NIN / 16; t += NGW) { const f32x4 a = skinny16(A, Bt, DM, 16 * t, lane); const int c = 16 * t + fr; const float bias = c >= ZC_Q ? P.in[8][c - ZC_Q] : 0.f;
#pragma unroll
        for (int r = 0; r < 4; ++r) { const int row = 4 * fq + r; float s = 0.f;
#pragma unroll 8
            for (int i = 0; i < 64; ++i) s += ssq[row * 64 + i];
            Zm[(size_t)row * NIN + c] = (bf16)f2bf(a[r] * __builtin_amdgcn_rsqf(s * (1.0f / 1024.0f) + 1e-5f) + bias); } }
}
constexpr int KS_LD = 72, VT_LD = 232, ATT_KS_BYTES = 208 * KS_LD * 2, ATT_VT_BYTES = 64 * VT_LD * 2;
__device__ __forceinline__ void attn_unit(const Ptrs& P, unsigned char* lds, int b, int g, int c, int tid, int wave, int lane) {
    unsigned char* ws = P.ws; const bf16* Z = (const bf16*)(ws + WS_BIG); const bf16* Zm = (const bf16*)(ws + WS_META + MO_ZM); bf16* Y = (bf16*)(ws + WS_XB);
    bf16* Ks = (bf16*)lds; bf16* Vt = (bf16*)(lds + ATT_KS_BYTES);
    const int fr = lane & 15, fq = lane >> 4;
    __syncthreads();
    for (int it = tid; it < 208 * 8; it += NWAVES * 64) { const int key = it >> 3, pc = it & 7; const bf16* src; bool valid = true;
        if (key < 16) src = Zm + (size_t)key * NIN; else { const int t = 64 * (c - 2) + (key - 16); valid = t >= 0; src = Z + ((size_t)b * TSEQ + (valid ? t : 0)) * NIN; }
        v4u kq = *(const v4u*)(src + ZC_K + 64 * g + 8 * pc), vq = *(const v4u*)(src + ZC_V + 64 * g + 8 * pc);
        if (!valid) { kq = (v4u){0u, 0u, 0u, 0u}; vq = kq; }
        *(v4u*)(Ks + key * KS_LD + 8 * pc) = kq;
#pragma unroll
        for (int e = 0; e < 4; ++e) { Vt[(8 * pc + 2 * e) * VT_LD + key] = (bf16)(vq[e] & 0xffffu); Vt[(8 * pc + 2 * e + 1) * VT_LD + key] = (bf16)(vq[e] >> 16); } }
    for (int it = tid; it < 64 * 16; it += NWAVES * 64) Vt[(it >> 4) * VT_LD + 208 + (it & 15)] = 0;
    __syncthreads();
    const int hq = 4 * g + (wave >> 1);
    const float slope = __builtin_amdgcn_exp2f(-(float)(hq + 1)), sink = P.in[20][hq];
#pragma unroll 1
    for (int sub = 0; sub < 2; ++sub) {
        const int i0 = 16 * (2 * (wave & 1) + sub), iq = i0 + fr;
        const size_t mrow = (size_t)b * TSEQ + 64 * c + iq;
        const bf16x8 q0 = *(const bf16x8*)(Z + mrow * NIN + ZC_Q + 64 * hq + 8 * fq), q1 = *(const bf16x8*)(Z + mrow * NIN + ZC_Q + 64 * hq + 32 + 8 * fq);
        f32x4 s[13]; float mx = sink;
#pragma unroll
        for (int kt = 0; kt < 13; ++kt) { const bf16* kp = Ks + (16 * kt + fr) * KS_LD + 8 * fq; f32x4 a = (f32x4){0.f, 0.f, 0.f, 0.f};
            a = __builtin_amdgcn_mfma_f32_16x16x32_bf16(*(const bf16x8*)(kp), q0, a, 0, 0, 0);
            a = __builtin_amdgcn_mfma_f32_16x16x32_bf16(*(const bf16x8*)(kp + 32), q1, a, 0, 0, 0);
#pragma unroll
            for (int r = 0; r < 4; ++r) { const int key = 16 * kt + 4 * fq + r; float v;
                if (kt == 0) v = a[r] * 0.125f - slope * (float)(16 + 64 * c + iq - key);
                else { const int jj = key - 16; const int d = 128 + iq - jj; v = a[r] * 0.125f - slope * (float)(d < 0 ? -d : d); if (64 * (c - 2) + jj < 0) v = -1e30f; }
                a[r] = v; mx = fmaxf(mx, v); }
            s[kt] = a; }
        mx = fmaxf(mx, __shfl_xor(mx, 16)); mx = fmaxf(mx, __shfl_xor(mx, 32));
        float sum = 0.f;
#pragma unroll
        for (int kt = 0; kt < 13; ++kt)
#pragma unroll
            for (int r = 0; r < 4; ++r) { const float p = __builtin_amdgcn_exp2f((s[kt][r] - mx) * 1.4426950408889634f); s[kt][r] = p; sum += p; }
        sum += __shfl_xor(sum, 16); sum += __shfl_xor(sum, 32);
        sum += __builtin_amdgcn_exp2f((sink - mx) * 1.4426950408889634f);
        const float rinv = 1.0f / sum;
        f32x4 o[4];
#pragma unroll
        for (int dt = 0; dt < 4; ++dt) o[dt] = (f32x4){0.f, 0.f, 0.f, 0.f};
#pragma unroll
        for (int ks = 0; ks < 7; ++ks) { const int ta = 2 * ks, tb = 2 * ks + 1; v4u pw;
            pw.x = pk2(s[ta][0], s[ta][1]); pw.y = pk2(s[ta][2], s[ta][3]);
            if (tb < 13) { pw.z = pk2(s[tb][0], s[tb][1]); pw.w = pk2(s[tb][2], s[tb][3]); } else { pw.z = 0u; pw.w = 0u; }
            const bf16x8 pf = __builtin_bit_cast(bf16x8, pw);
#pragma unroll
            for (int dt = 0; dt < 4; ++dt) { const bf16* vp = Vt + (16 * dt + fr) * VT_LD + 4 * fq; const v2u va = *(const v2u*)(vp + 16 * ta), vb = *(const v2u*)(vp + 16 * tb);
                const v4u vv = (v4u){va.x, va.y, vb.x, vb.y};
                o[dt] = __builtin_amdgcn_mfma_f32_16x16x32_bf16(__builtin_bit_cast(bf16x8, vv), pf, o[dt], 0, 0, 0); } }
#pragma unroll
        for (int dt = 0; dt < 4; ++dt) { v2u w; w.x = pk2(o[dt][0] * rinv, o[dt][1] * rinv); w.y = pk2(o[dt][2] * rinv, o[dt][3] * rinv);
            *(v2u*)(Y + mrow * DM + 512 + 64 * hq + 16 * dt + 4 * fq) = w; }
    }
}
template <int CTRL> __device__ __forceinline__ float dppf(float x) { return __builtin_bit_cast(float, __builtin_amdgcn_update_dpp(0, __builtin_bit_cast(int, x), CTRL, 0xF, 0xF, true)); }
template <int CTRL> __device__ __forceinline__ float dppf_old(float old, float x) { return __builtin_bit_cast(float, __builtin_amdgcn_update_dpp(__builtin_bit_cast(int, old), __builtin_bit_cast(int, x), CTRL, 0xF, 0xF, false)); }
__device__ __forceinline__ float red8(float x) { x += dppf<0xB1>(x); x += dppf<0x4E>(x); x += dppf<0x141>(x); return x; }
__device__ __forceinline__ float red16(float x) { x = red8(x); x += dppf<0x140>(x); return x; }
__device__ __forceinline__ float scan16(float x) { x += dppf<0x111>(x); x += dppf<0x112>(x); x += dppf<0x114>(x); x += dppf<0x118>(x); return x; }
constexpr int NCHUNK = 257, NSUPER = 65;
constexpr int CB_A = 0, CB_R = 2048, CB_BK = 4096, CB_VT = 8192, CB_TT = 10240, CB_AR = 11264, CB_G = 12288, CB_BON = 12544, CB_SIZE = 12800;
constexpr int CB_GATE = 12800, IMG_SIZE = 14848;
constexpr int WL_HS = IMG_SIZE, WL_SIZE = IMG_SIZE + 2048;
constexpr int SC_YB = 8 * CB_SIZE, SC_END = SC_YB + 8 * 4096;
static_assert(8 * WL_SIZE <= LDSCTL_OFF && SC_END <= LDSCTL_OFF, "LDS map");
__device__ __forceinline__ bf16x8 pack8(const float* v) { v4u o; o.x = pk2(v[0], v[1]); o.y = pk2(v[2], v[3]); o.z = pk2(v[4], v[5]); o.w = pk2(v[6], v[7]); return __builtin_bit_cast(bf16x8, o); }
__device__ __forceinline__ void unpack8(v4u w, float* v) { v[0] = bflo(w.x); v[1] = bfhi(w.x); v[2] = bflo(w.y); v[3] = bfhi(w.y); v[4] = bflo(w.z); v[5] = bfhi(w.z); v[6] = bflo(w.w); v[7] = bfhi(w.w); }


__device__ __forceinline__ void chunk_task(const Ptrs& P, unsigned char* ldsb, int woff, int b, int h, int ch, int lane) {
    int wo_ = woff; asm volatile("" : "+v"(wo_));
    unsigned char* wl = ldsb + wo_;
    unsigned char* ws = P.ws; const int fr = lane & 15, fq = lane >> 4, t = fr;
    const bf16* Z = (const bf16*)(ws + WS_BIG); const bf16* Zm = (const bf16*)(ws + WS_META + MO_ZM); const bf16* LT = (const bf16*)(ws + WS_LT);
    const bool meta = (ch == 0);
    const int tok = 16 * (ch - 1) + fr; const size_t m = (size_t)b * TSEQ + tok;
    const bf16* zc = meta ? Zm + (size_t)fr * NIN : Z + m * NIN;
    const bool pz = meta && fr == 0;
    const bf16* zp = meta ? Zm + (size_t)(fr > 0 ? fr - 1 : 0) * NIN : (tok == 0 ? Zm + (size_t)15 * NIN : Z + (m - 1) * NIN);
    const float* mu = P.in[9];
    bf16* sx = (bf16*)wl;
    {
    bf16x8 xf[5];
#pragma unroll
    for (int ks = 0; ks < 5; ++ks) { const int c0 = ZC_W + 32 * ks + 8 * fq; const v4u a = *(const v4u*)(zc + c0); v4u bq = *(const v4u*)(zp + c0); if (pz) bq = (v4u){0u, 0u, 0u, 0u};
        float va[8], vb[8], v[8]; unpack8(a, va); unpack8(bq, vb); const f32x4 m0 = *(const f32x4*)(mu + c0), m1 = *(const f32x4*)(mu + c0 + 4);
#pragma unroll
        for (int e = 0; e < 8; ++e) { const float mm = e < 4 ? m0[e & 3] : m1[e & 3]; const float z = va[e] + (vb[e] - va[e]) * mm; v[e] = (ks == 0) ? tanhf_(z) : (ks == 1) ? z : sigmoidf_(z); }
        xf[ks] = pack8(v); }
    f32x4 aw[4], aa[4], ag[4];
#pragma unroll
    for (int nt = 0; nt < 4; ++nt) { const bf16* lp = LT + (size_t)(h * 64 + 16 * nt + fr) * 160 + 8 * fq; const f32x4 z = (f32x4){0.f, 0.f, 0.f, 0.f};
        aw[nt] = __builtin_amdgcn_mfma_f32_16x16x32_bf16(*(const bf16x8*)(lp), xf[0], z, 0, 0, 0);
        aa[nt] = __builtin_amdgcn_mfma_f32_16x16x32_bf16(*(const bf16x8*)(lp + 32), xf[1], z, 0, 0, 0);
        ag[nt] = __builtin_amdgcn_mfma_f32_16x16x32_bf16(*(const bf16x8*)(lp + 64), xf[2], z, 0, 0, 0);
        ag[nt] = __builtin_amdgcn_mfma_f32_16x16x32_bf16(*(const bf16x8*)(lp + 96), xf[3], ag[nt], 0, 0, 0);
        ag[nt] = __builtin_amdgcn_mfma_f32_16x16x32_bf16(*(const bf16x8*)(lp + 128), xf[4], ag[nt], 0, 0, 0); }
    f32x4 kkr[4], kv[4], av[4]; float ss = 0.f;
#pragma unroll
    for (int nt = 0; nt < 4; ++nt) { const int c = h * 64 + 16 * nt + 4 * fq; const v2u a = *(const v2u*)(zc + 512 + c); v2u bq = *(const v2u*)(zp + 512 + c); if (pz) bq = (v2u){0u, 0u};
        const f32x4 za = unpack4(a), zb = unpack4(bq), mk = *(const f32x4*)(mu + 512 + c); const f32x4 zk = za + (zb - za) * mk;
        const f32x4 a0 = *(const f32x4*)(P.in[12] + c), kkw = *(const f32x4*)(P.in[15] + c), kaw = *(const f32x4*)(P.in[16] + c);
        f32x4 a_;
#pragma unroll
        for (int r = 0; r < 4; ++r) a_[r] = sigmoidf_(a0[r] + aa[nt][r]);
        av[nt] = a_; kkr[nt] = zk * kkw; kv[nt] = zk * (1.0f + (a_ - 1.0f) * kaw);
        ss += (kkr[nt][0] * kkr[nt][0] + kkr[nt][1] * kkr[nt][1]) + (kkr[nt][2] * kkr[nt][2] + kkr[nt][3] * kkr[nt][3]); }
    ss += __shfl_xor(ss, 16); ss += __shfl_xor(ss, 32);
    const float inv = 1.0f / fmaxf(sqrtf(ss), 1e-12f);
#pragma unroll
    for (int nt = 0; nt < 4; ++nt) { const int cl = 16 * nt + 4 * fq, c = h * 64 + cl; const f32x4 w0 = *(const f32x4*)(P.in[10] + c);
        const f32x4 kk = kkr[nt] * inv, bb = kk * av[nt]; f32x4 e;
#pragma unroll
        for (int r = 0; r < 4; ++r) e[r] = 0.6065306597126334f * sigmoidf_(w0[r] + aw[nt][r]);
        bf16* px = sx + t * 64 + cl; v2u o;
        o.x = pk2(kk[0], kk[1]); o.y = pk2(kk[2], kk[3]); *(v2u*)(px) = o;
        o.x = pk2(e[0], e[1]); o.y = pk2(e[2], e[3]); *(v2u*)(px + 1024) = o;
        o.x = pk2(bb[0], bb[1]); o.y = pk2(bb[2], bb[3]); *(v2u*)(px + 2048) = o;
        o.x = pk2(kv[nt][0], kv[nt][1]); o.y = pk2(kv[nt][2], kv[nt][3]); *(v2u*)(px + 3072) = o;
        o.x = pk2m(ag[nt][0], ag[nt][1]); o.y = pk2m(ag[nt][2], ag[nt][3]); *(v2u*)(px + 4096) = o; }
    }
    asm volatile("s_waitcnt lgkmcnt(0)" ::: "memory"); __builtin_amdgcn_sched_barrier(0);
    v4u xk[2], xe[2], xb[2], xx[2], xg[2];
#pragma unroll
    for (int ks = 0; ks < 2; ++ks) { const bf16* px = sx + t * 64 + 32 * ks + 8 * fq; xk[ks] = *(const v4u*)(px); xe[ks] = *(const v4u*)(px + 1024); xb[ks] = *(const v4u*)(px + 2048); xx[ks] = *(const v4u*)(px + 3072); xg[ks] = *(const v4u*)(px + 4096); }
    asm volatile("s_waitcnt lgkmcnt(0)" ::: "memory"); __builtin_amdgcn_sched_barrier(0);
    unsigned char* cb = wl; float* hs = (float*)(wl + WL_HS);
    const int cbase = h * 64 + 8 * fq;
    unsigned char* pbk = cb + CB_BK + ((((fq >> 1) * 4 + (t >> 2)) * 16 + 8 * (fq & 1)) * 8 + (t & 3)) * 2;
    unsigned char* pvt = cb + CB_VT + (((fq >> 1) * 4 + (t >> 2)) * 16 + 8 * (fq & 1)) * 8 + (t & 3) * 2;
    unsigned char* pgc = cb + CB_G + 8 * fq * 4;
    bf16x8 Af[2], Rf[2], Bf[2], Kf[2]; float bonp = 0.f;
#pragma unroll
    for (int ks = 0; ks < 2; ++ks) { const int c = cbase + 32 * ks, cl = 32 * ks + 8 * fq;
        asm volatile("" ::: "memory"); __builtin_amdgcn_sched_barrier(0);
        float kk[8], e_[8], bb[8], kx[8], rc[8], rp[8], vc[8], vp[8];
        unpack8(xk[ks], kk); unpack8(xe[ks], e_); unpack8(xb[ks], bb); unpack8(xx[ks], kx);
        unpack8(*(const v4u*)(zc + c), rc); unpack8(*(const v4u*)(zc + 1024 + c), vc);
        { v4u a = *(const v4u*)(zp + c), d = *(const v4u*)(zp + 1024 + c); if (pz) { a = (v4u){0u, 0u, 0u, 0u}; d = a; } unpack8(a, rp); unpack8(d, vp); }
        float At[8], Rt[8], Bt[8], Kt[8]; float mur[8], muv[8], rkk[8];
        { const f32x4 a0 = *(const f32x4*)(P.in[9] + c), a1 = *(const f32x4*)(P.in[9] + c + 4), b0 = *(const f32x4*)(P.in[9] + 1024 + c), b1 = *(const f32x4*)(P.in[9] + 1024 + c + 4), c0 = *(const f32x4*)(P.in[17] + c), c1 = *(const f32x4*)(P.in[17] + c + 4);
#pragma unroll
          for (int e = 0; e < 4; ++e) { mur[e] = a0[e]; mur[4 + e] = a1[e]; muv[e] = b0[e]; muv[4 + e] = b1[e]; rkk[e] = c0[e]; rkk[4 + e] = c1[e]; } }
#pragma unroll
        for (int e = 0; e < 8; ++e) { const float rr = rc[e] + (rp[e] - rc[e]) * mur[e]; const float vv = vc[e] + (vp[e] - vc[e]) * muv[e];
            bonp += rr * kx[e] * rkk[e];
            const float ec = scan16(e_[e]), etot = red16(e_[e]);
            const float g1 = __builtin_amdgcn_exp2f(-1.4426950408889634f * ec);
            const float gi = __builtin_amdgcn_exp2f(1.4426950408889634f * ec);
            const float gC = __builtin_amdgcn_exp2f(-1.4426950408889634f * etot);
            const float g0 = dppf_old<0x111>(1.0f, g1);
            At[e] = -kk[e] * g0; Rt[e] = rr * g1; Bt[e] = bb[e] * gi; Kt[e] = kx[e] * gi;
            const int ke = 32 * ks + e;
            *(bf16*)(pbk + ks * 2048 + e * 16) = (bf16)f2bf(Bt[e] * gC);
            *(bf16*)(pbk + ks * 2048 + e * 16 + 8) = (bf16)f2bf(Kt[e] * gC);
            *(bf16*)(pvt + ks * 1024 + e * 8) = (bf16)f2bf(vv);
            if (t == 15) *(float*)(pgc + ke * 4) = gC; }
        Af[ks] = pack8(At); Rf[ks] = pack8(Rt); Bf[ks] = pack8(Bt); Kf[ks] = pack8(Kt);
        { const int fqs = 2 * (fq & 1), bo = (fq >> 1) * 8; const v4u aw = __builtin_bit_cast(v4u, Af[ks]), rw = __builtin_bit_cast(v4u, Rf[ks]);
          *(v2u*)(cb + CB_A + ((ks * 4 + fqs) * 16 + t) * 16 + bo) = (v2u){aw.x, aw.y}; *(v2u*)(cb + CB_A + ((ks * 4 + fqs + 1) * 16 + t) * 16 + bo) = (v2u){aw.z, aw.w};
          *(v2u*)(cb + CB_R + ((ks * 4 + fqs) * 16 + t) * 16 + bo) = (v2u){rw.x, rw.y}; *(v2u*)(cb + CB_R + ((ks * 4 + fqs + 1) * 16 + t) * 16 + bo) = (v2u){rw.z, rw.w}; }
        *(v4u*)(cb + CB_GATE + (t * 64 + cl) * 2) = xg[ks]; }
    asm volatile("" ::: "memory"); __builtin_amdgcn_sched_barrier(0);
    bonp += __shfl_xor(bonp, 16); bonp += __shfl_xor(bonp, 32);
    if (fq == 0) *(float*)(cb + CB_BON + t * 4) = bonp;
    const f32x4 z4 = (f32x4){0.f, 0.f, 0.f, 0.f};
    f32x4 Mab = __builtin_amdgcn_mfma_f32_16x16x32_bf16(Af[0], Bf[0], z4, 0, 0, 0); Mab = __builtin_amdgcn_mfma_f32_16x16x32_bf16(Af[1], Bf[1], Mab, 0, 0, 0);
    f32x4 Mak = __builtin_amdgcn_mfma_f32_16x16x32_bf16(Af[0], Kf[0], z4, 0, 0, 0); Mak = __builtin_amdgcn_mfma_f32_16x16x32_bf16(Af[1], Kf[1], Mak, 0, 0, 0);
    f32x4 Mrb = __builtin_amdgcn_mfma_f32_16x16x32_bf16(Rf[0], Bf[0], z4, 0, 0, 0); Mrb = __builtin_amdgcn_mfma_f32_16x16x32_bf16(Rf[1], Bf[1], Mrb, 0, 0, 0);
    f32x4 Mrk = __builtin_amdgcn_mfma_f32_16x16x32_bf16(Rf[0], Kf[0], z4, 0, 0, 0); Mrk = __builtin_amdgcn_mfma_f32_16x16x32_bf16(Rf[1], Kf[1], Mrk, 0, 0, 0);
#pragma unroll
    for (int r = 0; r < 4; ++r) { const int tt = 4 * fq + r, i = fr;
        const float mab = (tt > i) ? Mab[r] : 0.f, mak = (tt > i) ? Mak[r] : 0.f, mrb = (tt >= i) ? Mrb[r] : 0.f, mrk = (tt >= i) ? Mrk[r] : 0.f;
        hs[tt * 16 + i] = mab; hs[256 + tt * 16 + i] = mak;
        const unsigned w = pk2m(mrb, mrk);
        *(bf16*)(cb + CB_AR + (((i >> 2) * 16 + tt) * 8 + (i & 3)) * 2) = (bf16)(w & 0xffffu);
        *(bf16*)(cb + CB_AR + (((i >> 2) * 16 + tt) * 8 + 4 + (i & 3)) * 2) = (bf16)(w >> 16); }
    asm volatile("s_waitcnt lgkmcnt(0)" ::: "memory");
    { const int c = lane & 31, cc = c & 15; const bool isT = c < 16; float out[16];
#pragma unroll
      for (int tt = 0; tt < 16; ++tt) { float acc = isT ? (tt == cc ? 1.0f : 0.0f) : hs[256 + tt * 16 + cc];
#pragma unroll
          for (int i4 = 0; i4 < (tt + 3) / 4; ++i4) { const f32x4 l = *(const f32x4*)(hs + tt * 16 + 4 * i4);
#pragma unroll
              for (int e = 0; e < 4; ++e) if (4 * i4 + e < tt) acc += l[e] * out[4 * i4 + e]; }
          out[tt] = acc;
          if (lane < 32) *(bf16*)(cb + CB_TT + (((cc >> 2) * 16 + tt) * 8 + (isT ? 0 : 4) + (cc & 3)) * 2) = (bf16)f2bf(acc); } }
    asm volatile("s_waitcnt lgkmcnt(0)" ::: "memory");
    { unsigned char* gi = ws + WS_IMG + ((size_t)(b * NHEAD + h) * NCHUNK + ch) * IMG_SIZE;
      for (int i = lane; i < IMG_SIZE / 16; i += 64) *(v4u*)(gi + i * 16) = *(const v4u*)(cb + i * 16); }
    asm volatile("s_waitcnt lgkmcnt(0)" ::: "memory"); __builtin_amdgcn_sched_barrier(0);
}

struct ScanOps { bf16x8 a0, a1, r0, r1, tt, ar, bk[4]; v2u vt; f32x4 g[4]; };
__device__ __forceinline__ void scan_load(ScanOps& o, const unsigned char* ib, int fr, int fq, int vcol) {
    const int ln = (fq * 16 + fr) * 16;
    o.a0 = *(const bf16x8*)(ib + CB_A + ln); o.a1 = *(const bf16x8*)(ib + CB_A + 1024 + ln);
    o.r0 = *(const bf16x8*)(ib + CB_R + ln); o.r1 = *(const bf16x8*)(ib + CB_R + 1024 + ln);
    o.tt = *(const bf16x8*)(ib + CB_TT + ln); o.ar = *(const bf16x8*)(ib + CB_AR + ln);
    o.vt = *(const v2u*)(ib + CB_VT + (((vcol >> 4) * 4 + fq) * 16 + fr) * 8);
#pragma unroll
    for (int kt = 0; kt < 4; ++kt) { o.g[kt] = *(const f32x4*)(ib + CB_G + (16 * kt + 4 * fq) * 4); o.bk[kt] = *(const bf16x8*)(ib + CB_BK + kt * 1024 + ln); }
}
__device__ __forceinline__ void scan_step(f32x4 (&H)[4], const ScanOps& o, float* yb, int fq, int vcol) {
    v4u hb0, hb1;
    hb0.x = pk2m(H[0][0], H[0][1]); hb0.y = pk2m(H[0][2], H[0][3]); hb0.z = pk2m(H[1][0], H[1][1]); hb0.w = pk2m(H[1][2], H[1][3]);
    hb1.x = pk2m(H[2][0], H[2][1]); hb1.y = pk2m(H[2][2], H[2][3]); hb1.z = pk2m(H[3][0], H[3][1]); hb1.w = pk2m(H[3][2], H[3][3]);
    const bf16x8 h0 = __builtin_bit_cast(bf16x8, hb0), h1 = __builtin_bit_cast(bf16x8, hb1);
    const f32x4 z4 = (f32x4){0.f, 0.f, 0.f, 0.f};
    f32x4 X = __builtin_amdgcn_mfma_f32_16x16x32_bf16(o.a0, h0, z4, 0, 0, 0); X = __builtin_amdgcn_mfma_f32_16x16x32_bf16(o.a1, h1, X, 0, 0, 0);
    f32x4 Y = __builtin_amdgcn_mfma_f32_16x16x32_bf16(o.r0, h0, z4, 0, 0, 0); Y = __builtin_amdgcn_mfma_f32_16x16x32_bf16(o.r1, h1, Y, 0, 0, 0);
    v4u xb; xb.x = pk2m(X[0], X[1]); xb.y = pk2m(X[2], X[3]); xb.z = o.vt.x; xb.w = o.vt.y;
    const f32x4 U = __builtin_amdgcn_mfma_f32_16x16x32_bf16(o.tt, __builtin_bit_cast(bf16x8, xb), z4, 0, 0, 0);
    v4u ub; ub.x = pk2m(U[0], U[1]); ub.y = pk2m(U[2], U[3]); ub.z = o.vt.x; ub.w = o.vt.y;
    const bf16x8 uf = __builtin_bit_cast(bf16x8, ub);
    Y = __builtin_amdgcn_mfma_f32_16x16x32_bf16(o.ar, uf, Y, 0, 0, 0);
#pragma unroll
    for (int kt = 0; kt < 4; ++kt) H[kt] = __builtin_amdgcn_mfma_f32_16x16x32_bf16(o.bk[kt], uf, H[kt] * o.g[kt], 0, 0, 0);
#pragma unroll
    for (int r = 0; r < 4; ++r) yb[(4 * fq + r) * 64 + vcol] = Y[r];
}
__device__ __forceinline__ void scan_phase(const Ptrs& P, unsigned char* lds, int sb, int tid, int wave, int lane, int never) {
    const int b = sb >> 3, h = sb & 7, fr = lane & 15, fq = lane >> 4;
    const unsigned char* img = P.ws + WS_IMG + (size_t)(b * NHEAD + h) * NCHUNK * IMG_SIZE;
    if (wave < 4) {
        f32x4 H[4];
#pragma unroll
        for (int kt = 0; kt < 4; ++kt) H[kt] = (f32x4){0.f, 0.f, 0.f, 0.f};
        const int vcol = 16 * wave + fr;
#pragma unroll 1
        for (int s = 0; s <= NSUPER + 1; ++s) {
            __syncthreads();
            if (s < 1 || s > NSUPER) continue;
            const int set = (s - 1) & 1;
#pragma unroll 1
            for (int j = 0; j < 4; ++j) { const int ch = 4 * (s - 1) + j; if (ch >= NCHUNK) break;
                ScanOps o; scan_load(o, lds + (set * 4 + j) * CB_SIZE, fr, fq, vcol);
                scan_step(H, o, (float*)(lds + SC_YB + (set * 4 + j) * 4096), fq, vcol); }
        }
    } else {
        const int hw = wave - 4, t = fr;
        const bf16* Z = (const bf16*)(P.ws + WS_BIG); const bf16* Zm = (const bf16*)(P.ws + WS_META + MO_ZM);
        bf16* Yo = (bf16*)(P.ws + WS_XB);
        const int cbase = h * 64 + 8 * fq;
        float muv[16], lw[16], lb[16];
#pragma unroll
        for (int ks = 0; ks < 2; ++ks) { const int c = cbase + 32 * ks;
            const f32x4 a0 = *(const f32x4*)(P.in[9] + 1024 + c), a1 = *(const f32x4*)(P.in[9] + 1024 + c + 4), b0 = *(const f32x4*)(P.in[18] + c), b1 = *(const f32x4*)(P.in[18] + c + 4), c0 = *(const f32x4*)(P.in[19] + c), c1 = *(const f32x4*)(P.in[19] + c + 4);
#pragma unroll
            for (int e = 0; e < 4; ++e) { muv[8 * ks + e] = a0[e]; muv[8 * ks + 4 + e] = a1[e]; lw[8 * ks + e] = b0[e]; lw[8 * ks + 4 + e] = b1[e]; lb[8 * ks + e] = c0[e]; lb[8 * ks + 4 + e] = c1[e]; } }
        v4u cvc[2], cvp[2], cg[2]; float cbon = 0.f;
        v4u im0[13], im1[13];
#define IMG_LOAD(IM, chx) do { const unsigned char* ip_ = img + (size_t)(chx) * IMG_SIZE; _Pragma("unroll") for (int i_ = 0; i_ < 13; ++i_) if (i_ < 12 || lane < 32) IM[i_] = *(const v4u*)(ip_ + (i_ * 64 + lane) * 16); } while (0)
        if (hw < NCHUNK) IMG_LOAD(im0, hw);
        if (4 + hw < NCHUNK) IMG_LOAD(im1, 4 + hw);
#pragma unroll
        for (int ks = 0; ks < 2; ++ks) { cvc[ks] = (v4u){0u, 0u, 0u, 0u}; cvp[ks] = cvc[ks]; cg[ks] = cvc[ks]; }
#pragma unroll 1
        for (int s2 = 0; s2 <= NSUPER + 1; s2 += 2) {
            { const int s = s2;
            __syncthreads();
            if (4 * s + hw < NCHUNK) { unsigned char* cbw = lds + ((s & 1) * 4 + hw) * CB_SIZE;
#pragma unroll
                for (int i_ = 0; i_ < 13; ++i_) if (i_ < 12 || lane < 32) *(v4u*)(cbw + (i_ * 64 + lane) * 16) = im0[i_]; }
            if (4 * (s + 2) + hw < NCHUNK) IMG_LOAD(im0, 4 * (s + 2) + hw);
            const int ch = 4 * (s - 2) + hw;
            if (s >= 2 && ch >= 1 && ch < NCHUNK) { const int set = s & 1; const float* yb = (const float*)(lds + SC_YB + (set * 4 + hw) * 4096);
                const int tok = 16 * (ch - 1) + t; const size_t m = (size_t)b * TSEQ + tok;
                float y[16]; float sm = 0.f;
#pragma unroll
                for (int ks = 0; ks < 2; ++ks) { const f32x4 y0 = *(const f32x4*)(yb + t * 64 + 32 * ks + 8 * fq), y1 = *(const f32x4*)(yb + t * 64 + 32 * ks + 8 * fq + 4);
#pragma unroll
                    for (int e = 0; e < 4; ++e) { y[8 * ks + e] = y0[e]; y[8 * ks + 4 + e] = y1[e]; sm += y0[e] + y1[e]; } }
                sm += __shfl_xor(sm, 16); sm += __shfl_xor(sm, 32); const float mean = sm * (1.0f / 64.0f); float sq = 0.f;
#pragma unroll
                for (int i = 0; i < 16; ++i) { y[i] -= mean; sq += y[i] * y[i]; }
                sq += __shfl_xor(sq, 16); sq += __shfl_xor(sq, 32); const float rs = __builtin_amdgcn_rsqf(sq * (1.0f / 64.0f) + 64e-5f);
#pragma unroll
                for (int ks = 0; ks < 2; ++ks) { const int c = cbase + 32 * ks;
                    float vc[8], vp[8], g[8], o[8]; unpack8(cvc[ks], vc); unpack8(cvp[ks], vp); unpack8(cg[ks], g);
#pragma unroll
                    for (int e = 0; e < 8; ++e) { const float vv = vc[e] + (vp[e] - vc[e]) * muv[8 * ks + e];
                        o[e] = (y[8 * ks + e] * rs * lw[8 * ks + e] + lb[8 * ks + e] + cbon * vv) * g[e]; }
                    *(bf16x8*)(Yo + m * DM + c) = pack8(o); } }
            { const int chn = 4 * (s - 1) + hw;
              if (s >= 1 && chn >= 1 && chn < NCHUNK) { const unsigned char* ib = img + (size_t)chn * IMG_SIZE; const int tok = 16 * (chn - 1) + t; const size_t m = (size_t)b * TSEQ + tok;
                const bf16* zc = Z + m * NIN; const bf16* zp = (tok == 0) ? Zm + (size_t)15 * NIN : Z + (m - 1) * NIN;
#pragma unroll
                for (int ks = 0; ks < 2; ++ks) { const int c = cbase + 32 * ks; cvc[ks] = *(const v4u*)(zc + 1024 + c); cvp[ks] = *(const v4u*)(zp + 1024 + c); cg[ks] = *(const v4u*)(ib + CB_GATE + (t * 64 + 32 * ks + 8 * fq) * 2); }
                cbon = *(const float*)(ib + CB_BON + t * 4); } }
            }
            if (s2 + 1 <= NSUPER + 1) { const int s = s2 + 1;
            __syncthreads();
            if (4 * s + hw < NCHUNK) { unsigned char* cbw = lds + ((s & 1) * 4 + hw) * CB_SIZE;
#pragma unroll
                for (int i_ = 0; i_ < 13; ++i_) if (i_ < 12 || lane < 32) *(v4u*)(cbw + (i_ * 64 + lane) * 16) = im1[i_]; }
            if (4 * (s + 2) + hw < NCHUNK) IMG_LOAD(im1, 4 * (s + 2) + hw);
            const int ch = 4 * (s - 2) + hw;
            if (s >= 2 && ch >= 1 && ch < NCHUNK) { const int set = s & 1; const float* yb = (const float*)(lds + SC_YB + (set * 4 + hw) * 4096);
                const int tok = 16 * (ch - 1) + t; const size_t m = (size_t)b * TSEQ + tok;
                float y[16]; float sm = 0.f;
#pragma unroll
                for (int ks = 0; ks < 2; ++ks) { const f32x4 y0 = *(const f32x4*)(yb + t * 64 + 32 * ks + 8 * fq), y1 = *(const f32x4*)(yb + t * 64 + 32 * ks + 8 * fq + 4);
#pragma unroll
                    for (int e = 0; e < 4; ++e) { y[8 * ks + e] = y0[e]; y[8 * ks + 4 + e] = y1[e]; sm += y0[e] + y1[e]; } }
                sm += __shfl_xor(sm, 16); sm += __shfl_xor(sm, 32); const float mean = sm * (1.0f / 64.0f); float sq = 0.f;
#pragma unroll
                for (int i = 0; i < 16; ++i) { y[i] -= mean; sq += y[i] * y[i]; }
                sq += __shfl_xor(sq, 16); sq += __shfl_xor(sq, 32); const float rs = __builtin_amdgcn_rsqf(sq * (1.0f / 64.0f) + 64e-5f);
#pragma unroll
                for (int ks = 0; ks < 2; ++ks) { const int c = cbase + 32 * ks;
                    float vc[8], vp[8], g[8], o[8]; unpack8(cvc[ks], vc); unpack8(cvp[ks], vp); unpack8(cg[ks], g);
#pragma unroll
                    for (int e = 0; e < 8; ++e) { const float vv = vc[e] + (vp[e] - vc[e]) * muv[8 * ks + e];
                        o[e] = (y[8 * ks + e] * rs * lw[8 * ks + e] + lb[8 * ks + e] + cbon * vv) * g[e]; }
                    *(bf16x8*)(Yo + m * DM + c) = pack8(o); } }
            { const int chn = 4 * (s - 1) + hw;
              if (s >= 1 && chn >= 1 && chn < NCHUNK) { const unsigned char* ib = img + (size_t)chn * IMG_SIZE; const int tok = 16 * (chn - 1) + t; const size_t m = (size_t)b * TSEQ + tok;
                const bf16* zc = Z + m * NIN; const bf16* zp = (tok == 0) ? Zm + (size_t)15 * NIN : Z + (m - 1) * NIN;
#pragma unroll
                for (int ks = 0; ks < 2; ++ks) { const int c = cbase + 32 * ks; cvc[ks] = *(const v4u*)(zc + 1024 + c); cvp[ks] = *(const v4u*)(zp + 1024 + c); cg[ks] = *(const v4u*)(ib + CB_GATE + (t * 64 + 32 * ks + 8 * fq) * 2); }
                cbon = *(const float*)(ib + CB_BON + t * 4); } }
            }
        }
#undef IMG_LOAD
    }
}
__device__ __forceinline__ void final_norm(const Ptrs& P, int gw, int NGW, int lane) {
    const float* ssq = (const float*)(P.ws + WS_SSQ4); const GAS f32x4* g4 = (const GAS f32x4*)P.in[26] + lane;
    f32x4 g[4];
#pragma unroll
    for (int j = 0; j < 4; ++j) g[j] = g4[64 * j];
    for (int m = gw; m < MR; m += NGW) { const float rs = pg8::rstd_from16(ssq, m); GAS f32x4* o = (GAS f32x4*)(P.out + (size_t)m * DM) + lane;
#pragma unroll
        for (int j = 0; j < 4; ++j) o[64 * j] = o[64 * j] * rs * g[j]; }
}
#ifndef MK_N_LAUNCHES
#define MK_N_LAUNCHES 1
#endif
constexpr int N_PHASES = 10;
struct Args { Ptrs p; int ph_lo, ph_hi, use_cg, pad; };
__global__ void __launch_bounds__(NWAVES * 64, 2) hymba_fwd(Args args) {
    extern __shared__ __attribute__((aligned(16))) unsigned char lds[];
    LAS unsigned char* ldsl = (LAS unsigned char*)lds;
    volatile LAS unsigned* MISC = (volatile LAS unsigned*)(ldsl + MISC_OFF);
    const int tid = threadIdx.x, lane = tid & 63, wave = __builtin_amdgcn_readfirstlane(tid >> 6);
    const int G = gridDim.x, bx = blockIdx.x, vcu = (G % 8 == 0) ? (bx % 8) * (G / 8) + bx / 8 : bx;
    const Ptrs& P = args.p; unsigned char* ws = P.ws;
    if (args.use_cg) cg::this_grid().sync();
    for (int u = tid; u < (LDS_BYTES - LDSCTL_OFF) / 4; u += NWAVES * 64) ((LAS unsigned*)(ldsl + LDSCTL_OFF))[u] = 0u;
    __syncthreads();
    const int lo = args.ph_lo, hi = args.ph_hi;
    XcdBarrier bar; bar.bar = (unsigned*)(ws + WS_CTL) + CW_BAR; bar.x = 0; bar.st = nullptr;
    if (hi - lo > 1) bar = xcd_barrier_post((unsigned*)(ws + WS_CTL) + CW_BAR, MISC + 8);
#define IN(k) (lo <= (k) && (k) < hi)
#define SEAM(k) do { if (IN(k) && IN((k) + 1)) xcd_barrier(bar); } while (0)
    const int gw = vcu * NWAVES + wave, NGW = G * NWAVES;
    const int gwm = bx + G * wave;

#ifndef REP_P0
#define REP_P0 1
#endif
    if (IN(0)) { for (int rep = 0; rep < REP_P0; ++rep) p0_prologue(P, ldsl, vcu, G, wave, lane); SEAM(0); }
    if (IN(1)) {
        meta_up(ws, gwm, NGW, lane);
        pg8::Gemm g{(const bf16*)(ws + WS_XB), (const bf16*)(ws + WS_WGU1), MR, NGU, DM}; pg8::StaticOrder S; S.init(MR, NGU, G, bx);
        pg8::EpiSwiglu E{(bf16*)(ws + WS_BIG), (const float*)(ws + WS_SSQ1), FF};
#ifndef REP_P1
#define REP_P1 1
#endif
        for (int rep = 0; rep < REP_P1; ++rep) pg8::gemm_phase<pg8::EpiSwiglu, pg8::StaticOrder, true, true>(ldsl, g, S, E);
        SEAM(1);
    }
    if (IN(2)) {
        meta_down(P, gwm, NGW, lane);
        pg8::Gemm g{(const bf16*)(ws + WS_BIG), (const bf16*)(ws + WS_WD1), MR, DM, FF}; pg8::StaticOrder S; S.init(MR, DM, G, bx);
        pg8::EpiResid<true> E{P.in[0], P.out, (bf16*)(ws + WS_XB), (float*)(ws + WS_SSQ2), 0.5f};
#ifndef REP_P2
#define REP_P2 1
#endif
        for (int rep = 0; rep < REP_P2; ++rep) pg8::gemm_phase<pg8::EpiResid<true>, pg8::StaticOrder, true, true>(ldsl, g, S, E);
        SEAM(2);
    }
    if (IN(3)) {
        meta_win(P, gwm, NGW, lane);
        pg8::Gemm g{(const bf16*)(ws + WS_XB), (const bf16*)(ws + WS_WIN), MR, NINP, DM}; pg8::StaticOrder S; S.init(MR, NINP, G, bx);
        pg8::EpiZ E{(bf16*)(ws + WS_BIG), (const float*)(ws + WS_SSQ2), P.in[8], NIN, NIN, ZC_Q};
        pg8::gemm_phase<pg8::EpiZ, pg8::StaticOrder, true, true>(ldsl, g, S, E);
        SEAM(3);
    }
    if (IN(4)) {
#ifndef REP_PREP
#define REP_PREP 1
#endif
        for (int rep = 0; rep < REP_PREP; ++rep) for (int task = gw; task < NBATCH * NHEAD * NCHUNK; task += NGW) { const int bc = task >> 3; chunk_task(P, lds, wave * WL_SIZE, bc / NCHUNK, task & 7, bc % NCHUNK, lane); }
        SEAM(4);
    }
    if (IN(5)) {
#ifndef REP_SCAN
#define REP_SCAN 1
#endif
#ifndef REP_ATTN
#define REP_ATTN 1
#endif
        if (bx < 64) { for (int rep = 0; rep < REP_SCAN; ++rep) { scan_phase(P, lds, bx, tid, wave, lane, args.use_cg); __syncthreads(); } }
        else { for (int rep = 0; rep < REP_ATTN; ++rep) for (int u = bx - 64; u < NBATCH * 2 * 64; u += G - 64) attn_unit(P, lds, u >> 7, (u >> 6) & 1, u & 63, tid, wave, lane);
            __syncthreads();
            p0_transposes(P, ldsl, 1, (bx - 64) * NWAVES + wave, (G - 64) * NWAVES, wave, lane); }
        __syncthreads();
        SEAM(5);
    }
    if (IN(6)) {
        pg8::Gemm g{(const bf16*)(ws + WS_XB), (const bf16*)(ws + WS_WOUT), MR, DM, DM}; pg8::StaticOrder S; S.init(MR, DM, G, bx);
        pg8::EpiResid<true> E{P.out, P.out, (bf16*)(ws + WS_P), (float*)(ws + WS_SSQ3), 1.0f};
        pg8::gemm_phase<pg8::EpiResid<true>, pg8::StaticOrder, true, true>(ldsl, g, S, E);
        SEAM(6);
    }
    if (IN(7)) {
        pg8::Gemm g{(const bf16*)(ws + WS_P), (const bf16*)(ws + WS_WGU2), MR, NGU, DM}; pg8::StaticOrder S; S.init(MR, NGU, G, bx);
        pg8::EpiSwiglu E{(bf16*)(ws + WS_BIG), (const float*)(ws + WS_SSQ3), FF};
        pg8::gemm_phase<pg8::EpiSwiglu, pg8::StaticOrder, true, true>(ldsl, g, S, E);
        SEAM(7);
    }
    if (IN(8)) {
        pg8::Gemm g{(const bf16*)(ws + WS_BIG), (const bf16*)(ws + WS_WD2), MR, DM, FF}; pg8::StaticOrder S; S.init(MR, DM, G, bx);
        pg8::EpiResid<false> E{P.out, P.out, nullptr, (float*)(ws + WS_SSQ4), 0.5f};
        pg8::gemm_phase<pg8::EpiResid<false>, pg8::StaticOrder, true, true>(ldsl, g, S, E);
        SEAM(8);
    }
    if (IN(9)) final_norm(P, gw, NGW, lane);
#undef IN
#undef SEAM
}

extern "C" void kernel_launch(void* const* d_in, const int* in_sizes, int n_in, void* d_out, int out_size, void* d_ws, size_t ws_size, hipStream_t stream) {
    static int grid = 0;
    if (grid == 0) {
        if (n_in != 27 || in_sizes[0] != MR * DM || out_size != MR * DM || ws_size < WS_END) { fprintf(stderr, "kernel_launch: unexpected shapes (n_in %d, in0 %d, out %d, ws %zu)\n", n_in, n_in > 0 ? in_sizes[0] : -1, out_size, ws_size); grid = -1; return; }
        int dev = 0, cus = 0, per_cu = 0;
        if (hipGetDevice(&dev) != hipSuccess || hipDeviceGetAttribute(&cus, hipDeviceAttributeMultiprocessorCount, dev) != hipSuccess) { grid = -1; return; }
        if (hipFuncSetAttribute((const void*)hymba_fwd, hipFuncAttributeMaxDynamicSharedMemorySize, LDS_BYTES) != hipSuccess) { fprintf(stderr, "kernel_launch: hipFuncSetAttribute failed\n"); grid = -1; return; }
        if (hipOccupancyMaxActiveBlocksPerMultiprocessor(&per_cu, (const void*)hymba_fwd, NWAVES * 64, LDS_BYTES) != hipSuccess || per_cu < 1) fprintf(stderr, "kernel_launch: occupancy query says %d blocks per CU\n", per_cu);
        (void)hipGetLastError();
        grid = cus;
    }
    if (grid < 0) return;
    if (hipMemsetAsync((char*)d_ws + WS_CTL, 0, CTL_ZERO_BYTES, stream) != hipSuccess) { fprintf(stderr, "kernel_launch: memset failed\n"); return; }
    Args a{};
    for (int i = 0; i < 27; ++i) a.p.in[i] = (const float*)d_in[i];
    a.p.out = (float*)d_out; a.p.ws = (unsigned char*)d_ws; a.use_cg = 0; a.pad = 0;
#if MK_N_LAUNCHES == 1
    a.ph_lo = 0; a.ph_hi = N_PHASES;
    void* kargs[] = {&a};
    hipError_t e = hipLaunchCooperativeKernel((const void*)hymba_fwd, dim3(grid), dim3(NWAVES * 64), kargs, LDS_BYTES, stream);
    if (e != hipSuccess) fprintf(stderr, "kernel_launch: cooperative launch failed: %s (grid %d)\n", hipGetErrorString(e), grid);
#else
    for (int li = 0; li < N_PHASES; ++li) { a.ph_lo = li; a.ph_hi = li + 1;
        hipLaunchKernelGGL(hymba_fwd, dim3(grid), dim3(NWAVES * 64), LDS_BYTES, stream, a);
        const hipError_t le = hipPeekAtLastError(); if (le != hipSuccess) { fprintf(stderr, "kernel_launch: launch %d failed: %s\n", li, hipGetErrorName(le)); break; } }
#endif
}
```

```cpp
#include <hip/hip_runtime.h>
#include <cstdio>
#include <cstdint>
namespace pg8 {
#define PG8_LAS __attribute__((address_space(3)))
typedef unsigned short bf16_t;
typedef short bf16x8 __attribute__((ext_vector_type(8)));
typedef float f32x4 __attribute__((ext_vector_type(4)));
typedef unsigned u32x4 __attribute__((ext_vector_type(4)));
constexpr int BM = 256, BK = 64, HALF = 128, HTB = HALF * BK * 2  , STAGE_BYTES = 8 * HTB, NXCD = 8, WGM = 8;

__host__ __device__ __forceinline__ int lds_byte(int r, int c) { const int st = (r >> 4) * 2 + (c >> 5), rr = r & 15, cc = c & 31, ob = rr * 64 + cc * 2; return st * 1024 + (ob ^ (((ob >> 9) & 1) << 5)); }
__host__ __device__ __forceinline__ void stage_rc(int b, int& R, int& C) { const int st = b / 1024, sb = b % 1024, swz = sb ^ (((sb >> 9) & 1) << 5); R = (st >> 1) * 16 + swz / 64; C = (st & 1) * 32 + (swz % 64) / 2; }
__host__ __device__ __forceinline__ int perm32(int rho) { const int n = rho >> 4, i = rho & 15; return 8 * (i >> 2) + 4 * n + (i & 3); }

struct Unit { int pm, pn; };
struct Gemm { const bf16_t* A; const bf16_t* Bt; int M, N, K; };

struct StaticOrder {
    int nM, nN, nwg, G, c;
    __host__ __device__ void init(int M, int N, int G_, int c_) { nM = M / BM; nN = N / BM; nwg = nM * nN; G = G_; c = c_; }
    __host__ __device__ bool next(int i, Unit& u) const {
        const long L = (long)i * G + c; if (L >= nwg) return false;
        int wgid = (int)L; { const int q = nwg / NXCD, r = nwg % NXCD, xcd = wgid % NXCD, off = wgid / NXCD; wgid = (xcd < r ? xcd * (q + 1) : r * (q + 1) + (xcd - r) * q) + off; }
        const int nig = WGM * nN, gid = wgid / nig, fm = gid * WGM, gsz = (nM - fm) < WGM ? (nM - fm) : WGM;
        u.pm = fm + ((wgid % nig) % gsz); u.pn = (wgid % nig) / gsz; return true;
    }
    __device__ __forceinline__ void a_ready(const Unit&) const {}
    __device__ __forceinline__ void done(const Unit&) const {}
};

__device__ __forceinline__ unsigned cvt_pk_bf16(float lo, float hi) { unsigned r; asm volatile("v_cvt_pk_bf16_f32 %0, %1, %2" : "=v"(r) : "v"(lo), "v"(hi)); return r; }
typedef float f32x2 __attribute__((ext_vector_type(2)));
typedef unsigned u32x2 __attribute__((ext_vector_type(2)));
__device__ __forceinline__ float rstd_from16(const float* ssq, int row) {
    const f32x4* p = (const f32x4*)(ssq + (size_t)row * 16);
    const f32x4 a = p[0], b = p[1], c = p[2], d = p[3];
    const float s = ((a[0] + a[1]) + (a[2] + a[3])) + ((b[0] + b[1]) + (b[2] + b[3])) + ((c[0] + c[1]) + (c[2] + c[3])) + ((d[0] + d[1]) + (d[2] + d[3]));
    return __builtin_amdgcn_rsqf(s * (1.0f / 1024.0f) + 1e-5f);
}
__device__ __forceinline__ float silu_mul(float g, float u) { return g * __builtin_amdgcn_rcpf(1.0f + __builtin_amdgcn_exp2f(-1.4426950408889634f * g)) * u; }
struct EpiSwiglu {
    static constexpr bool PERM = true, AFTER_DRAIN = false;
    bf16_t* U; const float* ssq; int ldu;
    __device__ __forceinline__ void operator()(const f32x4 (&acc)[2][2][4][2], const Unit& u, int wr, int wc, int fr, int fq) const {
        const int row0 = u.pm * BM + wr * 64 + fr, col0 = u.pn * HALF + wc * 32 + 8 * fq;
#pragma unroll
        for (int ai = 0; ai < 2; ++ai)
#pragma unroll
            for (int m = 0; m < 4; ++m) { const int row = row0 + ai * HALF + m * 16; const float rs = rstd_from16(ssq, row);
                const f32x4 g0 = acc[ai][0][m][0] * rs, g1 = acc[ai][0][m][1] * rs, u0 = acc[ai][1][m][0] * rs, u1 = acc[ai][1][m][1] * rs;
                u32x4 w; w.x = cvt_pk_bf16(silu_mul(g0[0], u0[0]), silu_mul(g0[1], u0[1])); w.y = cvt_pk_bf16(silu_mul(g0[2], u0[2]), silu_mul(g0[3], u0[3]));
                w.z = cvt_pk_bf16(silu_mul(g1[0], u1[0]), silu_mul(g1[1], u1[1])); w.w = cvt_pk_bf16(silu_mul(g1[2], u1[2]), silu_mul(g1[3], u1[3]));
                *(u32x4*)(U + (size_t)row * ldu + col0) = w; }
    }
};
struct EpiZ {
    static constexpr bool PERM = true, AFTER_DRAIN = false;
    bf16_t* Z; const float* ssq; const float* bias; int ldz, ncols, bias_from;
    __device__ __forceinline__ void operator()(const f32x4 (&acc)[2][2][4][2], const Unit& u, int wr, int wc, int fr, int fq) const {
        const int row0 = u.pm * BM + wr * 64 + fr, col0 = u.pn * BM + wc * 32 + 8 * fq;
        f32x4 bv[2][2];
#pragma unroll
        for (int bj = 0; bj < 2; ++bj)
#pragma unroll
            for (int n = 0; n < 2; ++n) { const int c = col0 + bj * HALF + 4 * n; bv[bj][n] = (c >= bias_from && c < ncols) ? *(const f32x4*)(bias + (c - bias_from)) : (f32x4){0.f, 0.f, 0.f, 0.f}; }
#pragma unroll
        for (int ai = 0; ai < 2; ++ai)
#pragma unroll
            for (int m = 0; m < 4; ++m) { const int row = row0 + ai * HALF + m * 16; const float rs = rstd_from16(ssq, row);
#pragma unroll
                for (int bj = 0; bj < 2; ++bj) { const int c = col0 + bj * HALF; if (c < ncols) {
                    const f32x4 v0 = acc[ai][bj][m][0] * rs + bv[bj][0], v1 = acc[ai][bj][m][1] * rs + bv[bj][1];
                    u32x4 w; w.x = cvt_pk_bf16(v0[0], v0[1]); w.y = cvt_pk_bf16(v0[2], v0[3]); w.z = cvt_pk_bf16(v1[0], v1[1]); w.w = cvt_pk_bf16(v1[2], v1[3]);
                    *(u32x4*)(Z + (size_t)row * ldz + c) = w; } } }
    }
};
template <bool WB> struct EpiResid {
    static constexpr bool PERM = false, AFTER_DRAIN = false;
    const float* base; float* out; bf16_t* outb; float* ssq; float scale;
    __device__ __forceinline__ void operator()(const f32x4 (&acc)[2][2][4][2], const Unit& u, int wr, int wc, int fr, int fq) const {
        const int row0 = u.pm * BM + wr * 64 + fr, col0 = u.pn * BM + wc * 32 + 4 * fq;
#pragma unroll
        for (int ai = 0; ai < 2; ++ai)
#pragma unroll
            for (int m = 0; m < 4; ++m) { const int row = row0 + ai * HALF + m * 16; const size_t off = (size_t)row * 1024 + col0; float ss = 0.f;
#pragma unroll
                for (int bj = 0; bj < 2; ++bj)
#pragma unroll
                    for (int n = 0; n < 2; ++n) { const size_t o2 = off + bj * HALF + n * 16; const f32x4 bs = *(const f32x4*)(base + o2); const f32x4 o = bs + acc[ai][bj][m][n] * scale;
                        *(f32x4*)(out + o2) = o; ss += (o[0] * o[0] + o[1] * o[1]) + (o[2] * o[2] + o[3] * o[3]);
                        if (WB) { u32x2 w; w.x = cvt_pk_bf16(o[0], o[1]); w.y = cvt_pk_bf16(o[2], o[3]); *(u32x2*)(outb + o2) = w; } }
                ss += __shfl_xor(ss, 16); ss += __shfl_xor(ss, 32);
                if (fq == 0) ssq[(size_t)row * 16 + u.pn * 4 + wc] = ss; }
    }
};
template <class Epi, class Sched, bool ALIGN_EPI = false, bool SP2 = false>
__device__ __forceinline__ void gemm_phase(PG8_LAS unsigned char* lds, const Gemm g, const Sched& S, const Epi& E) {
    const int tid = threadIdx.x, wid = __builtin_amdgcn_readfirstlane(tid >> 6), lane = tid & 63, wr = wid >> 2, wc = wid & 3, fr = lane & 15, fq = lane >> 4;
    const int K = g.K, nt = K / BK;
    unsigned voffA[2], voffB[2];
#pragma unroll
    for (int i = 0; i < 2; ++i) { int R, C; stage_rc(tid * 16 + i * 8192, R, C); const int Rb = Epi::PERM ? ((R & ~31) + perm32(R & 31)) : R;
        voffA[i] = (unsigned)(R * K + C) * 2u; voffB[i] = (unsigned)(Rb * K + C) * 2u; }
    const size_t kstep = (size_t)(BK * 2);
    const size_t hstep = (size_t)HALF * K * 2;
    const size_t tstep = 2 * hstep;
    const unsigned ldsw = (unsigned)wid * 1024u;
    const int aoff = lds_byte(wr * 64 + fr, fq * 8), boff = lds_byte(wc * 32 + fr, fq * 8);
#define PG8_SA(b, h) (((b) * 2 + (h)) * HTB)
#define PG8_SB(b, h) ((4 + (b) * 2 + (h)) * HTB)
#define PG8_STAGE(bufoff, gbase, voff) do { _Pragma("unroll") for (int _i = 0; _i < 2; ++_i) \
        __builtin_amdgcn_global_load_lds((const unsigned*)((const char*)(gbase) + (voff)[_i]), (PG8_LAS unsigned*)(lds + (bufoff) + ldsw + _i * 8192), 16, 0, 0); } while (0)
#define PG8_LDA(dst, b, h) do { _Pragma("unroll") for (int m = 0; m < 4; ++m) _Pragma("unroll") for (int k = 0; k < 2; ++k) dst[m][k] = *(const PG8_LAS bf16x8*)(lds + PG8_SA(b, h) + aoff + m * 2048 + k * 1024); } while (0)
#define PG8_LDB(dst, b, h) do { _Pragma("unroll") for (int n = 0; n < 2; ++n) _Pragma("unroll") for (int k = 0; k < 2; ++k) dst[n][k] = *(const PG8_LAS bf16x8*)(lds + PG8_SB(b, h) + boff + n * 2048 + k * 1024); } while (0)
#define PG8_MMA(ai, bj, At, Bt) do { __builtin_amdgcn_s_setprio(1); _Pragma("unroll") for (int m = 0; m < 4; ++m) _Pragma("unroll") for (int n = 0; n < 2; ++n) _Pragma("unroll") for (int k = 0; k < 2; ++k) \
        acc[ai][bj][m][n] = __builtin_amdgcn_mfma_f32_16x16x32_bf16(Bt[n][k], At[m][k], acc[ai][bj][m][n], 0, 0, 0); __builtin_amdgcn_s_setprio(0); } while (0)
#define PG8_WAIT_V(n) asm volatile("s_waitcnt vmcnt(" #n ")" ::: "memory")
#define PG8_WAIT_L(n) asm volatile("s_waitcnt lgkmcnt(" #n ")" ::: "memory")
#define PG8_BAR __builtin_amdgcn_s_barrier()
#define PG8_SCHED __builtin_amdgcn_sched_barrier(0)
    Unit cur, nxt; int ui = 0;
    if (!S.next(0, cur)) return;
    f32x4 acc[2][2][4][2];
#pragma unroll
    for (int a = 0; a < 2; ++a)
#pragma unroll
        for (int b = 0; b < 2; ++b)
#pragma unroll
            for (int m = 0; m < 4; ++m)
#pragma unroll
                for (int n = 0; n < 2; ++n) acc[a][b][m][n] = (f32x4){0.f, 0.f, 0.f, 0.f};
    bf16x8 At[4][2], B0[2][2], B1[2][2];
    const char* cA = (const char*)g.A + (size_t)cur.pm * tstep; const char* cB = (const char*)g.Bt + (size_t)cur.pn * tstep;
    S.a_ready(cur);
    if constexpr (SP2) {
        PG8_STAGE(PG8_SB(0, 0), cB, voffB); PG8_STAGE(PG8_SB(0, 1), cB + hstep, voffB); PG8_STAGE(PG8_SA(0, 0), cA, voffA); PG8_STAGE(PG8_SA(0, 1), cA + hstep, voffA);
        if (wr == 1) PG8_BAR;
        PG8_WAIT_V(2); PG8_BAR;
        PG8_STAGE(PG8_SB(1, 0), cB + kstep, voffB); PG8_STAGE(PG8_SA(1, 0), cA + kstep, voffA); PG8_STAGE(PG8_SB(1, 1), cB + hstep + kstep, voffB);
        PG8_WAIT_V(6); PG8_BAR;
    } else {
        PG8_STAGE(PG8_SB(0, 0), cB, voffB); PG8_STAGE(PG8_SA(0, 0), cA, voffA); PG8_STAGE(PG8_SB(0, 1), cB + hstep, voffB); PG8_STAGE(PG8_SA(0, 1), cA + hstep, voffA);
        if (wr == 1) PG8_BAR;
        PG8_WAIT_V(4); PG8_BAR;
        PG8_STAGE(PG8_SB(1, 0), cB + kstep, voffB); PG8_STAGE(PG8_SA(1, 0), cA + kstep, voffA); PG8_STAGE(PG8_SB(1, 1), cB + hstep + kstep, voffB);
        PG8_WAIT_V(6); PG8_BAR;
    }
    for (;;) {
        const bool has_next = S.next(ui + 1, nxt);
        const char* nA = has_next ? (const char*)g.A + (size_t)nxt.pm * tstep : cA; const char* nB = has_next ? (const char*)g.Bt + (size_t)nxt.pn * tstep : cB;
        for (int t = 0; t < nt; t += 2) {
            const bool last = (t == nt - 2);
            const char* a1 = cA + (size_t)(t + 1) * kstep;
            const char* a2 = last ? nA : cA + (size_t)(t + 2) * kstep; const char* b2 = last ? nB : cB + (size_t)(t + 2) * kstep;
            const char* a3 = a2 + kstep; const char* b3 = b2 + kstep;
            if (last && has_next) S.a_ready(nxt);
            if constexpr (SP2) {
            PG8_LDB(B0, 0, 0); PG8_LDB(B1, 0, 1); PG8_SCHED; PG8_LDA(At, 0, 0); PG8_STAGE(PG8_SA(1, 1), a1 + hstep, voffA);
            PG8_WAIT_V(8); PG8_WAIT_L(0); PG8_BAR; PG8_MMA(0, 0, At, B0); PG8_MMA(0, 1, At, B1); PG8_BAR; PG8_SCHED;
            PG8_LDA(At, 0, 1); PG8_STAGE(PG8_SB(0, 0), b2, voffB); PG8_STAGE(PG8_SB(0, 1), b2 + hstep, voffB); PG8_STAGE(PG8_SA(0, 0), a2, voffA);
            PG8_WAIT_V(8); PG8_WAIT_L(0); PG8_BAR; PG8_MMA(1, 0, At, B0); PG8_MMA(1, 1, At, B1); PG8_BAR; PG8_SCHED;
            PG8_LDB(B0, 1, 0); PG8_LDB(B1, 1, 1); PG8_SCHED; PG8_LDA(At, 1, 0); PG8_STAGE(PG8_SA(0, 1), a2 + hstep, voffA);
            PG8_WAIT_V(8); PG8_WAIT_L(0); PG8_BAR; PG8_MMA(0, 0, At, B0); PG8_MMA(0, 1, At, B1); PG8_BAR; PG8_SCHED;
            PG8_LDA(At, 1, 1); PG8_STAGE(PG8_SB(1, 0), b3, voffB); PG8_STAGE(PG8_SB(1, 1), b3 + hstep, voffB); PG8_STAGE(PG8_SA(1, 0), a3, voffA);
            PG8_WAIT_V(8); PG8_WAIT_L(0); PG8_BAR; PG8_MMA(1, 0, At, B0); PG8_MMA(1, 1, At, B1); PG8_BAR; PG8_SCHED;
            } else {
            PG8_LDB(B0, 0, 0); PG8_SCHED; PG8_LDA(At, 0, 0); PG8_STAGE(PG8_SA(1, 1), a1 + hstep, voffA);
            PG8_WAIT_L(8); PG8_BAR; PG8_WAIT_L(0); PG8_MMA(0, 0, At, B0); PG8_BAR; PG8_SCHED;
            PG8_LDB(B1, 0, 1); PG8_STAGE(PG8_SB(0, 0), b2, voffB);
            PG8_BAR; PG8_WAIT_L(0); PG8_MMA(0, 1, At, B1); PG8_BAR;
            PG8_LDA(At, 0, 1); PG8_STAGE(PG8_SA(0, 0), a2, voffA);
            PG8_BAR; PG8_WAIT_L(0); PG8_MMA(1, 0, At, B0); PG8_BAR; PG8_SCHED;
            PG8_STAGE(PG8_SB(0, 1), b2 + hstep, voffB);
            PG8_WAIT_V(6); PG8_BAR; PG8_MMA(1, 1, At, B1); PG8_BAR;
            PG8_LDB(B0, 1, 0); PG8_SCHED; PG8_LDA(At, 1, 0); PG8_STAGE(PG8_SA(0, 1), a2 + hstep, voffA);
            PG8_WAIT_L(8); PG8_BAR; PG8_WAIT_L(0); PG8_MMA(0, 0, At, B0); PG8_BAR; PG8_SCHED;
            PG8_LDB(B1, 1, 1); PG8_STAGE(PG8_SB(1, 0), b3, voffB);
            PG8_BAR; PG8_WAIT_L(0); PG8_MMA(0, 1, At, B1); PG8_BAR;
            PG8_LDA(At, 1, 1); PG8_STAGE(PG8_SA(1, 0), a3, voffA);
            PG8_BAR; PG8_WAIT_L(0); PG8_MMA(1, 0, At, B0); PG8_BAR; PG8_SCHED;
            PG8_STAGE(PG8_SB(1, 1), b3 + hstep, voffB);
            PG8_WAIT_V(6); PG8_BAR; PG8_MMA(1, 1, At, B1); PG8_BAR;
            }
        }
        if constexpr (ALIGN_EPI) { if (wr == 0) PG8_BAR; }
        if constexpr (!Epi::AFTER_DRAIN) { E(acc, cur, wr, wc, fr, fq); S.done(cur); }
        if (!has_next) break;
#pragma unroll
        for (int a = 0; a < 2; ++a)
#pragma unroll
            for (int b = 0; b < 2; ++b)
#pragma unroll
                for (int m = 0; m < 4; ++m)
#pragma unroll
                    for (int n = 0; n < 2; ++n) acc[a][b][m][n] = (f32x4){0.f, 0.f, 0.f, 0.f};
        cur = nxt; cA = nA; cB = nB; ++ui;
        if constexpr (ALIGN_EPI) { if (wr == 1) PG8_BAR; }
    }
    PG8_WAIT_V(0);
    if constexpr (!ALIGN_EPI) { if (wr == 0) PG8_BAR; }
    PG8_BAR;
    if constexpr (Epi::AFTER_DRAIN) { E.fused(acc, cur, wr, wc, fr, fq, lds, wid, lane); S.done(cur); }
#undef PG8_SA
#undef PG8_SB
#undef PG8_STAGE
#undef PG8_LDA
#undef PG8_LDB
#undef PG8_MMA
#undef PG8_WAIT_V
#undef PG8_WAIT_L
#undef PG8_BAR
#undef PG8_SCHED
}
}
#include <hip/hip_cooperative_groups.h>
namespace cg = cooperative_groups;
constexpr int NWAVES = 8;
constexpr int MR = 32768, DM = 1024, FF = 2816, NGU = 5632, NIN = 2464, NINP = 2560, TSEQ = 4096, NBATCH = 8, NHEAD = 8, NMETA = 16;
constexpr int ZC_W = 1536, ZC_Q = 1696, ZC_K = 2208, ZC_V = 2336;
constexpr int PV = 320;
constexpr size_t MiB = 1u << 20;
constexpr size_t WS_CTL = 0, CTL_ZERO_BYTES = 1 * MiB;
constexpr size_t WS_WGU1 = 2 * MiB, WS_WD1 = 13 * MiB, WS_WIN = 19 * MiB, WS_WOUT = 24 * MiB, WS_WGU2 = 26 * MiB, WS_WD2 = 37 * MiB, WS_LT = 43 * MiB;
constexpr size_t WS_SSQ1 = 44 * MiB, WS_SSQ2 = 46 * MiB, WS_SSQ3 = 48 * MiB, WS_SSQ4 = 50 * MiB, WS_META = 52 * MiB;
constexpr size_t MO_XMB = 0, MO_UM = 64 * 1024, MO_H1MB = 256 * 1024, MO_SSQM1 = 320 * 1024, MO_SSQM2 = 324 * 1024, MO_ZM = 384 * 1024, MO_PM = 512 * 1024;
constexpr size_t WS_XB = 56 * MiB, WS_BIG = 120 * MiB, WS_IMG = 274 * MiB, WS_P = 296 * MiB, WS_END = 507 * MiB;
constexpr int CW_BAR = 4096;
constexpr int RING_BYTES = 131072, LDSCTL_OFF = 143360, MISC_OFF = LDSCTL_OFF + 320, LDS_BYTES = 147456;

#define GAS __attribute__((address_space(1)))
#define LAS __attribute__((address_space(3)))
typedef unsigned short bf16;
typedef unsigned v4u __attribute__((ext_vector_type(4)));
typedef unsigned v2u __attribute__((ext_vector_type(2)));
typedef float f32x4 __attribute__((ext_vector_type(4)));
typedef float f32x2 __attribute__((ext_vector_type(2)));
typedef short bf16x8 __attribute__((ext_vector_type(8)));
typedef short bf16x4 __attribute__((ext_vector_type(4)));
typedef GAS unsigned gu32;
#define LDS_WAIT() asm volatile("s_waitcnt lgkmcnt(0)" ::: "memory")
__device__ __forceinline__ unsigned f2bf(float f) { unsigned u = __builtin_bit_cast(unsigned, f); return (u + 0x7fffu + ((u >> 16) & 1u)) >> 16; }
typedef __bf16 bf16x2_t __attribute__((ext_vector_type(2)));
__device__ __forceinline__ unsigned pk2m(float lo, float hi) { f32x2 v = {lo, hi}; bf16x2_t b = __builtin_convertvector(v, bf16x2_t); return __builtin_bit_cast(unsigned, b); }
__device__ __forceinline__ unsigned pk2(float lo, float hi) { return pg8::cvt_pk_bf16(lo, hi); }
__device__ __forceinline__ float bflo(unsigned w) { return __builtin_bit_cast(float, w << 16); }
__device__ __forceinline__ float bfhi(unsigned w) { return __builtin_bit_cast(float, w & 0xffff0000u); }
__device__ __forceinline__ f32x4 unpack4(v2u w) { return (f32x4){bflo(w.x), bfhi(w.x), bflo(w.y), bfhi(w.y)}; }
__device__ __forceinline__ float sigmoidf_(float x) { return __builtin_amdgcn_rcpf(1.0f + __builtin_amdgcn_exp2f(-1.4426950408889634f * x)); }
__device__ __forceinline__ float tanhf_(float x) { return 2.0f * sigmoidf_(2.0f * x) - 1.0f; }
#define XB_TMO      128
#define XB_XCNT(j)  (256  + 64 * (j))
#define XB_XSUB(j)  (1280 + 64 * (j))
#define XB_XGEN(j)  (2304 + 64 * (j))
#define XB_TOP      3328
#define XB_TOPGEN   3392
#define XCD_BAR_WORDS 3456
#define XB_SPIN_CAP (1u << 18)

__device__ __forceinline__ unsigned xb_ld(unsigned* p)              { return __hip_atomic_load(p, __ATOMIC_RELAXED, __HIP_MEMORY_SCOPE_AGENT); }
__device__ __forceinline__ unsigned xb_add(unsigned* p, unsigned v) { return __hip_atomic_fetch_add(p, v, __ATOMIC_RELAXED, __HIP_MEMORY_SCOPE_AGENT); }
__device__ __forceinline__ unsigned xb_xcc_id() { return (unsigned)__builtin_amdgcn_s_getreg((3 << 11) | 20) & 0xFu; }
#define XB_SPIN(cond, bar) do { unsigned _sp = 0; while (cond) { __builtin_amdgcn_s_sleep(1); \
    if ((++_sp & 255u) == 0u) { if (xb_ld(&(bar)[XB_TMO])) break; if (_sp > XB_SPIN_CAP) { atomicAdd(&(bar)[XB_TMO], 1u); break; } } } } while (0)

struct XcdBarrier {
    unsigned* bar; unsigned x;
    volatile LAS unsigned* st;
};

__device__ __forceinline__ XcdBarrier xcd_barrier_post(unsigned* bar, volatile LAS unsigned* st) {
    XcdBarrier b; b.bar = bar; b.x = xb_xcc_id(); b.st = st;
    if (threadIdx.x == 0) (void)xb_add(&bar[XB_XCNT(b.x)], 1u);
    return b;
}
__device__ __forceinline__ void xcd_barrier_complete(unsigned* bar, unsigned x, unsigned& nloc, unsigned& nx) {
    const unsigned G = gridDim.x * gridDim.y * gridDim.z;
    unsigned sum, cnt, mine, sp = 0u;
    for (;;) {
        sum = 0u; cnt = 0u; mine = 0u;
#pragma unroll
        for (unsigned j = 0; j < 16; ++j) { const unsigned c = xb_ld(&bar[XB_XCNT(j)]); sum += c; cnt += (c > 0u) ? 1u : 0u; mine = (j == x) ? c : mine; }
        if (sum == G) break;
        __builtin_amdgcn_s_sleep(1);
        if ((++sp & 255u) == 0u) { if (xb_ld(&bar[XB_TMO])) break; if (sp > XB_SPIN_CAP) { atomicAdd(&bar[XB_TMO], 1u); break; } }
    }
    nloc = mine > 0u ? mine : 1u; nx = cnt > 0u ? cnt : 1u;
}

__device__ __forceinline__ void xcd_barrier(const XcdBarrier& b) {
    asm volatile("s_waitcnt vmcnt(0)" ::: "memory");
    __syncthreads();
    if (threadIdx.x == 0) {
        unsigned* bar = b.bar;
        __builtin_amdgcn_s_waitcnt(0);
        unsigned nloc = b.st[0], nx = b.st[1];
        if (nloc == 0u) { xcd_barrier_complete(bar, b.x, nloc, nx); b.st[0] = nloc; b.st[1] = nx; }
        const unsigned old = xb_add(&bar[XB_XSUB(b.x)], 1u);
        const unsigned gen = old / nloc;
        if (old + 1u == (gen + 1u) * nloc) {
            __builtin_amdgcn_fence(__ATOMIC_RELEASE, "agent");
            asm volatile("s_waitcnt vmcnt(0)" ::: "memory");
            const unsigned og = xb_add(&bar[XB_TOP], 1u);
            const unsigned tg = og / nx;
            if (og + 1u == (tg + 1u) * nx) xb_add(&bar[XB_TOPGEN], 1u);
            else XB_SPIN(xb_ld(&bar[XB_TOPGEN]) == tg, bar);
            __builtin_amdgcn_fence(__ATOMIC_ACQUIRE, "agent");
            xb_add(&bar[XB_XGEN(b.x)], 1u);
            asm volatile("s_waitcnt vmcnt(0)" ::: "memory");
        } else {
            XB_SPIN(xb_ld(&bar[XB_XGEN(b.x)]) == gen, bar);
            __builtin_amdgcn_fence(__ATOMIC_ACQUIRE, "agent");
            asm volatile("s_waitcnt vmcnt(0)" ::: "memory");
        }
    }
    __syncthreads();
}
__device__ __forceinline__ float wave_sum(float v) {
#pragma unroll
    for (int o = 1; o < 64; o <<= 1) v += __shfl_xor(v, o);
    return v;
}
__device__ __forceinline__ void p0_transpose_item(const float* W, int K, int N, bf16* WT, const float* gain, int k0, int n0, int drow0, LAS float* scr, int lane) {
#pragma unroll
    for (int i = 0; i < 32; ++i) { const int kk = 2 * i + (lane >> 5); float w = W[(size_t)(k0 + kk) * N + n0 + (lane & 31)]; if (gain) w *= gain[k0 + kk]; scr[kk * 33 + (lane & 31)] = w; }
    LDS_WAIT(); asm volatile("" ::: "memory");
    const int c = lane & 7;
#pragma unroll
    for (int j = 0; j < 4; ++j) { const int n = (lane >> 3) + 8 * j; const LAS float* s = scr + (8 * c) * 33 + n;
        v4u o; o.x = pk2(s[0 * 33], s[1 * 33]); o.y = pk2(s[2 * 33], s[3 * 33]); o.z = pk2(s[4 * 33], s[5 * 33]); o.w = pk2(s[6 * 33], s[7 * 33]);
        *(GAS v4u*)(WT + (size_t)(drow0 + n) * K + k0 + 8 * c) = o; }
    LDS_WAIT(); asm volatile("" ::: "memory");
}
__device__ __forceinline__ void rows4_to_bf16(const float* const (&xrow)[4], bf16* const (&orow)[4], float* const (&ssq16)[4], int lane) {
    f32x4 v[4][4]; float s[4];
#pragma unroll
    for (int r = 0; r < 4; ++r) { const GAS f32x4* xr = (const GAS f32x4*)xrow[r] + lane;
#pragma unroll
        for (int j = 0; j < 4; ++j) v[r][j] = xr[64 * j]; }
#pragma unroll
    for (int r = 0; r < 4; ++r) { float a = 0.f;
#pragma unroll
        for (int j = 0; j < 4; ++j) a += (v[r][j].x * v[r][j].x + v[r][j].y * v[r][j].y) + (v[r][j].z * v[r][j].z + v[r][j].w * v[r][j].w);
        s[r] = a; }
#pragma unroll
    for (int o = 1; o < 64; o <<= 1) {
#pragma unroll
        for (int r = 0; r < 4; ++r) s[r] += __shfl_xor(s[r], o); }
#pragma unroll
    for (int r = 0; r < 4; ++r) { GAS v2u* o8 = (GAS v2u*)orow[r] + lane;
#pragma unroll
        for (int j = 0; j < 4; ++j) { v2u w; w.x = pk2(v[r][j].x, v[r][j].y); w.y = pk2(v[r][j].z, v[r][j].w); o8[64 * j] = w; }
        if (lane < 16) ssq16[r][lane] = (lane == 0) ? s[r] : 0.f; }
}
struct Ptrs {
    const float* in[27]; float* out; unsigned char* ws;
};
__device__ __forceinline__ void p0_transposes(const Ptrs& P, LAS unsigned char* lds, int part, int gw, int NGW, int wave, int lane) {
    unsigned char* ws = P.ws; LAS float* scr = (LAS float*)(lds + wave * 16384);
    constexpr int I_G = (DM / 64) * (FF / 32), I_D = (FF / 64) * (DM / 32), I_IN = (DM / 64) * (NIN / 32), I_O = (DM / 64) * (DM / 32);
    const int nitems = 2 * I_G + I_D + (part ? I_O : I_IN);
    for (int it = gw; it < nitems; it += NGW) {
        int r = it;
        if (r < 2 * I_G) { const int isup = r / I_G; r -= isup * I_G; const int nblk = FF / 32, kb = r / nblk, nb = r % nblk, n0 = 32 * nb;
            const float* W = P.in[part ? (isup ? 24 : 23) : (isup ? 4 : 3)]; const float* gain = P.in[part ? 22 : 2];
            bf16* WT = (bf16*)(ws + (part ? WS_WGU2 : WS_WGU1));
            const int drow0 = 256 * (n0 / 128) + 128 * isup + (n0 % 128);
            p0_transpose_item(W, DM, FF, WT, gain, 64 * kb, n0, drow0, scr, lane); continue; }
        r -= 2 * I_G;
        if (r < I_D) { const int nblk = DM / 32, kb = r / nblk, nb = r % nblk;
            p0_transpose_item(P.in[part ? 25 : 5], FF, DM, (bf16*)(ws + (part ? WS_WD2 : WS_WD1)), nullptr, 64 * kb, 32 * nb, 32 * nb, scr, lane); continue; }
        r -= I_D;
        if (!part) { const int nblk = NIN / 32, kb = r / nblk, nb = r % nblk;
            p0_transpose_item(P.in[7], DM, NIN, (bf16*)(ws + WS_WIN), P.in[6], 64 * kb, 32 * nb, 32 * nb, scr, lane); }
        else { const int nblk = DM / 32, kb = r / nblk, nb = r % nblk;
            p0_transpose_item(P.in[21], DM, DM, (bf16*)(ws + WS_WOUT), nullptr, 64 * kb, 32 * nb, 32 * nb, scr, lane); }
    }
}
__device__ __forceinline__ void p0_prologue(const Ptrs& P, LAS unsigned char* lds, int vcu, int G, int wave, int lane) {
    const int gw = vcu * NWAVES + wave, NGW = G * NWAVES;
    unsigned char* ws = P.ws;
    p0_transposes(P, lds, 0, gw, NGW, wave, lane);
    { GAS v4u* z = (GAS v4u*)(ws + WS_WIN + (size_t)NIN * DM * 2); const int n16 = (NINP - NIN) * DM * 2 / 16;
      for (int i = gw * 64 + lane; i < n16; i += NGW * 64) z[i] = (v4u){0u, 0u, 0u, 0u}; }
    { bf16* LT = (bf16*)(ws + WS_LT);
      for (int i = gw * 64 + lane; i < 512 * 160; i += NGW * 64) { const int n = i / 160, j = i % 160;
          const float v = j < 32 ? P.in[11][j * 512 + n] : j < 64 ? P.in[13][(j - 32) * 512 + n] : P.in[14][(j - 64) * 512 + n];
          LT[i] = (bf16)f2bf(v); } }
#ifndef REP_ROWS
#define REP_ROWS 1
#endif
    for (int rep_ = 0; rep_ < REP_ROWS; ++rep_)
    for (int m4 = gw; m4 < (MR + NMETA) / 4; m4 += NGW) { const float* xr[4]; bf16* orow[4]; float* sq[4];
#pragma unroll
        for (int r = 0; r < 4; ++r) { const int m = 4 * m4 + r;
            if (m < MR) { xr[r] = P.in[0] + (size_t)m * DM; orow[r] = (bf16*)(ws + WS_XB) + (size_t)m * DM; sq[r] = (float*)(ws + WS_SSQ1) + (size_t)m * 16; }
            else { const int i = m - MR; xr[r] = P.in[1] + (size_t)i * DM; orow[r] = (bf16*)(ws + WS_META + MO_XMB) + (size_t)i * DM; sq[r] = (float*)(ws + WS_META + MO_SSQM1) + i * 16; } }
        rows4_to_bf16(xr, orow, sq, lane); }
}
__device__ __forceinline__ f32x4 skinny16(const bf16* A, const bf16* Bt, int K, int n0, int lane) {
    const int fr = lane & 15, fq = lane >> 4;
    const bf16* ap = A + (size_t)fr * K + 8 * fq; const bf16* bp = Bt + (size_t)(n0 + fr) * K + 8 * fq;
    f32x4 acc = (f32x4){0.f, 0.f, 0.f, 0.f};
    for (int k = 0; k < K; k += 256) {
        bf16x8 a[8], b[8];
#pragma unroll
        for (int j = 0; j < 8; ++j) { a[j] = *(const bf16x8*)(ap + k + 32 * j); b[j] = *(const bf16x8*)(bp + k + 32 * j); }
#pragma unroll
        for (int j = 0; j < 8; ++j) acc = __builtin_amdgcn_mfma_f32_16x16x32_bf16(a[j], b[j], acc, 0, 0, 0); }
    return acc;
}
__device__ __forceinline__ float rstd_m16(const float* ssq16) { float s = 0.f;
#pragma unroll
    for (int i = 0; i < 16; ++i) s += ssq16[i];
    return __builtin_amdgcn_rsqf(s * (1.0f / 1024.0f) + 1e-5f); }
__device__ __forceinline__ void meta_up(unsigned char* ws, int gw, int NGW, int lane) {
    const bf16* A = (const bf16*)(ws + WS_META + MO_XMB); const bf16* Bt = (const bf16*)(ws + WS_WGU1); bf16* Um = (bf16*)(ws + WS_META + MO_UM);
    const float* ssq = (const float*)(ws + WS_META + MO_SSQM1); const int fr = lane & 15, fq = lane >> 4;
    for (int t = gw; t < FF / 16; t += NGW) { const int c0 = 16 * t, nr = 256 * (c0 / 128) + (c0 % 128);
        const f32x4 g = skinny16(A, Bt, DM, nr, lane), u = skinny16(A, Bt, DM, nr + 128, lane);
#pragma unroll
        for (int r = 0; r < 4; ++r) { const int row = 4 * fq + r; const float rs = rstd_m16(ssq + row * 16); Um[(size_t)row * FF + c0 + fr] = (bf16)f2bf(pg8::silu_mul(g[r] * rs, u[r] * rs)); } }
}
__device__ __forceinline__ void meta_down(const Ptrs& P, int gw, int NGW, int lane) {
    unsigned char* ws = P.ws; const bf16* A = (const bf16*)(ws + WS_META + MO_UM); const bf16* Bt = (const bf16*)(ws + WS_WD1); bf16* H = (bf16*)(ws + WS_META + MO_H1MB);
    float* ssq = (float*)(ws + WS_META + MO_SSQM2); const int fr = lane & 15, fq = lane >> 4;
    for (int t = gw; t < DM / 16; t += NGW) { const f32x4 a = skinny16(A, Bt, FF, 16 * t, lane);
#pragma unroll
        for (int r = 0; r < 4; ++r) { const int row = 4 * fq + r; const float o = P.in[1][row * DM + 16 * t + fr] + 0.5f * a[r]; H[row * DM + 16 * t + fr] = (bf16)f2bf(o);
            float s = o * o; s += __shfl_xor(s, 1); s += __shfl_xor(s, 2); s += __shfl_xor(s, 4); s += __shfl_xor(s, 8); if (fr == 0) ssq[row * 64 + t] = s; } }
}
__device__ __forceinline__ void meta_win(const Ptrs& P, int gw, int NGW, int lane) {
    unsigned char* ws = P.ws; const bf16* A = (const bf16*)(ws + WS_META + MO_H1MB); const bf16* Bt = (const bf16*)(ws + WS_WIN); bf16* Zm = (bf16*)(ws + WS_META + MO_ZM);
    const float* ssq = (const float*)(ws + WS_META + MO_SSQM2); const int fr = lane & 15, fq = lane >> 4;
    for (int t = gw; t < NIN / 16; t += NGW) { const f32x4 a = skinny16(A, Bt, DM, 16 * t, lane); const int c = 16 * t + fr; const float bias = c >= ZC_Q ? P.in[8][c - ZC_Q] : 0.f;
#pragma unroll
        for (int r = 0; r < 4; ++r) { const int row = 4 * fq + r; float s = 0.f;
#pragma unroll 8
            for (int i = 0; i < 64; ++i) s += ssq[row * 64 + i];
            Zm[(size_t)row * NIN + c] = (bf16)f2bf(a[r] * __builtin_amdgcn_rsqf(s * (1.0f / 1024.0f) + 1e-5f) + bias); } }
}
constexpr int KS_LD = 72, VT_LD = 232, ATT_KS_BYTES = 208 * KS_LD * 2, ATT_VT_BYTES = 64 * VT_LD * 2;
__device__ __forceinline__ void attn_unit(const Ptrs& P, unsigned char* lds, int b, int g, int c, int tid, int wave, int lane) {
    unsigned char* ws = P.ws; const bf16* Z = (const bf16*)(ws + WS_BIG); const bf16* Zm = (const bf16*)(ws + WS_META + MO_ZM); bf16* Y = (bf16*)(ws + WS_XB);
    bf16* Ks = (bf16*)lds; bf16* Vt = (bf16*)(lds + ATT_KS_BYTES);
    const int fr = lane & 15, fq = lane >> 4;
    __syncthreads();
    for (int it = tid; it < 208 * 8; it += NWAVES * 64) { const int key = it >> 3, pc = it & 7; const bf16* src; bool valid = true;
        if (key < 16) src = Zm + (size_t)key * NIN; else { const int t = 64 * (c - 2) + (key - 16); valid = t >= 0; src = Z + ((size_t)b * TSEQ + (valid ? t : 0)) * NIN; }
        v4u kq = *(const v4u*)(src + ZC_K + 64 * g + 8 * pc), vq = *(const v4u*)(src + ZC_V + 64 * g + 8 * pc);
        if (!valid) { kq = (v4u){0u, 0u, 0u, 0u}; vq = kq; }
        *(v4u*)(Ks + key * KS_LD + 8 * pc) = kq;
#pragma unroll
        for (int e = 0; e < 4; ++e) { Vt[(8 * pc + 2 * e) * VT_LD + key] = (bf16)(vq[e] & 0xffffu); Vt[(8 * pc + 2 * e + 1) * VT_LD + key] = (bf16)(vq[e] >> 16); } }
    for (int it = tid; it < 64 * 16; it += NWAVES * 64) Vt[(it >> 4) * VT_LD + 208 + (it & 15)] = 0;
    __syncthreads();
    const int hq = 4 * g + (wave >> 1);
    const float slope = __builtin_amdgcn_exp2f(-(float)(hq + 1)), sink = P.in[20][hq];
#pragma unroll 1
    for (int sub = 0; sub < 2; ++sub) {
        const int i0 = 16 * (2 * (wave & 1) + sub), iq = i0 + fr;
        const size_t mrow = (size_t)b * TSEQ + 64 * c + iq;
        const bf16x8 q0 = *(const bf16x8*)(Z + mrow * NIN + ZC_Q + 64 * hq + 8 * fq), q1 = *(const bf16x8*)(Z + mrow * NIN + ZC_Q + 64 * hq + 32 + 8 * fq);
        f32x4 s[13]; float mx = sink;
#pragma unroll
        for (int kt = 0; kt < 13; ++kt) { const bf16* kp = Ks + (16 * kt + fr) * KS_LD + 8 * fq; f32x4 a = (f32x4){0.f, 0.f, 0.f, 0.f};
            a = __builtin_amdgcn_mfma_f32_16x16x32_bf16(*(const bf16x8*)(kp), q0, a, 0, 0, 0);
            a = __builtin_amdgcn_mfma_f32_16x16x32_bf16(*(const bf16x8*)(kp + 32), q1, a, 0, 0, 0);
#pragma unroll
            for (int r = 0; r < 4; ++r) { const int key = 16 * kt + 4 * fq + r; float v;
                if (kt == 0) v = a[r] * 0.125f - slope * (float)(16 + 64 * c + iq - key);
                else { const int jj = key - 16; const int d = 128 + iq - jj; v = a[r] * 0.125f - slope * (float)(d < 0 ? -d : d); if (64 * (c - 2) + jj < 0) v = -1e30f; }
                a[r] = v; mx = fmaxf(mx, v); }
            s[kt] = a; }
        mx = fmaxf(mx, __shfl_xor(mx, 16)); mx = fmaxf(mx, __shfl_xor(mx, 32));
        float sum = 0.f;
#pragma unroll
        for (int kt = 0; kt < 13; ++kt)
#pragma unroll
            for (int r = 0; r < 4; ++r) { const float p = __builtin_amdgcn_exp2f((s[kt][r] - mx) * 1.4426950408889634f); s[kt][r] = p; sum += p; }
        sum += __shfl_xor(sum, 16); sum += __shfl_xor(sum, 32);
        sum += __builtin_amdgcn_exp2f((sink - mx) * 1.4426950408889634f);
        const float rinv = 1.0f / sum;
        f32x4 o[4];
#pragma unroll
        for (int dt = 0; dt < 4; ++dt) o[dt] = (f32x4){0.f, 0.f, 0.f, 0.f};
#pragma unroll
        for (int ks = 0; ks < 7; ++ks) { const int ta = 2 * ks, tb = 2 * ks + 1; v4u pw;
            pw.x = pk2(s[ta][0], s[ta][1]); pw.y = pk2(s[ta][2], s[ta][3]);
            if (tb < 13) { pw.z = pk2(s[tb][0], s[tb][1]); pw.w = pk2(s[tb][2], s[tb][3]); } else { pw.z = 0u; pw.w = 0u; }
            const bf16x8 pf = __builtin_bit_cast(bf16x8, pw);
#pragma unroll
            for (int dt = 0; dt < 4; ++dt) { const bf16* vp = Vt + (16 * dt + fr) * VT_LD + 4 * fq; const v2u va = *(const v2u*)(vp + 16 * ta), vb = *(const v2u*)(vp + 16 * tb);
                const v4u vv = (v4u){va.x, va.y, vb.x, vb.y};
                o[dt] = __builtin_amdgcn_mfma_f32_16x16x32_bf16(__builtin_bit_cast(bf16x8, vv), pf, o[dt], 0, 0, 0); } }
#pragma unroll
        for (int dt = 0; dt < 4; ++dt) { v2u w; w.x = pk2(o[dt][0] * rinv, o[dt][1] * rinv); w.y = pk2(o[dt][2] * rinv, o[dt][3] * rinv);
            *(v2u*)(Y + mrow * DM + 512 + 64 * hq + 16 * dt + 4 * fq) = w; }
    }
}
template <int CTRL> __device__ __forceinline__ float dppf(float x) { return __builtin_bit_cast(float, __builtin_amdgcn_update_dpp(0, __builtin_bit_cast(int, x), CTRL, 0xF, 0xF, true)); }
template <int CTRL> __device__ __forceinline__ float dppf_old(float old, float x) { return __builtin_bit_cast(float, __builtin_amdgcn_update_dpp(__builtin_bit_cast(int, old), __builtin_bit_cast(int, x), CTRL, 0xF, 0xF, false)); }
__device__ __forceinline__ float red8(float x) { x += dppf<0xB1>(x); x += dppf<0x4E>(x); x += dppf<0x141>(x); return x; }
__device__ __forceinline__ float red16(float x) { x = red8(x); x += dppf<0x140>(x); return x; }
__device__ __forceinline__ float scan16(float x) { x += dppf<0x111>(x); x += dppf<0x112>(x); x += dppf<0x114>(x); x += dppf<0x118>(x); return x; }
constexpr int NCHUNK = 257, NSUPER = 65;
constexpr int CB_A = 0, CB_R = 2048, CB_BK = 4096, CB_VT = 8192, CB_TT = 10240, CB_AR = 11264, CB_G = 12288, CB_BON = 12544, CB_SIZE = 12800;
constexpr int CB_GATE = 12800, IMG_SIZE = 14848;
constexpr int WL_HS = IMG_SIZE, WL_SIZE = IMG_SIZE + 2048;
constexpr int SC_YB = 8 * CB_SIZE, SC_END = SC_YB + 8 * 4096, SC_CST = 768;
static_assert(8 * WL_SIZE <= LDSCTL_OFF && SC_END + SC_CST <= LDSCTL_OFF, "LDS map");
__device__ __forceinline__ bf16x8 pack8(const float* v) { v4u o; o.x = pk2(v[0], v[1]); o.y = pk2(v[2], v[3]); o.z = pk2(v[4], v[5]); o.w = pk2(v[6], v[7]); return __builtin_bit_cast(bf16x8, o); }
__device__ __forceinline__ void unpack8(v4u w, float* v) { v[0] = bflo(w.x); v[1] = bfhi(w.x); v[2] = bflo(w.y); v[3] = bfhi(w.y); v[4] = bflo(w.z); v[5] = bfhi(w.z); v[6] = bflo(w.w); v[7] = bfhi(w.w); }


__device__ __forceinline__ void chunk_task(const Ptrs& P, unsigned char* ldsb, int woff, int b, int h, int ch, int lane) {
    int wo_ = woff; asm volatile("" : "+v"(wo_));
    unsigned char* wl = ldsb + wo_;
    unsigned char* ws = P.ws; const int fr = lane & 15, fq = lane >> 4, t = fr;
    const bf16* Z = (const bf16*)(ws + WS_BIG); const bf16* Zm = (const bf16*)(ws + WS_META + MO_ZM); const bf16* LT = (const bf16*)(ws + WS_LT);
    const bool meta = (ch == 0);
    const int tok = 16 * (ch - 1) + fr; const size_t m = (size_t)b * TSEQ + tok;
    const bf16* zc = meta ? Zm + (size_t)fr * NIN : Z + m * NIN;
    const bool pz = meta && fr == 0;
    const bf16* zp = meta ? Zm + (size_t)(fr > 0 ? fr - 1 : 0) * NIN : (tok == 0 ? Zm + (size_t)15 * NIN : Z + (m - 1) * NIN);
    const float* mu = P.in[9];
    bf16* sx = (bf16*)wl;
    {
    bf16x8 xf[5];
#pragma unroll
    for (int ks = 0; ks < 5; ++ks) { const int c0 = ZC_W + 32 * ks + 8 * fq; const v4u a = *(const v4u*)(zc + c0); v4u bq = *(const v4u*)(zp + c0); if (pz) bq = (v4u){0u, 0u, 0u, 0u};
        float va[8], vb[8], v[8]; unpack8(a, va); unpack8(bq, vb); const f32x4 m0 = *(const f32x4*)(mu + c0), m1 = *(const f32x4*)(mu + c0 + 4);
#pragma unroll
        for (int e = 0; e < 8; ++e) { const float mm = e < 4 ? m0[e & 3] : m1[e & 3]; const float z = va[e] + (vb[e] - va[e]) * mm; v[e] = (ks == 0) ? tanhf_(z) : (ks == 1) ? z : sigmoidf_(z); }
        xf[ks] = pack8(v); }
    f32x4 aw[4], aa[4], ag[4];
#pragma unroll
    for (int nt = 0; nt < 4; ++nt) { const bf16* lp = LT + (size_t)(h * 64 + 16 * nt + fr) * 160 + 8 * fq; const f32x4 z = (f32x4){0.f, 0.f, 0.f, 0.f};
        aw[nt] = __builtin_amdgcn_mfma_f32_16x16x32_bf16(*(const bf16x8*)(lp), xf[0], z, 0, 0, 0);
        aa[nt] = __builtin_amdgcn_mfma_f32_16x16x32_bf16(*(const bf16x8*)(lp + 32), xf[1], z, 0, 0, 0);
        ag[nt] = __builtin_amdgcn_mfma_f32_16x16x32_bf16(*(const bf16x8*)(lp + 64), xf[2], z, 0, 0, 0);
        ag[nt] = __builtin_amdgcn_mfma_f32_16x16x32_bf16(*(const bf16x8*)(lp + 96), xf[3], ag[nt], 0, 0, 0);
        ag[nt] = __builtin_amdgcn_mfma_f32_16x16x32_bf16(*(const bf16x8*)(lp + 128), xf[4], ag[nt], 0, 0, 0); }
    f32x4 kkr[4], kv[4], av[4]; float ss = 0.f;
#pragma unroll
    for (int nt = 0; nt < 4; ++nt) { const int c = h * 64 + 16 * nt + 4 * fq; const v2u a = *(const v2u*)(zc + 512 + c); v2u bq = *(const v2u*)(zp + 512 + c); if (pz) bq = (v2u){0u, 0u};
        const f32x4 za = unpack4(a), zb = unpack4(bq), mk = *(const f32x4*)(mu + 512 + c); const f32x4 zk = za + (zb - za) * mk;
        const f32x4 a0 = *(const f32x4*)(P.in[12] + c), kkw = *(const f32x4*)(P.in[15] + c), kaw = *(const f32x4*)(P.in[16] + c);
        f32x4 a_;
#pragma unroll
        for (int r = 0; r < 4; ++r) a_[r] = sigmoidf_(a0[r] + aa[nt][r]);
        av[nt] = a_; kkr[nt] = zk * kkw; kv[nt] = zk * (1.0f + (a_ - 1.0f) * kaw);
        ss += (kkr[nt][0] * kkr[nt][0] + kkr[nt][1] * kkr[nt][1]) + (kkr[nt][2] * kkr[nt][2] + kkr[nt][3] * kkr[nt][3]); }
    ss += __shfl_xor(ss, 16); ss += __shfl_xor(ss, 32);
    const float inv = 1.0f / fmaxf(sqrtf(ss), 1e-12f);
#pragma unroll
    for (int nt = 0; nt < 4; ++nt) { const int cl = 16 * nt + 4 * fq, c = h * 64 + cl; const f32x4 w0 = *(const f32x4*)(P.in[10] + c);
        const f32x4 kk = kkr[nt] * inv, bb = kk * av[nt]; f32x4 e;
#pragma unroll
        for (int r = 0; r < 4; ++r) e[r] = 0.6065306597126334f * sigmoidf_(w0[r] + aw[nt][r]);
        bf16* px = sx + t * 64 + cl; v2u o;
        o.x = pk2(kk[0], kk[1]); o.y = pk2(kk[2], kk[3]); *(v2u*)(px) = o;
        o.x = pk2(e[0], e[1]); o.y = pk2(e[2], e[3]); *(v2u*)(px + 1024) = o;
        o.x = pk2(bb[0], bb[1]); o.y = pk2(bb[2], bb[3]); *(v2u*)(px + 2048) = o;
        o.x = pk2(kv[nt][0], kv[nt][1]); o.y = pk2(kv[nt][2], kv[nt][3]); *(v2u*)(px + 3072) = o;
        o.x = pk2m(ag[nt][0], ag[nt][1]); o.y = pk2m(ag[nt][2], ag[nt][3]); *(v2u*)(px + 4096) = o; }
    }
    asm volatile("s_waitcnt lgkmcnt(0)" ::: "memory"); __builtin_amdgcn_sched_barrier(0);
    v4u xk[2], xe[2], xb[2], xx[2], xg[2];
#pragma unroll
    for (int ks = 0; ks < 2; ++ks) { const bf16* px = sx + t * 64 + 32 * ks + 8 * fq; xk[ks] = *(const v4u*)(px); xe[ks] = *(const v4u*)(px + 1024); xb[ks] = *(const v4u*)(px + 2048); xx[ks] = *(const v4u*)(px + 3072); xg[ks] = *(const v4u*)(px + 4096); }
    asm volatile("s_waitcnt lgkmcnt(0)" ::: "memory"); __builtin_amdgcn_sched_barrier(0);
    unsigned char* cb = wl; float* hs = (float*)(wl + WL_HS);
    const int cbase = h * 64 + 8 * fq;
    unsigned char* pbk = cb + CB_BK + ((((fq >> 1) * 4 + (t >> 2)) * 16 + 8 * (fq & 1)) * 8 + (t & 3)) * 2;
    unsigned char* pvt = cb + CB_VT + (((fq >> 1) * 4 + (t >> 2)) * 16 + 8 * (fq & 1)) * 8 + (t & 3) * 2;
    unsigned char* pgc = cb + CB_G + 8 * fq * 4;
    bf16x8 Af[2], Rf[2], Bf[2], Kf[2]; float bonp = 0.f;
#pragma unroll
    for (int ks = 0; ks < 2; ++ks) { const int c = cbase + 32 * ks, cl = 32 * ks + 8 * fq;
        asm volatile("" ::: "memory"); __builtin_amdgcn_sched_barrier(0);
        float kk[8], e_[8], bb[8], kx[8], rc[8], rp[8], vc[8], vp[8];
        unpack8(xk[ks], kk); unpack8(xe[ks], e_); unpack8(xb[ks], bb); unpack8(xx[ks], kx);
        unpack8(*(const v4u*)(zc + c), rc); unpack8(*(const v4u*)(zc + 1024 + c), vc);
        { v4u a = *(const v4u*)(zp + c), d = *(const v4u*)(zp + 1024 + c); if (pz) { a = (v4u){0u, 0u, 0u, 0u}; d = a; } unpack8(a, rp); unpack8(d, vp); }
        float At[8], Rt[8], Bt[8], Kt[8]; float mur[8], muv[8], rkk[8];
        { const f32x4 a0 = *(const f32x4*)(P.in[9] + c), a1 = *(const f32x4*)(P.in[9] + c + 4), b0 = *(const f32x4*)(P.in[9] + 1024 + c), b1 = *(const f32x4*)(P.in[9] + 1024 + c + 4), c0 = *(const f32x4*)(P.in[17] + c), c1 = *(const f32x4*)(P.in[17] + c + 4);
#pragma unroll
          for (int e = 0; e < 4; ++e) { mur[e] = a0[e]; mur[4 + e] = a1[e]; muv[e] = b0[e]; muv[4 + e] = b1[e]; rkk[e] = c0[e]; rkk[4 + e] = c1[e]; } }
#pragma unroll
        for (int e = 0; e < 8; ++e) { const float rr = rc[e] + (rp[e] - rc[e]) * mur[e]; const float vv = vc[e] + (vp[e] - vc[e]) * muv[e];
            bonp += rr * kx[e] * rkk[e];
            const float ec = scan16(e_[e]), etot = red16(e_[e]);
            const float g1 = __builtin_amdgcn_exp2f(-1.4426950408889634f * ec);
            const float gi = __builtin_amdgcn_exp2f(1.4426950408889634f * ec);
            const float gC = __builtin_amdgcn_exp2f(-1.4426950408889634f * etot);
            const float g0 = dppf_old<0x111>(1.0f, g1);
            At[e] = -kk[e] * g0; Rt[e] = rr * g1; Bt[e] = bb[e] * gi; Kt[e] = kx[e] * gi;
            const int ke = 32 * ks + e;
            *(bf16*)(pbk + ks * 2048 + e * 16) = (bf16)f2bf(Bt[e] * gC);
            *(bf16*)(pbk + ks * 2048 + e * 16 + 8) = (bf16)f2bf(Kt[e] * gC);
            *(bf16*)(pvt + ks * 1024 + e * 8) = (bf16)f2bf(vv);
            if (t == 15) *(float*)(pgc + ke * 4) = gC; }
        Af[ks] = pack8(At); Rf[ks] = pack8(Rt); Bf[ks] = pack8(Bt); Kf[ks] = pack8(Kt);
        { const int fqs = 2 * (fq & 1), bo = (fq >> 1) * 8; const v4u aw = __builtin_bit_cast(v4u, Af[ks]), rw = __builtin_bit_cast(v4u, Rf[ks]);
          *(v2u*)(cb + CB_A + ((ks * 4 + fqs) * 16 + t) * 16 + bo) = (v2u){aw.x, aw.y}; *(v2u*)(cb + CB_A + ((ks * 4 + fqs + 1) * 16 + t) * 16 + bo) = (v2u){aw.z, aw.w};
          *(v2u*)(cb + CB_R + ((ks * 4 + fqs) * 16 + t) * 16 + bo) = (v2u){rw.x, rw.y}; *(v2u*)(cb + CB_R + ((ks * 4 + fqs + 1) * 16 + t) * 16 + bo) = (v2u){rw.z, rw.w}; }
        *(v4u*)(cb + CB_GATE + (t * 64 + cl) * 2) = xg[ks]; }
    asm volatile("" ::: "memory"); __builtin_amdgcn_sched_barrier(0);
    bonp += __shfl_xor(bonp, 16); bonp += __shfl_xor(bonp, 32);
    if (fq == 0) *(float*)(cb + CB_BON + t * 4) = bonp;
    const f32x4 z4 = (f32x4){0.f, 0.f, 0.f, 0.f};
    f32x4 Mab = __builtin_amdgcn_mfma_f32_16x16x32_bf16(Af[0], Bf[0], z4, 0, 0, 0); Mab = __builtin_amdgcn_mfma_f32_16x16x32_bf16(Af[1], Bf[1], Mab, 0, 0, 0);
    f32x4 Mak = __builtin_amdgcn_mfma_f32_16x16x32_bf16(Af[0], Kf[0], z4, 0, 0, 0); Mak = __builtin_amdgcn_mfma_f32_16x16x32_bf16(Af[1], Kf[1], Mak, 0, 0, 0);
    f32x4 Mrb = __builtin_amdgcn_mfma_f32_16x16x32_bf16(Rf[0], Bf[0], z4, 0, 0, 0); Mrb = __builtin_amdgcn_mfma_f32_16x16x32_bf16(Rf[1], Bf[1], Mrb, 0, 0, 0);
    f32x4 Mrk = __builtin_amdgcn_mfma_f32_16x16x32_bf16(Rf[0], Kf[0], z4, 0, 0, 0); Mrk = __builtin_amdgcn_mfma_f32_16x16x32_bf16(Rf[1], Kf[1], Mrk, 0, 0, 0);
#pragma unroll
    for (int r = 0; r < 4; ++r) { const int tt = 4 * fq + r, i = fr;
        const float mab = (tt > i) ? Mab[r] : 0.f, mak = (tt > i) ? Mak[r] : 0.f, mrb = (tt >= i) ? Mrb[r] : 0.f, mrk = (tt >= i) ? Mrk[r] : 0.f;
        hs[tt * 16 + i] = mab; hs[256 + tt * 16 + i] = mak;
        const unsigned w = pk2m(mrb, mrk);
        *(bf16*)(cb + CB_AR + (((i >> 2) * 16 + tt) * 8 + (i & 3)) * 2) = (bf16)(w & 0xffffu);
        *(bf16*)(cb + CB_AR + (((i >> 2) * 16 + tt) * 8 + 4 + (i & 3)) * 2) = (bf16)(w >> 16); }
    asm volatile("s_waitcnt lgkmcnt(0)" ::: "memory");
    { const int c = lane & 31, cc = c & 15; const bool isT = c < 16; float out[16];
#pragma unroll
      for (int tt = 0; tt < 16; ++tt) { float acc = isT ? (tt == cc ? 1.0f : 0.0f) : hs[256 + tt * 16 + cc];
#pragma unroll
          for (int i4 = 0; i4 < (tt + 3) / 4; ++i4) { const f32x4 l = *(const f32x4*)(hs + tt * 16 + 4 * i4);
#pragma unroll
              for (int e = 0; e < 4; ++e) if (4 * i4 + e < tt) acc += l[e] * out[4 * i4 + e]; }
          out[tt] = acc;
          if (lane < 32) *(bf16*)(cb + CB_TT + (((cc >> 2) * 16 + tt) * 8 + (isT ? 0 : 4) + (cc & 3)) * 2) = (bf16)f2bf(acc); } }
    asm volatile("s_waitcnt lgkmcnt(0)" ::: "memory");
    { unsigned char* gi = ws + WS_IMG + ((size_t)(b * NHEAD + h) * NCHUNK + ch) * IMG_SIZE;
      for (int i = lane; i < IMG_SIZE / 16; i += 64) *(v4u*)(gi + i * 16) = *(const v4u*)(cb + i * 16); }
    asm volatile("s_waitcnt lgkmcnt(0)" ::: "memory"); __builtin_amdgcn_sched_barrier(0);
}

struct ScanOps { bf16x8 a0, a1, r0, r1, tt, ar, bk[4]; v2u vt; f32x4 g[4]; };
__device__ __forceinline__ void scan_load(ScanOps& o, const unsigned char* ib, int fr, int fq, int vcol) {
    const int ln = (fq * 16 + fr) * 16;
    o.a0 = *(const bf16x8*)(ib + CB_A + ln); o.a1 = *(const bf16x8*)(ib + CB_A + 1024 + ln);
    o.r0 = *(const bf16x8*)(ib + CB_R + ln); o.r1 = *(const bf16x8*)(ib + CB_R + 1024 + ln);
    o.tt = *(const bf16x8*)(ib + CB_TT + ln); o.ar = *(const bf16x8*)(ib + CB_AR + ln);
    o.vt = *(const v2u*)(ib + CB_VT + (((vcol >> 4) * 4 + fq) * 16 + fr) * 8);
#pragma unroll
    for (int kt = 0; kt < 4; ++kt) { o.g[kt] = *(const f32x4*)(ib + CB_G + (16 * kt + 4 * fq) * 4); o.bk[kt] = *(const bf16x8*)(ib + CB_BK + kt * 1024 + ln); }
}
__device__ __forceinline__ void scan_step(f32x4 (&H)[4], const ScanOps& o, float* yb, int fq, int vcol) {
    v4u hb0, hb1;
    hb0.x = pk2m(H[0][0], H[0][1]); hb0.y = pk2m(H[0][2], H[0][3]); hb0.z = pk2m(H[1][0], H[1][1]); hb0.w = pk2m(H[1][2], H[1][3]);
    hb1.x = pk2m(H[2][0], H[2][1]); hb1.y = pk2m(H[2][2], H[2][3]); hb1.z = pk2m(H[3][0], H[3][1]); hb1.w = pk2m(H[3][2], H[3][3]);
    const bf16x8 h0 = __builtin_bit_cast(bf16x8, hb0), h1 = __builtin_bit_cast(bf16x8, hb1);
    const f32x4 z4 = (f32x4){0.f, 0.f, 0.f, 0.f};
    f32x4 X = __builtin_amdgcn_mfma_f32_16x16x32_bf16(o.a0, h0, z4, 0, 0, 0); X = __builtin_amdgcn_mfma_f32_16x16x32_bf16(o.a1, h1, X, 0, 0, 0);
    f32x4 Y = __builtin_amdgcn_mfma_f32_16x16x32_bf16(o.r0, h0, z4, 0, 0, 0); Y = __builtin_amdgcn_mfma_f32_16x16x32_bf16(o.r1, h1, Y, 0, 0, 0);
    v4u xb; xb.x = pk2m(X[0], X[1]); xb.y = pk2m(X[2], X[3]); xb.z = o.vt.x; xb.w = o.vt.y;
    const f32x4 U = __builtin_amdgcn_mfma_f32_16x16x32_bf16(o.tt, __builtin_bit_cast(bf16x8, xb), z4, 0, 0, 0);
    v4u ub; ub.x = pk2m(U[0], U[1]); ub.y = pk2m(U[2], U[3]); ub.z = o.vt.x; ub.w = o.vt.y;
    const bf16x8 uf = __builtin_bit_cast(bf16x8, ub);
    Y = __builtin_amdgcn_mfma_f32_16x16x32_bf16(o.ar, uf, Y, 0, 0, 0);
#pragma unroll
    for (int kt = 0; kt < 4; ++kt) H[kt] = __builtin_amdgcn_mfma_f32_16x16x32_bf16(o.bk[kt], uf, H[kt] * o.g[kt], 0, 0, 0);
#pragma unroll
    for (int r = 0; r < 4; ++r) yb[(4 * fq + r) * 64 + vcol] = Y[r];
}
__device__ __forceinline__ void scan_phase(const Ptrs& P, unsigned char* lds, int sb, int tid, int wave, int lane, int never) {
    const int b = sb >> 3, h = sb & 7, fr = lane & 15, fq = lane >> 4;
    const unsigned char* img = P.ws + WS_IMG + (size_t)(b * NHEAD + h) * NCHUNK * IMG_SIZE;
    if (wave < 4) {
        f32x4 H[4];
#pragma unroll
        for (int kt = 0; kt < 4; ++kt) H[kt] = (f32x4){0.f, 0.f, 0.f, 0.f};
        const int vcol = 16 * wave + fr;
#pragma unroll 1
        for (int s = 0; s <= NSUPER + 1; ++s) {
            __syncthreads();
            if (s < 1 || s > NSUPER) continue;
            const int set = (s - 1) & 1;
#pragma unroll 1
            for (int j = 0; j < 4; ++j) { const int ch = 4 * (s - 1) + j; if (ch >= NCHUNK) break;
                ScanOps o; scan_load(o, lds + (set * 4 + j) * CB_SIZE, fr, fq, vcol);
                scan_step(H, o, (float*)(lds + SC_YB + (set * 4 + j) * 4096), fq, vcol); }
        }
    } else {
        const int hw = wave - 4, t = fr;
        const bf16* Z = (const bf16*)(P.ws + WS_BIG); const bf16* Zm = (const bf16*)(P.ws + WS_META + MO_ZM);
        bf16* Yo = (bf16*)(P.ws + WS_XB);
        const int cbase = h * 64 + 8 * fq;
        float* cst = (float*)(lds + SC_END);
        if (lane < 48) { const int a_ = lane >> 4, c4 = (lane & 15) * 4; const float* src = a_ == 0 ? P.in[9] + 1024 + h * 64 : a_ == 1 ? P.in[18] + h * 64 : P.in[19] + h * 64;
            *(f32x4*)(cst + a_ * 64 + c4) = *(const f32x4*)(src + c4); }
        v4u cg0[2], cg1[2]; v4u im0[13], im1[13];
        const int pvt_off = CB_VT + (((fq >> 1) * 4 + (t >> 2)) * 16 + 8 * (fq & 1)) * 8 + (t & 3) * 2;
#define GLD16(dst, ptr) asm volatile("global_load_dwordx4 %0, %1, off" : "=v"(dst) : "v"(ptr) : "memory")
#define GLD4(dst, ptr) asm volatile("global_load_dword %0, %1, off" : "=v"(dst) : "v"(ptr) : "memory")
#define IMG_LOAD(IM, chx) do { const unsigned char* ip_ = img + (size_t)(chx) * IMG_SIZE + lane * 16; _Pragma("unroll") for (int i_ = 0; i_ < 13; ++i_) GLD16(IM[i_], ip_ + i_ * 1024); } while (0)
#define VM_WAIT_ALL(N) asm volatile("s_waitcnt vmcnt(" #N ")" : "+v"(im0[0]), "+v"(im0[1]), "+v"(im0[2]), "+v"(im0[3]), "+v"(im0[4]), "+v"(im0[5]), "+v"(im0[6]), "+v"(im0[7]), "+v"(im0[8]), "+v"(im0[9]), "+v"(im0[10]), "+v"(im0[11]), "+v"(im0[12]), \
            "+v"(im1[0]), "+v"(im1[1]), "+v"(im1[2]), "+v"(im1[3]), "+v"(im1[4]), "+v"(im1[5]), "+v"(im1[6]), "+v"(im1[7]), "+v"(im1[8]), "+v"(im1[9]), "+v"(im1[10]), "+v"(im1[11]), "+v"(im1[12]) :: "memory")
#define VM_WAIT_POST(N) asm volatile("s_waitcnt vmcnt(" #N ")" : "+v"(cg0[0]), "+v"(cg0[1]), "+v"(cg1[0]), "+v"(cg1[1]) :: "memory")
#define POST_LOAD(CG, sx) do { int chn_ = 4 * ((sx) - 2) + hw; chn_ = chn_ < 1 ? 1 : (chn_ >= NCHUNK ? NCHUNK - 1 : chn_);     \
            const unsigned char* ib_ = img + (size_t)chn_ * IMG_SIZE; \
            _Pragma("unroll") for (int ks = 0; ks < 2; ++ks) GLD16(CG[ks], ib_ + CB_GATE + (t * 64 + 32 * ks + 8 * fq) * 2); } while (0)
        POST_LOAD(cg0, 0); IMG_LOAD(im0, hw);
        POST_LOAD(cg1, 1); IMG_LOAD(im1, 4 + hw);
#define HELPER_ITER(IM, CG) do { \
            __syncthreads(); \
            VM_WAIT_ALL(15); VM_WAIT_POST(15);        \
            unsigned char* cbw = lds + ((s & 1) * 4 + hw) * CB_SIZE;            \
            { const int ch = 4 * (s - 2) + hw; \
              if (s >= 2 && ch >= 1 && ch < NCHUNK) { const float* yb = (const float*)(lds + SC_YB + ((s & 1) * 4 + hw) * 4096); \
                const int tok = 16 * (ch - 1) + t; const size_t m = (size_t)b * TSEQ + tok; \
                float y[16]; float sm = 0.f; \
                _Pragma("unroll") for (int ks = 0; ks < 2; ++ks) { const f32x4 y0 = *(const f32x4*)(yb + t * 64 + 32 * ks + 8 * fq), y1 = *(const f32x4*)(yb + t * 64 + 32 * ks + 8 * fq + 4); \
                    _Pragma("unroll") for (int e = 0; e < 4; ++e) { y[8 * ks + e] = y0[e]; y[8 * ks + 4 + e] = y1[e]; sm += y0[e] + y1[e]; } } \
                sm += __shfl_xor(sm, 16); sm += __shfl_xor(sm, 32); const float mean = sm * (1.0f / 64.0f); float sq = 0.f; \
                _Pragma("unroll") for (int i = 0; i < 16; ++i) { y[i] -= mean; sq += y[i] * y[i]; } \
                sq += __shfl_xor(sq, 16); sq += __shfl_xor(sq, 32); const float rs = __builtin_amdgcn_rsqf(sq * (1.0f / 64.0f) + 64e-5f); \
                const float bon = *(const float*)(cbw + CB_BON + t * 4); \
                _Pragma("unroll") for (int ks = 0; ks < 2; ++ks) { const int c = cbase + 32 * ks; \
                    float g[8], o[8]; unpack8(CG[ks], g); \
                    const float* cq = cst + 32 * ks + 8 * fq; const f32x4 wA = *(const f32x4*)(cq + 64), wB = *(const f32x4*)(cq + 68), bA = *(const f32x4*)(cq + 128), bB = *(const f32x4*)(cq + 132); \
                    _Pragma("unroll") for (int e = 0; e < 8; ++e) { const float lw_ = e < 4 ? wA[e & 3] : wB[e & 3], lb_ = e < 4 ? bA[e & 3] : bB[e & 3]; \
                        const float vv = __builtin_bit_cast(float, (unsigned)(*(const bf16*)(cbw + pvt_off + ks * 1024 + e * 8)) << 16); \
                        o[e] = (y[8 * ks + e] * rs * lw_ + lb_ + bon * vv) * g[e]; } \
                    *(bf16x8*)(Yo + m * DM + c) = pack8(o); } } } \
            asm volatile("s_waitcnt lgkmcnt(0)" ::: "memory");                   \
            if (4 * s + hw < NCHUNK) { \
                _Pragma("unroll") for (int i_ = 0; i_ < 13; ++i_) if (i_ < 12 || lane < 32) *(v4u*)(cbw + (i_ * 64 + lane) * 16) = IM[i_]; } \
            POST_LOAD(CG, s + 2); \
            { const int cl_ = 4 * (s + 2) + hw; IMG_LOAD(IM, cl_ < NCHUNK ? cl_ : NCHUNK - 1); } \
        } while (0)
#pragma unroll 1
        for (int s2 = 0; s2 <= NSUPER + 1; s2 += 2) {
            { const int s = s2; HELPER_ITER(im0, cg0); }
            if (s2 + 1 <= NSUPER + 1) { const int s = s2 + 1; HELPER_ITER(im1, cg1); }
        }
        asm volatile("s_waitcnt vmcnt(0)" ::: "memory");
#undef HELPER_ITER
#undef POST_LOAD
#undef VM_WAIT_ALL
#undef VM_WAIT_POST
#undef GLD16
#undef GLD4
#undef IMG_LOAD
    }
}
__device__ __forceinline__ void final_norm(const Ptrs& P, int gw, int NGW, int lane) {
    const float* ssq = (const float*)(P.ws + WS_SSQ4); const GAS f32x4* g4 = (const GAS f32x4*)P.in[26] + lane;
    f32x4 g[4];
#pragma unroll
    for (int j = 0; j < 4; ++j) g[j] = g4[64 * j];
    for (int m = gw; m < MR; m += NGW) { const float rs = pg8::rstd_from16(ssq, m); GAS f32x4* o = (GAS f32x4*)(P.out + (size_t)m * DM) + lane;
#pragma unroll
        for (int j = 0; j < 4; ++j) o[64 * j] = o[64 * j] * rs * g[j]; }
}
#ifndef MK_N_LAUNCHES
#define MK_N_LAUNCHES 1
#endif
constexpr int N_PHASES = 10;
struct Args { Ptrs p; int ph_lo, ph_hi, use_cg, pad; };
__global__ void __launch_bounds__(NWAVES * 64, 2) hymba_fwd(Args args) {
    extern __shared__ __attribute__((aligned(16))) unsigned char lds[];
    LAS unsigned char* ldsl = (LAS unsigned char*)lds;
    volatile LAS unsigned* MISC = (volatile LAS unsigned*)(ldsl + MISC_OFF);
    const int tid = threadIdx.x, lane = tid & 63, wave = __builtin_amdgcn_readfirstlane(tid >> 6);
    const int G = gridDim.x, bx = blockIdx.x, vcu = (G % 8 == 0) ? (bx % 8) * (G / 8) + bx / 8 : bx;
    const Ptrs& P = args.p; unsigned char* ws = P.ws;
    if (args.use_cg) cg::this_grid().sync();
    for (int u = tid; u < (LDS_BYTES - LDSCTL_OFF) / 4; u += NWAVES * 64) ((LAS unsigned*)(ldsl + LDSCTL_OFF))[u] = 0u;
    __syncthreads();
    const int lo = args.ph_lo, hi = args.ph_hi;
    XcdBarrier bar; bar.bar = (unsigned*)(ws + WS_CTL) + CW_BAR; bar.x = 0; bar.st = nullptr;
    if (hi - lo > 1) bar = xcd_barrier_post((unsigned*)(ws + WS_CTL) + CW_BAR, MISC + 8);
#define IN(k) (lo <= (k) && (k) < hi)
#define SEAM(k) do { if (IN(k) && IN((k) + 1)) xcd_barrier(bar); } while (0)
    const int gw = vcu * NWAVES + wave, NGW = G * NWAVES;
    const int gwm = bx + G * wave;

#ifndef REP_P0
#define REP_P0 1
#endif
    if (IN(0)) { for (int rep = 0; rep < REP_P0; ++rep) p0_prologue(P, ldsl, vcu, G, wave, lane); SEAM(0); }
    if (IN(1)) {
        meta_up(ws, gwm, NGW, lane);
        pg8::Gemm g{(const bf16*)(ws + WS_XB), (const bf16*)(ws + WS_WGU1), MR, NGU, DM}; pg8::StaticOrder S; S.init(MR, NGU, G, bx);
        pg8::EpiSwiglu E{(bf16*)(ws + WS_BIG), (const float*)(ws + WS_SSQ1), FF};
#ifndef REP_P1
#define REP_P1 1
#endif
        for (int rep = 0; rep < REP_P1; ++rep) pg8::gemm_phase<pg8::EpiSwiglu, pg8::StaticOrder, true, true>(ldsl, g, S, E);
        SEAM(1);
    }
    if (IN(2)) {
        meta_down(P, gwm, NGW, lane);
        pg8::Gemm g{(const bf16*)(ws + WS_BIG), (const bf16*)(ws + WS_WD1), MR, DM, FF}; pg8::StaticOrder S; S.init(MR, DM, G, bx);
        pg8::EpiResid<true> E{P.in[0], P.out, (bf16*)(ws + WS_XB), (float*)(ws + WS_SSQ2), 0.5f};
#ifndef REP_P2
#define REP_P2 1
#endif
        for (int rep = 0; rep < REP_P2; ++rep) pg8::gemm_phase<pg8::EpiResid<true>, pg8::StaticOrder, true, true>(ldsl, g, S, E);
        SEAM(2);
    }
    if (IN(3)) {
        meta_win(P, gwm, NGW, lane);
        pg8::Gemm g{(const bf16*)(ws + WS_XB), (const bf16*)(ws + WS_WIN), MR, NINP, DM}; pg8::StaticOrder S; S.init(MR, NINP, G, bx);
        pg8::EpiZ E{(bf16*)(ws + WS_BIG), (const float*)(ws + WS_SSQ2), P.in[8], NIN, NIN, ZC_Q};
        pg8::gemm_phase<pg8::EpiZ, pg8::StaticOrder, true, true>(ldsl, g, S, E);
        SEAM(3);
    }
    if (IN(4)) {
#ifndef REP_PREP
#define REP_PREP 1
#endif
        for (int rep = 0; rep < REP_PREP; ++rep) for (int task = gw; task < NBATCH * NHEAD * NCHUNK; task += NGW) { const int bc = task >> 3; chunk_task(P, lds, wave * WL_SIZE, bc / NCHUNK, task & 7, bc % NCHUNK, lane); }
        SEAM(4);
    }
    if (IN(5)) {
#ifndef REP_SCAN
#define REP_SCAN 1
#endif
#ifndef REP_ATTN
#define REP_ATTN 1
#endif
        if (bx < 64) { for (int rep = 0; rep < REP_SCAN; ++rep) { scan_phase(P, lds, bx, tid, wave, lane, args.use_cg); __syncthreads(); } }
        else { for (int rep = 0; rep < REP_ATTN; ++rep) for (int u = bx - 64; u < NBATCH * 2 * 64; u += G - 64) attn_unit(P, lds, u >> 7, (u >> 6) & 1, u & 63, tid, wave, lane);
            __syncthreads();
#ifndef REP_TR1
#define REP_TR1 1
#endif
            for (int rep = 0; rep < REP_TR1; ++rep) p0_transposes(P, ldsl, 1, (bx - 64) * NWAVES + wave, (G - 64) * NWAVES, wave, lane); }
        __syncthreads();
        SEAM(5);
    }
    if (IN(6)) {
        pg8::Gemm g{(const bf16*)(ws + WS_XB), (const bf16*)(ws + WS_WOUT), MR, DM, DM}; pg8::StaticOrder S; S.init(MR, DM, G, bx);
        pg8::EpiResid<true> E{P.out, P.out, (bf16*)(ws + WS_P), (float*)(ws + WS_SSQ3), 1.0f};
        pg8::gemm_phase<pg8::EpiResid<true>, pg8::StaticOrder, true, true>(ldsl, g, S, E);
        SEAM(6);
    }
    if (IN(7)) {
        pg8::Gemm g{(const bf16*)(ws + WS_P), (const bf16*)(ws + WS_WGU2), MR, NGU, DM}; pg8::StaticOrder S; S.init(MR, NGU, G, bx);
        pg8::EpiSwiglu E{(bf16*)(ws + WS_BIG), (const float*)(ws + WS_SSQ3), FF};
        pg8::gemm_phase<pg8::EpiSwiglu, pg8::StaticOrder, true, true>(ldsl, g, S, E);
        SEAM(7);
    }
    if (IN(8)) {
        pg8::Gemm g{(const bf16*)(ws + WS_BIG), (const bf16*)(ws + WS_WD2), MR, DM, FF}; pg8::StaticOrder S; S.init(MR, DM, G, bx);
        pg8::EpiResid<false> E{P.out, P.out, nullptr, (float*)(ws + WS_SSQ4), 0.5f};
        pg8::gemm_phase<pg8::EpiResid<false>, pg8::StaticOrder, true, true>(ldsl, g, S, E);
        SEAM(8);
    }
    if (IN(9)) final_norm(P, gw, NGW, lane);
#undef IN
#undef SEAM
}

extern "C" void kernel_launch(void* const* d_in, const int* in_sizes, int n_in, void* d_out, int out_size, void* d_ws, size_t ws_size, hipStream_t stream) {
    static int grid = 0;
    if (grid == 0) {
        if (n_in != 27 || in_sizes[0] != MR * DM || out_size != MR * DM || ws_size < WS_END) { fprintf(stderr, "kernel_launch: unexpected shapes (n_in %d, in0 %d, out %d, ws %zu)\n", n_in, n_in > 0 ? in_sizes[0] : -1, out_size, ws_size); grid = -1; return; }
        int dev = 0, cus = 0, per_cu = 0;
        if (hipGetDevice(&dev) != hipSuccess || hipDeviceGetAttribute(&cus, hipDeviceAttributeMultiprocessorCount, dev) != hipSuccess) { grid = -1; return; }
        if (hipFuncSetAttribute((const void*)hymba_fwd, hipFuncAttributeMaxDynamicSharedMemorySize, LDS_BYTES) != hipSuccess) { fprintf(stderr, "kernel_launch: hipFuncSetAttribute failed\n"); grid = -1; return; }
        if (hipOccupancyMaxActiveBlocksPerMultiprocessor(&per_cu, (const void*)hymba_fwd, NWAVES * 64, LDS_BYTES) != hipSuccess || per_cu < 1) fprintf(stderr, "kernel_launch: occupancy query says %d blocks per CU\n", per_cu);
        (void)hipGetLastError();
        grid = cus;
    }
    if (grid < 0) return;
    if (hipMemsetAsync((char*)d_ws + WS_CTL, 0, CTL_ZERO_BYTES, stream) != hipSuccess) { fprintf(stderr, "kernel_launch: memset failed\n"); return; }
    Args a{};
    for (int i = 0; i < 27; ++i) a.p.in[i] = (const float*)d_in[i];
    a.p.out = (float*)d_out; a.p.ws = (unsigned char*)d_ws; a.use_cg = 0; a.pad = 0;
#if MK_N_LAUNCHES == 1
    a.ph_lo = 0; a.ph_hi = N_PHASES;
    void* kargs[] = {&a};
    hipError_t e = hipLaunchCooperativeKernel((const void*)hymba_fwd, dim3(grid), dim3(NWAVES * 64), kargs, LDS_BYTES, stream);
    if (e != hipSuccess) fprintf(stderr, "kernel_launch: cooperative launch failed: %s (grid %d)\n", hipGetErrorString(e), grid);
#else
    for (int li = 0; li < N_PHASES; ++li) { a.ph_lo = li; a.ph_hi = li + 1;
        hipLaunchKernelGGL(hymba_fwd, dim3(grid), dim3(NWAVES * 64), LDS_BYTES, stream, a);
        const hipError_t le = hipPeekAtLastError(); if (le != hipSuccess) { fprintf(stderr, "kernel_launch: launch %d failed: %s\n", li, hipGetErrorName(le)); break; } }
#endif
}
```

```cpp
#include <hip/hip_runtime.h>
#include <cstdio>
#include <cstdint>
namespace pg8 {
#define PG8_LAS __attribute__((address_space(3)))
typedef unsigned short bf16_t;
typedef short bf16x8 __attribute__((ext_vector_type(8)));
typedef float f32x4 __attribute__((ext_vector_type(4)));
typedef unsigned u32x4 __attribute__((ext_vector_type(4)));
constexpr int BM = 256, BK = 64, HALF = 128, HTB = HALF * BK * 2  , STAGE_BYTES = 8 * HTB, NXCD = 8, WGM = 8;

__host__ __device__ __forceinline__ int lds_byte(int r, int c) { const int st = (r >> 4) * 2 + (c >> 5), rr = r & 15, cc = c & 31, ob = rr * 64 + cc * 2; return st * 1024 + (ob ^ (((ob >> 9) & 1) << 5)); }
__host__ __device__ __forceinline__ void stage_rc(int b, int& R, int& C) { const int st = b / 1024, sb = b % 1024, swz = sb ^ (((sb >> 9) & 1) << 5); R = (st >> 1) * 16 + swz / 64; C = (st & 1) * 32 + (swz % 64) / 2; }
__host__ __device__ __forceinline__ int perm32(int rho) { const int n = rho >> 4, i = rho & 15; return 8 * (i >> 2) + 4 * n + (i & 3); }

struct Unit { int pm, pn; };
struct Gemm { const bf16_t* A; const bf16_t* Bt; int M, N, K; };

struct StaticOrder {
    int nM, nN, nwg, G, c;
    __host__ __device__ void init(int M, int N, int G_, int c_) { nM = M / BM; nN = N / BM; nwg = nM * nN; G = G_; c = c_; }
    __host__ __device__ bool next(int i, Unit& u) const {
        const long L = (long)i * G + c; if (L >= nwg) return false;
        int wgid = (int)L; { const int q = nwg / NXCD, r = nwg % NXCD, xcd = wgid % NXCD, off = wgid / NXCD; wgid = (xcd < r ? xcd * (q + 1) : r * (q + 1) + (xcd - r) * q) + off; }
        const int nig = WGM * nN, gid = wgid / nig, fm = gid * WGM, gsz = (nM - fm) < WGM ? (nM - fm) : WGM;
        u.pm = fm + ((wgid % nig) % gsz); u.pn = (wgid % nig) / gsz; return true;
    }
    __device__ __forceinline__ void a_ready(const Unit&) const {}
    __device__ __forceinline__ void done(const Unit&) const {}
};

__device__ __forceinline__ unsigned cvt_pk_bf16(float lo, float hi) { unsigned r; asm volatile("v_cvt_pk_bf16_f32 %0, %1, %2" : "=v"(r) : "v"(lo), "v"(hi)); return r; }
typedef float f32x2 __attribute__((ext_vector_type(2)));
typedef unsigned u32x2 __attribute__((ext_vector_type(2)));
__device__ __forceinline__ float rstd_from16(const float* ssq, int row) {
    const f32x4* p = (const f32x4*)(ssq + (size_t)row * 16);
    const f32x4 a = p[0], b = p[1], c = p[2], d = p[3];
    const float s = ((a[0] + a[1]) + (a[2] + a[3])) + ((b[0] + b[1]) + (b[2] + b[3])) + ((c[0] + c[1]) + (c[2] + c[3])) + ((d[0] + d[1]) + (d[2] + d[3]));
    return __builtin_amdgcn_rsqf(s * (1.0f / 1024.0f) + 1e-5f);
}
__device__ __forceinline__ float silu_mul(float g, float u) { return g * __builtin_amdgcn_rcpf(1.0f + __builtin_amdgcn_exp2f(-1.4426950408889634f * g)) * u; }
template <class Sched> __device__ __forceinline__ void fill_rstd_cache(PG8_LAS float* tab, const float* ssq, const Sched& S) {
    const int tid = threadIdx.x; int t0 = -1, t1 = -1, t2 = -1, t3 = -1; Unit u;
    for (int i = 0; S.next(i, u); ++i) { const int pm = u.pm;
        if (pm == t0 || pm == t1 || pm == t2 || pm == t3) continue;
        if (t0 < 0) t0 = pm; else if (t1 < 0) t1 = pm; else if (t2 < 0) t2 = pm; else if (t3 < 0) t3 = pm; }
    if (tid == 0) { tab[0] = __builtin_bit_cast(float, t0); tab[1] = __builtin_bit_cast(float, t1); tab[2] = __builtin_bit_cast(float, t2); tab[3] = __builtin_bit_cast(float, t3); }
    if (tid < 256) { if (t0 >= 0) tab[4 + tid] = rstd_from16(ssq, t0 * BM + tid); if (t1 >= 0) tab[4 + 256 + tid] = rstd_from16(ssq, t1 * BM + tid);
        if (t2 >= 0) tab[4 + 512 + tid] = rstd_from16(ssq, t2 * BM + tid); if (t3 >= 0) tab[4 + 768 + tid] = rstd_from16(ssq, t3 * BM + tid); }
    __syncthreads();
}
__device__ __forceinline__ int rstd_slot(const PG8_LAS float* tab, int pm) {
    const int a = __builtin_bit_cast(int, tab[0]), b = __builtin_bit_cast(int, tab[1]), c = __builtin_bit_cast(int, tab[2]), d = __builtin_bit_cast(int, tab[3]);
    return pm == a ? 0 : pm == b ? 1 : pm == c ? 2 : pm == d ? 3 : -1;
}
struct EpiSwiglu {
    static constexpr bool PERM = true, AFTER_DRAIN = false;
    bf16_t* U; const float* ssq; int ldu; const PG8_LAS float* rc;
    __device__ __forceinline__ void operator()(const f32x4 (&acc)[2][2][4][2], const Unit& u, int wr, int wc, int fr, int fq) const {
        const int row0 = u.pm * BM + wr * 64 + fr, col0 = u.pn * HALF + wc * 32 + 8 * fq; const int slot = rstd_slot(rc, u.pm);
#pragma unroll
        for (int ai = 0; ai < 2; ++ai)
#pragma unroll
            for (int m = 0; m < 4; ++m) { const int row = row0 + ai * HALF + m * 16; const float rs = slot >= 0 ? rc[4 + slot * 256 + (row - u.pm * BM)] : rstd_from16(ssq, row);
                const f32x4 g0 = acc[ai][0][m][0] * rs, g1 = acc[ai][0][m][1] * rs, u0 = acc[ai][1][m][0] * rs, u1 = acc[ai][1][m][1] * rs;
                u32x4 w; w.x = cvt_pk_bf16(silu_mul(g0[0], u0[0]), silu_mul(g0[1], u0[1])); w.y = cvt_pk_bf16(silu_mul(g0[2], u0[2]), silu_mul(g0[3], u0[3]));
                w.z = cvt_pk_bf16(silu_mul(g1[0], u1[0]), silu_mul(g1[1], u1[1])); w.w = cvt_pk_bf16(silu_mul(g1[2], u1[2]), silu_mul(g1[3], u1[3]));
                *(u32x4*)(U + (size_t)row * ldu + col0) = w; }
    }
};
struct EpiZ {
    static constexpr bool PERM = true, AFTER_DRAIN = false;
    bf16_t* Z; const float* ssq; const float* bias; int ldz, ncols, bias_from; const PG8_LAS float* rc;
    __device__ __forceinline__ void operator()(const f32x4 (&acc)[2][2][4][2], const Unit& u, int wr, int wc, int fr, int fq) const {
        const int row0 = u.pm * BM + wr * 64 + fr, col0 = u.pn * BM + wc * 32 + 8 * fq; const int slot = rstd_slot(rc, u.pm);
        f32x4 bv[2][2];
#pragma unroll
        for (int bj = 0; bj < 2; ++bj)
#pragma unroll
            for (int n = 0; n < 2; ++n) { const int c = col0 + bj * HALF + 4 * n; bv[bj][n] = (c >= bias_from && c < ncols) ? *(const f32x4*)(bias + (c - bias_from)) : (f32x4){0.f, 0.f, 0.f, 0.f}; }
#pragma unroll
        for (int ai = 0; ai < 2; ++ai)
#pragma unroll
            for (int m = 0; m < 4; ++m) { const int row = row0 + ai * HALF + m * 16; const float rs = slot >= 0 ? rc[4 + slot * 256 + (row - u.pm * BM)] : rstd_from16(ssq, row);
#pragma unroll
                for (int bj = 0; bj < 2; ++bj) { const int c = col0 + bj * HALF; if (c < ncols) {
                    const f32x4 v0 = acc[ai][bj][m][0] * rs + bv[bj][0], v1 = acc[ai][bj][m][1] * rs + bv[bj][1];
                    u32x4 w; w.x = cvt_pk_bf16(v0[0], v0[1]); w.y = cvt_pk_bf16(v0[2], v0[3]); w.z = cvt_pk_bf16(v1[0], v1[1]); w.w = cvt_pk_bf16(v1[2], v1[3]);
                    *(u32x4*)(Z + (size_t)row * ldz + c) = w; } } }
    }
};
template <bool WB> struct EpiResid {
    static constexpr bool PERM = false, AFTER_DRAIN = false;
    const float* base; float* out; bf16_t* outb; float* ssq; float scale;
    __device__ __forceinline__ void operator()(const f32x4 (&acc)[2][2][4][2], const Unit& u, int wr, int wc, int fr, int fq) const {
        const int row0 = u.pm * BM + wr * 64 + fr, col0 = u.pn * BM + wc * 32 + 4 * fq;
#pragma unroll
        for (int ai = 0; ai < 2; ++ai)
#pragma unroll
            for (int m = 0; m < 4; ++m) { const int row = row0 + ai * HALF + m * 16; const size_t off = (size_t)row * 1024 + col0; float ss = 0.f;
#pragma unroll
                for (int bj = 0; bj < 2; ++bj)
#pragma unroll
                    for (int n = 0; n < 2; ++n) { const size_t o2 = off + bj * HALF + n * 16; const f32x4 bs = *(const f32x4*)(base + o2); const f32x4 o = bs + acc[ai][bj][m][n] * scale;
                        *(f32x4*)(out + o2) = o; ss += (o[0] * o[0] + o[1] * o[1]) + (o[2] * o[2] + o[3] * o[3]);
                        if (WB) { u32x2 w; w.x = cvt_pk_bf16(o[0], o[1]); w.y = cvt_pk_bf16(o[2], o[3]); *(u32x2*)(outb + o2) = w; } }
                ss += __shfl_xor(ss, 16); ss += __shfl_xor(ss, 32);
                if (fq == 0) ssq[(size_t)row * 16 + u.pn * 4 + wc] = ss; }
    }
};
template <class Epi, class Sched, bool ALIGN_EPI = false, bool SP2 = false>
__device__ __forceinline__ void gemm_phase(PG8_LAS unsigned char* lds, const Gemm g, const Sched& S, const Epi& E) {
    const int tid = threadIdx.x, wid = __builtin_amdgcn_readfirstlane(tid >> 6), lane = tid & 63, wr = wid >> 2, wc = wid & 3, fr = lane & 15, fq = lane >> 4;
    const int K = g.K, nt = K / BK;
    unsigned voffA[2], voffB[2];
#pragma unroll
    for (int i = 0; i < 2; ++i) { int R, C; stage_rc(tid * 16 + i * 8192, R, C); const int Rb = Epi::PERM ? ((R & ~31) + perm32(R & 31)) : R;
        voffA[i] = (unsigned)(R * K + C) * 2u; voffB[i] = (unsigned)(Rb * K + C) * 2u; }
    const size_t kstep = (size_t)(BK * 2);
    const size_t hstep = (size_t)HALF * K * 2;
    const size_t tstep = 2 * hstep;
    const unsigned ldsw = (unsigned)wid * 1024u;
    const int aoff = lds_byte(wr * 64 + fr, fq * 8), boff = lds_byte(wc * 32 + fr, fq * 8);
#define PG8_SA(b, h) (((b) * 2 + (h)) * HTB)
#define PG8_SB(b, h) ((4 + (b) * 2 + (h)) * HTB)
#define PG8_STAGE(bufoff, gbase, voff) do { _Pragma("unroll") for (int _i = 0; _i < 2; ++_i) \
        __builtin_amdgcn_global_load_lds((const unsigned*)((const char*)(gbase) + (voff)[_i]), (PG8_LAS unsigned*)(lds + (bufoff) + ldsw + _i * 8192), 16, 0, 0); } while (0)
#define PG8_LDA(dst, b, h) do { _Pragma("unroll") for (int m = 0; m < 4; ++m) _Pragma("unroll") for (int k = 0; k < 2; ++k) dst[m][k] = *(const PG8_LAS bf16x8*)(lds + PG8_SA(b, h) + aoff + m * 2048 + k * 1024); } while (0)
#define PG8_LDB(dst, b, h) do { _Pragma("unroll") for (int n = 0; n < 2; ++n) _Pragma("unroll") for (int k = 0; k < 2; ++k) dst[n][k] = *(const PG8_LAS bf16x8*)(lds + PG8_SB(b, h) + boff + n * 2048 + k * 1024); } while (0)
#define PG8_MMA(ai, bj, At, Bt) do { __builtin_amdgcn_s_setprio(1); _Pragma("unroll") for (int m = 0; m < 4; ++m) _Pragma("unroll") for (int n = 0; n < 2; ++n) _Pragma("unroll") for (int k = 0; k < 2; ++k) \
        acc[ai][bj][m][n] = __builtin_amdgcn_mfma_f32_16x16x32_bf16(Bt[n][k], At[m][k], acc[ai][bj][m][n], 0, 0, 0); __builtin_amdgcn_s_setprio(0); } while (0)
#define PG8_WAIT_V(n) asm volatile("s_waitcnt vmcnt(" #n ")" ::: "memory")
#define PG8_WAIT_L(n) asm volatile("s_waitcnt lgkmcnt(" #n ")" ::: "memory")
#define PG8_BAR __builtin_amdgcn_s_barrier()
#define PG8_SCHED __builtin_amdgcn_sched_barrier(0)
    Unit cur, nxt; int ui = 0;
    if (!S.next(0, cur)) return;
    f32x4 acc[2][2][4][2];
#pragma unroll
    for (int a = 0; a < 2; ++a)
#pragma unroll
        for (int b = 0; b < 2; ++b)
#pragma unroll
            for (int m = 0; m < 4; ++m)
#pragma unroll
                for (int n = 0; n < 2; ++n) acc[a][b][m][n] = (f32x4){0.f, 0.f, 0.f, 0.f};
    bf16x8 At[4][2], B0[2][2], B1[2][2];
    const char* cA = (const char*)g.A + (size_t)cur.pm * tstep; const char* cB = (const char*)g.Bt + (size_t)cur.pn * tstep;
    S.a_ready(cur);
    if constexpr (SP2) {
        PG8_STAGE(PG8_SB(0, 0), cB, voffB); PG8_STAGE(PG8_SB(0, 1), cB + hstep, voffB); PG8_STAGE(PG8_SA(0, 0), cA, voffA); PG8_STAGE(PG8_SA(0, 1), cA + hstep, voffA);
        if (wr == 1) PG8_BAR;
        PG8_WAIT_V(2); PG8_BAR;
        PG8_STAGE(PG8_SB(1, 0), cB + kstep, voffB); PG8_STAGE(PG8_SA(1, 0), cA + kstep, voffA); PG8_STAGE(PG8_SB(1, 1), cB + hstep + kstep, voffB);
        PG8_WAIT_V(6); PG8_BAR;
    } else {
        PG8_STAGE(PG8_SB(0, 0), cB, voffB); PG8_STAGE(PG8_SA(0, 0), cA, voffA); PG8_STAGE(PG8_SB(0, 1), cB + hstep, voffB); PG8_STAGE(PG8_SA(0, 1), cA + hstep, voffA);
        if (wr == 1) PG8_BAR;
        PG8_WAIT_V(4); PG8_BAR;
        PG8_STAGE(PG8_SB(1, 0), cB + kstep, voffB); PG8_STAGE(PG8_SA(1, 0), cA + kstep, voffA); PG8_STAGE(PG8_SB(1, 1), cB + hstep + kstep, voffB);
        PG8_WAIT_V(6); PG8_BAR;
    }
    for (;;) {
        const bool has_next = S.next(ui + 1, nxt);
        const char* nA = has_next ? (const char*)g.A + (size_t)nxt.pm * tstep : cA; const char* nB = has_next ? (const char*)g.Bt + (size_t)nxt.pn * tstep : cB;
        for (int t = 0; t < nt; t += 2) {
            const bool last = (t == nt - 2);
            const char* a1 = cA + (size_t)(t + 1) * kstep;
            const char* a2 = last ? nA : cA + (size_t)(t + 2) * kstep; const char* b2 = last ? nB : cB + (size_t)(t + 2) * kstep;
            const char* a3 = a2 + kstep; const char* b3 = b2 + kstep;
            if (last && has_next) S.a_ready(nxt);
            if constexpr (SP2) {
            PG8_LDB(B0, 0, 0); PG8_LDB(B1, 0, 1); PG8_SCHED; PG8_LDA(At, 0, 0); PG8_STAGE(PG8_SA(1, 1), a1 + hstep, voffA);
            PG8_WAIT_V(8); PG8_WAIT_L(0); PG8_BAR; PG8_MMA(0, 0, At, B0); PG8_MMA(0, 1, At, B1); PG8_BAR; PG8_SCHED;
            PG8_LDA(At, 0, 1); PG8_STAGE(PG8_SB(0, 0), b2, voffB); PG8_STAGE(PG8_SB(0, 1), b2 + hstep, voffB); PG8_STAGE(PG8_SA(0, 0), a2, voffA);
            PG8_WAIT_V(8); PG8_WAIT_L(0); PG8_BAR; PG8_MMA(1, 0, At, B0); PG8_MMA(1, 1, At, B1); PG8_BAR; PG8_SCHED;
            PG8_LDB(B0, 1, 0); PG8_LDB(B1, 1, 1); PG8_SCHED; PG8_LDA(At, 1, 0); PG8_STAGE(PG8_SA(0, 1), a2 + hstep, voffA);
            PG8_WAIT_V(8); PG8_WAIT_L(0); PG8_BAR; PG8_MMA(0, 0, At, B0); PG8_MMA(0, 1, At, B1); PG8_BAR; PG8_SCHED;
            PG8_LDA(At, 1, 1); PG8_STAGE(PG8_SB(1, 0), b3, voffB); PG8_STAGE(PG8_SB(1, 1), b3 + hstep, voffB); PG8_STAGE(PG8_SA(1, 0), a3, voffA);
            PG8_WAIT_V(8); PG8_WAIT_L(0); PG8_BAR; PG8_MMA(1, 0, At, B0); PG8_MMA(1, 1, At, B1); PG8_BAR; PG8_SCHED;
            } else {
            PG8_LDB(B0, 0, 0); PG8_SCHED; PG8_LDA(At, 0, 0); PG8_STAGE(PG8_SA(1, 1), a1 + hstep, voffA);
            PG8_WAIT_L(8); PG8_BAR; PG8_WAIT_L(0); PG8_MMA(0, 0, At, B0); PG8_BAR; PG8_SCHED;
            PG8_LDB(B1, 0, 1); PG8_STAGE(PG8_SB(0, 0), b2, voffB);
            PG8_BAR; PG8_WAIT_L(0); PG8_MMA(0, 1, At, B1); PG8_BAR;
            PG8_LDA(At, 0, 1); PG8_STAGE(PG8_SA(0, 0), a2, voffA);
            PG8_BAR; PG8_WAIT_L(0); PG8_MMA(1, 0, At, B0); PG8_BAR; PG8_SCHED;
            PG8_STAGE(PG8_SB(0, 1), b2 + hstep, voffB);
            PG8_WAIT_V(6); PG8_BAR; PG8_MMA(1, 1, At, B1); PG8_BAR;
            PG8_LDB(B0, 1, 0); PG8_SCHED; PG8_LDA(At, 1, 0); PG8_STAGE(PG8_SA(0, 1), a2 + hstep, voffA);
            PG8_WAIT_L(8); PG8_BAR; PG8_WAIT_L(0); PG8_MMA(0, 0, At, B0); PG8_BAR; PG8_SCHED;
            PG8_LDB(B1, 1, 1); PG8_STAGE(PG8_SB(1, 0), b3, voffB);
            PG8_BAR; PG8_WAIT_L(0); PG8_MMA(0, 1, At, B1); PG8_BAR;
            PG8_LDA(At, 1, 1); PG8_STAGE(PG8_SA(1, 0), a3, voffA);
            PG8_BAR; PG8_WAIT_L(0); PG8_MMA(1, 0, At, B0); PG8_BAR; PG8_SCHED;
            PG8_STAGE(PG8_SB(1, 1), b3 + hstep, voffB);
            PG8_WAIT_V(6); PG8_BAR; PG8_MMA(1, 1, At, B1); PG8_BAR;
            }
        }
        if constexpr (ALIGN_EPI) { if (wr == 0) PG8_BAR; }
        if constexpr (!Epi::AFTER_DRAIN) { E(acc, cur, wr, wc, fr, fq); S.done(cur); }
        if (!has_next) break;
#pragma unroll
        for (int a = 0; a < 2; ++a)
#pragma unroll
            for (int b = 0; b < 2; ++b)
#pragma unroll
                for (int m = 0; m < 4; ++m)
#pragma unroll
                    for (int n = 0; n < 2; ++n) acc[a][b][m][n] = (f32x4){0.f, 0.f, 0.f, 0.f};
        cur = nxt; cA = nA; cB = nB; ++ui;
        if constexpr (ALIGN_EPI) { if (wr == 1) PG8_BAR; }
    }
    PG8_WAIT_V(0);
    if constexpr (!ALIGN_EPI) { if (wr == 0) PG8_BAR; }
    PG8_BAR;
    if constexpr (Epi::AFTER_DRAIN) { E.fused(acc, cur, wr, wc, fr, fq, lds, wid, lane); S.done(cur); }
#undef PG8_SA
#undef PG8_SB
#undef PG8_STAGE
#undef PG8_LDA
#undef PG8_LDB
#undef PG8_MMA
#undef PG8_WAIT_V
#undef PG8_WAIT_L
#undef PG8_BAR
#undef PG8_SCHED
}
}
#include <hip/hip_cooperative_groups.h>
namespace cg = cooperative_groups;
constexpr int NWAVES = 8;
constexpr int MR = 32768, DM = 1024, FF = 2816, NGU = 5632, NIN = 2464, NINP = 2560, TSEQ = 4096, NBATCH = 8, NHEAD = 8, NMETA = 16;
constexpr int ZC_W = 1536, ZC_Q = 1696, ZC_K = 2208, ZC_V = 2336;
constexpr int PV = 320;
constexpr size_t MiB = 1u << 20;
constexpr size_t WS_CTL = 0, CTL_ZERO_BYTES = 1 * MiB;
constexpr size_t WS_WGU1 = 2 * MiB, WS_WD1 = 13 * MiB, WS_WIN = 19 * MiB, WS_WOUT = 24 * MiB, WS_WGU2 = 26 * MiB, WS_WD2 = 37 * MiB, WS_LT = 43 * MiB;
constexpr size_t WS_SSQ1 = 44 * MiB, WS_SSQ2 = 46 * MiB, WS_SSQ3 = 48 * MiB, WS_SSQ4 = 50 * MiB, WS_META = 52 * MiB;
constexpr size_t MO_XMB = 0, MO_UM = 64 * 1024, MO_H1MB = 256 * 1024, MO_SSQM1 = 320 * 1024, MO_SSQM2 = 324 * 1024, MO_ZM = 384 * 1024, MO_PM = 512 * 1024;
constexpr size_t WS_XB = 56 * MiB, WS_BIG = 120 * MiB, WS_IMG = 274 * MiB, WS_P = 296 * MiB, WS_END = 507 * MiB;
constexpr int CW_BAR = 4096;
constexpr int RING_BYTES = 131072, LDSCTL_OFF = 143360, MISC_OFF = LDSCTL_OFF + 320, LDS_BYTES = 147456;

#define GAS __attribute__((address_space(1)))
#define LAS __attribute__((address_space(3)))
typedef unsigned short bf16;
typedef unsigned v4u __attribute__((ext_vector_type(4)));
typedef unsigned v2u __attribute__((ext_vector_type(2)));
typedef float f32x4 __attribute__((ext_vector_type(4)));
typedef float f32x2 __attribute__((ext_vector_type(2)));
typedef short bf16x8 __attribute__((ext_vector_type(8)));
typedef short bf16x4 __attribute__((ext_vector_type(4)));
typedef GAS unsigned gu32;
#define LDS_WAIT() asm volatile("s_waitcnt lgkmcnt(0)" ::: "memory")
__device__ __forceinline__ unsigned f2bf(float f) { unsigned u = __builtin_bit_cast(unsigned, f); return (u + 0x7fffu + ((u >> 16) & 1u)) >> 16; }
typedef __bf16 bf16x2_t __attribute__((ext_vector_type(2)));
__device__ __forceinline__ unsigned pk2m(float lo, float hi) { f32x2 v = {lo, hi}; bf16x2_t b = __builtin_convertvector(v, bf16x2_t); return __builtin_bit_cast(unsigned, b); }
__device__ __forceinline__ unsigned pk2(float lo, float hi) { return pg8::cvt_pk_bf16(lo, hi); }
__device__ __forceinline__ float bflo(unsigned w) { return __builtin_bit_cast(float, w << 16); }
__device__ __forceinline__ float bfhi(unsigned w) { return __builtin_bit_cast(float, w & 0xffff0000u); }
__device__ __forceinline__ f32x4 unpack4(v2u w) { return (f32x4){bflo(w.x), bfhi(w.x), bflo(w.y), bfhi(w.y)}; }
__device__ __forceinline__ float sigmoidf_(float x) { return __builtin_amdgcn_rcpf(1.0f + __builtin_amdgcn_exp2f(-1.4426950408889634f * x)); }
__device__ __forceinline__ float tanhf_(float x) { return 2.0f * sigmoidf_(2.0f * x) - 1.0f; }
#define XB_TMO      128
#define XB_XCNT(j)  (256  + 64 * (j))
#define XB_XSUB(j)  (1280 + 64 * (j))
#define XB_XGEN(j)  (2304 + 64 * (j))
#define XB_TOP      3328
#define XB_TOPGEN   3392
#define XCD_BAR_WORDS 3456
#define XB_SPIN_CAP (1u << 18)

__device__ __forceinline__ unsigned xb_ld(unsigned* p)              { return __hip_atomic_load(p, __ATOMIC_RELAXED, __HIP_MEMORY_SCOPE_AGENT); }
__device__ __forceinline__ unsigned xb_add(unsigned* p, unsigned v) { return __hip_atomic_fetch_add(p, v, __ATOMIC_RELAXED, __HIP_MEMORY_SCOPE_AGENT); }
__device__ __forceinline__ unsigned xb_xcc_id() { return (unsigned)__builtin_amdgcn_s_getreg((3 << 11) | 20) & 0xFu; }
#define XB_SPIN(cond, bar) do { unsigned _sp = 0; while (cond) { __builtin_amdgcn_s_sleep(1); \
    if ((++_sp & 255u) == 0u) { if (xb_ld(&(bar)[XB_TMO])) break; if (_sp > XB_SPIN_CAP) { atomicAdd(&(bar)[XB_TMO], 1u); break; } } } } while (0)

struct XcdBarrier {
    unsigned* bar; unsigned x;
    volatile LAS unsigned* st;
};

__device__ __forceinline__ XcdBarrier xcd_barrier_post(unsigned* bar, volatile LAS unsigned* st) {
    XcdBarrier b; b.bar = bar; b.x = xb_xcc_id(); b.st = st;
    if (threadIdx.x == 0) (void)xb_add(&bar[XB_XCNT(b.x)], 1u);
    return b;
}
__device__ __forceinline__ void xcd_barrier_complete(unsigned* bar, unsigned x, unsigned& nloc, unsigned& nx) {
    const unsigned G = gridDim.x * gridDim.y * gridDim.z;
    unsigned sum, cnt, mine, sp = 0u;
    for (;;) {
        sum = 0u; cnt = 0u; mine = 0u;
#pragma unroll
        for (unsigned j = 0; j < 16; ++j) { const unsigned c = xb_ld(&bar[XB_XCNT(j)]); sum += c; cnt += (c > 0u) ? 1u : 0u; mine = (j == x) ? c : mine; }
        if (sum == G) break;
        __builtin_amdgcn_s_sleep(1);
        if ((++sp & 255u) == 0u) { if (xb_ld(&bar[XB_TMO])) break; if (sp > XB_SPIN_CAP) { atomicAdd(&bar[XB_TMO], 1u); break; } }
    }
    nloc = mine > 0u ? mine : 1u; nx = cnt > 0u ? cnt : 1u;
}

__device__ __forceinline__ void xcd_barrier(const XcdBarrier& b) {
    asm volatile("s_waitcnt vmcnt(0)" ::: "memory");
    __syncthreads();
    if (threadIdx.x == 0) {
        unsigned* bar = b.bar;
        __builtin_amdgcn_s_waitcnt(0);
        unsigned nloc = b.st[0], nx = b.st[1];
        if (nloc == 0u) { xcd_barrier_complete(bar, b.x, nloc, nx); b.st[0] = nloc; b.st[1] = nx; }
        const unsigned old = xb_add(&bar[XB_XSUB(b.x)], 1u);
        const unsigned gen = old / nloc;
        if (old + 1u == (gen + 1u) * nloc) {
            __builtin_amdgcn_fence(__ATOMIC_RELEASE, "agent");
            asm volatile("s_waitcnt vmcnt(0)" ::: "memory");
            const unsigned og = xb_add(&bar[XB_TOP], 1u);
            const unsigned tg = og / nx;
            if (og + 1u == (tg + 1u) * nx) xb_add(&bar[XB_TOPGEN], 1u);
            else XB_SPIN(xb_ld(&bar[XB_TOPGEN]) == tg, bar);
            __builtin_amdgcn_fence(__ATOMIC_ACQUIRE, "agent");
            xb_add(&bar[XB_XGEN(b.x)], 1u);
            asm volatile("s_waitcnt vmcnt(0)" ::: "memory");
        } else {
            XB_SPIN(xb_ld(&bar[XB_XGEN(b.x)]) == gen, bar);
            __builtin_amdgcn_fence(__ATOMIC_ACQUIRE, "agent");
            asm volatile("s_waitcnt vmcnt(0)" ::: "memory");
        }
    }
    __syncthreads();
}
__device__ __forceinline__ float wave_sum(float v) {
#pragma unroll
    for (int o = 1; o < 64; o <<= 1) v += __shfl_xor(v, o);
    return v;
}
__device__ __forceinline__ void p0_transpose_item(const float* W, int K, int N, bf16* WT, const float* gain, int k0, int n0, int drow0, LAS float* scr, int lane) {
#pragma unroll
    for (int i = 0; i < 32; ++i) { const int kk = 2 * i + (lane >> 5); float w = W[(size_t)(k0 + kk) * N + n0 + (lane & 31)]; if (gain) w *= gain[k0 + kk]; scr[kk * 33 + (lane & 31)] = w; }
    LDS_WAIT(); asm volatile("" ::: "memory");
    const int c = lane & 7;
#pragma unroll
    for (int j = 0; j < 4; ++j) { const int n = (lane >> 3) + 8 * j; const LAS float* s = scr + (8 * c) * 33 + n;
        v4u o; o.x = pk2(s[0 * 33], s[1 * 33]); o.y = pk2(s[2 * 33], s[3 * 33]); o.z = pk2(s[4 * 33], s[5 * 33]); o.w = pk2(s[6 * 33], s[7 * 33]);
        *(GAS v4u*)(WT + (size_t)(drow0 + n) * K + k0 + 8 * c) = o; }
    LDS_WAIT(); asm volatile("" ::: "memory");
}
__device__ __forceinline__ void rows4_to_bf16(const float* const (&xrow)[4], bf16* const (&orow)[4], float* const (&ssq16)[4], int lane) {
    f32x4 v[4][4]; float s[4];
#pragma unroll
    for (int r = 0; r < 4; ++r) { const GAS f32x4* xr = (const GAS f32x4*)xrow[r] + lane;
#pragma unroll
        for (int j = 0; j < 4; ++j) v[r][j] = xr[64 * j]; }
#pragma unroll
    for (int r = 0; r < 4; ++r) { float a = 0.f;
#pragma unroll
        for (int j = 0; j < 4; ++j) a += (v[r][j].x * v[r][j].x + v[r][j].y * v[r][j].y) + (v[r][j].z * v[r][j].z + v[r][j].w * v[r][j].w);
        s[r] = a; }
#pragma unroll
    for (int o = 1; o < 64; o <<= 1) {
#pragma unroll
        for (int r = 0; r < 4; ++r) s[r] += __shfl_xor(s[r], o); }
#pragma unroll
    for (int r = 0; r < 4; ++r) { GAS v2u* o8 = (GAS v2u*)orow[r] + lane;
#pragma unroll
        for (int j = 0; j < 4; ++j) { v2u w; w.x = pk2(v[r][j].x, v[r][j].y); w.y = pk2(v[r][j].z, v[r][j].w); o8[64 * j] = w; }
        if (lane < 16) ssq16[r][lane] = (lane == 0) ? s[r] : 0.f; }
}
struct Ptrs {
    const float* in[27]; float* out; unsigned char* ws;
};
__device__ __forceinline__ void p0_transposes(const Ptrs& P, LAS unsigned char* lds, int part, int gw, int NGW, int wave, int lane) {
    unsigned char* ws = P.ws; LAS float* scr = (LAS float*)(lds + wave * 16384);
    constexpr int I_G = (DM / 64) * (FF / 32), I_D = (FF / 64) * (DM / 32), I_IN = (DM / 64) * (NIN / 32), I_O = (DM / 64) * (DM / 32);
    const int nitems = 2 * I_G + I_D + (part ? I_O : I_IN);
    for (int it = gw; it < nitems; it += NGW) {
        int r = it;
        if (r < 2 * I_G) { const int isup = r / I_G; r -= isup * I_G; const int nblk = FF / 32, kb = r / nblk, nb = r % nblk, n0 = 32 * nb;
            const float* W = P.in[part ? (isup ? 24 : 23) : (isup ? 4 : 3)]; const float* gain = P.in[part ? 22 : 2];
            bf16* WT = (bf16*)(ws + (part ? WS_WGU2 : WS_WGU1));
            const int drow0 = 256 * (n0 / 128) + 128 * isup + (n0 % 128);
            p0_transpose_item(W, DM, FF, WT, gain, 64 * kb, n0, drow0, scr, lane); continue; }
        r -= 2 * I_G;
        if (r < I_D) { const int nblk = DM / 32, kb = r / nblk, nb = r % nblk;
            p0_transpose_item(P.in[part ? 25 : 5], FF, DM, (bf16*)(ws + (part ? WS_WD2 : WS_WD1)), nullptr, 64 * kb, 32 * nb, 32 * nb, scr, lane); continue; }
        r -= I_D;
        if (!part) { const int nblk = NIN / 32, kb = r / nblk, nb = r % nblk;
            p0_transpose_item(P.in[7], DM, NIN, (bf16*)(ws + WS_WIN), P.in[6], 64 * kb, 32 * nb, 32 * nb, scr, lane); }
        else { const int nblk = DM / 32, kb = r / nblk, nb = r % nblk;
            p0_transpose_item(P.in[21], DM, DM, (bf16*)(ws + WS_WOUT), nullptr, 64 * kb, 32 * nb, 32 * nb, scr, lane); }
    }
}
__device__ __forceinline__ void p0_prologue(const Ptrs& P, LAS unsigned char* lds, int vcu, int G, int wave, int lane) {
    const int gw = vcu * NWAVES + wave, NGW = G * NWAVES;
    unsigned char* ws = P.ws;
    p0_transposes(P, lds, 0, gw, NGW, wave, lane);
    { GAS v4u* z = (GAS v4u*)(ws + WS_WIN + (size_t)NIN * DM * 2); const int n16 = (NINP - NIN) * DM * 2 / 16;
      for (int i = gw * 64 + lane; i < n16; i += NGW * 64) z[i] = (v4u){0u, 0u, 0u, 0u}; }
    { bf16* LT = (bf16*)(ws + WS_LT);
      for (int i = gw * 64 + lane; i < 512 * 160; i += NGW * 64) { const int n = i / 160, j = i % 160;
          const float v = j < 32 ? P.in[11][j * 512 + n] : j < 64 ? P.in[13][(j - 32) * 512 + n] : P.in[14][(j - 64) * 512 + n];
          LT[i] = (bf16)f2bf(v); } }
#ifndef REP_ROWS
#define REP_ROWS 1
#endif
    for (int rep_ = 0; rep_ < REP_ROWS; ++rep_)
    for (int m4 = gw; m4 < (MR + NMETA) / 4; m4 += NGW) { const float* xr[4]; bf16* orow[4]; float* sq[4];
#pragma unroll
        for (int r = 0; r < 4; ++r) { const int m = 4 * m4 + r;
            if (m < MR) { xr[r] = P.in[0] + (size_t)m * DM; orow[r] = (bf16*)(ws + WS_XB) + (size_t)m * DM; sq[r] = (float*)(ws + WS_SSQ1) + (size_t)m * 16; }
            else { const int i = m - MR; xr[r] = P.in[1] + (size_t)i * DM; orow[r] = (bf16*)(ws + WS_META + MO_XMB) + (size_t)i * DM; sq[r] = (float*)(ws + WS_META + MO_SSQM1) + i * 16; } }
        rows4_to_bf16(xr, orow, sq, lane); }
}
__device__ __forceinline__ f32x4 skinny16(const bf16* A, const bf16* Bt, int K, int n0, int lane) {
    const int fr = lane & 15, fq = lane >> 4;
    const bf16* ap = A + (size_t)fr * K + 8 * fq; const bf16* bp = Bt + (size_t)(n0 + fr) * K + 8 * fq;
    f32x4 acc = (f32x4){0.f, 0.f, 0.f, 0.f};
    for (int k = 0; k < K; k += 256) {
        bf16x8 a[8], b[8];
#pragma unroll
        for (int j = 0; j < 8; ++j) { a[j] = *(const bf16x8*)(ap + k + 32 * j); b[j] = *(const bf16x8*)(bp + k + 32 * j); }
#pragma unroll
        for (int j = 0; j < 8; ++j) acc = __builtin_amdgcn_mfma_f32_16x16x32_bf16(a[j], b[j], acc, 0, 0, 0); }
    return acc;
}
__device__ __forceinline__ float rstd_m16(const float* ssq16) { float s = 0.f;
#pragma unroll
    for (int i = 0; i < 16; ++i) s += ssq16[i];
    return __builtin_amdgcn_rsqf(s * (1.0f / 1024.0f) + 1e-5f); }
__device__ __forceinline__ void meta_up(unsigned char* ws, int gw, int NGW, int lane) {
    const bf16* A = (const bf16*)(ws + WS_META + MO_XMB); const bf16* Bt = (const bf16*)(ws + WS_WGU1); bf16* Um = (bf16*)(ws + WS_META + MO_UM);
    const float* ssq = (const float*)(ws + WS_META + MO_SSQM1); const int fr = lane & 15, fq = lane >> 4;
    for (int t = gw; t < FF / 16; t += NGW) { const int c0 = 16 * t, nr = 256 * (c0 / 128) + (c0 % 128);
        const f32x4 g = skinny16(A, Bt, DM, nr, lane), u = skinny16(A, Bt, DM, nr + 128, lane);
#pragma unroll
        for (int r = 0; r < 4; ++r) { const int row = 4 * fq + r; const float rs = rstd_m16(ssq + row * 16); Um[(size_t)row * FF + c0 + fr] = (bf16)f2bf(pg8::silu_mul(g[r] * rs, u[r] * rs)); } }
}
__device__ __forceinline__ void meta_down(const Ptrs& P, int gw, int NGW, int lane) {
    unsigned char* ws = P.ws; const bf16* A = (const bf16*)(ws + WS_META + MO_UM); const bf16* Bt = (const bf16*)(ws + WS_WD1); bf16* H = (bf16*)(ws + WS_META + MO_H1MB);
    float* ssq = (float*)(ws + WS_META + MO_SSQM2); const int fr = lane & 15, fq = lane >> 4;
    for (int t = gw; t < DM / 16; t += NGW) { const f32x4 a = skinny16(A, Bt, FF, 16 * t, lane);
#pragma unroll
        for (int r = 0; r < 4; ++r) { const int row = 4 * fq + r; const float o = P.in[1][row * DM + 16 * t + fr] + 0.5f * a[r]; H[row * DM + 16 * t + fr] = (bf16)f2bf(o);
            float s = o * o; s += __shfl_xor(s, 1); s += __shfl_xor(s, 2); s += __shfl_xor(s, 4); s += __shfl_xor(s, 8); if (fr == 0) ssq[row * 64 + t] = s; } }
}
__device__ __forceinline__ void meta_win(const Ptrs& P, int gw, int NGW, int lane) {
    unsigned char* ws = P.ws; const bf16* A = (const bf16*)(ws + WS_META + MO_H1MB); const bf16* Bt = (const bf16*)(ws + WS_WIN); bf16* Zm = (bf16*)(ws + WS_META + MO_ZM);
    const float* ssq = (const float*)(ws + WS_META + MO_SSQM2); const int fr = lane & 15, fq = lane >> 4;
    for (int t = gw; t < NIN / 16; t += NGW) { const f32x4 a = skinny16(A, Bt, DM, 16 * t, lane); const int c = 16 * t + fr; const float bias = c >= ZC_Q ? P.in[8][c - ZC_Q] : 0.f;
#pragma unroll
        for (int r = 0; r < 4; ++r) { const int row = 4 * fq + r; float s = 0.f;
#pragma unroll 8
            for (int i = 0; i < 64; ++i) s += ssq[row * 64 + i];
            Zm[(size_t)row * NIN + c] = (bf16)f2bf(a[r] * __builtin_amdgcn_rsqf(s * (1.0f / 1024.0f) + 1e-5f) + bias); } }
}
constexpr int KS_LD = 72, VT_LD = 232, ATT_KS_BYTES = 208 * KS_LD * 2, ATT_VT_BYTES = 64 * VT_LD * 2;
__device__ __forceinline__ void attn_unit(const Ptrs& P, unsigned char* lds, int b, int g, int c, int tid, int wave, int lane) {
    unsigned char* ws = P.ws; const bf16* Z = (const bf16*)(ws + WS_BIG); const bf16* Zm = (const bf16*)(ws + WS_META + MO_ZM); bf16* Y = (bf16*)(ws + WS_XB);
    bf16* Ks = (bf16*)lds; bf16* Vt = (bf16*)(lds + ATT_KS_BYTES);
    const int fr = lane & 15, fq = lane >> 4;
    __syncthreads();
    for (int it = tid; it < 208 * 8; it += NWAVES * 64) { const int key = it >> 3, pc = it & 7; const bf16* src; bool valid = true;
        if (key < 16) src = Zm + (size_t)key * NIN; else { const int t = 64 * (c - 2) + (key - 16); valid = t >= 0; src = Z + ((size_t)b * TSEQ + (valid ? t : 0)) * NIN; }
        v4u kq = *(const v4u*)(src + ZC_K + 64 * g + 8 * pc), vq = *(const v4u*)(src + ZC_V + 64 * g + 8 * pc);
        if (!valid) { kq = (v4u){0u, 0u, 0u, 0u}; vq = kq; }
        *(v4u*)(Ks + key * KS_LD + 8 * pc) = kq;
#pragma unroll
        for (int e = 0; e < 4; ++e) { Vt[(8 * pc + 2 * e) * VT_LD + key] = (bf16)(vq[e] & 0xffffu); Vt[(8 * pc + 2 * e + 1) * VT_LD + key] = (bf16)(vq[e] >> 16); } }
    for (int it = tid; it < 64 * 16; it += NWAVES * 64) Vt[(it >> 4) * VT_LD + 208 + (it & 15)] = 0;
    __syncthreads();
    const int hq = 4 * g + (wave >> 1);
    const float slope = __builtin_amdgcn_exp2f(-(float)(hq + 1)), sink = P.in[20][hq];
#pragma unroll 1
    for (int sub = 0; sub < 2; ++sub) {
        const int i0 = 16 * (2 * (wave & 1) + sub), iq = i0 + fr;
        const size_t mrow = (size_t)b * TSEQ + 64 * c + iq;
        const bf16x8 q0 = *(const bf16x8*)(Z + mrow * NIN + ZC_Q + 64 * hq + 8 * fq), q1 = *(const bf16x8*)(Z + mrow * NIN + ZC_Q + 64 * hq + 32 + 8 * fq);
        f32x4 s[13]; float mx = sink;
#pragma unroll
        for (int kt = 0; kt < 13; ++kt) { const bf16* kp = Ks + (16 * kt + fr) * KS_LD + 8 * fq; f32x4 a = (f32x4){0.f, 0.f, 0.f, 0.f};
            a = __builtin_amdgcn_mfma_f32_16x16x32_bf16(*(const bf16x8*)(kp), q0, a, 0, 0, 0);
            a = __builtin_amdgcn_mfma_f32_16x16x32_bf16(*(const bf16x8*)(kp + 32), q1, a, 0, 0, 0);
#pragma unroll
            for (int r = 0; r < 4; ++r) { const int key = 16 * kt + 4 * fq + r; float v;
                if (kt == 0) v = a[r] * 0.125f - slope * (float)(16 + 64 * c + iq - key);
                else { const int jj = key - 16; const int d = 128 + iq - jj; v = a[r] * 0.125f - slope * (float)(d < 0 ? -d : d); if (64 * (c - 2) + jj < 0) v = -1e30f; }
                a[r] = v; mx = fmaxf(mx, v); }
            s[kt] = a; }
        mx = fmaxf(mx, __shfl_xor(mx, 16)); mx = fmaxf(mx, __shfl_xor(mx, 32));
        float sum = 0.f;
#pragma unroll
        for (int kt = 0; kt < 13; ++kt)
#pragma unroll
            for (int r = 0; r < 4; ++r) { const float p = __builtin_amdgcn_exp2f((s[kt][r] - mx) * 1.4426950408889634f); s[kt][r] = p; sum += p; }
        sum += __shfl_xor(sum, 16); sum += __shfl_xor(sum, 32);
        sum += __builtin_amdgcn_exp2f((sink - mx) * 1.4426950408889634f);
        const float rinv = 1.0f / sum;
        f32x4 o[4];
#pragma unroll
        for (int dt = 0; dt < 4; ++dt) o[dt] = (f32x4){0.f, 0.f, 0.f, 0.f};
#pragma unroll
        for (int ks = 0; ks < 7; ++ks) { const int ta = 2 * ks, tb = 2 * ks + 1; v4u pw;
            pw.x = pk2(s[ta][0], s[ta][1]); pw.y = pk2(s[ta][2], s[ta][3]);
            if (tb < 13) { pw.z = pk2(s[tb][0], s[tb][1]); pw.w = pk2(s[tb][2], s[tb][3]); } else { pw.z = 0u; pw.w = 0u; }
            const bf16x8 pf = __builtin_bit_cast(bf16x8, pw);
#pragma unroll
            for (int dt = 0; dt < 4; ++dt) { const bf16* vp = Vt + (16 * dt + fr) * VT_LD + 4 * fq; const v2u va = *(const v2u*)(vp + 16 * ta), vb = *(const v2u*)(vp + 16 * tb);
                const v4u vv = (v4u){va.x, va.y, vb.x, vb.y};
                o[dt] = __builtin_amdgcn_mfma_f32_16x16x32_bf16(__builtin_bit_cast(bf16x8, vv), pf, o[dt], 0, 0, 0); } }
#pragma unroll
        for (int dt = 0; dt < 4; ++dt) { v2u w; w.x = pk2(o[dt][0] * rinv, o[dt][1] * rinv); w.y = pk2(o[dt][2] * rinv, o[dt][3] * rinv);
            *(v2u*)(Y + mrow * DM + 512 + 64 * hq + 16 * dt + 4 * fq) = w; }
    }
}
template <int CTRL> __device__ __forceinline__ float dppf(float x) { return __builtin_bit_cast(float, __builtin_amdgcn_update_dpp(0, __builtin_bit_cast(int, x), CTRL, 0xF, 0xF, true)); }
template <int CTRL> __device__ __forceinline__ float dppf_old(float old, float x) { return __builtin_bit_cast(float, __builtin_amdgcn_update_dpp(__builtin_bit_cast(int, old), __builtin_bit_cast(int, x), CTRL, 0xF, 0xF, false)); }
__device__ __forceinline__ float red8(float x) { x += dppf<0xB1>(x); x += dppf<0x4E>(x); x += dppf<0x141>(x); return x; }
__device__ __forceinline__ float red16(float x) { x = red8(x); x += dppf<0x140>(x); return x; }
__device__ __forceinline__ float scan16(float x) { x += dppf<0x111>(x); x += dppf<0x112>(x); x += dppf<0x114>(x); x += dppf<0x118>(x); return x; }
constexpr int NCHUNK = 257, NSUPER = 65;
constexpr int CB_A = 0, CB_R = 2048, CB_BK = 4096, CB_VT = 8192, CB_TT = 10240, CB_AR = 11264, CB_G = 12288, CB_BON = 12544, CB_SIZE = 12800;
constexpr int CB_GATE = 12800, IMG_SIZE = 14848;
constexpr int WL_HS = IMG_SIZE, WL_SIZE = IMG_SIZE + 2048;
constexpr int SC_YB = 8 * CB_SIZE, SC_END = SC_YB + 8 * 4096, SC_CST = 768;
static_assert(8 * WL_SIZE <= LDSCTL_OFF && SC_END + SC_CST <= LDSCTL_OFF, "LDS map");
__device__ __forceinline__ bf16x8 pack8(const float* v) { v4u o; o.x = pk2(v[0], v[1]); o.y = pk2(v[2], v[3]); o.z = pk2(v[4], v[5]); o.w = pk2(v[6], v[7]); return __builtin_bit_cast(bf16x8, o); }
__device__ __forceinline__ void unpack8(v4u w, float* v) { v[0] = bflo(w.x); v[1] = bfhi(w.x); v[2] = bflo(w.y); v[3] = bfhi(w.y); v[4] = bflo(w.z); v[5] = bfhi(w.z); v[6] = bflo(w.w); v[7] = bfhi(w.w); }


__device__ __forceinline__ void chunk_task(const Ptrs& P, unsigned char* ldsb, int woff, int b, int h, int ch, int lane) {
    int wo_ = woff; asm volatile("" : "+v"(wo_));
    unsigned char* wl = ldsb + wo_;
    unsigned char* ws = P.ws; const int fr = lane & 15, fq = lane >> 4, t = fr;
    const bf16* Z = (const bf16*)(ws + WS_BIG); const bf16* Zm = (const bf16*)(ws + WS_META + MO_ZM); const bf16* LT = (const bf16*)(ws + WS_LT);
    const bool meta = (ch == 0);
    const int tok = 16 * (ch - 1) + fr; const size_t m = (size_t)b * TSEQ + tok;
    const bf16* zc = meta ? Zm + (size_t)fr * NIN : Z + m * NIN;
    const bool pz = meta && fr == 0;
    const bf16* zp = meta ? Zm + (size_t)(fr > 0 ? fr - 1 : 0) * NIN : (tok == 0 ? Zm + (size_t)15 * NIN : Z + (m - 1) * NIN);
    const float* mu = P.in[9];
    bf16* sx = (bf16*)wl;
    {
    bf16x8 xf[5];
#pragma unroll
    for (int ks = 0; ks < 5; ++ks) { const int c0 = ZC_W + 32 * ks + 8 * fq; const v4u a = *(const v4u*)(zc + c0); v4u bq = *(const v4u*)(zp + c0); if (pz) bq = (v4u){0u, 0u, 0u, 0u};
        float va[8], vb[8], v[8]; unpack8(a, va); unpack8(bq, vb); const f32x4 m0 = *(const f32x4*)(mu + c0), m1 = *(const f32x4*)(mu + c0 + 4);
#pragma unroll
        for (int e = 0; e < 8; ++e) { const float mm = e < 4 ? m0[e & 3] : m1[e & 3]; const float z = va[e] + (vb[e] - va[e]) * mm; v[e] = (ks == 0) ? tanhf_(z) : (ks == 1) ? z : sigmoidf_(z); }
        xf[ks] = pack8(v); }
    f32x4 aw[4], aa[4], ag[4];
#pragma unroll
    for (int nt = 0; nt < 4; ++nt) { const bf16* lp = LT + (size_t)(h * 64 + 16 * nt + fr) * 160 + 8 * fq; const f32x4 z = (f32x4){0.f, 0.f, 0.f, 0.f};
        aw[nt] = __builtin_amdgcn_mfma_f32_16x16x32_bf16(*(const bf16x8*)(lp), xf[0], z, 0, 0, 0);
        aa[nt] = __builtin_amdgcn_mfma_f32_16x16x32_bf16(*(const bf16x8*)(lp + 32), xf[1], z, 0, 0, 0);
        ag[nt] = __builtin_amdgcn_mfma_f32_16x16x32_bf16(*(const bf16x8*)(lp + 64), xf[2], z, 0, 0, 0);
        ag[nt] = __builtin_amdgcn_mfma_f32_16x16x32_bf16(*(const bf16x8*)(lp + 96), xf[3], ag[nt], 0, 0, 0);
        ag[nt] = __builtin_amdgcn_mfma_f32_16x16x32_bf16(*(const bf16x8*)(lp + 128), xf[4], ag[nt], 0, 0, 0); }
    f32x4 kkr[4], kv[4], av[4]; float ss = 0.f;
#pragma unroll
    for (int nt = 0; nt < 4; ++nt) { const int c = h * 64 + 16 * nt + 4 * fq; const v2u a = *(const v2u*)(zc + 512 + c); v2u bq = *(const v2u*)(zp + 512 + c); if (pz) bq = (v2u){0u, 0u};
        const f32x4 za = unpack4(a), zb = unpack4(bq), mk = *(const f32x4*)(mu + 512 + c); const f32x4 zk = za + (zb - za) * mk;
        const f32x4 a0 = *(const f32x4*)(P.in[12] + c), kkw = *(const f32x4*)(P.in[15] + c), kaw = *(const f32x4*)(P.in[16] + c);
        f32x4 a_;
#pragma unroll
        for (int r = 0; r < 4; ++r) a_[r] = sigmoidf_(a0[r] + aa[nt][r]);
        av[nt] = a_; kkr[nt] = zk * kkw; kv[nt] = zk * (1.0f + (a_ - 1.0f) * kaw);
        ss += (kkr[nt][0] * kkr[nt][0] + kkr[nt][1] * kkr[nt][1]) + (kkr[nt][2] * kkr[nt][2] + kkr[nt][3] * kkr[nt][3]); }
    ss += __shfl_xor(ss, 16); ss += __shfl_xor(ss, 32);
    const float inv = 1.0f / fmaxf(sqrtf(ss), 1e-12f);
#pragma unroll
    for (int nt = 0; nt < 4; ++nt) { const int cl = 16 * nt + 4 * fq, c = h * 64 + cl; const f32x4 w0 = *(const f32x4*)(P.in[10] + c);
        const f32x4 kk = kkr[nt] * inv, bb = kk * av[nt]; f32x4 e;
#pragma unroll
        for (int r = 0; r < 4; ++r) e[r] = 0.6065306597126334f * sigmoidf_(w0[r] + aw[nt][r]);
        bf16* px = sx + t * 64 + cl; v2u o;
        o.x = pk2(kk[0], kk[1]); o.y = pk2(kk[2], kk[3]); *(v2u*)(px) = o;
        o.x = pk2(e[0], e[1]); o.y = pk2(e[2], e[3]); *(v2u*)(px + 1024) = o;
        o.x = pk2(bb[0], bb[1]); o.y = pk2(bb[2], bb[3]); *(v2u*)(px + 2048) = o;
        o.x = pk2(kv[nt][0], kv[nt][1]); o.y = pk2(kv[nt][2], kv[nt][3]); *(v2u*)(px + 3072) = o;
        o.x = pk2m(ag[nt][0], ag[nt][1]); o.y = pk2m(ag[nt][2], ag[nt][3]); *(v2u*)(px + 4096) = o; }
    }
    asm volatile("s_waitcnt lgkmcnt(0)" ::: "memory"); __builtin_amdgcn_sched_barrier(0);
    v4u xk[2], xe[2], xb[2], xx[2], xg[2];
#pragma unroll
    for (int ks = 0; ks < 2; ++ks) { const bf16* px = sx + t * 64 + 32 * ks + 8 * fq; xk[ks] = *(const v4u*)(px); xe[ks] = *(const v4u*)(px + 1024); xb[ks] = *(const v4u*)(px + 2048); xx[ks] = *(const v4u*)(px + 3072); xg[ks] = *(const v4u*)(px + 4096); }
    asm volatile("s_waitcnt lgkmcnt(0)" ::: "memory"); __builtin_amdgcn_sched_barrier(0);
    unsigned char* cb = wl; float* hs = (float*)(wl + WL_HS);
    const int cbase = h * 64 + 8 * fq;
    unsigned char* pbk = cb + CB_BK + ((((fq >> 1) * 4 + (t >> 2)) * 16 + 8 * (fq & 1)) * 8 + (t & 3)) * 2;
    unsigned char* pvt = cb + CB_VT + (((fq >> 1) * 4 + (t >> 2)) * 16 + 8 * (fq & 1)) * 8 + (t & 3) * 2;
    unsigned char* pgc = cb + CB_G + 8 * fq * 4;
    bf16x8 Af[2], Rf[2], Bf[2], Kf[2]; float bonp = 0.f;
#pragma unroll
    for (int ks = 0; ks < 2; ++ks) { const int c = cbase + 32 * ks, cl = 32 * ks + 8 * fq;
        asm volatile("" ::: "memory"); __builtin_amdgcn_sched_barrier(0);
        float kk[8], e_[8], bb[8], kx[8], rc[8], rp[8], vc[8], vp[8];
        unpack8(xk[ks], kk); unpack8(xe[ks], e_); unpack8(xb[ks], bb); unpack8(xx[ks], kx);
        unpack8(*(const v4u*)(zc + c), rc); unpack8(*(const v4u*)(zc + 1024 + c), vc);
        { v4u a = *(const v4u*)(zp + c), d = *(const v4u*)(zp + 1024 + c); if (pz) { a = (v4u){0u, 0u, 0u, 0u}; d = a; } unpack8(a, rp); unpack8(d, vp); }
        float At[8], Rt[8], Bt[8], Kt[8]; float mur[8], muv[8], rkk[8];
        { const f32x4 a0 = *(const f32x4*)(P.in[9] + c), a1 = *(const f32x4*)(P.in[9] + c + 4), b0 = *(const f32x4*)(P.in[9] + 1024 + c), b1 = *(const f32x4*)(P.in[9] + 1024 + c + 4), c0 = *(const f32x4*)(P.in[17] + c), c1 = *(const f32x4*)(P.in[17] + c + 4);
#pragma unroll
          for (int e = 0; e < 4; ++e) { mur[e] = a0[e]; mur[4 + e] = a1[e]; muv[e] = b0[e]; muv[4 + e] = b1[e]; rkk[e] = c0[e]; rkk[4 + e] = c1[e]; } }
#pragma unroll
        for (int e = 0; e < 8; ++e) { const float rr = rc[e] + (rp[e] - rc[e]) * mur[e]; const float vv = vc[e] + (vp[e] - vc[e]) * muv[e];
            bonp += rr * kx[e] * rkk[e];
            const float ec = scan16(e_[e]), etot = red16(e_[e]);
            const float g1 = __builtin_amdgcn_exp2f(-1.4426950408889634f * ec);
            const float gi = __builtin_amdgcn_exp2f(1.4426950408889634f * ec);
            const float gC = __builtin_amdgcn_exp2f(-1.4426950408889634f * etot);
            const float g0 = dppf_old<0x111>(1.0f, g1);
            At[e] = -kk[e] * g0; Rt[e] = rr * g1; Bt[e] = bb[e] * gi; Kt[e] = kx[e] * gi;
            const int ke = 32 * ks + e;
            *(bf16*)(pbk + ks * 2048 + e * 16) = (bf16)f2bf(Bt[e] * gC);
            *(bf16*)(pbk + ks * 2048 + e * 16 + 8) = (bf16)f2bf(Kt[e] * gC);
            *(bf16*)(pvt + ks * 1024 + e * 8) = (bf16)f2bf(vv);
            if (t == 15) *(float*)(pgc + ke * 4) = gC; }
        Af[ks] = pack8(At); Rf[ks] = pack8(Rt); Bf[ks] = pack8(Bt); Kf[ks] = pack8(Kt);
        { const int fqs = 2 * (fq & 1), bo = (fq >> 1) * 8; const v4u aw = __builtin_bit_cast(v4u, Af[ks]), rw = __builtin_bit_cast(v4u, Rf[ks]);
          *(v2u*)(cb + CB_A + ((ks * 4 + fqs) * 16 + t) * 16 + bo) = (v2u){aw.x, aw.y}; *(v2u*)(cb + CB_A + ((ks * 4 + fqs + 1) * 16 + t) * 16 + bo) = (v2u){aw.z, aw.w};
          *(v2u*)(cb + CB_R + ((ks * 4 + fqs) * 16 + t) * 16 + bo) = (v2u){rw.x, rw.y}; *(v2u*)(cb + CB_R + ((ks * 4 + fqs + 1) * 16 + t) * 16 + bo) = (v2u){rw.z, rw.w}; }
        *(v4u*)(cb + CB_GATE + (t * 64 + cl) * 2) = xg[ks]; }
    asm volatile("" ::: "memory"); __builtin_amdgcn_sched_barrier(0);
    bonp += __shfl_xor(bonp, 16); bonp += __shfl_xor(bonp, 32);
    if (fq == 0) *(float*)(cb + CB_BON + t * 4) = bonp;
    const f32x4 z4 = (f32x4){0.f, 0.f, 0.f, 0.f};
    f32x4 Mab = __builtin_amdgcn_mfma_f32_16x16x32_bf16(Af[0], Bf[0], z4, 0, 0, 0); Mab = __builtin_amdgcn_mfma_f32_16x16x32_bf16(Af[1], Bf[1], Mab, 0, 0, 0);
    f32x4 Mak = __builtin_amdgcn_mfma_f32_16x16x32_bf16(Af[0], Kf[0], z4, 0, 0, 0); Mak = __builtin_amdgcn_mfma_f32_16x16x32_bf16(Af[1], Kf[1], Mak, 0, 0, 0);
    f32x4 Mrb = __builtin_amdgcn_mfma_f32_16x16x32_bf16(Rf[0], Bf[0], z4, 0, 0, 0); Mrb = __builtin_amdgcn_mfma_f32_16x16x32_bf16(Rf[1], Bf[1], Mrb, 0, 0, 0);
    f32x4 Mrk = __builtin_amdgcn_mfma_f32_16x16x32_bf16(Rf[0], Kf[0], z4, 0, 0, 0); Mrk = __builtin_amdgcn_mfma_f32_16x16x32_bf16(Rf[1], Kf[1], Mrk, 0, 0, 0);
#pragma unroll
    for (int r = 0; r < 4; ++r) { const int tt = 4 * fq + r, i = fr;
        const float mab = (tt > i) ? Mab[r] : 0.f, mak = (tt > i) ? Mak[r] : 0.f, mrb = (tt >= i) ? Mrb[r] : 0.f, mrk = (tt >= i) ? Mrk[r] : 0.f;
        hs[tt * 16 + i] = mab; hs[256 + tt * 16 + i] = mak;
        const unsigned w = pk2m(mrb, mrk);
        *(bf16*)(cb + CB_AR + (((i >> 2) * 16 + tt) * 8 + (i & 3)) * 2) = (bf16)(w & 0xffffu);
        *(bf16*)(cb + CB_AR + (((i >> 2) * 16 + tt) * 8 + 4 + (i & 3)) * 2) = (bf16)(w >> 16); }
    asm volatile("s_waitcnt lgkmcnt(0)" ::: "memory");
    { const int c = lane & 31, cc = c & 15; const bool isT = c < 16; float out[16];
#pragma unroll
      for (int tt = 0; tt < 16; ++tt) { float acc = isT ? (tt == cc ? 1.0f : 0.0f) : hs[256 + tt * 16 + cc];
#pragma unroll
          for (int i4 = 0; i4 < (tt + 3) / 4; ++i4) { const f32x4 l = *(const f32x4*)(hs + tt * 16 + 4 * i4);
#pragma unroll
              for (int e = 0; e < 4; ++e) if (4 * i4 + e < tt) acc += l[e] * out[4 * i4 + e]; }
          out[tt] = acc;
          if (lane < 32) *(bf16*)(cb + CB_TT + (((cc >> 2) * 16 + tt) * 8 + (isT ? 0 : 4) + (cc & 3)) * 2) = (bf16)f2bf(acc); } }
    asm volatile("s_waitcnt lgkmcnt(0)" ::: "memory");
    { unsigned char* gi = ws + WS_IMG + ((size_t)(b * NHEAD + h) * NCHUNK + ch) * IMG_SIZE;
      for (int i = lane; i < IMG_SIZE / 16; i += 64) *(v4u*)(gi + i * 16) = *(const v4u*)(cb + i * 16); }
    asm volatile("s_waitcnt lgkmcnt(0)" ::: "memory"); __builtin_amdgcn_sched_barrier(0);
}

struct ScanOps { bf16x8 a0, a1, r0, r1, tt, ar, bk[4]; v2u vt; f32x4 g[4]; };
__device__ __forceinline__ void scan_load(ScanOps& o, const unsigned char* ib, int fr, int fq, int vcol) {
    const int ln = (fq * 16 + fr) * 16;
    o.a0 = *(const bf16x8*)(ib + CB_A + ln); o.a1 = *(const bf16x8*)(ib + CB_A + 1024 + ln);
    o.r0 = *(const bf16x8*)(ib + CB_R + ln); o.r1 = *(const bf16x8*)(ib + CB_R + 1024 + ln);
    o.tt = *(const bf16x8*)(ib + CB_TT + ln); o.ar = *(const bf16x8*)(ib + CB_AR + ln);
    o.vt = *(const v2u*)(ib + CB_VT + (((vcol >> 4) * 4 + fq) * 16 + fr) * 8);
#pragma unroll
    for (int kt = 0; kt < 4; ++kt) { o.g[kt] = *(const f32x4*)(ib + CB_G + (16 * kt + 4 * fq) * 4); o.bk[kt] = *(const bf16x8*)(ib + CB_BK + kt * 1024 + ln); }
}
__device__ __forceinline__ void scan_step(f32x4 (&H)[4], const ScanOps& o, float* yb, int fq, int vcol) {
    v4u hb0, hb1;
    hb0.x = pk2m(H[0][0], H[0][1]); hb0.y = pk2m(H[0][2], H[0][3]); hb0.z = pk2m(H[1][0], H[1][1]); hb0.w = pk2m(H[1][2], H[1][3]);
    hb1.x = pk2m(H[2][0], H[2][1]); hb1.y = pk2m(H[2][2], H[2][3]); hb1.z = pk2m(H[3][0], H[3][1]); hb1.w = pk2m(H[3][2], H[3][3]);
    const bf16x8 h0 = __builtin_bit_cast(bf16x8, hb0), h1 = __builtin_bit_cast(bf16x8, hb1);
    const f32x4 z4 = (f32x4){0.f, 0.f, 0.f, 0.f};
    f32x4 X = __builtin_amdgcn_mfma_f32_16x16x32_bf16(o.a0, h0, z4, 0, 0, 0); X = __builtin_amdgcn_mfma_f32_16x16x32_bf16(o.a1, h1, X, 0, 0, 0);
    f32x4 Y = __builtin_amdgcn_mfma_f32_16x16x32_bf16(o.r0, h0, z4, 0, 0, 0); Y = __builtin_amdgcn_mfma_f32_16x16x32_bf16(o.r1, h1, Y, 0, 0, 0);
    v4u xb; xb.x = pk2m(X[0], X[1]); xb.y = pk2m(X[2], X[3]); xb.z = o.vt.x; xb.w = o.vt.y;
    const f32x4 U = __builtin_amdgcn_mfma_f32_16x16x32_bf16(o.tt, __builtin_bit_cast(bf16x8, xb), z4, 0, 0, 0);
    v4u ub; ub.x = pk2m(U[0], U[1]); ub.y = pk2m(U[2], U[3]); ub.z = o.vt.x; ub.w = o.vt.y;
    const bf16x8 uf = __builtin_bit_cast(bf16x8, ub);
    Y = __builtin_amdgcn_mfma_f32_16x16x32_bf16(o.ar, uf, Y, 0, 0, 0);
#pragma unroll
    for (int kt = 0; kt < 4; ++kt) H[kt] = __builtin_amdgcn_mfma_f32_16x16x32_bf16(o.bk[kt], uf, H[kt] * o.g[kt], 0, 0, 0);
#pragma unroll
    for (int r = 0; r < 4; ++r) yb[(4 * fq + r) * 64 + vcol] = Y[r];
}
__device__ __forceinline__ void scan_phase(const Ptrs& P, unsigned char* lds, int sb, int tid, int wave, int lane, int never) {
    const int b = sb >> 3, h = sb & 7, fr = lane & 15, fq = lane >> 4;
    const unsigned char* img = P.ws + WS_IMG + (size_t)(b * NHEAD + h) * NCHUNK * IMG_SIZE;
    if (wave < 4) {
        f32x4 H[4];
#pragma unroll
        for (int kt = 0; kt < 4; ++kt) H[kt] = (f32x4){0.f, 0.f, 0.f, 0.f};
        const int vcol = 16 * wave + fr;
#pragma unroll 1
        for (int s = 0; s <= NSUPER + 1; ++s) {
            __syncthreads();
            if (s < 1 || s > NSUPER) continue;
            const int set = (s - 1) & 1;
#pragma unroll 1
            for (int j = 0; j < 4; ++j) { const int ch = 4 * (s - 1) + j; if (ch >= NCHUNK) break;
                ScanOps o; scan_load(o, lds + (set * 4 + j) * CB_SIZE, fr, fq, vcol);
                scan_step(H, o, (float*)(lds + SC_YB + (set * 4 + j) * 4096), fq, vcol); }
        }
    } else {
        const int hw = wave - 4, t = fr;
        const bf16* Z = (const bf16*)(P.ws + WS_BIG); const bf16* Zm = (const bf16*)(P.ws + WS_META + MO_ZM);
        bf16* Yo = (bf16*)(P.ws + WS_XB);
        const int cbase = h * 64 + 8 * fq;
        float* cst = (float*)(lds + SC_END);
        if (lane < 48) { const int a_ = lane >> 4, c4 = (lane & 15) * 4; const float* src = a_ == 0 ? P.in[9] + 1024 + h * 64 : a_ == 1 ? P.in[18] + h * 64 : P.in[19] + h * 64;
            *(f32x4*)(cst + a_ * 64 + c4) = *(const f32x4*)(src + c4); }
        v4u cg0[2], cg1[2]; v4u im0[13], im1[13];
        const int pvt_off = CB_VT + (((fq >> 1) * 4 + (t >> 2)) * 16 + 8 * (fq & 1)) * 8 + (t & 3) * 2;
#define GLD16(dst, ptr) asm volatile("global_load_dwordx4 %0, %1, off" : "=v"(dst) : "v"(ptr) : "memory")
#define GLD4(dst, ptr) asm volatile("global_load_dword %0, %1, off" : "=v"(dst) : "v"(ptr) : "memory")
#define IMG_LOAD(IM, chx) do { const unsigned char* ip_ = img + (size_t)(chx) * IMG_SIZE + lane * 16; _Pragma("unroll") for (int i_ = 0; i_ < 13; ++i_) GLD16(IM[i_], ip_ + i_ * 1024); } while (0)
#define VM_WAIT_ALL(N) asm volatile("s_waitcnt vmcnt(" #N ")" : "+v"(im0[0]), "+v"(im0[1]), "+v"(im0[2]), "+v"(im0[3]), "+v"(im0[4]), "+v"(im0[5]), "+v"(im0[6]), "+v"(im0[7]), "+v"(im0[8]), "+v"(im0[9]), "+v"(im0[10]), "+v"(im0[11]), "+v"(im0[12]), \
            "+v"(im1[0]), "+v"(im1[1]), "+v"(im1[2]), "+v"(im1[3]), "+v"(im1[4]), "+v"(im1[5]), "+v"(im1[6]), "+v"(im1[7]), "+v"(im1[8]), "+v"(im1[9]), "+v"(im1[10]), "+v"(im1[11]), "+v"(im1[12]) :: "memory")
#define VM_WAIT_POST(N) asm volatile("s_waitcnt vmcnt(" #N ")" : "+v"(cg0[0]), "+v"(cg0[1]), "+v"(cg1[0]), "+v"(cg1[1]) :: "memory")
#define POST_LOAD(CG, sx) do { int chn_ = 4 * ((sx) - 2) + hw; chn_ = chn_ < 1 ? 1 : (chn_ >= NCHUNK ? NCHUNK - 1 : chn_);     \
            const unsigned char* ib_ = img + (size_t)chn_ * IMG_SIZE; \
            _Pragma("unroll") for (int ks = 0; ks < 2; ++ks) GLD16(CG[ks], ib_ + CB_GATE + (t * 64 + 32 * ks + 8 * fq) * 2); } while (0)
        POST_LOAD(cg0, 0); IMG_LOAD(im0, hw);
        POST_LOAD(cg1, 1); IMG_LOAD(im1, 4 + hw);
#define HELPER_ITER(IM, CG) do { \
            __syncthreads(); \
            VM_WAIT_ALL(15); VM_WAIT_POST(15);        \
            unsigned char* cbw = lds + ((s & 1) * 4 + hw) * CB_SIZE;            \
            { const int ch = 4 * (s - 2) + hw; \
              if (s >= 2 && ch >= 1 && ch < NCHUNK) { const float* yb = (const float*)(lds + SC_YB + ((s & 1) * 4 + hw) * 4096); \
                const int tok = 16 * (ch - 1) + t; const size_t m = (size_t)b * TSEQ + tok; \
                float y[16]; float sm = 0.f; \
                _Pragma("unroll") for (int ks = 0; ks < 2; ++ks) { const f32x4 y0 = *(const f32x4*)(yb + t * 64 + 32 * ks + 8 * fq), y1 = *(const f32x4*)(yb + t * 64 + 32 * ks + 8 * fq + 4); \
                    _Pragma("unroll") for (int e = 0; e < 4; ++e) { y[8 * ks + e] = y0[e]; y[8 * ks + 4 + e] = y1[e]; sm += y0[e] + y1[e]; } } \
                sm += __shfl_xor(sm, 16); sm += __shfl_xor(sm, 32); const float mean = sm * (1.0f / 64.0f); float sq = 0.f; \
                _Pragma("unroll") for (int i = 0; i < 16; ++i) { y[i] -= mean; sq += y[i] * y[i]; } \
                sq += __shfl_xor(sq, 16); sq += __shfl_xor(sq, 32); const float rs = __builtin_amdgcn_rsqf(sq * (1.0f / 64.0f) + 64e-5f); \
                const float bon = *(const float*)(cbw + CB_BON + t * 4); \
                _Pragma("unroll") for (int ks = 0; ks < 2; ++ks) { const int c = cbase + 32 * ks; \
                    float g[8], o[8]; unpack8(CG[ks], g); \
                    const float* cq = cst + 32 * ks + 8 * fq; const f32x4 wA = *(const f32x4*)(cq + 64), wB = *(const f32x4*)(cq + 68), bA = *(const f32x4*)(cq + 128), bB = *(const f32x4*)(cq + 132); \
                    _Pragma("unroll") for (int e = 0; e < 8; ++e) { const float lw_ = e < 4 ? wA[e & 3] : wB[e & 3], lb_ = e < 4 ? bA[e & 3] : bB[e & 3]; \
                        const float vv = __builtin_bit_cast(float, (unsigned)(*(const bf16*)(cbw + pvt_off + ks * 1024 + e * 8)) << 16); \
                        o[e] = (y[8 * ks + e] * rs * lw_ + lb_ + bon * vv) * g[e]; } \
                    *(bf16x8*)(Yo + m * DM + c) = pack8(o); } } } \
            asm volatile("s_waitcnt lgkmcnt(0)" ::: "memory");                   \
            if (4 * s + hw < NCHUNK) { \
                _Pragma("unroll") for (int i_ = 0; i_ < 13; ++i_) if (i_ < 12 || lane < 32) *(v4u*)(cbw + (i_ * 64 + lane) * 16) = IM[i_]; } \
            POST_LOAD(CG, s + 2); \
            { const int cl_ = 4 * (s + 2) + hw; IMG_LOAD(IM, cl_ < NCHUNK ? cl_ : NCHUNK - 1); } \
        } while (0)
#pragma unroll 1
        for (int s2 = 0; s2 <= NSUPER + 1; s2 += 2) {
            { const int s = s2; HELPER_ITER(im0, cg0); }
            if (s2 + 1 <= NSUPER + 1) { const int s = s2 + 1; HELPER_ITER(im1, cg1); }
        }
        asm volatile("s_waitcnt vmcnt(0)" ::: "memory");
#undef HELPER_ITER
#undef POST_LOAD
#undef VM_WAIT_ALL
#undef VM_WAIT_POST
#undef GLD16
#undef GLD4
#undef IMG_LOAD
    }
}
__device__ __forceinline__ void final_norm(const Ptrs& P, int gw, int NGW, int lane) {
    const float* ssq = (const float*)(P.ws + WS_SSQ4); const GAS f32x4* g4 = (const GAS f32x4*)P.in[26] + lane;
    f32x4 g[4];
#pragma unroll
    for (int j = 0; j < 4; ++j) g[j] = g4[64 * j];
    for (int m = gw; m < MR; m += NGW) { const float rs = pg8::rstd_from16(ssq, m); GAS f32x4* o = (GAS f32x4*)(P.out + (size_t)m * DM) + lane;
#pragma unroll
        for (int j = 0; j < 4; ++j) o[64 * j] = o[64 * j] * rs * g[j]; }
}
#ifndef MK_N_LAUNCHES
#define MK_N_LAUNCHES 1
#endif
constexpr int N_PHASES = 10;
struct Args { Ptrs p; int ph_lo, ph_hi, use_cg, pad; };
__global__ void __launch_bounds__(NWAVES * 64, 2) hymba_fwd(Args args) {
    extern __shared__ __attribute__((aligned(16))) unsigned char lds[];
    LAS unsigned char* ldsl = (LAS unsigned char*)lds;
    volatile LAS unsigned* MISC = (volatile LAS unsigned*)(ldsl + MISC_OFF);
    const int tid = threadIdx.x, lane = tid & 63, wave = __builtin_amdgcn_readfirstlane(tid >> 6);
    const int G = gridDim.x, bx = blockIdx.x, vcu = (G % 8 == 0) ? (bx % 8) * (G / 8) + bx / 8 : bx;
    const Ptrs& P = args.p; unsigned char* ws = P.ws;
    if (args.use_cg) cg::this_grid().sync();
    for (int u = tid; u < (LDS_BYTES - LDSCTL_OFF) / 4; u += NWAVES * 64) ((LAS unsigned*)(ldsl + LDSCTL_OFF))[u] = 0u;
    __syncthreads();
    const int lo = args.ph_lo, hi = args.ph_hi;
    XcdBarrier bar; bar.bar = (unsigned*)(ws + WS_CTL) + CW_BAR; bar.x = 0; bar.st = nullptr;
    if (hi - lo > 1) bar = xcd_barrier_post((unsigned*)(ws + WS_CTL) + CW_BAR, MISC + 8);
#define IN(k) (lo <= (k) && (k) < hi)
#define SEAM(k) do { if (IN(k) && IN((k) + 1)) xcd_barrier(bar); } while (0)
    const int gw = vcu * NWAVES + wave, NGW = G * NWAVES;
    const int gwm = bx + G * wave;

#ifndef REP_P0
#define REP_P0 1
#endif
    if (IN(0)) { for (int rep = 0; rep < REP_P0; ++rep) p0_prologue(P, ldsl, vcu, G, wave, lane); SEAM(0); }
    if (IN(1)) {
        meta_up(ws, gwm, NGW, lane);
        pg8::Gemm g{(const bf16*)(ws + WS_XB), (const bf16*)(ws + WS_WGU1), MR, NGU, DM}; pg8::StaticOrder S; S.init(MR, NGU, G, bx);
        LAS float* rcache = (LAS float*)(ldsl + RING_BYTES); pg8::fill_rstd_cache(rcache, (const float*)(ws + WS_SSQ1), S);
        pg8::EpiSwiglu E{(bf16*)(ws + WS_BIG), (const float*)(ws + WS_SSQ1), FF, rcache};
#ifndef REP_P1
#define REP_P1 1
#endif
        for (int rep = 0; rep < REP_P1; ++rep) pg8::gemm_phase<pg8::EpiSwiglu, pg8::StaticOrder, true, true>(ldsl, g, S, E);
        SEAM(1);
    }
    if (IN(2)) {
        meta_down(P, gwm, NGW, lane);
        pg8::Gemm g{(const bf16*)(ws + WS_BIG), (const bf16*)(ws + WS_WD1), MR, DM, FF}; pg8::StaticOrder S; S.init(MR, DM, G, bx);
        pg8::EpiResid<true> E{P.in[0], P.out, (bf16*)(ws + WS_XB), (float*)(ws + WS_SSQ2), 0.5f};
#ifndef REP_P2
#define REP_P2 1
#endif
        for (int rep = 0; rep < REP_P2; ++rep) pg8::gemm_phase<pg8::EpiResid<true>, pg8::StaticOrder, true, true>(ldsl, g, S, E);
        SEAM(2);
    }
    if (IN(3)) {
        meta_win(P, gwm, NGW, lane);
        pg8::Gemm g{(const bf16*)(ws + WS_XB), (const bf16*)(ws + WS_WIN), MR, NINP, DM}; pg8::StaticOrder S; S.init(MR, NINP, G, bx);
        LAS float* rcache = (LAS float*)(ldsl + RING_BYTES); pg8::fill_rstd_cache(rcache, (const float*)(ws + WS_SSQ2), S);
        pg8::EpiZ E{(bf16*)(ws + WS_BIG), (const float*)(ws + WS_SSQ2), P.in[8], NIN, NIN, ZC_Q, rcache};
        pg8::gemm_phase<pg8::EpiZ, pg8::StaticOrder, true, true>(ldsl, g, S, E);
        SEAM(3);
    }
    if (IN(4)) {
#ifndef REP_PREP
#define REP_PREP 1
#endif
        for (int rep = 0; rep < REP_PREP; ++rep) for (int task = gw; task < NBATCH * NHEAD * NCHUNK; task += NGW) { const int bc = task >> 3; chunk_task(P, lds, wave * WL_SIZE, bc / NCHUNK, task & 7, bc % NCHUNK, lane); }
        SEAM(4);
    }
    if (IN(5)) {
#ifndef REP_SCAN
#define REP_SCAN 1
#endif
#ifndef REP_ATTN
#define REP_ATTN 1
#endif
        if (bx < 64) { for (int rep = 0; rep < REP_SCAN; ++rep) { scan_phase(P, lds, bx, tid, wave, lane, args.use_cg); __syncthreads(); } }
        else { for (int rep = 0; rep < REP_ATTN; ++rep) for (int u = bx - 64; u < NBATCH * 2 * 64; u += G - 64) attn_unit(P, lds, u >> 7, (u >> 6) & 1, u & 63, tid, wave, lane);
            __syncthreads();
#ifndef REP_TR1
#define REP_TR1 1
#endif
            for (int rep = 0; rep < REP_TR1; ++rep) p0_transposes(P, ldsl, 1, (bx - 64) * NWAVES + wave, (G - 64) * NWAVES, wave, lane); }
        __syncthreads();
        SEAM(5);
    }
    if (IN(6)) {
        pg8::Gemm g{(const bf16*)(ws + WS_XB), (const bf16*)(ws + WS_WOUT), MR, DM, DM}; pg8::StaticOrder S; S.init(MR, DM, G, bx);
        pg8::EpiResid<true> E{P.out, P.out, (bf16*)(ws + WS_P), (float*)(ws + WS_SSQ3), 1.0f};
        pg8::gemm_phase<pg8::EpiResid<true>, pg8::StaticOrder, true, true>(ldsl, g, S, E);
        SEAM(6);
    }
    if (IN(7)) {
        pg8::Gemm g{(const bf16*)(ws + WS_P), (const bf16*)(ws + WS_WGU2), MR, NGU, DM}; pg8::StaticOrder S; S.init(MR, NGU, G, bx);
        LAS float* rcache = (LAS float*)(ldsl + RING_BYTES); pg8::fill_rstd_cache(rcache, (const float*)(ws + WS_SSQ3), S);
        pg8::EpiSwiglu E{(bf16*)(ws + WS_BIG), (const float*)(ws + WS_SSQ3), FF, rcache};
        pg8::gemm_phase<pg8::EpiSwiglu, pg8::StaticOrder, true, true>(ldsl, g, S, E);
        SEAM(7);
    }
    if (IN(8)) {
        pg8::Gemm g{(const bf16*)(ws + WS_BIG), (const bf16*)(ws + WS_WD2), MR, DM, FF}; pg8::StaticOrder S; S.init(MR, DM, G, bx);
        pg8::EpiResid<false> E{P.out, P.out, nullptr, (float*)(ws + WS_SSQ4), 0.5f};
        pg8::gemm_phase<pg8::EpiResid<false>, pg8::StaticOrder, true, true>(ldsl, g, S, E);
        SEAM(8);
    }
    if (IN(9)) final_norm(P, gw, NGW, lane);
#undef IN
#undef SEAM
}

extern "C" void kernel_launch(void* const* d_in, const int* in_sizes, int n_in, void* d_out, int out_size, void* d_ws, size_t ws_size, hipStream_t stream) {
    static int grid = 0;
    if (grid == 0) {
        if (n_in != 27 || in_sizes[0] != MR * DM || out_size != MR * DM || ws_size < WS_END) { fprintf(stderr, "kernel_launch: unexpected shapes (n_in %d, in0 %d, out %d, ws %zu)\n", n_in, n_in > 0 ? in_sizes[0] : -1, out_size, ws_size); grid = -1; return; }
        int dev = 0, cus = 0, per_cu = 0;
        if (hipGetDevice(&dev) != hipSuccess || hipDeviceGetAttribute(&cus, hipDeviceAttributeMultiprocessorCount, dev) != hipSuccess) { grid = -1; return; }
        if (hipFuncSetAttribute((const void*)hymba_fwd, hipFuncAttributeMaxDynamicSharedMemorySize, LDS_BYTES) != hipSuccess) { fprintf(stderr, "kernel_launch: hipFuncSetAttribute failed\n"); grid = -1; return; }
        if (hipOccupancyMaxActiveBlocksPerMultiprocessor(&per_cu, (const void*)hymba_fwd, NWAVES * 64, LDS_BYTES) != hipSuccess || per_cu < 1) fprintf(stderr, "kernel_launch: occupancy query says %d blocks per CU\n", per_cu);
        (void)hipGetLastError();
        grid = cus;
    }
    if (grid < 0) return;
    if (hipMemsetAsync((char*)d_ws + WS_CTL, 0, CTL_ZERO_BYTES, stream) != hipSuccess) { fprintf(stderr, "kernel_launch: memset failed\n"); return; }
    Args a{};
    for (int i = 0; i < 27; ++i) a.p.in[i] = (const float*)d_in[i];
    a.p.out = (float*)d_out; a.p.ws = (unsigned char*)d_ws; a.use_cg = 0; a.pad = 0;
#if MK_N_LAUNCHES == 1
    a.ph_lo = 0; a.ph_hi = N_PHASES;
    void* kargs[] = {&a};
    hipError_t e = hipLaunchCooperativeKernel((const void*)hymba_fwd, dim3(grid), dim3(NWAVES * 64), kargs, LDS_BYTES, stream);
    if (e != hipSuccess) fprintf(stderr, "kernel_launch: cooperative launch failed: %s (grid %d)\n", hipGetErrorString(e), grid);
#else
    for (int li = 0; li < N_PHASES; ++li) { a.ph_lo = li; a.ph_hi = li + 1;
        hipLaunchKernelGGL(hymba_fwd, dim3(grid), dim3(NWAVES * 64), LDS_BYTES, stream, a);
        const hipError_t le = hipPeekAtLastError(); if (le != hipSuccess) { fprintf(stderr, "kernel_launch: launch %d failed: %s\n", li, hipGetErrorName(le)); break; } }
#endif
}
```

```cpp
#include <hip/hip_runtime.h>
#include <cstdio>
#include <cstdint>
namespace pg8 {
#define PG8_LAS __attribute__((address_space(3)))
typedef unsigned short bf16_t;
typedef short bf16x8 __attribute__((ext_vector_type(8)));
typedef float f32x4 __attribute__((ext_vector_type(4)));
typedef unsigned u32x4 __attribute__((ext_vector_type(4)));
constexpr int BM = 256, BK = 64, HALF = 128, HTB = HALF * BK * 2  , STAGE_BYTES = 8 * HTB, NXCD = 8, WGM = 8;

__host__ __device__ __forceinline__ int lds_byte(int r, int c) { const int st = (r >> 4) * 2 + (c >> 5), rr = r & 15, cc = c & 31, ob = rr * 64 + cc * 2; return st * 1024 + (ob ^ (((ob >> 9) & 1) << 5)); }
__host__ __device__ __forceinline__ void stage_rc(int b, int& R, int& C) { const int st = b / 1024, sb = b % 1024, swz = sb ^ (((sb >> 9) & 1) << 5); R = (st >> 1) * 16 + swz / 64; C = (st & 1) * 32 + (swz % 64) / 2; }
__host__ __device__ __forceinline__ int perm32(int rho) { const int n = rho >> 4, i = rho & 15; return 8 * (i >> 2) + 4 * n + (i & 3); }

struct Unit { int pm, pn; };
struct Gemm { const bf16_t* A; const bf16_t* Bt; int M, N, K; };

struct StaticOrder {
    int nM, nN, nwg, G, c;
    __host__ __device__ void init(int M, int N, int G_, int c_) { nM = M / BM; nN = N / BM; nwg = nM * nN; G = G_; c = c_; }
    __host__ __device__ bool next(int i, Unit& u) const {
        const long L = (long)i * G + c; if (L >= nwg) return false;
        int wgid = (int)L; { const int q = nwg / NXCD, r = nwg % NXCD, xcd = wgid % NXCD, off = wgid / NXCD; wgid = (xcd < r ? xcd * (q + 1) : r * (q + 1) + (xcd - r) * q) + off; }
        const int nig = WGM * nN, gid = wgid / nig, fm = gid * WGM, gsz = (nM - fm) < WGM ? (nM - fm) : WGM;
        u.pm = fm + ((wgid % nig) % gsz); u.pn = (wgid % nig) / gsz; return true;
    }
    __device__ __forceinline__ void a_ready(const Unit&) const {}
    __device__ __forceinline__ void done(const Unit&) const {}
};

__device__ __forceinline__ unsigned cvt_pk_bf16(float lo, float hi) { unsigned r; asm volatile("v_cvt_pk_bf16_f32 %0, %1, %2" : "=v"(r) : "v"(lo), "v"(hi)); return r; }
typedef float f32x2 __attribute__((ext_vector_type(2)));
typedef unsigned u32x2 __attribute__((ext_vector_type(2)));
__device__ __forceinline__ float rstd_from16(const float* ssq, int row) {
    const f32x4* p = (const f32x4*)(ssq + (size_t)row * 16);
    const f32x4 a = p[0], b = p[1], c = p[2], d = p[3];
    const float s = ((a[0] + a[1]) + (a[2] + a[3])) + ((b[0] + b[1]) + (b[2] + b[3])) + ((c[0] + c[1]) + (c[2] + c[3])) + ((d[0] + d[1]) + (d[2] + d[3]));
    return __builtin_amdgcn_rsqf(s * (1.0f / 1024.0f) + 1e-5f);
}
__device__ __forceinline__ float silu_mul(float g, float u) { return g * __builtin_amdgcn_rcpf(1.0f + __builtin_amdgcn_exp2f(-1.4426950408889634f * g)) * u; }
template <class Sched> __device__ __forceinline__ void fill_rstd_cache(PG8_LAS float* tab, const float* ssq, const Sched& S) {
    const int tid = threadIdx.x; int t0 = -1, t1 = -1, t2 = -1, t3 = -1; Unit u;
    for (int i = 0; S.next(i, u); ++i) { const int pm = u.pm;
        if (pm == t0 || pm == t1 || pm == t2 || pm == t3) continue;
        if (t0 < 0) t0 = pm; else if (t1 < 0) t1 = pm; else if (t2 < 0) t2 = pm; else if (t3 < 0) t3 = pm; }
    if (tid == 0) { tab[0] = __builtin_bit_cast(float, t0); tab[1] = __builtin_bit_cast(float, t1); tab[2] = __builtin_bit_cast(float, t2); tab[3] = __builtin_bit_cast(float, t3); }
    if (tid < 256) { if (t0 >= 0) tab[4 + tid] = rstd_from16(ssq, t0 * BM + tid); if (t1 >= 0) tab[4 + 256 + tid] = rstd_from16(ssq, t1 * BM + tid);
        if (t2 >= 0) tab[4 + 512 + tid] = rstd_from16(ssq, t2 * BM + tid); if (t3 >= 0) tab[4 + 768 + tid] = rstd_from16(ssq, t3 * BM + tid); }
    __syncthreads();
}
__device__ __forceinline__ int rstd_slot(const PG8_LAS float* tab, int pm) {
    const int a = __builtin_bit_cast(int, tab[0]), b = __builtin_bit_cast(int, tab[1]), c = __builtin_bit_cast(int, tab[2]), d = __builtin_bit_cast(int, tab[3]);
    return pm == a ? 0 : pm == b ? 1 : pm == c ? 2 : pm == d ? 3 : -1;
}
struct EpiSwiglu {
    static constexpr bool PERM = true, AFTER_DRAIN = false;
    bf16_t* U; const float* ssq; int ldu; const PG8_LAS float* rc;
    __device__ __forceinline__ void operator()(const f32x4 (&acc)[2][2][4][2], const Unit& u, int wr, int wc, int fr, int fq) const {
        const int row0 = u.pm * BM + wr * 64 + fr, col0 = u.pn * HALF + wc * 32 + 8 * fq; const int slot = rstd_slot(rc, u.pm);
#pragma unroll
        for (int ai = 0; ai < 2; ++ai)
#pragma unroll
            for (int m = 0; m < 4; ++m) { const int row = row0 + ai * HALF + m * 16; const float rs = slot >= 0 ? rc[4 + slot * 256 + (row - u.pm * BM)] : rstd_from16(ssq, row);
                const float rs2 = rs * rs, cc = -1.4426950408889634f * rs;
                f32x4 o0, o1;
                { const f32x4 g = acc[ai][0][m][0], uu = acc[ai][1][m][0]; const f32x4 a = g * cc; f32x4 e; e[0] = __builtin_amdgcn_exp2f(a[0]); e[1] = __builtin_amdgcn_exp2f(a[1]); e[2] = __builtin_amdgcn_exp2f(a[2]); e[3] = __builtin_amdgcn_exp2f(a[3]);
                  const f32x4 d = e + 1.0f; f32x4 r; r[0] = __builtin_amdgcn_rcpf(d[0]); r[1] = __builtin_amdgcn_rcpf(d[1]); r[2] = __builtin_amdgcn_rcpf(d[2]); r[3] = __builtin_amdgcn_rcpf(d[3]); o0 = (g * rs2) * uu * r; }
                { const f32x4 g = acc[ai][0][m][1], uu = acc[ai][1][m][1]; const f32x4 a = g * cc; f32x4 e; e[0] = __builtin_amdgcn_exp2f(a[0]); e[1] = __builtin_amdgcn_exp2f(a[1]); e[2] = __builtin_amdgcn_exp2f(a[2]); e[3] = __builtin_amdgcn_exp2f(a[3]);
                  const f32x4 d = e + 1.0f; f32x4 r; r[0] = __builtin_amdgcn_rcpf(d[0]); r[1] = __builtin_amdgcn_rcpf(d[1]); r[2] = __builtin_amdgcn_rcpf(d[2]); r[3] = __builtin_amdgcn_rcpf(d[3]); o1 = (g * rs2) * uu * r; }
                u32x4 w; w.x = cvt_pk_bf16(o0[0], o0[1]); w.y = cvt_pk_bf16(o0[2], o0[3]); w.z = cvt_pk_bf16(o1[0], o1[1]); w.w = cvt_pk_bf16(o1[2], o1[3]);
                *(u32x4*)(U + (size_t)row * ldu + col0) = w; }
    }
};
struct EpiZ {
    static constexpr bool PERM = true, AFTER_DRAIN = false;
    bf16_t* Z; const float* ssq; const float* bias; int ldz, ncols, bias_from; const PG8_LAS float* rc;
    __device__ __forceinline__ void operator()(const f32x4 (&acc)[2][2][4][2], const Unit& u, int wr, int wc, int fr, int fq) const {
        const int row0 = u.pm * BM + wr * 64 + fr, col0 = u.pn * BM + wc * 32 + 8 * fq; const int slot = rstd_slot(rc, u.pm);
        f32x4 bv[2][2];
#pragma unroll
        for (int bj = 0; bj < 2; ++bj)
#pragma unroll
            for (int n = 0; n < 2; ++n) { const int c = col0 + bj * HALF + 4 * n; bv[bj][n] = (c >= bias_from && c < ncols) ? *(const f32x4*)(bias + (c - bias_from)) : (f32x4){0.f, 0.f, 0.f, 0.f}; }
#pragma unroll
        for (int ai = 0; ai < 2; ++ai)
#pragma unroll
            for (int m = 0; m < 4; ++m) { const int row = row0 + ai * HALF + m * 16; const float rs = slot >= 0 ? rc[4 + slot * 256 + (row - u.pm * BM)] : rstd_from16(ssq, row);
#pragma unroll
                for (int bj = 0; bj < 2; ++bj) { const int c = col0 + bj * HALF; if (c < ncols) {
                    const f32x4 v0 = acc[ai][bj][m][0] * rs + bv[bj][0], v1 = acc[ai][bj][m][1] * rs + bv[bj][1];
                    u32x4 w; w.x = cvt_pk_bf16(v0[0], v0[1]); w.y = cvt_pk_bf16(v0[2], v0[3]); w.z = cvt_pk_bf16(v1[0], v1[1]); w.w = cvt_pk_bf16(v1[2], v1[3]);
                    *(u32x4*)(Z + (size_t)row * ldz + c) = w; } } }
    }
};
template <bool WB> struct EpiResid {
    static constexpr bool PERM = false, AFTER_DRAIN = false;
    const float* base; float* out; bf16_t* outb; float* ssq; float scale;
    __device__ __forceinline__ void operator()(const f32x4 (&acc)[2][2][4][2], const Unit& u, int wr, int wc, int fr, int fq) const {
        const int row0 = u.pm * BM + wr * 64 + fr, col0 = u.pn * BM + wc * 32 + 4 * fq;
#pragma unroll
        for (int ai = 0; ai < 2; ++ai)
#pragma unroll
            for (int m = 0; m < 4; ++m) { const int row = row0 + ai * HALF + m * 16; const size_t off = (size_t)row * 1024 + col0; float ss = 0.f;
#pragma unroll
                for (int bj = 0; bj < 2; ++bj)
#pragma unroll
                    for (int n = 0; n < 2; ++n) { const size_t o2 = off + bj * HALF + n * 16; const f32x4 bs = *(const f32x4*)(base + o2); const f32x4 o = bs + acc[ai][bj][m][n] * scale;
                        *(f32x4*)(out + o2) = o; ss += (o[0] * o[0] + o[1] * o[1]) + (o[2] * o[2] + o[3] * o[3]);
                        if (WB) { u32x2 w; w.x = cvt_pk_bf16(o[0], o[1]); w.y = cvt_pk_bf16(o[2], o[3]); *(u32x2*)(outb + o2) = w; } }
                ss += __shfl_xor(ss, 16); ss += __shfl_xor(ss, 32);
                if (fq == 0) ssq[(size_t)row * 16 + u.pn * 4 + wc] = ss; }
    }
};
template <class Epi, class Sched, bool ALIGN_EPI = false, bool SP2 = false>
__device__ __forceinline__ void gemm_phase(PG8_LAS unsigned char* lds, const Gemm g, const Sched& S, const Epi& E) {
    const int tid = threadIdx.x, wid = __builtin_amdgcn_readfirstlane(tid >> 6), lane = tid & 63, wr = wid >> 2, wc = wid & 3, fr = lane & 15, fq = lane >> 4;
    const int K = g.K, nt = K / BK;
    unsigned voffA[2], voffB[2];
#pragma unroll
    for (int i = 0; i < 2; ++i) { int R, C; stage_rc(tid * 16 + i * 8192, R, C); const int Rb = Epi::PERM ? ((R & ~31) + perm32(R & 31)) : R;
        voffA[i] = (unsigned)(R * K + C) * 2u; voffB[i] = (unsigned)(Rb * K + C) * 2u; }
    const size_t kstep = (size_t)(BK * 2);
    const size_t hstep = (size_t)HALF * K * 2;
    const size_t tstep = 2 * hstep;
    const unsigned ldsw = (unsigned)wid * 1024u;
    const int aoff = lds_byte(wr * 64 + fr, fq * 8), boff = lds_byte(wc * 32 + fr, fq * 8);
#define PG8_SA(b, h) (((b) * 2 + (h)) * HTB)
#define PG8_SB(b, h) ((4 + (b) * 2 + (h)) * HTB)
#define PG8_STAGE(bufoff, gbase, voff) do { _Pragma("unroll") for (int _i = 0; _i < 2; ++_i) \
        __builtin_amdgcn_global_load_lds((const unsigned*)((const char*)(gbase) + (voff)[_i]), (PG8_LAS unsigned*)(lds + (bufoff) + ldsw + _i * 8192), 16, 0, 0); } while (0)
#define PG8_LDA(dst, b, h) do { _Pragma("unroll") for (int m = 0; m < 4; ++m) _Pragma("unroll") for (int k = 0; k < 2; ++k) dst[m][k] = *(const PG8_LAS bf16x8*)(lds + PG8_SA(b, h) + aoff + m * 2048 + k * 1024); } while (0)
#define PG8_LDB(dst, b, h) do { _Pragma("unroll") for (int n = 0; n < 2; ++n) _Pragma("unroll") for (int k = 0; k < 2; ++k) dst[n][k] = *(const PG8_LAS bf16x8*)(lds + PG8_SB(b, h) + boff + n * 2048 + k * 1024); } while (0)
#define PG8_MMA(ai, bj, At, Bt) do { __builtin_amdgcn_s_setprio(1); _Pragma("unroll") for (int m = 0; m < 4; ++m) _Pragma("unroll") for (int n = 0; n < 2; ++n) _Pragma("unroll") for (int k = 0; k < 2; ++k) \
        acc[ai][bj][m][n] = __builtin_amdgcn_mfma_f32_16x16x32_bf16(Bt[n][k], At[m][k], acc[ai][bj][m][n], 0, 0, 0); __builtin_amdgcn_s_setprio(0); } while (0)
#define PG8_WAIT_V(n) asm volatile("s_waitcnt vmcnt(" #n ")" ::: "memory")
#define PG8_WAIT_L(n) asm volatile("s_waitcnt lgkmcnt(" #n ")" ::: "memory")
#define PG8_BAR __builtin_amdgcn_s_barrier()
#define PG8_SCHED __builtin_amdgcn_sched_barrier(0)
    Unit cur, nxt; int ui = 0;
    if (!S.next(0, cur)) return;
    f32x4 acc[2][2][4][2];
#pragma unroll
    for (int a = 0; a < 2; ++a)
#pragma unroll
        for (int b = 0; b < 2; ++b)
#pragma unroll
            for (int m = 0; m < 4; ++m)
#pragma unroll
                for (int n = 0; n < 2; ++n) acc[a][b][m][n] = (f32x4){0.f, 0.f, 0.f, 0.f};
    bf16x8 At[4][2], B0[2][2], B1[2][2];
    const char* cA = (const char*)g.A + (size_t)cur.pm * tstep; const char* cB = (const char*)g.Bt + (size_t)cur.pn * tstep;
    S.a_ready(cur);
    if constexpr (SP2) {
        PG8_STAGE(PG8_SB(0, 0), cB, voffB); PG8_STAGE(PG8_SB(0, 1), cB + hstep, voffB); PG8_STAGE(PG8_SA(0, 0), cA, voffA); PG8_STAGE(PG8_SA(0, 1), cA + hstep, voffA);
        if (wr == 1) PG8_BAR;
        PG8_WAIT_V(2); PG8_BAR;
        PG8_STAGE(PG8_SB(1, 0), cB + kstep, voffB); PG8_STAGE(PG8_SA(1, 0), cA + kstep, voffA); PG8_STAGE(PG8_SB(1, 1), cB + hstep + kstep, voffB);
        PG8_WAIT_V(6); PG8_BAR;
    } else {
        PG8_STAGE(PG8_SB(0, 0), cB, voffB); PG8_STAGE(PG8_SA(0, 0), cA, voffA); PG8_STAGE(PG8_SB(0, 1), cB + hstep, voffB); PG8_STAGE(PG8_SA(0, 1), cA + hstep, voffA);
        if (wr == 1) PG8_BAR;
        PG8_WAIT_V(4); PG8_BAR;
        PG8_STAGE(PG8_SB(1, 0), cB + kstep, voffB); PG8_STAGE(PG8_SA(1, 0), cA + kstep, voffA); PG8_STAGE(PG8_SB(1, 1), cB + hstep + kstep, voffB);
        PG8_WAIT_V(6); PG8_BAR;
    }
    for (;;) {
        const bool has_next = S.next(ui + 1, nxt);
        const char* nA = has_next ? (const char*)g.A + (size_t)nxt.pm * tstep : cA; const char* nB = has_next ? (const char*)g.Bt + (size_t)nxt.pn * tstep : cB;
        for (int t = 0; t < nt; t += 2) {
            const bool last = (t == nt - 2);
            const char* a1 = cA + (size_t)(t + 1) * kstep;
            const char* a2 = last ? nA : cA + (size_t)(t + 2) * kstep; const char* b2 = last ? nB : cB + (size_t)(t + 2) * kstep;
            const char* a3 = a2 + kstep; const char* b3 = b2 + kstep;
            if (last && has_next) S.a_ready(nxt);
            if constexpr (SP2) {
            PG8_LDB(B0, 0, 0); PG8_LDB(B1, 0, 1); PG8_SCHED; PG8_LDA(At, 0, 0); PG8_STAGE(PG8_SA(1, 1), a1 + hstep, voffA);
            PG8_WAIT_V(8); PG8_WAIT_L(0); PG8_BAR; PG8_MMA(0, 0, At, B0); PG8_MMA(0, 1, At, B1); PG8_BAR; PG8_SCHED;
            PG8_LDA(At, 0, 1); PG8_STAGE(PG8_SB(0, 0), b2, voffB); PG8_STAGE(PG8_SB(0, 1), b2 + hstep, voffB); PG8_STAGE(PG8_SA(0, 0), a2, voffA);
            PG8_WAIT_V(8); PG8_WAIT_L(0); PG8_BAR; PG8_MMA(1, 0, At, B0); PG8_MMA(1, 1, At, B1); PG8_BAR; PG8_SCHED;
            PG8_LDB(B0, 1, 0); PG8_LDB(B1, 1, 1); PG8_SCHED; PG8_LDA(At, 1, 0); PG8_STAGE(PG8_SA(0, 1), a2 + hstep, voffA);
            PG8_WAIT_V(8); PG8_WAIT_L(0); PG8_BAR; PG8_MMA(0, 0, At, B0); PG8_MMA(0, 1, At, B1); PG8_BAR; PG8_SCHED;
            PG8_LDA(At, 1, 1); PG8_STAGE(PG8_SB(1, 0), b3, voffB); PG8_STAGE(PG8_SB(1, 1), b3 + hstep, voffB); PG8_STAGE(PG8_SA(1, 0), a3, voffA);
            PG8_WAIT_V(8); PG8_WAIT_L(0); PG8_BAR; PG8_MMA(1, 0, At, B0); PG8_MMA(1, 1, At, B1); PG8_BAR; PG8_SCHED;
            } else {
            PG8_LDB(B0, 0, 0); PG8_SCHED; PG8_LDA(At, 0, 0); PG8_STAGE(PG8_SA(1, 1), a1 + hstep, voffA);
            PG8_WAIT_L(8); PG8_BAR; PG8_WAIT_L(0); PG8_MMA(0, 0, At, B0); PG8_BAR; PG8_SCHED;
            PG8_LDB(B1, 0, 1); PG8_STAGE(PG8_SB(0, 0), b2, voffB);
            PG8_BAR; PG8_WAIT_L(0); PG8_MMA(0, 1, At, B1); PG8_BAR;
            PG8_LDA(At, 0, 1); PG8_STAGE(PG8_SA(0, 0), a2, voffA);
            PG8_BAR; PG8_WAIT_L(0); PG8_MMA(1, 0, At, B0); PG8_BAR; PG8_SCHED;
            PG8_STAGE(PG8_SB(0, 1), b2 + hstep, voffB);
            PG8_WAIT_V(6); PG8_BAR; PG8_MMA(1, 1, At, B1); PG8_BAR;
            PG8_LDB(B0, 1, 0); PG8_SCHED; PG8_LDA(At, 1, 0); PG8_STAGE(PG8_SA(0, 1), a2 + hstep, voffA);
            PG8_WAIT_L(8); PG8_BAR; PG8_WAIT_L(0); PG8_MMA(0, 0, At, B0); PG8_BAR; PG8_SCHED;
            PG8_LDB(B1, 1, 1); PG8_STAGE(PG8_SB(1, 0), b3, voffB);
            PG8_BAR; PG8_WAIT_L(0); PG8_MMA(0, 1, At, B1); PG8_BAR;
            PG8_LDA(At, 1, 1); PG8_STAGE(PG8_SA(1, 0), a3, voffA);
            PG8_BAR; PG8_WAIT_L(0); PG8_MMA(1, 0, At, B0); PG8_BAR; PG8_SCHED;
            PG8_STAGE(PG8_SB(1, 1), b3 + hstep, voffB);
            PG8_WAIT_V(6); PG8_BAR; PG8_MMA(1, 1, At, B1); PG8_BAR;
            }
        }
        if constexpr (ALIGN_EPI) { if (wr == 0) PG8_BAR; }
        if constexpr (!Epi::AFTER_DRAIN) { E(acc, cur, wr, wc, fr, fq); S.done(cur); }
        if (!has_next) break;
#pragma unroll
        for (int a = 0; a < 2; ++a)
#pragma unroll
            for (int b = 0; b < 2; ++b)
#pragma unroll
                for (int m = 0; m < 4; ++m)
#pragma unroll
                    for (int n = 0; n < 2; ++n) acc[a][b][m][n] = (f32x4){0.f, 0.f, 0.f, 0.f};
        cur = nxt; cA = nA; cB = nB; ++ui;
        if constexpr (ALIGN_EPI) { if (wr == 1) PG8_BAR; }
    }
    PG8_WAIT_V(0);
    if constexpr (!ALIGN_EPI) { if (wr == 0) PG8_BAR; }
    PG8_BAR;
    if constexpr (Epi::AFTER_DRAIN) { E.fused(acc, cur, wr, wc, fr, fq, lds, wid, lane); S.done(cur); }
#undef PG8_SA
#undef PG8_SB
#undef PG8_STAGE
#undef PG8_LDA
#undef PG8_LDB
#undef PG8_MMA
#undef PG8_WAIT_V
#undef PG8_WAIT_L
#undef PG8_BAR
#undef PG8_SCHED
}
}
#include <hip/hip_cooperative_groups.h>
namespace cg = cooperative_groups;
constexpr int NWAVES = 8;
constexpr int MR = 32768, DM = 1024, FF = 2816, NGU = 5632, NIN = 2464, NINP = 2560, TSEQ = 4096, NBATCH = 8, NHEAD = 8, NMETA = 16;
constexpr int ZC_W = 1536, ZC_Q = 1696, ZC_K = 2208, ZC_V = 2336;
constexpr int PV = 320;
constexpr size_t MiB = 1u << 20;
constexpr size_t WS_CTL = 0, CTL_ZERO_BYTES = 1 * MiB;
constexpr size_t WS_WGU1 = 2 * MiB, WS_WD1 = 13 * MiB, WS_WIN = 19 * MiB, WS_WOUT = 24 * MiB, WS_WGU2 = 26 * MiB, WS_WD2 = 37 * MiB, WS_LT = 43 * MiB;
constexpr size_t WS_SSQ1 = 44 * MiB, WS_SSQ2 = 46 * MiB, WS_SSQ3 = 48 * MiB, WS_SSQ4 = 50 * MiB, WS_META = 52 * MiB;
constexpr size_t MO_XMB = 0, MO_UM = 64 * 1024, MO_H1MB = 256 * 1024, MO_SSQM1 = 320 * 1024, MO_SSQM2 = 324 * 1024, MO_ZM = 384 * 1024, MO_PM = 512 * 1024;
constexpr size_t WS_XB = 56 * MiB, WS_BIG = 120 * MiB, WS_IMG = 274 * MiB, WS_P = 296 * MiB, WS_END = 507 * MiB;
constexpr int CW_BAR = 4096;
constexpr int RING_BYTES = 131072, LDSCTL_OFF = 143360, MISC_OFF = LDSCTL_OFF + 320, LDS_BYTES = 147456;

#define GAS __attribute__((address_space(1)))
#define LAS __attribute__((address_space(3)))
typedef unsigned short bf16;
typedef unsigned v4u __attribute__((ext_vector_type(4)));
typedef unsigned v2u __attribute__((ext_vector_type(2)));
typedef float f32x4 __attribute__((ext_vector_type(4)));
typedef float f32x2 __attribute__((ext_vector_type(2)));
typedef short bf16x8 __attribute__((ext_vector_type(8)));
typedef short bf16x4 __attribute__((ext_vector_type(4)));
typedef GAS unsigned gu32;
#define LDS_WAIT() asm volatile("s_waitcnt lgkmcnt(0)" ::: "memory")
__device__ __forceinline__ unsigned f2bf(float f) { unsigned u = __builtin_bit_cast(unsigned, f); return (u + 0x7fffu + ((u >> 16) & 1u)) >> 16; }
typedef __bf16 bf16x2_t __attribute__((ext_vector_type(2)));
__device__ __forceinline__ unsigned pk2m(float lo, float hi) { f32x2 v = {lo, hi}; bf16x2_t b = __builtin_convertvector(v, bf16x2_t); return __builtin_bit_cast(unsigned, b); }
__device__ __forceinline__ unsigned pk2(float lo, float hi) { return pg8::cvt_pk_bf16(lo, hi); }
__device__ __forceinline__ float bflo(unsigned w) { return __builtin_bit_cast(float, w << 16); }
__device__ __forceinline__ float bfhi(unsigned w) { return __builtin_bit_cast(float, w & 0xffff0000u); }
__device__ __forceinline__ f32x4 unpack4(v2u w) { return (f32x4){bflo(w.x), bfhi(w.x), bflo(w.y), bfhi(w.y)}; }
__device__ __forceinline__ float sigmoidf_(float x) { return __builtin_amdgcn_rcpf(1.0f + __builtin_amdgcn_exp2f(-1.4426950408889634f * x)); }
__device__ __forceinline__ float tanhf_(float x) { return 2.0f * sigmoidf_(2.0f * x) - 1.0f; }
#define XB_TMO      128
#define XB_XCNT(j)  (256  + 64 * (j))
#define XB_XSUB(j)  (1280 + 64 * (j))
#define XB_XGEN(j)  (2304 + 64 * (j))
#define XB_TOP      3328
#define XB_TOPGEN   3392
#define XCD_BAR_WORDS 3456
#define XB_SPIN_CAP (1u << 18)

__device__ __forceinline__ unsigned xb_ld(unsigned* p)              { return __hip_atomic_load(p, __ATOMIC_RELAXED, __HIP_MEMORY_SCOPE_AGENT); }
__device__ __forceinline__ unsigned xb_add(unsigned* p, unsigned v) { return __hip_atomic_fetch_add(p, v, __ATOMIC_RELAXED, __HIP_MEMORY_SCOPE_AGENT); }
__device__ __forceinline__ unsigned xb_xcc_id() { return (unsigned)__builtin_amdgcn_s_getreg((3 << 11) | 20) & 0xFu; }
#define XB_SPIN(cond, bar) do { unsigned _sp = 0; while (cond) { __builtin_amdgcn_s_sleep(1); \
    if ((++_sp & 255u) == 0u) { if (xb_ld(&(bar)[XB_TMO])) break; if (_sp > XB_SPIN_CAP) { atomicAdd(&(bar)[XB_TMO], 1u); break; } } } } while (0)

struct XcdBarrier {
    unsigned* bar; unsigned x;
    volatile LAS unsigned* st;
};

__device__ __forceinline__ XcdBarrier xcd_barrier_post(unsigned* bar, volatile LAS unsigned* st) {
    XcdBarrier b; b.bar = bar; b.x = xb_xcc_id(); b.st = st;
    if (threadIdx.x == 0) (void)xb_add(&bar[XB_XCNT(b.x)], 1u);
    return b;
}
__device__ __forceinline__ void xcd_barrier_complete(unsigned* bar, unsigned x, unsigned& nloc, unsigned& nx) {
    const unsigned G = gridDim.x * gridDim.y * gridDim.z;
    unsigned sum, cnt, mine, sp = 0u;
    for (;;) {
        sum = 0u; cnt = 0u; mine = 0u;
#pragma unroll
        for (unsigned j = 0; j < 16; ++j) { const unsigned c = xb_ld(&bar[XB_XCNT(j)]); sum += c; cnt += (c > 0u) ? 1u : 0u; mine = (j == x) ? c : mine; }
        if (sum == G) break;
        __builtin_amdgcn_s_sleep(1);
        if ((++sp & 255u) == 0u) { if (xb_ld(&bar[XB_TMO])) break; if (sp > XB_SPIN_CAP) { atomicAdd(&bar[XB_TMO], 1u); break; } }
    }
    nloc = mine > 0u ? mine : 1u; nx = cnt > 0u ? cnt : 1u;
}

__device__ __forceinline__ void xcd_barrier(const XcdBarrier& b) {
    asm volatile("s_waitcnt vmcnt(0)" ::: "memory");
    __syncthreads();
    if (threadIdx.x == 0) {
        unsigned* bar = b.bar;
        __builtin_amdgcn_s_waitcnt(0);
        unsigned nloc = b.st[0], nx = b.st[1];
        if (nloc == 0u) { xcd_barrier_complete(bar, b.x, nloc, nx); b.st[0] = nloc; b.st[1] = nx; }
        const unsigned old = xb_add(&bar[XB_XSUB(b.x)], 1u);
        const unsigned gen = old / nloc;
        if (old + 1u == (gen + 1u) * nloc) {
            __builtin_amdgcn_fence(__ATOMIC_RELEASE, "agent");
            asm volatile("s_waitcnt vmcnt(0)" ::: "memory");
            const unsigned og = xb_add(&bar[XB_TOP], 1u);
            const unsigned tg = og / nx;
            if (og + 1u == (tg + 1u) * nx) xb_add(&bar[XB_TOPGEN], 1u);
            else XB_SPIN(xb_ld(&bar[XB_TOPGEN]) == tg, bar);
            __builtin_amdgcn_fence(__ATOMIC_ACQUIRE, "agent");
            xb_add(&bar[XB_XGEN(b.x)], 1u);
            asm volatile("s_waitcnt vmcnt(0)" ::: "memory");
        } else {
            XB_SPIN(xb_ld(&bar[XB_XGEN(b.x)]) == gen, bar);
            __builtin_amdgcn_fence(__ATOMIC_ACQUIRE, "agent");
            asm volatile("s_waitcnt vmcnt(0)" ::: "memory");
        }
    }
    __syncthreads();
}
__device__ __forceinline__ float wave_sum(float v) {
#pragma unroll
    for (int o = 1; o < 64; o <<= 1) v += __shfl_xor(v, o);
    return v;
}
__device__ __forceinline__ void p0_transpose_item(const float* W, int K, int N, bf16* WT, const float* gain, int k0, int n0, int drow0, LAS float* scr, int lane) {
#pragma unroll
    for (int i = 0; i < 32; ++i) { const int kk = 2 * i + (lane >> 5); float w = W[(size_t)(k0 + kk) * N + n0 + (lane & 31)]; if (gain) w *= gain[k0 + kk]; scr[kk * 33 + (lane & 31)] = w; }
    LDS_WAIT(); asm volatile("" ::: "memory");
    const int c = lane & 7;
#pragma unroll
    for (int j = 0; j < 4; ++j) { const int n = (lane >> 3) + 8 * j; const LAS float* s = scr + (8 * c) * 33 + n;
        v4u o; o.x = pk2(s[0 * 33], s[1 * 33]); o.y = pk2(s[2 * 33], s[3 * 33]); o.z = pk2(s[4 * 33], s[5 * 33]); o.w = pk2(s[6 * 33], s[7 * 33]);
        *(GAS v4u*)(WT + (size_t)(drow0 + n) * K + k0 + 8 * c) = o; }
    LDS_WAIT(); asm volatile("" ::: "memory");
}
__device__ __forceinline__ void rows4_to_bf16(const float* const (&xrow)[4], bf16* const (&orow)[4], float* const (&ssq16)[4], int lane) {
    f32x4 v[4][4]; float s[4];
#pragma unroll
    for (int r = 0; r < 4; ++r) { const GAS f32x4* xr = (const GAS f32x4*)xrow[r] + lane;
#pragma unroll
        for (int j = 0; j < 4; ++j) v[r][j] = xr[64 * j]; }
#pragma unroll
    for (int r = 0; r < 4; ++r) { float a = 0.f;
#pragma unroll
        for (int j = 0; j < 4; ++j) a += (v[r][j].x * v[r][j].x + v[r][j].y * v[r][j].y) + (v[r][j].z * v[r][j].z + v[r][j].w * v[r][j].w);
        s[r] = a; }
#pragma unroll
    for (int o = 1; o < 64; o <<= 1) {
#pragma unroll
        for (int r = 0; r < 4; ++r) s[r] += __shfl_xor(s[r], o); }
#pragma unroll
    for (int r = 0; r < 4; ++r) { GAS v2u* o8 = (GAS v2u*)orow[r] + lane;
#pragma unroll
        for (int j = 0; j < 4; ++j) { v2u w; w.x = pk2(v[r][j].x, v[r][j].y); w.y = pk2(v[r][j].z, v[r][j].w); o8[64 * j] = w; }
        if (lane < 16) ssq16[r][lane] = (lane == 0) ? s[r] : 0.f; }
}
struct Ptrs {
    const float* in[27]; float* out; unsigned char* ws;
};
__device__ __forceinline__ void p0_transposes(const Ptrs& P, LAS unsigned char* lds, int part, int gw, int NGW, int wave, int lane) {
    unsigned char* ws = P.ws; LAS float* scr = (LAS float*)(lds + wave * 16384);
    constexpr int I_G = (DM / 64) * (FF / 32), I_D = (FF / 64) * (DM / 32), I_IN = (DM / 64) * (NIN / 32), I_O = (DM / 64) * (DM / 32);
    const int nitems = 2 * I_G + I_D + (part ? I_O : I_IN);
    for (int it = gw; it < nitems; it += NGW) {
        int r = it;
        if (r < 2 * I_G) { const int isup = r / I_G; r -= isup * I_G; const int nblk = FF / 32, kb = r / nblk, nb = r % nblk, n0 = 32 * nb;
            const float* W = P.in[part ? (isup ? 24 : 23) : (isup ? 4 : 3)]; const float* gain = P.in[part ? 22 : 2];
            bf16* WT = (bf16*)(ws + (part ? WS_WGU2 : WS_WGU1));
            const int drow0 = 256 * (n0 / 128) + 128 * isup + (n0 % 128);
            p0_transpose_item(W, DM, FF, WT, gain, 64 * kb, n0, drow0, scr, lane); continue; }
        r -= 2 * I_G;
        if (r < I_D) { const int nblk = DM / 32, kb = r / nblk, nb = r % nblk;
            p0_transpose_item(P.in[part ? 25 : 5], FF, DM, (bf16*)(ws + (part ? WS_WD2 : WS_WD1)), nullptr, 64 * kb, 32 * nb, 32 * nb, scr, lane); continue; }
        r -= I_D;
        if (!part) { const int nblk = NIN / 32, kb = r / nblk, nb = r % nblk;
            p0_transpose_item(P.in[7], DM, NIN, (bf16*)(ws + WS_WIN), P.in[6], 64 * kb, 32 * nb, 32 * nb, scr, lane); }
        else { const int nblk = DM / 32, kb = r / nblk, nb = r % nblk;
            p0_transpose_item(P.in[21], DM, DM, (bf16*)(ws + WS_WOUT), nullptr, 64 * kb, 32 * nb, 32 * nb, scr, lane); }
    }
}
__device__ __forceinline__ void p0_prologue(const Ptrs& P, LAS unsigned char* lds, int vcu, int G, int wave, int lane) {
    const int gw = vcu * NWAVES + wave, NGW = G * NWAVES;
    unsigned char* ws = P.ws;
    p0_transposes(P, lds, 0, gw, NGW, wave, lane);
    { GAS v4u* z = (GAS v4u*)(ws + WS_WIN + (size_t)NIN * DM * 2); const int n16 = (NINP - NIN) * DM * 2 / 16;
      for (int i = gw * 64 + lane; i < n16; i += NGW * 64) z[i] = (v4u){0u, 0u, 0u, 0u}; }
    { bf16* LT = (bf16*)(ws + WS_LT);
      for (int i = gw * 64 + lane; i < 512 * 160; i += NGW * 64) { const int n = i / 160, j = i % 160;
          const float v = j < 32 ? P.in[11][j * 512 + n] : j < 64 ? P.in[13][(j - 32) * 512 + n] : P.in[14][(j - 64) * 512 + n];
          LT[i] = (bf16)f2bf(v); } }
#ifndef REP_ROWS
#define REP_ROWS 1
#endif
    for (int rep_ = 0; rep_ < REP_ROWS; ++rep_)
    for (int m4 = gw; m4 < (MR + NMETA) / 4; m4 += NGW) { const float* xr[4]; bf16* orow[4]; float* sq[4];
#pragma unroll
        for (int r = 0; r < 4; ++r) { const int m = 4 * m4 + r;
            if (m < MR) { xr[r] = P.in[0] + (size_t)m * DM; orow[r] = (bf16*)(ws + WS_XB) + (size_t)m * DM; sq[r] = (float*)(ws + WS_SSQ1) + (size_t)m * 16; }
            else { const int i = m - MR; xr[r] = P.in[1] + (size_t)i * DM; orow[r] = (bf16*)(ws + WS_META + MO_XMB) + (size_t)i * DM; sq[r] = (float*)(ws + WS_META + MO_SSQM1) + i * 16; } }
        rows4_to_bf16(xr, orow, sq, lane); }
}
__device__ __forceinline__ f32x4 skinny16(const bf16* A, const bf16* Bt, int K, int n0, int lane) {
    const int fr = lane & 15, fq = lane >> 4;
    const bf16* ap = A + (size_t)fr * K + 8 * fq; const bf16* bp = Bt + (size_t)(n0 + fr) * K + 8 * fq;
    f32x4 acc = (f32x4){0.f, 0.f, 0.f, 0.f};
    for (int k = 0; k < K; k += 256) {
        bf16x8 a[8], b[8];
#pragma unroll
        for (int j = 0; j < 8; ++j) { a[j] = *(const bf16x8*)(ap + k + 32 * j); b[j] = *(const bf16x8*)(bp + k + 32 * j); }
#pragma unroll
        for (int j = 0; j < 8; ++j) acc = __builtin_amdgcn_mfma_f32_16x16x32_bf16(a[j], b[j], acc, 0, 0, 0); }
    return acc;
}
__device__ __forceinline__ float rstd_m16(const float* ssq16) { float s = 0.f;
#pragma unroll
    for (int i = 0; i < 16; ++i) s += ssq16[i];
    return __builtin_amdgcn_rsqf(s * (1.0f / 1024.0f) + 1e-5f); }
__device__ __forceinline__ void meta_up(unsigned char* ws, int gw, int NGW, int lane) {
    const bf16* A = (const bf16*)(ws + WS_META + MO_XMB); const bf16* Bt = (const bf16*)(ws + WS_WGU1); bf16* Um = (bf16*)(ws + WS_META + MO_UM);
    const float* ssq = (const float*)(ws + WS_META + MO_SSQM1); const int fr = lane & 15, fq = lane >> 4;
    for (int t = gw; t < FF / 16; t += NGW) { const int c0 = 16 * t, nr = 256 * (c0 / 128) + (c0 % 128);
        const f32x4 g = skinny16(A, Bt, DM, nr, lane), u = skinny16(A, Bt, DM, nr + 128, lane);
#pragma unroll
        for (int r = 0; r < 4; ++r) { const int row = 4 * fq + r; const float rs = rstd_m16(ssq + row * 16); Um[(size_t)row * FF + c0 + fr] = (bf16)f2bf(pg8::silu_mul(g[r] * rs, u[r] * rs)); } }
}
__device__ __forceinline__ void meta_down(const Ptrs& P, int gw, int NGW, int lane) {
    unsigned char* ws = P.ws; const bf16* A = (const bf16*)(ws + WS_META + MO_UM); const bf16* Bt = (const bf16*)(ws + WS_WD1); bf16* H = (bf16*)(ws + WS_META + MO_H1MB);
    float* ssq = (float*)(ws + WS_META + MO_SSQM2); const int fr = lane & 15, fq = lane >> 4;
    for (int t = gw; t < DM / 16; t += NGW) { const f32x4 a = skinny16(A, Bt, FF, 16 * t, lane);
#pragma unroll
        for (int r = 0; r < 4; ++r) { const int row = 4 * fq + r; const float o = P.in[1][row * DM + 16 * t + fr] + 0.5f * a[r]; H[row * DM + 16 * t + fr] = (bf16)f2bf(o);
            float s = o * o; s += __shfl_xor(s, 1); s += __shfl_xor(s, 2); s += __shfl_xor(s, 4); s += __shfl_xor(s, 8); if (fr == 0) ssq[row * 64 + t] = s; } }
}
__device__ __forceinline__ void meta_win(const Ptrs& P, int gw, int NGW, int lane) {
    unsigned char* ws = P.ws; const bf16* A = (const bf16*)(ws + WS_META + MO_H1MB); const bf16* Bt = (const bf16*)(ws + WS_WIN); bf16* Zm = (bf16*)(ws + WS_META + MO_ZM);
    const float* ssq = (const float*)(ws + WS_META + MO_SSQM2); const int fr = lane & 15, fq = lane >> 4;
    for (int t = gw; t < NIN / 16; t += NGW) { const f32x4 a = skinny16(A, Bt, DM, 16 * t, lane); const int c = 16 * t + fr; const float bias = c >= ZC_Q ? P.in[8][c - ZC_Q] : 0.f;
#pragma unroll
        for (int r = 0; r < 4; ++r) { const int row = 4 * fq + r; float s = 0.f;
#pragma unroll 8
            for (int i = 0; i < 64; ++i) s += ssq[row * 64 + i];
            Zm[(size_t)row * NIN + c] = (bf16)f2bf(a[r] * __builtin_amdgcn_rsqf(s * (1.0f / 1024.0f) + 1e-5f) + bias); } }
}
constexpr int KS_LD = 72, VT_LD = 232, ATT_KS_BYTES = 208 * KS_LD * 2, ATT_VT_BYTES = 64 * VT_LD * 2;
__device__ __forceinline__ void attn_unit(const Ptrs& P, unsigned char* lds, int b, int g, int c, int tid, int wave, int lane) {
    unsigned char* ws = P.ws; const bf16* Z = (const bf16*)(ws + WS_BIG); const bf16* Zm = (const bf16*)(ws + WS_META + MO_ZM); bf16* Y = (bf16*)(ws + WS_XB);
    bf16* Ks = (bf16*)lds; bf16* Vt = (bf16*)(lds + ATT_KS_BYTES);
    const int fr = lane & 15, fq = lane >> 4;
    __syncthreads();
    for (int it = tid; it < 208 * 8; it += NWAVES * 64) { const int key = it >> 3, pc = it & 7; const bf16* src; bool valid = true;
        if (key < 16) src = Zm + (size_t)key * NIN; else { const int t = 64 * (c - 2) + (key - 16); valid = t >= 0; src = Z + ((size_t)b * TSEQ + (valid ? t : 0)) * NIN; }
        v4u kq = *(const v4u*)(src + ZC_K + 64 * g + 8 * pc), vq = *(const v4u*)(src + ZC_V + 64 * g + 8 * pc);
        if (!valid) { kq = (v4u){0u, 0u, 0u, 0u}; vq = kq; }
        *(v4u*)(Ks + key * KS_LD + 8 * pc) = kq;
#pragma unroll
        for (int e = 0; e < 4; ++e) { Vt[(8 * pc + 2 * e) * VT_LD + key] = (bf16)(vq[e] & 0xffffu); Vt[(8 * pc + 2 * e + 1) * VT_LD + key] = (bf16)(vq[e] >> 16); } }
    for (int it = tid; it < 64 * 16; it += NWAVES * 64) Vt[(it >> 4) * VT_LD + 208 + (it & 15)] = 0;
    __syncthreads();
    const int hq = 4 * g + (wave >> 1);
    const float slope = __builtin_amdgcn_exp2f(-(float)(hq + 1)), sink = P.in[20][hq];
#pragma unroll 1
    for (int sub = 0; sub < 2; ++sub) {
        const int i0 = 16 * (2 * (wave & 1) + sub), iq = i0 + fr;
        const size_t mrow = (size_t)b * TSEQ + 64 * c + iq;
        const bf16x8 q0 = *(const bf16x8*)(Z + mrow * NIN + ZC_Q + 64 * hq + 8 * fq), q1 = *(const bf16x8*)(Z + mrow * NIN + ZC_Q + 64 * hq + 32 + 8 * fq);
        f32x4 s[13]; float mx = sink;
#pragma unroll
        for (int kt = 0; kt < 13; ++kt) { const bf16* kp = Ks + (16 * kt + fr) * KS_LD + 8 * fq; f32x4 a = (f32x4){0.f, 0.f, 0.f, 0.f};
            a = __builtin_amdgcn_mfma_f32_16x16x32_bf16(*(const bf16x8*)(kp), q0, a, 0, 0, 0);
            a = __builtin_amdgcn_mfma_f32_16x16x32_bf16(*(const bf16x8*)(kp + 32), q1, a, 0, 0, 0);
#pragma unroll
            for (int r = 0; r < 4; ++r) { const int key = 16 * kt + 4 * fq + r; float v;
                if (kt == 0) v = a[r] * 0.125f - slope * (float)(16 + 64 * c + iq - key);
                else { const int jj = key - 16; const int d = 128 + iq - jj; v = a[r] * 0.125f - slope * (float)(d < 0 ? -d : d); if (64 * (c - 2) + jj < 0) v = -1e30f; }
                a[r] = v; mx = fmaxf(mx, v); }
            s[kt] = a; }
        mx = fmaxf(mx, __shfl_xor(mx, 16)); mx = fmaxf(mx, __shfl_xor(mx, 32));
        float sum = 0.f;
#pragma unroll
        for (int kt = 0; kt < 13; ++kt)
#pragma unroll
            for (int r = 0; r < 4; ++r) { const float p = __builtin_amdgcn_exp2f((s[kt][r] - mx) * 1.4426950408889634f); s[kt][r] = p; sum += p; }
        sum += __shfl_xor(sum, 16); sum += __shfl_xor(sum, 32);
        sum += __builtin_amdgcn_exp2f((sink - mx) * 1.4426950408889634f);
        const float rinv = 1.0f / sum;
        f32x4 o[4];
#pragma unroll
        for (int dt = 0; dt < 4; ++dt) o[dt] = (f32x4){0.f, 0.f, 0.f, 0.f};
#pragma unroll
        for (int ks = 0; ks < 7; ++ks) { const int ta = 2 * ks, tb = 2 * ks + 1; v4u pw;
            pw.x = pk2(s[ta][0], s[ta][1]); pw.y = pk2(s[ta][2], s[ta][3]);
            if (tb < 13) { pw.z = pk2(s[tb][0], s[tb][1]); pw.w = pk2(s[tb][2], s[tb][3]); } else { pw.z = 0u; pw.w = 0u; }
            const bf16x8 pf = __builtin_bit_cast(bf16x8, pw);
#pragma unroll
            for (int dt = 0; dt < 4; ++dt) { const bf16* vp = Vt + (16 * dt + fr) * VT_LD + 4 * fq; const v2u va = *(const v2u*)(vp + 16 * ta), vb = *(const v2u*)(vp + 16 * tb);
                const v4u vv = (v4u){va.x, va.y, vb.x, vb.y};
                o[dt] = __builtin_amdgcn_mfma_f32_16x16x32_bf16(__builtin_bit_cast(bf16x8, vv), pf, o[dt], 0, 0, 0); } }
#pragma unroll
        for (int dt = 0; dt < 4; ++dt) { v2u w; w.x = pk2(o[dt][0] * rinv, o[dt][1] * rinv); w.y = pk2(o[dt][2] * rinv, o[dt][3] * rinv);
            *(v2u*)(Y + mrow * DM + 512 + 64 * hq + 16 * dt + 4 * fq) = w; }
    }
}
template <int CTRL> __device__ __forceinline__ float dppf(float x) { return __builtin_bit_cast(float, __builtin_amdgcn_update_dpp(0, __builtin_bit_cast(int, x), CTRL, 0xF, 0xF, true)); }
template <int CTRL> __device__ __forceinline__ float dppf_old(float old, float x) { return __builtin_bit_cast(float, __builtin_amdgcn_update_dpp(__builtin_bit_cast(int, old), __builtin_bit_cast(int, x), CTRL, 0xF, 0xF, false)); }
__device__ __forceinline__ float red8(float x) { x += dppf<0xB1>(x); x += dppf<0x4E>(x); x += dppf<0x141>(x); return x; }
__device__ __forceinline__ float red16(float x) { x = red8(x); x += dppf<0x140>(x); return x; }
__device__ __forceinline__ float scan16(float x) { x += dppf<0x111>(x); x += dppf<0x112>(x); x += dppf<0x114>(x); x += dppf<0x118>(x); return x; }
constexpr int NCHUNK = 257, NSUPER = 65;
constexpr int CB_A = 0, CB_R = 2048, CB_BK = 4096, CB_VT = 8192, CB_TT = 10240, CB_AR = 11264, CB_G = 12288, CB_BON = 12544, CB_SIZE = 12800;
constexpr int CB_GATE = 12800, IMG_SIZE = 14848;
constexpr int WL_HS = IMG_SIZE, WL_SIZE = IMG_SIZE + 2048;
constexpr int SC_YB = 8 * CB_SIZE, SC_END = SC_YB + 8 * 4096, SC_CST = 768;
static_assert(8 * WL_SIZE <= LDSCTL_OFF && SC_END + SC_CST <= LDSCTL_OFF, "LDS map");
__device__ __forceinline__ bf16x8 pack8(const float* v) { v4u o; o.x = pk2(v[0], v[1]); o.y = pk2(v[2], v[3]); o.z = pk2(v[4], v[5]); o.w = pk2(v[6], v[7]); return __builtin_bit_cast(bf16x8, o); }
__device__ __forceinline__ void unpack8(v4u w, float* v) { v[0] = bflo(w.x); v[1] = bfhi(w.x); v[2] = bflo(w.y); v[3] = bfhi(w.y); v[4] = bflo(w.z); v[5] = bfhi(w.z); v[6] = bflo(w.w); v[7] = bfhi(w.w); }


__device__ __forceinline__ void chunk_task(const Ptrs& P, unsigned char* ldsb, int woff, int b, int h, int ch, int lane) {
    int wo_ = woff; asm volatile("" : "+v"(wo_));
    unsigned char* wl = ldsb + wo_;
    unsigned char* ws = P.ws; const int fr = lane & 15, fq = lane >> 4, t = fr;
    const bf16* Z = (const bf16*)(ws + WS_BIG); const bf16* Zm = (const bf16*)(ws + WS_META + MO_ZM); const bf16* LT = (const bf16*)(ws + WS_LT);
    const bool meta = (ch == 0);
    const int tok = 16 * (ch - 1) + fr; const size_t m = (size_t)b * TSEQ + tok;
    const bf16* zc = meta ? Zm + (size_t)fr * NIN : Z + m * NIN;
    const bool pz = meta && fr == 0;
    const bf16* zp = meta ? Zm + (size_t)(fr > 0 ? fr - 1 : 0) * NIN : (tok == 0 ? Zm + (size_t)15 * NIN : Z + (m - 1) * NIN);
    const float* mu = P.in[9];
    bf16* sx = (bf16*)wl;
    {
    bf16x8 xf[5];
#pragma unroll
    for (int ks = 0; ks < 5; ++ks) { const int c0 = ZC_W + 32 * ks + 8 * fq; const v4u a = *(const v4u*)(zc + c0); v4u bq = *(const v4u*)(zp + c0); if (pz) bq = (v4u){0u, 0u, 0u, 0u};
        float va[8], vb[8], v[8]; unpack8(a, va); unpack8(bq, vb); const f32x4 m0 = *(const f32x4*)(mu + c0), m1 = *(const f32x4*)(mu + c0 + 4);
#pragma unroll
        for (int e = 0; e < 8; ++e) { const float mm = e < 4 ? m0[e & 3] : m1[e & 3]; const float z = va[e] + (vb[e] - va[e]) * mm; v[e] = (ks == 0) ? tanhf_(z) : (ks == 1) ? z : sigmoidf_(z); }
        xf[ks] = pack8(v); }
    f32x4 aw[4], aa[4], ag[4];
#pragma unroll
    for (int nt = 0; nt < 4; ++nt) { const bf16* lp = LT + (size_t)(h * 64 + 16 * nt + fr) * 160 + 8 * fq; const f32x4 z = (f32x4){0.f, 0.f, 0.f, 0.f};
        aw[nt] = __builtin_amdgcn_mfma_f32_16x16x32_bf16(*(const bf16x8*)(lp), xf[0], z, 0, 0, 0);
        aa[nt] = __builtin_amdgcn_mfma_f32_16x16x32_bf16(*(const bf16x8*)(lp + 32), xf[1], z, 0, 0, 0);
        ag[nt] = __builtin_amdgcn_mfma_f32_16x16x32_bf16(*(const bf16x8*)(lp + 64), xf[2], z, 0, 0, 0);
        ag[nt] = __builtin_amdgcn_mfma_f32_16x16x32_bf16(*(const bf16x8*)(lp + 96), xf[3], ag[nt], 0, 0, 0);
        ag[nt] = __builtin_amdgcn_mfma_f32_16x16x32_bf16(*(const bf16x8*)(lp + 128), xf[4], ag[nt], 0, 0, 0); }
    f32x4 kkr[4], kv[4], av[4]; float ss = 0.f;
#pragma unroll
    for (int nt = 0; nt < 4; ++nt) { const int c = h * 64 + 16 * nt + 4 * fq; const v2u a = *(const v2u*)(zc + 512 + c); v2u bq = *(const v2u*)(zp + 512 + c); if (pz) bq = (v2u){0u, 0u};
        const f32x4 za = unpack4(a), zb = unpack4(bq), mk = *(const f32x4*)(mu + 512 + c); const f32x4 zk = za + (zb - za) * mk;
        const f32x4 a0 = *(const f32x4*)(P.in[12] + c), kkw = *(const f32x4*)(P.in[15] + c), kaw = *(const f32x4*)(P.in[16] + c);
        f32x4 a_;
#pragma unroll
        for (int r = 0; r < 4; ++r) a_[r] = sigmoidf_(a0[r] + aa[nt][r]);
        av[nt] = a_; kkr[nt] = zk * kkw; kv[nt] = zk * (1.0f + (a_ - 1.0f) * kaw);
        ss += (kkr[nt][0] * kkr[nt][0] + kkr[nt][1] * kkr[nt][1]) + (kkr[nt][2] * kkr[nt][2] + kkr[nt][3] * kkr[nt][3]); }
    ss += __shfl_xor(ss, 16); ss += __shfl_xor(ss, 32);
    const float inv = 1.0f / fmaxf(sqrtf(ss), 1e-12f);
#pragma unroll
    for (int nt = 0; nt < 4; ++nt) { const int cl = 16 * nt + 4 * fq, c = h * 64 + cl; const f32x4 w0 = *(const f32x4*)(P.in[10] + c);
        const f32x4 kk = kkr[nt] * inv, bb = kk * av[nt]; f32x4 e;
#pragma unroll
        for (int r = 0; r < 4; ++r) e[r] = 0.6065306597126334f * sigmoidf_(w0[r] + aw[nt][r]);
        bf16* px = sx + t * 64 + cl; v2u o;
        o.x = pk2(kk[0], kk[1]); o.y = pk2(kk[2], kk[3]); *(v2u*)(px) = o;
        o.x = pk2(e[0], e[1]); o.y = pk2(e[2], e[3]); *(v2u*)(px + 1024) = o;
        o.x = pk2(bb[0], bb[1]); o.y = pk2(bb[2], bb[3]); *(v2u*)(px + 2048) = o;
        o.x = pk2(kv[nt][0], kv[nt][1]); o.y = pk2(kv[nt][2], kv[nt][3]); *(v2u*)(px + 3072) = o;
        o.x = pk2m(ag[nt][0], ag[nt][1]); o.y = pk2m(ag[nt][2], ag[nt][3]); *(v2u*)(px + 4096) = o; }
    }
    asm volatile("s_waitcnt lgkmcnt(0)" ::: "memory"); __builtin_amdgcn_sched_barrier(0);
    v4u xk[2], xe[2], xb[2], xx[2], xg[2];
#pragma unroll
    for (int ks = 0; ks < 2; ++ks) { const bf16* px = sx + t * 64 + 32 * ks + 8 * fq; xk[ks] = *(const v4u*)(px); xe[ks] = *(const v4u*)(px + 1024); xb[ks] = *(const v4u*)(px + 2048); xx[ks] = *(const v4u*)(px + 3072); xg[ks] = *(const v4u*)(px + 4096); }
    asm volatile("s_waitcnt lgkmcnt(0)" ::: "memory"); __builtin_amdgcn_sched_barrier(0);
    unsigned char* cb = wl; float* hs = (float*)(wl + WL_HS);
    const int cbase = h * 64 + 8 * fq;
    unsigned char* pbk = cb + CB_BK + ((((fq >> 1) * 4 + (t >> 2)) * 16 + 8 * (fq & 1)) * 8 + (t & 3)) * 2;
    unsigned char* pvt = cb + CB_VT + (((fq >> 1) * 4 + (t >> 2)) * 16 + 8 * (fq & 1)) * 8 + (t & 3) * 2;
    unsigned char* pgc = cb + CB_G + 8 * fq * 4;
    bf16x8 Af[2], Rf[2], Bf[2], Kf[2]; float bonp = 0.f;
#pragma unroll
    for (int ks = 0; ks < 2; ++ks) { const int c = cbase + 32 * ks, cl = 32 * ks + 8 * fq;
        asm volatile("" ::: "memory"); __builtin_amdgcn_sched_barrier(0);
        float kk[8], e_[8], bb[8], kx[8], rc[8], rp[8], vc[8], vp[8];
        unpack8(xk[ks], kk); unpack8(xe[ks], e_); unpack8(xb[ks], bb); unpack8(xx[ks], kx);
        unpack8(*(const v4u*)(zc + c), rc); unpack8(*(const v4u*)(zc + 1024 + c), vc);
        { v4u a = *(const v4u*)(zp + c), d = *(const v4u*)(zp + 1024 + c); if (pz) { a = (v4u){0u, 0u, 0u, 0u}; d = a; } unpack8(a, rp); unpack8(d, vp); }
        float At[8], Rt[8], Bt[8], Kt[8]; float mur[8], muv[8], rkk[8];
        { const f32x4 a0 = *(const f32x4*)(P.in[9] + c), a1 = *(const f32x4*)(P.in[9] + c + 4), b0 = *(const f32x4*)(P.in[9] + 1024 + c), b1 = *(const f32x4*)(P.in[9] + 1024 + c + 4), c0 = *(const f32x4*)(P.in[17] + c), c1 = *(const f32x4*)(P.in[17] + c + 4);
#pragma unroll
          for (int e = 0; e < 4; ++e) { mur[e] = a0[e]; mur[4 + e] = a1[e]; muv[e] = b0[e]; muv[4 + e] = b1[e]; rkk[e] = c0[e]; rkk[4 + e] = c1[e]; } }
#pragma unroll
        for (int e = 0; e < 8; ++e) { const float rr = rc[e] + (rp[e] - rc[e]) * mur[e]; const float vv = vc[e] + (vp[e] - vc[e]) * muv[e];
            bonp += rr * kx[e] * rkk[e];
            const float ec = scan16(e_[e]), etot = red16(e_[e]);
            const float g1 = __builtin_amdgcn_exp2f(-1.4426950408889634f * ec);
            const float gi = __builtin_amdgcn_exp2f(1.4426950408889634f * ec);
            const float gC = __builtin_amdgcn_exp2f(-1.4426950408889634f * etot);
            const float g0 = dppf_old<0x111>(1.0f, g1);
            At[e] = -kk[e] * g0; Rt[e] = rr * g1; Bt[e] = bb[e] * gi; Kt[e] = kx[e] * gi;
            const int ke = 32 * ks + e;
            *(bf16*)(pbk + ks * 2048 + e * 16) = (bf16)f2bf(Bt[e] * gC);
            *(bf16*)(pbk + ks * 2048 + e * 16 + 8) = (bf16)f2bf(Kt[e] * gC);
            *(bf16*)(pvt + ks * 1024 + e * 8) = (bf16)f2bf(vv);
            if (t == 15) *(float*)(pgc + ke * 4) = gC; }
        Af[ks] = pack8(At); Rf[ks] = pack8(Rt); Bf[ks] = pack8(Bt); Kf[ks] = pack8(Kt);
        { const int fqs = 2 * (fq & 1), bo = (fq >> 1) * 8; const v4u aw = __builtin_bit_cast(v4u, Af[ks]), rw = __builtin_bit_cast(v4u, Rf[ks]);
          *(v2u*)(cb + CB_A + ((ks * 4 + fqs) * 16 + t) * 16 + bo) = (v2u){aw.x, aw.y}; *(v2u*)(cb + CB_A + ((ks * 4 + fqs + 1) * 16 + t) * 16 + bo) = (v2u){aw.z, aw.w};
          *(v2u*)(cb + CB_R + ((ks * 4 + fqs) * 16 + t) * 16 + bo) = (v2u){rw.x, rw.y}; *(v2u*)(cb + CB_R + ((ks * 4 + fqs + 1) * 16 + t) * 16 + bo) = (v2u){rw.z, rw.w}; }
        *(v4u*)(cb + CB_GATE + (t * 64 + cl) * 2) = xg[ks]; }
    asm volatile("" ::: "memory"); __builtin_amdgcn_sched_barrier(0);
    bonp += __shfl_xor(bonp, 16); bonp += __shfl_xor(bonp, 32);
    if (fq == 0) *(float*)(cb + CB_BON + t * 4) = bonp;
    const f32x4 z4 = (f32x4){0.f, 0.f, 0.f, 0.f};
    f32x4 Mab = __builtin_amdgcn_mfma_f32_16x16x32_bf16(Af[0], Bf[0], z4, 0, 0, 0); Mab = __builtin_amdgcn_mfma_f32_16x16x32_bf16(Af[1], Bf[1], Mab, 0, 0, 0);
    f32x4 Mak = __builtin_amdgcn_mfma_f32_16x16x32_bf16(Af[0], Kf[0], z4, 0, 0, 0); Mak = __builtin_amdgcn_mfma_f32_16x16x32_bf16(Af[1], Kf[1], Mak, 0, 0, 0);
    f32x4 Mrb = __builtin_amdgcn_mfma_f32_16x16x32_bf16(Rf[0], Bf[0], z4, 0, 0, 0); Mrb = __builtin_amdgcn_mfma_f32_16x16x32_bf16(Rf[1], Bf[1], Mrb, 0, 0, 0);
    f32x4 Mrk = __builtin_amdgcn_mfma_f32_16x16x32_bf16(Rf[0], Kf[0], z4, 0, 0, 0); Mrk = __builtin_amdgcn_mfma_f32_16x16x32_bf16(Rf[1], Kf[1], Mrk, 0, 0, 0);
#pragma unroll
    for (int r = 0; r < 4; ++r) { const int tt = 4 * fq + r, i = fr;
        const float mab = (tt > i) ? Mab[r] : 0.f, mak = (tt > i) ? Mak[r] : 0.f, mrb = (tt >= i) ? Mrb[r] : 0.f, mrk = (tt >= i) ? Mrk[r] : 0.f;
        hs[tt * 16 + i] = mab; hs[256 + tt * 16 + i] = mak;
        const unsigned w = pk2m(mrb, mrk);
        *(bf16*)(cb + CB_AR + (((i >> 2) * 16 + tt) * 8 + (i & 3)) * 2) = (bf16)(w & 0xffffu);
        *(bf16*)(cb + CB_AR + (((i >> 2) * 16 + tt) * 8 + 4 + (i & 3)) * 2) = (bf16)(w >> 16); }
    asm volatile("s_waitcnt lgkmcnt(0)" ::: "memory");
    { const int c = lane & 31, cc = c & 15; const bool isT = c < 16; float out[16];
#pragma unroll
      for (int tt = 0; tt < 16; ++tt) { float acc = isT ? (tt == cc ? 1.0f : 0.0f) : hs[256 + tt * 16 + cc];
#pragma unroll
          for (int i4 = 0; i4 < (tt + 3) / 4; ++i4) { const f32x4 l = *(const f32x4*)(hs + tt * 16 + 4 * i4);
#pragma unroll
              for (int e = 0; e < 4; ++e) if (4 * i4 + e < tt) acc += l[e] * out[4 * i4 + e]; }
          out[tt] = acc;
          if (lane < 32) *(bf16*)(cb + CB_TT + (((cc >> 2) * 16 + tt) * 8 + (isT ? 0 : 4) + (cc & 3)) * 2) = (bf16)f2bf(acc); } }
    asm volatile("s_waitcnt lgkmcnt(0)" ::: "memory");
    { unsigned char* gi = ws + WS_IMG + ((size_t)(b * NHEAD + h) * NCHUNK + ch) * IMG_SIZE;
      for (int i = lane; i < IMG_SIZE / 16; i += 64) *(v4u*)(gi + i * 16) = *(const v4u*)(cb + i * 16); }
    asm volatile("s_waitcnt lgkmcnt(0)" ::: "memory"); __builtin_amdgcn_sched_barrier(0);
}

struct ScanOps { bf16x8 a0, a1, r0, r1, tt, ar, bk[4]; v2u vt; f32x4 g[4]; };
__device__ __forceinline__ void scan_load(ScanOps& o, const unsigned char* ib, int fr, int fq, int vcol) {
    const int ln = (fq * 16 + fr) * 16;
    o.a0 = *(const bf16x8*)(ib + CB_A + ln); o.a1 = *(const bf16x8*)(ib + CB_A + 1024 + ln);
    o.r0 = *(const bf16x8*)(ib + CB_R + ln); o.r1 = *(const bf16x8*)(ib + CB_R + 1024 + ln);
    o.tt = *(const bf16x8*)(ib + CB_TT + ln); o.ar = *(const bf16x8*)(ib + CB_AR + ln);
    o.vt = *(const v2u*)(ib + CB_VT + (((vcol >> 4) * 4 + fq) * 16 + fr) * 8);
#pragma unroll
    for (int kt = 0; kt < 4; ++kt) { o.g[kt] = *(const f32x4*)(ib + CB_G + (16 * kt + 4 * fq) * 4); o.bk[kt] = *(const bf16x8*)(ib + CB_BK + kt * 1024 + ln); }
}
__device__ __forceinline__ void scan_step(f32x4 (&H)[4], const ScanOps& o, float* yb, int fq, int vcol) {
    v4u hb0, hb1;
    hb0.x = pk2m(H[0][0], H[0][1]); hb0.y = pk2m(H[0][2], H[0][3]); hb0.z = pk2m(H[1][0], H[1][1]); hb0.w = pk2m(H[1][2], H[1][3]);
    hb1.x = pk2m(H[2][0], H[2][1]); hb1.y = pk2m(H[2][2], H[2][3]); hb1.z = pk2m(H[3][0], H[3][1]); hb1.w = pk2m(H[3][2], H[3][3]);
    const bf16x8 h0 = __builtin_bit_cast(bf16x8, hb0), h1 = __builtin_bit_cast(bf16x8, hb1);
    const f32x4 z4 = (f32x4){0.f, 0.f, 0.f, 0.f};
    f32x4 X = __builtin_amdgcn_mfma_f32_16x16x32_bf16(o.a0, h0, z4, 0, 0, 0); X = __builtin_amdgcn_mfma_f32_16x16x32_bf16(o.a1, h1, X, 0, 0, 0);
    f32x4 Y = __builtin_amdgcn_mfma_f32_16x16x32_bf16(o.r0, h0, z4, 0, 0, 0); Y = __builtin_amdgcn_mfma_f32_16x16x32_bf16(o.r1, h1, Y, 0, 0, 0);
    v4u xb; xb.x = pk2m(X[0], X[1]); xb.y = pk2m(X[2], X[3]); xb.z = o.vt.x; xb.w = o.vt.y;
    const f32x4 U = __builtin_amdgcn_mfma_f32_16x16x32_bf16(o.tt, __builtin_bit_cast(bf16x8, xb), z4, 0, 0, 0);
    v4u ub; ub.x = pk2m(U[0], U[1]); ub.y = pk2m(U[2], U[3]); ub.z = o.vt.x; ub.w = o.vt.y;
    const bf16x8 uf = __builtin_bit_cast(bf16x8, ub);
    Y = __builtin_amdgcn_mfma_f32_16x16x32_bf16(o.ar, uf, Y, 0, 0, 0);
#pragma unroll
    for (int kt = 0; kt < 4; ++kt) H[kt] = __builtin_amdgcn_mfma_f32_16x16x32_bf16(o.bk[kt], uf, H[kt] * o.g[kt], 0, 0, 0);
#pragma unroll
    for (int r = 0; r < 4; ++r) yb[(4 * fq + r) * 64 + vcol] = Y[r];
}
__device__ __forceinline__ void scan_phase(const Ptrs& P, unsigned char* lds, int sb, int tid, int wave, int lane, int never) {
    const int b = sb >> 3, h = sb & 7, fr = lane & 15, fq = lane >> 4;
    const unsigned char* img = P.ws + WS_IMG + (size_t)(b * NHEAD + h) * NCHUNK * IMG_SIZE;
    if (wave < 4) {
        f32x4 H[4];
#pragma unroll
        for (int kt = 0; kt < 4; ++kt) H[kt] = (f32x4){0.f, 0.f, 0.f, 0.f};
        const int vcol = 16 * wave + fr;
#pragma unroll 1
        for (int s = 0; s <= NSUPER + 1; ++s) {
            __syncthreads();
            if (s < 1 || s > NSUPER) continue;
            const int set = (s - 1) & 1;
#pragma unroll 1
            for (int j = 0; j < 4; ++j) { const int ch = 4 * (s - 1) + j; if (ch >= NCHUNK) break;
                ScanOps o; scan_load(o, lds + (set * 4 + j) * CB_SIZE, fr, fq, vcol);
                scan_step(H, o, (float*)(lds + SC_YB + (set * 4 + j) * 4096), fq, vcol); }
        }
    } else {
        const int hw = wave - 4, t = fr;
        const bf16* Z = (const bf16*)(P.ws + WS_BIG); const bf16* Zm = (const bf16*)(P.ws + WS_META + MO_ZM);
        bf16* Yo = (bf16*)(P.ws + WS_XB);
        const int cbase = h * 64 + 8 * fq;
        float* cst = (float*)(lds + SC_END);
        if (lane < 48) { const int a_ = lane >> 4, c4 = (lane & 15) * 4; const float* src = a_ == 0 ? P.in[9] + 1024 + h * 64 : a_ == 1 ? P.in[18] + h * 64 : P.in[19] + h * 64;
            *(f32x4*)(cst + a_ * 64 + c4) = *(const f32x4*)(src + c4); }
        v4u cg0[2], cg1[2]; v4u im0[13], im1[13];
        const int pvt_off = CB_VT + (((fq >> 1) * 4 + (t >> 2)) * 16 + 8 * (fq & 1)) * 8 + (t & 3) * 2;
#define GLD16(dst, ptr) asm volatile("global_load_dwordx4 %0, %1, off" : "=v"(dst) : "v"(ptr) : "memory")
#define GLD4(dst, ptr) asm volatile("global_load_dword %0, %1, off" : "=v"(dst) : "v"(ptr) : "memory")
#define IMG_LOAD(IM, chx) do { const unsigned char* ip_ = img + (size_t)(chx) * IMG_SIZE + lane * 16; _Pragma("unroll") for (int i_ = 0; i_ < 13; ++i_) GLD16(IM[i_], ip_ + i_ * 1024); } while (0)
#define VM_WAIT_ALL(N) asm volatile("s_waitcnt vmcnt(" #N ")" : "+v"(im0[0]), "+v"(im0[1]), "+v"(im0[2]), "+v"(im0[3]), "+v"(im0[4]), "+v"(im0[5]), "+v"(im0[6]), "+v"(im0[7]), "+v"(im0[8]), "+v"(im0[9]), "+v"(im0[10]), "+v"(im0[11]), "+v"(im0[12]), \
            "+v"(im1[0]), "+v"(im1[1]), "+v"(im1[2]), "+v"(im1[3]), "+v"(im1[4]), "+v"(im1[5]), "+v"(im1[6]), "+v"(im1[7]), "+v"(im1[8]), "+v"(im1[9]), "+v"(im1[10]), "+v"(im1[11]), "+v"(im1[12]) :: "memory")
#define VM_WAIT_POST(N) asm volatile("s_waitcnt vmcnt(" #N ")" : "+v"(cg0[0]), "+v"(cg0[1]), "+v"(cg1[0]), "+v"(cg1[1]) :: "memory")
#define POST_LOAD(CG, sx) do { int chn_ = 4 * ((sx) - 2) + hw; chn_ = chn_ < 1 ? 1 : (chn_ >= NCHUNK ? NCHUNK - 1 : chn_);     \
            const unsigned char* ib_ = img + (size_t)chn_ * IMG_SIZE; \
            _Pragma("unroll") for (int ks = 0; ks < 2; ++ks) GLD16(CG[ks], ib_ + CB_GATE + (t * 64 + 32 * ks + 8 * fq) * 2); } while (0)
        POST_LOAD(cg0, 0); IMG_LOAD(im0, hw);
        POST_LOAD(cg1, 1); IMG_LOAD(im1, 4 + hw);
#define HELPER_ITER(IM, CG) do { \
            __syncthreads(); \
            VM_WAIT_ALL(15); VM_WAIT_POST(15);        \
            unsigned char* cbw = lds + ((s & 1) * 4 + hw) * CB_SIZE;            \
            { const int ch = 4 * (s - 2) + hw; \
              if (s >= 2 && ch >= 1 && ch < NCHUNK) { const float* yb = (const float*)(lds + SC_YB + ((s & 1) * 4 + hw) * 4096); \
                const int tok = 16 * (ch - 1) + t; const size_t m = (size_t)b * TSEQ + tok; \
                float y[16]; float sm = 0.f; \
                _Pragma("unroll") for (int ks = 0; ks < 2; ++ks) { const f32x4 y0 = *(const f32x4*)(yb + t * 64 + 32 * ks + 8 * fq), y1 = *(const f32x4*)(yb + t * 64 + 32 * ks + 8 * fq + 4); \
                    _Pragma("unroll") for (int e = 0; e < 4; ++e) { y[8 * ks + e] = y0[e]; y[8 * ks + 4 + e] = y1[e]; sm += y0[e] + y1[e]; } } \
                sm += __shfl_xor(sm, 16); sm += __shfl_xor(sm, 32); const float mean = sm * (1.0f / 64.0f); float sq = 0.f; \
                _Pragma("unroll") for (int i = 0; i < 16; ++i) { y[i] -= mean; sq += y[i] * y[i]; } \
                sq += __shfl_xor(sq, 16); sq += __shfl_xor(sq, 32); const float rs = __builtin_amdgcn_rsqf(sq * (1.0f / 64.0f) + 64e-5f); \
                const float bon = *(const float*)(cbw + CB_BON + t * 4); \
                _Pragma("unroll") for (int ks = 0; ks < 2; ++ks) { const int c = cbase + 32 * ks; \
                    float g[8], o[8]; unpack8(CG[ks], g); \
                    const float* cq = cst + 32 * ks + 8 * fq; const f32x4 wA = *(const f32x4*)(cq + 64), wB = *(const f32x4*)(cq + 68), bA = *(const f32x4*)(cq + 128), bB = *(const f32x4*)(cq + 132); \
                    _Pragma("unroll") for (int e = 0; e < 8; ++e) { const float lw_ = e < 4 ? wA[e & 3] : wB[e & 3], lb_ = e < 4 ? bA[e & 3] : bB[e & 3]; \
                        const float vv = __builtin_bit_cast(float, (unsigned)(*(const bf16*)(cbw + pvt_off + ks * 1024 + e * 8)) << 16); \
                        o[e] = (y[8 * ks + e] * rs * lw_ + lb_ + bon * vv) * g[e]; } \
                    *(bf16x8*)(Yo + m * DM + c) = pack8(o); } } } \
            asm volatile("s_waitcnt lgkmcnt(0)" ::: "memory");                   \
            if (4 * s + hw < NCHUNK) { \
                _Pragma("unroll") for (int i_ = 0; i_ < 13; ++i_) if (i_ < 12 || lane < 32) *(v4u*)(cbw + (i_ * 64 + lane) * 16) = IM[i_]; } \
            POST_LOAD(CG, s + 2); \
            { const int cl_ = 4 * (s + 2) + hw; IMG_LOAD(IM, cl_ < NCHUNK ? cl_ : NCHUNK - 1); } \
        } while (0)
#pragma unroll 1
        for (int s2 = 0; s2 <= NSUPER + 1; s2 += 2) {
            { const int s = s2; HELPER_ITER(im0, cg0); }
            if (s2 + 1 <= NSUPER + 1) { const int s = s2 + 1; HELPER_ITER(im1, cg1); }
        }
        asm volatile("s_waitcnt vmcnt(0)" ::: "memory");
#undef HELPER_ITER
#undef POST_LOAD
#undef VM_WAIT_ALL
#undef VM_WAIT_POST
#undef GLD16
#undef GLD4
#undef IMG_LOAD
    }
}
__device__ __forceinline__ void final_norm(const Ptrs& P, int gw, int NGW, int lane) {
    const float* ssq = (const float*)(P.ws + WS_SSQ4); const GAS f32x4* g4 = (const GAS f32x4*)P.in[26] + lane;
    f32x4 g[4];
#pragma unroll
    for (int j = 0; j < 4; ++j) g[j] = g4[64 * j];
    for (int m = gw; m < MR; m += NGW) { const float rs = pg8::rstd_from16(ssq, m); GAS f32x4* o = (GAS f32x4*)(P.out + (size_t)m * DM) + lane;
#pragma unroll
        for (int j = 0; j < 4; ++j) o[64 * j] = o[64 * j] * rs * g[j]; }
}
#ifndef MK_N_LAUNCHES
#define MK_N_LAUNCHES 1
#endif
constexpr int N_PHASES = 10;
struct Args { Ptrs p; int ph_lo, ph_hi, use_cg, pad; };
__global__ void __launch_bounds__(NWAVES * 64, 2) hymba_fwd(Args args) {
    extern __shared__ __attribute__((aligned(16))) unsigned char lds[];
    LAS unsigned char* ldsl = (LAS unsigned char*)lds;
    volatile LAS unsigned* MISC = (volatile LAS unsigned*)(ldsl + MISC_OFF);
    const int tid = threadIdx.x, lane = tid & 63, wave = __builtin_amdgcn_readfirstlane(tid >> 6);
    const int G = gridDim.x, bx = blockIdx.x, vcu = (G % 8 == 0) ? (bx % 8) * (G / 8) + bx / 8 : bx;
    const Ptrs& P = args.p; unsigned char* ws = P.ws;
    if (args.use_cg) cg::this_grid().sync();
    for (int u = tid; u < (LDS_BYTES - LDSCTL_OFF) / 4; u += NWAVES * 64) ((LAS unsigned*)(ldsl + LDSCTL_OFF))[u] = 0u;
    __syncthreads();
    const int lo = args.ph_lo, hi = args.ph_hi;
    XcdBarrier bar; bar.bar = (unsigned*)(ws + WS_CTL) + CW_BAR; bar.x = 0; bar.st = nullptr;
    if (hi - lo > 1) bar = xcd_barrier_post((unsigned*)(ws + WS_CTL) + CW_BAR, MISC + 8);
#define IN(k) (lo <= (k) && (k) < hi)
#define SEAM(k) do { if (IN(k) && IN((k) + 1)) xcd_barrier(bar); } while (0)
    const int gw = vcu * NWAVES + wave, NGW = G * NWAVES;
    const int gwm = bx + G * wave;

#ifndef REP_P0
#define REP_P0 1
#endif
    if (IN(0)) { for (int rep = 0; rep < REP_P0; ++rep) p0_prologue(P, ldsl, vcu, G, wave, lane); SEAM(0); }
    if (IN(1)) {
        meta_up(ws, gwm, NGW, lane);
        pg8::Gemm g{(const bf16*)(ws + WS_XB), (const bf16*)(ws + WS_WGU1), MR, NGU, DM}; pg8::StaticOrder S; S.init(MR, NGU, G, bx);
        LAS float* rcache = (LAS float*)(ldsl + RING_BYTES); pg8::fill_rstd_cache(rcache, (const float*)(ws + WS_SSQ1), S);
        pg8::EpiSwiglu E{(bf16*)(ws + WS_BIG), (const float*)(ws + WS_SSQ1), FF, rcache};
#ifndef REP_P1
#define REP_P1 1
#endif
        for (int rep = 0; rep < REP_P1; ++rep) pg8::gemm_phase<pg8::EpiSwiglu, pg8::StaticOrder, true, true>(ldsl, g, S, E);
        SEAM(1);
    }
    if (IN(2)) {
        meta_down(P, gwm, NGW, lane);
        pg8::Gemm g{(const bf16*)(ws + WS_BIG), (const bf16*)(ws + WS_WD1), MR, DM, FF}; pg8::StaticOrder S; S.init(MR, DM, G, bx);
        pg8::EpiResid<true> E{P.in[0], P.out, (bf16*)(ws + WS_XB), (float*)(ws + WS_SSQ2), 0.5f};
#ifndef REP_P2
#define REP_P2 1
#endif
        for (int rep = 0; rep < REP_P2; ++rep) pg8::gemm_phase<pg8::EpiResid<true>, pg8::StaticOrder, true, true>(ldsl, g, S, E);
        SEAM(2);
    }
    if (IN(3)) {
        meta_win(P, gwm, NGW, lane);
        pg8::Gemm g{(const bf16*)(ws + WS_XB), (const bf16*)(ws + WS_WIN), MR, NINP, DM}; pg8::StaticOrder S; S.init(MR, NINP, G, bx);
        LAS float* rcache = (LAS float*)(ldsl + RING_BYTES); pg8::fill_rstd_cache(rcache, (const float*)(ws + WS_SSQ2), S);
        pg8::EpiZ E{(bf16*)(ws + WS_BIG), (const float*)(ws + WS_SSQ2), P.in[8], NIN, NIN, ZC_Q, rcache};
        pg8::gemm_phase<pg8::EpiZ, pg8::StaticOrder, true, true>(ldsl, g, S, E);
        SEAM(3);
    }
    if (IN(4)) {
#ifndef REP_PREP
#define REP_PREP 1
#endif
        for (int rep = 0; rep < REP_PREP; ++rep) for (int task = gw; task < NBATCH * NHEAD * NCHUNK; task += NGW) { const int bc = task >> 3; chunk_task(P, lds, wave * WL_SIZE, bc / NCHUNK, task & 7, bc % NCHUNK, lane); }
        SEAM(4);
    }
    if (IN(5)) {
#ifndef REP_SCAN
#define REP_SCAN 1
#endif
#ifndef REP_ATTN
#define REP_ATTN 1
#endif
        if (bx < 64) { for (int rep = 0; rep < REP_SCAN; ++rep) { scan_phase(P, lds, bx, tid, wave, lane, args.use_cg); __syncthreads(); } }
        else { for (int rep = 0; rep < REP_ATTN; ++rep) for (int u = bx - 64; u < NBATCH * 2 * 64; u += G - 64) attn_unit(P, lds, u >> 7, (u >> 6) & 1, u & 63, tid, wave, lane);
            __syncthreads();
#ifndef REP_TR1
#define REP_TR1 1
#endif
            for (int rep = 0; rep < REP_TR1; ++rep) p0_transposes(P, ldsl, 1, (bx - 64) * NWAVES + wave, (G - 64) * NWAVES, wave, lane); }
        __syncthreads();
        SEAM(5);
    }
    if (IN(6)) {
        pg8::Gemm g{(const bf16*)(ws + WS_XB), (const bf16*)(ws + WS_WOUT), MR, DM, DM}; pg8::StaticOrder S; S.init(MR, DM, G, bx);
        pg8::EpiResid<true> E{P.out, P.out, (bf16*)(ws + WS_P), (float*)(ws + WS_SSQ3), 1.0f};
        pg8::gemm_phase<pg8::EpiResid<true>, pg8::StaticOrder, true, true>(ldsl, g, S, E);
        SEAM(6);
    }
    if (IN(7)) {
        pg8::Gemm g{(const bf16*)(ws + WS_P), (const bf16*)(ws + WS_WGU2), MR, NGU, DM}; pg8::StaticOrder S; S.init(MR, NGU, G, bx);
        LAS float* rcache = (LAS float*)(ldsl + RING_BYTES); pg8::fill_rstd_cache(rcache, (const float*)(ws + WS_SSQ3), S);
        pg8::EpiSwiglu E{(bf16*)(ws + WS_BIG), (const float*)(ws + WS_SSQ3), FF, rcache};
        pg8::gemm_phase<pg8::EpiSwiglu, pg8::StaticOrder, true, true>(ldsl, g, S, E);
        SEAM(7);
    }
    if (IN(8)) {
        pg8::Gemm g{(const bf16*)(ws + WS_BIG), (const bf16*)(ws + WS_WD2), MR, DM, FF}; pg8::StaticOrder S; S.init(MR, DM, G, bx);
        pg8::EpiResid<false> E{P.out, P.out, nullptr, (float*)(ws + WS_SSQ4), 0.5f};
        pg8::gemm_phase<pg8::EpiResid<false>, pg8::StaticOrder, true, true>(ldsl, g, S, E);
        SEAM(8);
    }
    if (IN(9)) final_norm(P, gw, NGW, lane);
#undef IN
#undef SEAM
}

extern "C" void kernel_launch(void* const* d_in, const int* in_sizes, int n_in, void* d_out, int out_size, void* d_ws, size_t ws_size, hipStream_t stream) {
    static int grid = 0;
    if (grid == 0) {
        if (n_in != 27 || in_sizes[0] != MR * DM || out_size != MR * DM || ws_size < WS_END) { fprintf(stderr, "kernel_launch: unexpected shapes (n_in %d, in0 %d, out %d, ws %zu)\n", n_in, n_in > 0 ? in_sizes[0] : -1, out_size, ws_size); grid = -1; return; }
        int dev = 0, cus = 0, per_cu = 0;
        if (hipGetDevice(&dev) != hipSuccess || hipDeviceGetAttribute(&cus, hipDeviceAttributeMultiprocessorCount, dev) != hipSuccess) { grid = -1; return; }
        if (hipFuncSetAttribute((const void*)hymba_fwd, hipFuncAttributeMaxDynamicSharedMemorySize, LDS_BYTES) != hipSuccess) { fprintf(stderr, "kernel_launch: hipFuncSetAttribute failed\n"); grid = -1; return; }
        if (hipOccupancyMaxActiveBlocksPerMultiprocessor(&per_cu, (const void*)hymba_fwd, NWAVES * 64, LDS_BYTES) != hipSuccess || per_cu < 1) fprintf(stderr, "kernel_launch: occupancy query says %d blocks per CU\n", per_cu);
        (void)hipGetLastError();
        grid = cus;
    }
    if (grid < 0) return;
    if (hipMemsetAsync((char*)d_ws + WS_CTL, 0, CTL_ZERO_BYTES, stream) != hipSuccess) { fprintf(stderr, "kernel_launch: memset failed\n"); return; }
    Args a{};
    for (int i = 0; i < 27; ++i) a.p.in[i] = (const float*)d_in[i];
    a.p.out = (float*)d_out; a.p.ws = (unsigned char*)d_ws; a.use_cg = 0; a.pad = 0;
#if MK_N_LAUNCHES == 1
    a.ph_lo = 0; a.ph_hi = N_PHASES;
    void* kargs[] = {&a};
    hipError_t e = hipLaunchCooperativeKernel((const void*)hymba_fwd, dim3(grid), dim3(NWAVES * 64), kargs, LDS_BYTES, stream);
    if (e != hipSuccess) fprintf(stderr, "kernel_launch: cooperative launch failed: %s (grid %d)\n", hipGetErrorString(e), grid);
#else
    for (int li = 0; li < N_PHASES; ++li) { a.ph_lo = li; a.ph_hi = li + 1;
        hipLaunchKernelGGL(hymba_fwd, dim3(grid), dim3(NWAVES * 64), LDS_BYTES, stream, a);
        const hipError_t le = hipPeekAtLastError(); if (le != hipSuccess) { fprintf(stderr, "kernel_launch: launch %d failed: %s\n", li, hipGetErrorName(le)); break; } }
#endif
}
```

```cpp
#include <hip/hip_runtime.h>
#include <cstdio>
#include <cstdint>
namespace pg8 {
#define PG8_LAS __attribute__((address_space(3)))
typedef unsigned short bf16_t;
typedef short bf16x8 __attribute__((ext_vector_type(8)));
typedef float f32x4 __attribute__((ext_vector_type(4)));
typedef unsigned u32x4 __attribute__((ext_vector_type(4)));
constexpr int BM = 256, BK = 64, HALF = 128, HTB = HALF * BK * 2  , STAGE_BYTES = 8 * HTB, NXCD = 8, WGM = 8;

__host__ __device__ __forceinline__ int lds_byte(int r, int c) { const int st = (r >> 4) * 2 + (c >> 5), rr = r & 15, cc = c & 31, ob = rr * 64 + cc * 2; return st * 1024 + (ob ^ (((ob >> 9) & 1) << 5)); }
__host__ __device__ __forceinline__ void stage_rc(int b, int& R, int& C) { const int st = b / 1024, sb = b % 1024, swz = sb ^ (((sb >> 9) & 1) << 5); R = (st >> 1) * 16 + swz / 64; C = (st & 1) * 32 + (swz % 64) / 2; }
__host__ __device__ __forceinline__ int perm32(int rho) { const int n = rho >> 4, i = rho & 15; return 8 * (i >> 2) + 4 * n + (i & 3); }

struct Unit { int pm, pn; };
struct Gemm { const bf16_t* A; const bf16_t* Bt; int M, N, K; };

struct StaticOrder {
    int nM, nN, nwg, G, c;
    __host__ __device__ void init(int M, int N, int G_, int c_) { nM = M / BM; nN = N / BM; nwg = nM * nN; G = G_; c = c_; }
    __host__ __device__ bool next(int i, Unit& u) const {
        const long L = (long)i * G + c; if (L >= nwg) return false;
        int wgid = (int)L; { const int q = nwg / NXCD, r = nwg % NXCD, xcd = wgid % NXCD, off = wgid / NXCD; wgid = (xcd < r ? xcd * (q + 1) : r * (q + 1) + (xcd - r) * q) + off; }
        const int nig = WGM * nN, gid = wgid / nig, fm = gid * WGM, gsz = (nM - fm) < WGM ? (nM - fm) : WGM;
        u.pm = fm + ((wgid % nig) % gsz); u.pn = (wgid % nig) / gsz; return true;
    }
    __device__ __forceinline__ void a_ready(const Unit&) const {}
    __device__ __forceinline__ void done(const Unit&) const {}
};

__device__ __forceinline__ unsigned cvt_pk_bf16(float lo, float hi) { unsigned r; asm volatile("v_cvt_pk_bf16_f32 %0, %1, %2" : "=v"(r) : "v"(lo), "v"(hi)); return r; }
typedef float f32x2 __attribute__((ext_vector_type(2)));
typedef unsigned u32x2 __attribute__((ext_vector_type(2)));
__device__ __forceinline__ float rstd_from16(const float* ssq, int row) {
    const f32x4* p = (const f32x4*)(ssq + (size_t)row * 16);
    const f32x4 a = p[0], b = p[1], c = p[2], d = p[3];
    const float s = ((a[0] + a[1]) + (a[2] + a[3])) + ((b[0] + b[1]) + (b[2] + b[3])) + ((c[0] + c[1]) + (c[2] + c[3])) + ((d[0] + d[1]) + (d[2] + d[3]));
    return __builtin_amdgcn_rsqf(s * (1.0f / 1024.0f) + 1e-5f);
}
__device__ __forceinline__ float silu_mul(float g, float u) { return g * __builtin_amdgcn_rcpf(1.0f + __builtin_amdgcn_exp2f(-1.4426950408889634f * g)) * u; }
template <class Sched> __device__ __forceinline__ void fill_rstd_cache(PG8_LAS float* tab, const float* ssq, const Sched& S) {
    const int tid = threadIdx.x; int t0 = -1, t1 = -1, t2 = -1, t3 = -1; Unit u;
    for (int i = 0; S.next(i, u); ++i) { const int pm = u.pm;
        if (pm == t0 || pm == t1 || pm == t2 || pm == t3) continue;
        if (t0 < 0) t0 = pm; else if (t1 < 0) t1 = pm; else if (t2 < 0) t2 = pm; else if (t3 < 0) t3 = pm; }
    if (tid == 0) { tab[0] = __builtin_bit_cast(float, t0); tab[1] = __builtin_bit_cast(float, t1); tab[2] = __builtin_bit_cast(float, t2); tab[3] = __builtin_bit_cast(float, t3); }
    if (tid < 256) { if (t0 >= 0) tab[4 + tid] = rstd_from16(ssq, t0 * BM + tid); if (t1 >= 0) tab[4 + 256 + tid] = rstd_from16(ssq, t1 * BM + tid);
        if (t2 >= 0) tab[4 + 512 + tid] = rstd_from16(ssq, t2 * BM + tid); if (t3 >= 0) tab[4 + 768 + tid] = rstd_from16(ssq, t3 * BM + tid); }
    __syncthreads();
}
__device__ __forceinline__ int rstd_slot(const PG8_LAS float* tab, int pm) {
    const int a = __builtin_bit_cast(int, tab[0]), b = __builtin_bit_cast(int, tab[1]), c = __builtin_bit_cast(int, tab[2]), d = __builtin_bit_cast(int, tab[3]);
    return pm == a ? 0 : pm == b ? 1 : pm == c ? 2 : pm == d ? 3 : -1;
}
struct EpiSwiglu {
    static constexpr bool PERM = true, AFTER_DRAIN = false;
    bf16_t* U; const float* ssq; int ldu; const PG8_LAS float* rc;
    __device__ __forceinline__ void operator()(const f32x4 (&acc)[2][2][4][2], const Unit& u, int wr, int wc, int fr, int fq) const {
        const int row0 = u.pm * BM + wr * 64 + fr, col0 = u.pn * HALF + wc * 32 + 8 * fq; const int slot = rstd_slot(rc, u.pm);
#pragma unroll
        for (int ai = 0; ai < 2; ++ai)
#pragma unroll
            for (int m = 0; m < 4; ++m) { const int row = row0 + ai * HALF + m * 16; const float rs = slot >= 0 ? rc[4 + slot * 256 + (row - u.pm * BM)] : rstd_from16(ssq, row);
                const float rs2 = rs * rs, cc = -1.4426950408889634f * rs;
                f32x4 o0, o1;
                { const f32x4 g = acc[ai][0][m][0], uu = acc[ai][1][m][0]; const f32x4 a = g * cc; f32x4 e; e[0] = __builtin_amdgcn_exp2f(a[0]); e[1] = __builtin_amdgcn_exp2f(a[1]); e[2] = __builtin_amdgcn_exp2f(a[2]); e[3] = __builtin_amdgcn_exp2f(a[3]);
                  const f32x4 d = e + 1.0f; f32x4 r; r[0] = __builtin_amdgcn_rcpf(d[0]); r[1] = __builtin_amdgcn_rcpf(d[1]); r[2] = __builtin_amdgcn_rcpf(d[2]); r[3] = __builtin_amdgcn_rcpf(d[3]); o0 = (g * rs2) * uu * r; }
                { const f32x4 g = acc[ai][0][m][1], uu = acc[ai][1][m][1]; const f32x4 a = g * cc; f32x4 e; e[0] = __builtin_amdgcn_exp2f(a[0]); e[1] = __builtin_amdgcn_exp2f(a[1]); e[2] = __builtin_amdgcn_exp2f(a[2]); e[3] = __builtin_amdgcn_exp2f(a[3]);
                  const f32x4 d = e + 1.0f; f32x4 r; r[0] = __builtin_amdgcn_rcpf(d[0]); r[1] = __builtin_amdgcn_rcpf(d[1]); r[2] = __builtin_amdgcn_rcpf(d[2]); r[3] = __builtin_amdgcn_rcpf(d[3]); o1 = (g * rs2) * uu * r; }
                u32x4 w; w.x = cvt_pk_bf16(o0[0], o0[1]); w.y = cvt_pk_bf16(o0[2], o0[3]); w.z = cvt_pk_bf16(o1[0], o1[1]); w.w = cvt_pk_bf16(o1[2], o1[3]);
                *(u32x4*)(U + (size_t)row * ldu + col0) = w; }
    }
};
struct EpiZ {
    static constexpr bool PERM = true, AFTER_DRAIN = false;
    bf16_t* Z; const float* ssq; const float* bias; int ldz, ncols, bias_from; const PG8_LAS float* rc;
    __device__ __forceinline__ void operator()(const f32x4 (&acc)[2][2][4][2], const Unit& u, int wr, int wc, int fr, int fq) const {
        const int row0 = u.pm * BM + wr * 64 + fr, col0 = u.pn * BM + wc * 32 + 8 * fq; const int slot = rstd_slot(rc, u.pm);
        f32x4 bv[2][2];
#pragma unroll
        for (int bj = 0; bj < 2; ++bj)
#pragma unroll
            for (int n = 0; n < 2; ++n) { const int c = col0 + bj * HALF + 4 * n; bv[bj][n] = (c >= bias_from && c < ncols) ? *(const f32x4*)(bias + (c - bias_from)) : (f32x4){0.f, 0.f, 0.f, 0.f}; }
#pragma unroll
        for (int ai = 0; ai < 2; ++ai)
#pragma unroll
            for (int m = 0; m < 4; ++m) { const int row = row0 + ai * HALF + m * 16; const float rs = slot >= 0 ? rc[4 + slot * 256 + (row - u.pm * BM)] : rstd_from16(ssq, row);
#pragma unroll
                for (int bj = 0; bj < 2; ++bj) { const int c = col0 + bj * HALF; if (c < ncols) {
                    const f32x4 v0 = acc[ai][bj][m][0] * rs + bv[bj][0], v1 = acc[ai][bj][m][1] * rs + bv[bj][1];
                    u32x4 w; w.x = cvt_pk_bf16(v0[0], v0[1]); w.y = cvt_pk_bf16(v0[2], v0[3]); w.z = cvt_pk_bf16(v1[0], v1[1]); w.w = cvt_pk_bf16(v1[2], v1[3]);
                    *(u32x4*)(Z + (size_t)row * ldz + c) = w; } } }
    }
};
template <bool WB> struct EpiResid {
    static constexpr bool PERM = false, AFTER_DRAIN = false;
    const float* base; float* out; bf16_t* outb; float* ssq; float scale;
    __device__ __forceinline__ void operator()(const f32x4 (&acc)[2][2][4][2], const Unit& u, int wr, int wc, int fr, int fq) const {
        const int row0 = u.pm * BM + wr * 64 + fr, col0 = u.pn * BM + wc * 32 + 4 * fq;
        f32x4 nb[4]; float ssv[8];
        { const size_t off = (size_t)row0 * 1024 + col0;
#pragma unroll
          for (int q = 0; q < 4; ++q) nb[q] = *(const f32x4*)(base + off + (q >> 1) * HALF + (q & 1) * 16); }
#pragma unroll
        for (int ri = 0; ri < 8; ++ri) { const int ai = ri >> 2, m = ri & 3; const int row = row0 + ai * HALF + m * 16; const size_t off = (size_t)row * 1024 + col0;
            f32x4 cb[4];
#pragma unroll
            for (int q = 0; q < 4; ++q) cb[q] = nb[q];
            if (ri < 7) { const int r2 = ri + 1; const size_t off2 = (size_t)(row0 + (r2 >> 2) * HALF + (r2 & 3) * 16) * 1024 + col0;
#pragma unroll
                for (int q = 0; q < 4; ++q) nb[q] = *(const f32x4*)(base + off2 + (q >> 1) * HALF + (q & 1) * 16);
                asm volatile("" ::: "memory"); }
            float ss = 0.f;
#pragma unroll
            for (int q = 0; q < 4; ++q) { const int bj = q >> 1, n = q & 1; const size_t o2 = off + bj * HALF + n * 16; const f32x4 o = cb[q] + acc[ai][bj][m][n] * scale;
                *(f32x4*)(out + o2) = o; ss += (o[0] * o[0] + o[1] * o[1]) + (o[2] * o[2] + o[3] * o[3]);
                if (WB) { u32x2 w; w.x = cvt_pk_bf16(o[0], o[1]); w.y = cvt_pk_bf16(o[2], o[3]); *(u32x2*)(outb + o2) = w; } }
            ssv[ri] = ss; }
#pragma unroll
        for (int ri = 0; ri < 8; ++ri) ssv[ri] += __shfl_xor(ssv[ri], 16);
#pragma unroll
        for (int ri = 0; ri < 8; ++ri) ssv[ri] += __shfl_xor(ssv[ri], 32);
        if (fq == 0) {
#pragma unroll
            for (int ri = 0; ri < 8; ++ri) ssq[(size_t)(row0 + (ri >> 2) * HALF + (ri & 3) * 16) * 16 + u.pn * 4 + wc] = ssv[ri]; }
    }
};
template <class Epi, class Sched, bool ALIGN_EPI = false, bool SP2 = false>
__device__ __forceinline__ void gemm_phase(PG8_LAS unsigned char* lds, const Gemm g, const Sched& S, const Epi& E) {
    const int tid = threadIdx.x, wid = __builtin_amdgcn_readfirstlane(tid >> 6), lane = tid & 63, wr = wid >> 2, wc = wid & 3, fr = lane & 15, fq = lane >> 4;
    const int K = g.K, nt = K / BK;
    unsigned voffA[2], voffB[2];
#pragma unroll
    for (int i = 0; i < 2; ++i) { int R, C; stage_rc(tid * 16 + i * 8192, R, C); const int Rb = Epi::PERM ? ((R & ~31) + perm32(R & 31)) : R;
        voffA[i] = (unsigned)(R * K + C) * 2u; voffB[i] = (unsigned)(Rb * K + C) * 2u; }
    const size_t kstep = (size_t)(BK * 2);
    const size_t hstep = (size_t)HALF * K * 2;
    const size_t tstep = 2 * hstep;
    const unsigned ldsw = (unsigned)wid * 1024u;
    const int aoff = lds_byte(wr * 64 + fr, fq * 8), boff = lds_byte(wc * 32 + fr, fq * 8);
#define PG8_SA(b, h) (((b) * 2 + (h)) * HTB)
#define PG8_SB(b, h) ((4 + (b) * 2 + (h)) * HTB)
#define PG8_STAGE(bufoff, gbase, voff) do { _Pragma("unroll") for (int _i = 0; _i < 2; ++_i) \
        __builtin_amdgcn_global_load_lds((const unsigned*)((const char*)(gbase) + (voff)[_i]), (PG8_LAS unsigned*)(lds + (bufoff) + ldsw + _i * 8192), 16, 0, 0); } while (0)
#define PG8_LDA(dst, b, h) do { _Pragma("unroll") for (int m = 0; m < 4; ++m) _Pragma("unroll") for (int k = 0; k < 2; ++k) dst[m][k] = *(const PG8_LAS bf16x8*)(lds + PG8_SA(b, h) + aoff + m * 2048 + k * 1024); } while (0)
#define PG8_LDB(dst, b, h) do { _Pragma("unroll") for (int n = 0; n < 2; ++n) _Pragma("unroll") for (int k = 0; k < 2; ++k) dst[n][k] = *(const PG8_LAS bf16x8*)(lds + PG8_SB(b, h) + boff + n * 2048 + k * 1024); } while (0)
#define PG8_MMA(ai, bj, At, Bt) do { __builtin_amdgcn_s_setprio(1); _Pragma("unroll") for (int m = 0; m < 4; ++m) _Pragma("unroll") for (int n = 0; n < 2; ++n) _Pragma("unroll") for (int k = 0; k < 2; ++k) \
        acc[ai][bj][m][n] = __builtin_amdgcn_mfma_f32_16x16x32_bf16(Bt[n][k], At[m][k], acc[ai][bj][m][n], 0, 0, 0); __builtin_amdgcn_s_setprio(0); } while (0)
#define PG8_WAIT_V(n) asm volatile("s_waitcnt vmcnt(" #n ")" ::: "memory")
#define PG8_WAIT_L(n) asm volatile("s_waitcnt lgkmcnt(" #n ")" ::: "memory")
#define PG8_BAR __builtin_amdgcn_s_barrier()
#define PG8_SCHED __builtin_amdgcn_sched_barrier(0)
    Unit cur, nxt; int ui = 0;
    if (!S.next(0, cur)) return;
    f32x4 acc[2][2][4][2];
#pragma unroll
    for (int a = 0; a < 2; ++a)
#pragma unroll
        for (int b = 0; b < 2; ++b)
#pragma unroll
            for (int m = 0; m < 4; ++m)
#pragma unroll
                for (int n = 0; n < 2; ++n) acc[a][b][m][n] = (f32x4){0.f, 0.f, 0.f, 0.f};
    bf16x8 At[4][2], B0[2][2], B1[2][2];
    const char* cA = (const char*)g.A + (size_t)cur.pm * tstep; const char* cB = (const char*)g.Bt + (size_t)cur.pn * tstep;
    S.a_ready(cur);
    if constexpr (SP2) {
        PG8_STAGE(PG8_SB(0, 0), cB, voffB); PG8_STAGE(PG8_SB(0, 1), cB + hstep, voffB); PG8_STAGE(PG8_SA(0, 0), cA, voffA); PG8_STAGE(PG8_SA(0, 1), cA + hstep, voffA);
        if (wr == 1) PG8_BAR;
        PG8_WAIT_V(2); PG8_BAR;
        PG8_STAGE(PG8_SB(1, 0), cB + kstep, voffB); PG8_STAGE(PG8_SA(1, 0), cA + kstep, voffA); PG8_STAGE(PG8_SB(1, 1), cB + hstep + kstep, voffB);
        PG8_WAIT_V(6); PG8_BAR;
    } else {
        PG8_STAGE(PG8_SB(0, 0), cB, voffB); PG8_STAGE(PG8_SA(0, 0), cA, voffA); PG8_STAGE(PG8_SB(0, 1), cB + hstep, voffB); PG8_STAGE(PG8_SA(0, 1), cA + hstep, voffA);
        if (wr == 1) PG8_BAR;
        PG8_WAIT_V(4); PG8_BAR;
        PG8_STAGE(PG8_SB(1, 0), cB + kstep, voffB); PG8_STAGE(PG8_SA(1, 0), cA + kstep, voffA); PG8_STAGE(PG8_SB(1, 1), cB + hstep + kstep, voffB);
        PG8_WAIT_V(6); PG8_BAR;
    }
    for (;;) {
        const bool has_next = S.next(ui + 1, nxt);
        const char* nA = has_next ? (const char*)g.A + (size_t)nxt.pm * tstep : cA; const char* nB = has_next ? (const char*)g.Bt + (size_t)nxt.pn * tstep : cB;
        for (int t = 0; t < nt; t += 2) {
            const bool last = (t == nt - 2);
            const char* a1 = cA + (size_t)(t + 1) * kstep;
            const char* a2 = last ? nA : cA + (size_t)(t + 2) * kstep; const char* b2 = last ? nB : cB + (size_t)(t + 2) * kstep;
            const char* a3 = a2 + kstep; const char* b3 = b2 + kstep;
            if (last && has_next) S.a_ready(nxt);
            if constexpr (SP2) {
            PG8_LDB(B0, 0, 0); PG8_LDB(B1, 0, 1); PG8_SCHED; PG8_LDA(At, 0, 0); PG8_STAGE(PG8_SA(1, 1), a1 + hstep, voffA);
            PG8_WAIT_V(8); PG8_WAIT_L(0); PG8_BAR; PG8_MMA(0, 0, At, B0); PG8_MMA(0, 1, At, B1); PG8_BAR; PG8_SCHED;
            PG8_LDA(At, 0, 1); PG8_STAGE(PG8_SB(0, 0), b2, voffB); PG8_STAGE(PG8_SB(0, 1), b2 + hstep, voffB); PG8_STAGE(PG8_SA(0, 0), a2, voffA);
            PG8_WAIT_V(8); PG8_WAIT_L(0); PG8_BAR; PG8_MMA(1, 0, At, B0); PG8_MMA(1, 1, At, B1); PG8_BAR; PG8_SCHED;
            PG8_LDB(B0, 1, 0); PG8_LDB(B1, 1, 1); PG8_SCHED; PG8_LDA(At, 1, 0); PG8_STAGE(PG8_SA(0, 1), a2 + hstep, voffA);
            PG8_WAIT_V(8); PG8_WAIT_L(0); PG8_BAR; PG8_MMA(0, 0, At, B0); PG8_MMA(0, 1, At, B1); PG8_BAR; PG8_SCHED;
            PG8_LDA(At, 1, 1); PG8_STAGE(PG8_SB(1, 0), b3, voffB); PG8_STAGE(PG8_SB(1, 1), b3 + hstep, voffB); PG8_STAGE(PG8_SA(1, 0), a3, voffA);
            PG8_WAIT_V(8); PG8_WAIT_L(0); PG8_BAR; PG8_MMA(1, 0, At, B0); PG8_MMA(1, 1, At, B1); PG8_BAR; PG8_SCHED;
            } else {
            PG8_LDB(B0, 0, 0); PG8_SCHED; PG8_LDA(At, 0, 0); PG8_STAGE(PG8_SA(1, 1), a1 + hstep, voffA);
            PG8_WAIT_L(8); PG8_BAR; PG8_WAIT_L(0); PG8_MMA(0, 0, At, B0); PG8_BAR; PG8_SCHED;
            PG8_LDB(B1, 0, 1); PG8_STAGE(PG8_SB(0, 0), b2, voffB);
            PG8_BAR; PG8_WAIT_L(0); PG8_MMA(0, 1, At, B1); PG8_BAR;
            PG8_LDA(At, 0, 1); PG8_STAGE(PG8_SA(0, 0), a2, voffA);
            PG8_BAR; PG8_WAIT_L(0); PG8_MMA(1, 0, At, B0); PG8_BAR; PG8_SCHED;
            PG8_STAGE(PG8_SB(0, 1), b2 + hstep, voffB);
            PG8_WAIT_V(6); PG8_BAR; PG8_MMA(1, 1, At, B1); PG8_BAR;
            PG8_LDB(B0, 1, 0); PG8_SCHED; PG8_LDA(At, 1, 0); PG8_STAGE(PG8_SA(0, 1), a2 + hstep, voffA);
            PG8_WAIT_L(8); PG8_BAR; PG8_WAIT_L(0); PG8_MMA(0, 0, At, B0); PG8_BAR; PG8_SCHED;
            PG8_LDB(B1, 1, 1); PG8_STAGE(PG8_SB(1, 0), b3, voffB);
            PG8_BAR; PG8_WAIT_L(0); PG8_MMA(0, 1, At, B1); PG8_BAR;
            PG8_LDA(At, 1, 1); PG8_STAGE(PG8_SA(1, 0), a3, voffA);
            PG8_BAR; PG8_WAIT_L(0); PG8_MMA(1, 0, At, B0); PG8_BAR; PG8_SCHED;
            PG8_STAGE(PG8_SB(1, 1), b3 + hstep, voffB);
            PG8_WAIT_V(6); PG8_BAR; PG8_MMA(1, 1, At, B1); PG8_BAR;
            }
        }
        if constexpr (ALIGN_EPI) { if (wr == 0) PG8_BAR; }
        if constexpr (!Epi::AFTER_DRAIN) { E(acc, cur, wr, wc, fr, fq); S.done(cur); }
        if (!has_next) break;
#pragma unroll
        for (int a = 0; a < 2; ++a)
#pragma unroll
            for (int b = 0; b < 2; ++b)
#pragma unroll
                for (int m = 0; m < 4; ++m)
#pragma unroll
                    for (int n = 0; n < 2; ++n) acc[a][b][m][n] = (f32x4){0.f, 0.f, 0.f, 0.f};
        cur = nxt; cA = nA; cB = nB; ++ui;
        if constexpr (ALIGN_EPI) { if (wr == 1) PG8_BAR; }
    }
    PG8_WAIT_V(0);
    if constexpr (!ALIGN_EPI) { if (wr == 0) PG8_BAR; }
    PG8_BAR;
    if constexpr (Epi::AFTER_DRAIN) { E.fused(acc, cur, wr, wc, fr, fq, lds, wid, lane); S.done(cur); }
#undef PG8_SA
#undef PG8_SB
#undef PG8_STAGE
#undef PG8_LDA
#undef PG8_LDB
#undef PG8_MMA
#undef PG8_WAIT_V
#undef PG8_WAIT_L
#undef PG8_BAR
#undef PG8_SCHED
}
}
#include <hip/hip_cooperative_groups.h>
namespace cg = cooperative_groups;
constexpr int NWAVES = 8;
constexpr int MR = 32768, DM = 1024, FF = 2816, NGU = 5632, NIN = 2464, NINP = 2560, TSEQ = 4096, NBATCH = 8, NHEAD = 8, NMETA = 16;
constexpr int ZC_W = 1536, ZC_Q = 1696, ZC_K = 2208, ZC_V = 2336;
constexpr int PV = 320;
constexpr size_t MiB = 1u << 20;
constexpr size_t WS_CTL = 0, CTL_ZERO_BYTES = 1 * MiB;
constexpr size_t WS_WGU1 = 2 * MiB, WS_WD1 = 13 * MiB, WS_WIN = 19 * MiB, WS_WOUT = 24 * MiB, WS_WGU2 = 26 * MiB, WS_WD2 = 37 * MiB, WS_LT = 43 * MiB;
constexpr size_t WS_SSQ1 = 44 * MiB, WS_SSQ2 = 46 * MiB, WS_SSQ3 = 48 * MiB, WS_SSQ4 = 50 * MiB, WS_META = 52 * MiB;
constexpr size_t MO_XMB = 0, MO_UM = 64 * 1024, MO_H1MB = 256 * 1024, MO_SSQM1 = 320 * 1024, MO_SSQM2 = 324 * 1024, MO_ZM = 384 * 1024, MO_PM = 512 * 1024;
constexpr size_t WS_XB = 56 * MiB, WS_BIG = 120 * MiB, WS_IMG = 274 * MiB, WS_P = 296 * MiB, WS_END = 507 * MiB;
constexpr int CW_BAR = 4096;
constexpr int RING_BYTES = 131072, LDSCTL_OFF = 143360, MISC_OFF = LDSCTL_OFF + 320, LDS_BYTES = 147456;

#define GAS __attribute__((address_space(1)))
#define LAS __attribute__((address_space(3)))
typedef unsigned short bf16;
typedef unsigned v4u __attribute__((ext_vector_type(4)));
typedef unsigned v2u __attribute__((ext_vector_type(2)));
typedef float f32x4 __attribute__((ext_vector_type(4)));
typedef float f32x2 __attribute__((ext_vector_type(2)));
typedef short bf16x8 __attribute__((ext_vector_type(8)));
typedef short bf16x4 __attribute__((ext_vector_type(4)));
typedef GAS unsigned gu32;
#define LDS_WAIT() asm volatile("s_waitcnt lgkmcnt(0)" ::: "memory")
__device__ __forceinline__ unsigned f2bf(float f) { unsigned u = __builtin_bit_cast(unsigned, f); return (u + 0x7fffu + ((u >> 16) & 1u)) >> 16; }
typedef __bf16 bf16x2_t __attribute__((ext_vector_type(2)));
__device__ __forceinline__ unsigned pk2m(float lo, float hi) { f32x2 v = {lo, hi}; bf16x2_t b = __builtin_convertvector(v, bf16x2_t); return __builtin_bit_cast(unsigned, b); }
__device__ __forceinline__ unsigned pk2(float lo, float hi) { return pg8::cvt_pk_bf16(lo, hi); }
__device__ __forceinline__ float bflo(unsigned w) { return __builtin_bit_cast(float, w << 16); }
__device__ __forceinline__ float bfhi(unsigned w) { return __builtin_bit_cast(float, w & 0xffff0000u); }
__device__ __forceinline__ f32x4 unpack4(v2u w) { return (f32x4){bflo(w.x), bfhi(w.x), bflo(w.y), bfhi(w.y)}; }
__device__ __forceinline__ float sigmoidf_(float x) { return __builtin_amdgcn_rcpf(1.0f + __builtin_amdgcn_exp2f(-1.4426950408889634f * x)); }
__device__ __forceinline__ float tanhf_(float x) { return 2.0f * sigmoidf_(2.0f * x) - 1.0f; }
#define XB_TMO      128
#define XB_XCNT(j)  (256  + 64 * (j))
#define XB_XSUB(j)  (1280 + 64 * (j))
#define XB_XGEN(j)  (2304 + 64 * (j))
#define XB_TOP      3328
#define XB_TOPGEN   3392
#define XCD_BAR_WORDS 3456
#define XB_SPIN_CAP (1u << 18)

__device__ __forceinline__ unsigned xb_ld(unsigned* p)              { return __hip_atomic_load(p, __ATOMIC_RELAXED, __HIP_MEMORY_SCOPE_AGENT); }
__device__ __forceinline__ unsigned xb_add(unsigned* p, unsigned v) { return __hip_atomic_fetch_add(p, v, __ATOMIC_RELAXED, __HIP_MEMORY_SCOPE_AGENT); }
__device__ __forceinline__ unsigned xb_xcc_id() { return (unsigned)__builtin_amdgcn_s_getreg((3 << 11) | 20) & 0xFu; }
#define XB_SPIN(cond, bar) do { unsigned _sp = 0; while (cond) { __builtin_amdgcn_s_sleep(1); \
    if ((++_sp & 255u) == 0u) { if (xb_ld(&(bar)[XB_TMO])) break; if (_sp > XB_SPIN_CAP) { atomicAdd(&(bar)[XB_TMO], 1u); break; } } } } while (0)

struct XcdBarrier {
    unsigned* bar; unsigned x;
    volatile LAS unsigned* st;
};

__device__ __forceinline__ XcdBarrier xcd_barrier_post(unsigned* bar, volatile LAS unsigned* st) {
    XcdBarrier b; b.bar = bar; b.x = xb_xcc_id(); b.st = st;
    if (threadIdx.x == 0) (void)xb_add(&bar[XB_XCNT(b.x)], 1u);
    return b;
}
__device__ __forceinline__ void xcd_barrier_complete(unsigned* bar, unsigned x, unsigned& nloc, unsigned& nx) {
    const unsigned G = gridDim.x * gridDim.y * gridDim.z;
    unsigned sum, cnt, mine, sp = 0u;
    for (;;) {
        sum = 0u; cnt = 0u; mine = 0u;
#pragma unroll
        for (unsigned j = 0; j < 16; ++j) { const unsigned c = xb_ld(&bar[XB_XCNT(j)]); sum += c; cnt += (c > 0u) ? 1u : 0u; mine = (j == x) ? c : mine; }
        if (sum == G) break;
        __builtin_amdgcn_s_sleep(1);
        if ((++sp & 255u) == 0u) { if (xb_ld(&bar[XB_TMO])) break; if (sp > XB_SPIN_CAP) { atomicAdd(&bar[XB_TMO], 1u); break; } }
    }
    nloc = mine > 0u ? mine : 1u; nx = cnt > 0u ? cnt : 1u;
}

__device__ __forceinline__ void xcd_barrier(const XcdBarrier& b) {
    asm volatile("s_waitcnt vmcnt(0)" ::: "memory");
    __syncthreads();
    if (threadIdx.x == 0) {
        unsigned* bar = b.bar;
        __builtin_amdgcn_s_waitcnt(0);
        unsigned nloc = b.st[0], nx = b.st[1];
        if (nloc == 0u) { xcd_barrier_complete(bar, b.x, nloc, nx); b.st[0] = nloc; b.st[1] = nx; }
        const unsigned old = xb_add(&bar[XB_XSUB(b.x)], 1u);
        const unsigned gen = old / nloc;
        if (old + 1u == (gen + 1u) * nloc) {
            __builtin_amdgcn_fence(__ATOMIC_RELEASE, "agent");
            asm volatile("s_waitcnt vmcnt(0)" ::: "memory");
            const unsigned og = xb_add(&bar[XB_TOP], 1u);
            const unsigned tg = og / nx;
            if (og + 1u == (tg + 1u) * nx) xb_add(&bar[XB_TOPGEN], 1u);
            else XB_SPIN(xb_ld(&bar[XB_TOPGEN]) == tg, bar);
            __builtin_amdgcn_fence(__ATOMIC_ACQUIRE, "agent");
            xb_add(&bar[XB_XGEN(b.x)], 1u);
            asm volatile("s_waitcnt vmcnt(0)" ::: "memory");
        } else {
            XB_SPIN(xb_ld(&bar[XB_XGEN(b.x)]) == gen, bar);
            __builtin_amdgcn_fence(__ATOMIC_ACQUIRE, "agent");
            asm volatile("s_waitcnt vmcnt(0)" ::: "memory");
        }
    }
    __syncthreads();
}
__device__ __forceinline__ float wave_sum(float v) {
#pragma unroll
    for (int o = 1; o < 64; o <<= 1) v += __shfl_xor(v, o);
    return v;
}
__device__ __forceinline__ void p0_transpose_item(const float* W, int K, int N, bf16* WT, const float* gain, int k0, int n0, int drow0, LAS float* scr, int lane) {
#pragma unroll
    for (int i = 0; i < 32; ++i) { const int kk = 2 * i + (lane >> 5); float w = W[(size_t)(k0 + kk) * N + n0 + (lane & 31)]; if (gain) w *= gain[k0 + kk]; scr[kk * 33 + (lane & 31)] = w; }
    LDS_WAIT(); asm volatile("" ::: "memory");
    const int c = lane & 7;
#pragma unroll
    for (int j = 0; j < 4; ++j) { const int n = (lane >> 3) + 8 * j; const LAS float* s = scr + (8 * c) * 33 + n;
        v4u o; o.x = pk2(s[0 * 33], s[1 * 33]); o.y = pk2(s[2 * 33], s[3 * 33]); o.z = pk2(s[4 * 33], s[5 * 33]); o.w = pk2(s[6 * 33], s[7 * 33]);
        *(GAS v4u*)(WT + (size_t)(drow0 + n) * K + k0 + 8 * c) = o; }
    LDS_WAIT(); asm volatile("" ::: "memory");
}
__device__ __forceinline__ void rows4_to_bf16(const float* const (&xrow)[4], bf16* const (&orow)[4], float* const (&ssq16)[4], int lane) {
    f32x4 v[4][4]; float s[4];
#pragma unroll
    for (int r = 0; r < 4; ++r) { const GAS f32x4* xr = (const GAS f32x4*)xrow[r] + lane;
#pragma unroll
        for (int j = 0; j < 4; ++j) v[r][j] = xr[64 * j]; }
#pragma unroll
    for (int r = 0; r < 4; ++r) { float a = 0.f;
#pragma unroll
        for (int j = 0; j < 4; ++j) a += (v[r][j].x * v[r][j].x + v[r][j].y * v[r][j].y) + (v[r][j].z * v[r][j].z + v[r][j].w * v[r][j].w);
        s[r] = a; }
#pragma unroll
    for (int o = 1; o < 64; o <<= 1) {
#pragma unroll
        for (int r = 0; r < 4; ++r) s[r] += __shfl_xor(s[r], o); }
#pragma unroll
    for (int r = 0; r < 4; ++r) { GAS v2u* o8 = (GAS v2u*)orow[r] + lane;
#pragma unroll
        for (int j = 0; j < 4; ++j) { v2u w; w.x = pk2(v[r][j].x, v[r][j].y); w.y = pk2(v[r][j].z, v[r][j].w); o8[64 * j] = w; }
        if (lane < 16) ssq16[r][lane] = (lane == 0) ? s[r] : 0.f; }
}
struct Ptrs {
    const float* in[27]; float* out; unsigned char* ws;
};
__device__ __forceinline__ void p0_transposes(const Ptrs& P, LAS unsigned char* lds, int part, int gw, int NGW, int wave, int lane) {
    unsigned char* ws = P.ws; LAS float* scr = (LAS float*)(lds + wave * 16384);
    constexpr int I_G = (DM / 64) * (FF / 32), I_D = (FF / 64) * (DM / 32), I_IN = (DM / 64) * (NIN / 32), I_O = (DM / 64) * (DM / 32);
    const int nitems = 2 * I_G + I_D + (part ? I_O : I_IN);
    for (int it = gw; it < nitems; it += NGW) {
        int r = it;
        if (r < 2 * I_G) { const int isup = r / I_G; r -= isup * I_G; const int nblk = FF / 32, kb = r / nblk, nb = r % nblk, n0 = 32 * nb;
            const float* W = P.in[part ? (isup ? 24 : 23) : (isup ? 4 : 3)]; const float* gain = P.in[part ? 22 : 2];
            bf16* WT = (bf16*)(ws + (part ? WS_WGU2 : WS_WGU1));
            const int drow0 = 256 * (n0 / 128) + 128 * isup + (n0 % 128);
            p0_transpose_item(W, DM, FF, WT, gain, 64 * kb, n0, drow0, scr, lane); continue; }
        r -= 2 * I_G;
        if (r < I_D) { const int nblk = DM / 32, kb = r / nblk, nb = r % nblk;
            p0_transpose_item(P.in[part ? 25 : 5], FF, DM, (bf16*)(ws + (part ? WS_WD2 : WS_WD1)), nullptr, 64 * kb, 32 * nb, 32 * nb, scr, lane); continue; }
        r -= I_D;
        if (!part) { const int nblk = NIN / 32, kb = r / nblk, nb = r % nblk;
            p0_transpose_item(P.in[7], DM, NIN, (bf16*)(ws + WS_WIN), P.in[6], 64 * kb, 32 * nb, 32 * nb, scr, lane); }
        else { const int nblk = DM / 32, kb = r / nblk, nb = r % nblk;
            p0_transpose_item(P.in[21], DM, DM, (bf16*)(ws + WS_WOUT), nullptr, 64 * kb, 32 * nb, 32 * nb, scr, lane); }
    }
}
__device__ __forceinline__ void p0_prologue(const Ptrs& P, LAS unsigned char* lds, int vcu, int G, int wave, int lane) {
    const int gw = vcu * NWAVES + wave, NGW = G * NWAVES;
    unsigned char* ws = P.ws;
    p0_transposes(P, lds, 0, gw, NGW, wave, lane);
    { GAS v4u* z = (GAS v4u*)(ws + WS_WIN + (size_t)NIN * DM * 2); const int n16 = (NINP - NIN) * DM * 2 / 16;
      for (int i = gw * 64 + lane; i < n16; i += NGW * 64) z[i] = (v4u){0u, 0u, 0u, 0u}; }
    { bf16* LT = (bf16*)(ws + WS_LT);
      for (int i = gw * 64 + lane; i < 512 * 160; i += NGW * 64) { const int n = i / 160, j = i % 160;
          const float v = j < 32 ? P.in[11][j * 512 + n] : j < 64 ? P.in[13][(j - 32) * 512 + n] : P.in[14][(j - 64) * 512 + n];
          LT[i] = (bf16)f2bf(v); } }
#ifndef REP_ROWS
#define REP_ROWS 1
#endif
    for (int rep_ = 0; rep_ < REP_ROWS; ++rep_)
    for (int m4 = gw; m4 < (MR + NMETA) / 4; m4 += NGW) { const float* xr[4]; bf16* orow[4]; float* sq[4];
#pragma unroll
        for (int r = 0; r < 4; ++r) { const int m = 4 * m4 + r;
            if (m < MR) { xr[r] = P.in[0] + (size_t)m * DM; orow[r] = (bf16*)(ws + WS_XB) + (size_t)m * DM; sq[r] = (float*)(ws + WS_SSQ1) + (size_t)m * 16; }
            else { const int i = m - MR; xr[r] = P.in[1] + (size_t)i * DM; orow[r] = (bf16*)(ws + WS_META + MO_XMB) + (size_t)i * DM; sq[r] = (float*)(ws + WS_META + MO_SSQM1) + i * 16; } }
        rows4_to_bf16(xr, orow, sq, lane); }
}
__device__ __forceinline__ f32x4 skinny16(const bf16* A, const bf16* Bt, int K, int n0, int lane) {
    const int fr = lane & 15, fq = lane >> 4;
    const bf16* ap = A + (size_t)fr * K + 8 * fq; const bf16* bp = Bt + (size_t)(n0 + fr) * K + 8 * fq;
    f32x4 acc = (f32x4){0.f, 0.f, 0.f, 0.f};
    for (int k = 0; k < K; k += 256) {
        bf16x8 a[8], b[8];
#pragma unroll
        for (int j = 0; j < 8; ++j) { a[j] = *(const bf16x8*)(ap + k + 32 * j); b[j] = *(const bf16x8*)(bp + k + 32 * j); }
#pragma unroll
        for (int j = 0; j < 8; ++j) acc = __builtin_amdgcn_mfma_f32_16x16x32_bf16(a[j], b[j], acc, 0, 0, 0); }
    return acc;
}
__device__ __forceinline__ float rstd_m16(const float* ssq16) { float s = 0.f;
#pragma unroll
    for (int i = 0; i < 16; ++i) s += ssq16[i];
    return __builtin_amdgcn_rsqf(s * (1.0f / 1024.0f) + 1e-5f); }
__device__ __forceinline__ void meta_up(unsigned char* ws, int gw, int NGW, int lane) {
    const bf16* A = (const bf16*)(ws + WS_META + MO_XMB); const bf16* Bt = (const bf16*)(ws + WS_WGU1); bf16* Um = (bf16*)(ws + WS_META + MO_UM);
    const float* ssq = (const float*)(ws + WS_META + MO_SSQM1); const int fr = lane & 15, fq = lane >> 4;
    for (int t = gw; t < FF / 16; t += NGW) { const int c0 = 16 * t, nr = 256 * (c0 / 128) + (c0 % 128);
        const f32x4 g = skinny16(A, Bt, DM, nr, lane), u = skinny16(A, Bt, DM, nr + 128, lane);
#pragma unroll
        for (int r = 0; r < 4; ++r) { const int row = 4 * fq + r; const float rs = rstd_m16(ssq + row * 16); Um[(size_t)row * FF + c0 + fr] = (bf16)f2bf(pg8::silu_mul(g[r] * rs, u[r] * rs)); } }
}
__device__ __forceinline__ void meta_down(const Ptrs& P, int gw, int NGW, int lane) {
    unsigned char* ws = P.ws; const bf16* A = (const bf16*)(ws + WS_META + MO_UM); const bf16* Bt = (const bf16*)(ws + WS_WD1); bf16* H = (bf16*)(ws + WS_META + MO_H1MB);
    float* ssq = (float*)(ws + WS_META + MO_SSQM2); const int fr = lane & 15, fq = lane >> 4;
    for (int t = gw; t < DM / 16; t += NGW) { const f32x4 a = skinny16(A, Bt, FF, 16 * t, lane);
#pragma unroll
        for (int r = 0; r < 4; ++r) { const int row = 4 * fq + r; const float o = P.in[1][row * DM + 16 * t + fr] + 0.5f * a[r]; H[row * DM + 16 * t + fr] = (bf16)f2bf(o);
            float s = o * o; s += __shfl_xor(s, 1); s += __shfl_xor(s, 2); s += __shfl_xor(s, 4); s += __shfl_xor(s, 8); if (fr == 0) ssq[row * 64 + t] = s; } }
}
__device__ __forceinline__ void meta_win(const Ptrs& P, int gw, int NGW, int lane) {
    unsigned char* ws = P.ws; const bf16* A = (const bf16*)(ws + WS_META + MO_H1MB); const bf16* Bt = (const bf16*)(ws + WS_WIN); bf16* Zm = (bf16*)(ws + WS_META + MO_ZM);
    const float* ssq = (const float*)(ws + WS_META + MO_SSQM2); const int fr = lane & 15, fq = lane >> 4;
    for (int t = gw; t < NIN / 16; t += NGW) { const f32x4 a = skinny16(A, Bt, DM, 16 * t, lane); const int c = 16 * t + fr; const float bias = c >= ZC_Q ? P.in[8][c - ZC_Q] : 0.f;
#pragma unroll
        for (int r = 0; r < 4; ++r) { const int row = 4 * fq + r; float s = 0.f;
#pragma unroll 8
            for (int i = 0; i < 64; ++i) s += ssq[row * 64 + i];
            Zm[(size_t)row * NIN + c] = (bf16)f2bf(a[r] * __builtin_amdgcn_rsqf(s * (1.0f / 1024.0f) + 1e-5f) + bias); } }
}
constexpr int KS_LD = 72, VT_LD = 232, ATT_KS_BYTES = 208 * KS_LD * 2, ATT_VT_BYTES = 64 * VT_LD * 2;
__device__ __forceinline__ void attn_unit(const Ptrs& P, unsigned char* lds, int b, int g, int c, int tid, int wave, int lane) {
    unsigned char* ws = P.ws; const bf16* Z = (const bf16*)(ws + WS_BIG); const bf16* Zm = (const bf16*)(ws + WS_META + MO_ZM); bf16* Y = (bf16*)(ws + WS_XB);
    bf16* Ks = (bf16*)lds; bf16* Vt = (bf16*)(lds + ATT_KS_BYTES);
    const int fr = lane & 15, fq = lane >> 4;
    __syncthreads();
    for (int it = tid; it < 208 * 8; it += NWAVES * 64) { const int key = it >> 3, pc = it & 7; const bf16* src; bool valid = true;
        if (key < 16) src = Zm + (size_t)key * NIN; else { const int t = 64 * (c - 2) + (key - 16); valid = t >= 0; src = Z + ((size_t)b * TSEQ + (valid ? t : 0)) * NIN; }
        v4u kq = *(const v4u*)(src + ZC_K + 64 * g + 8 * pc), vq = *(const v4u*)(src + ZC_V + 64 * g + 8 * pc);
        if (!valid) { kq = (v4u){0u, 0u, 0u, 0u}; vq = kq; }
        *(v4u*)(Ks + key * KS_LD + 8 * pc) = kq;
#pragma unroll
        for (int e = 0; e < 4; ++e) { Vt[(8 * pc + 2 * e) * VT_LD + key] = (bf16)(vq[e] & 0xffffu); Vt[(8 * pc + 2 * e + 1) * VT_LD + key] = (bf16)(vq[e] >> 16); } }
    for (int it = tid; it < 64 * 16; it += NWAVES * 64) Vt[(it >> 4) * VT_LD + 208 + (it & 15)] = 0;
    __syncthreads();
    const int hq = 4 * g + (wave >> 1);
    const float slope = __builtin_amdgcn_exp2f(-(float)(hq + 1)), sink = P.in[20][hq];
#pragma unroll 1
    for (int sub = 0; sub < 2; ++sub) {
        const int i0 = 16 * (2 * (wave & 1) + sub), iq = i0 + fr;
        const size_t mrow = (size_t)b * TSEQ + 64 * c + iq;
        const bf16x8 q0 = *(const bf16x8*)(Z + mrow * NIN + ZC_Q + 64 * hq + 8 * fq), q1 = *(const bf16x8*)(Z + mrow * NIN + ZC_Q + 64 * hq + 32 + 8 * fq);
        f32x4 s[13]; float mx = sink;
#pragma unroll
        for (int kt = 0; kt < 13; ++kt) { const bf16* kp = Ks + (16 * kt + fr) * KS_LD + 8 * fq; f32x4 a = (f32x4){0.f, 0.f, 0.f, 0.f};
            a = __builtin_amdgcn_mfma_f32_16x16x32_bf16(*(const bf16x8*)(kp), q0, a, 0, 0, 0);
            a = __builtin_amdgcn_mfma_f32_16x16x32_bf16(*(const bf16x8*)(kp + 32), q1, a, 0, 0, 0);
#pragma unroll
            for (int r = 0; r < 4; ++r) { const int key = 16 * kt + 4 * fq + r; float v;
                if (kt == 0) v = a[r] * 0.125f - slope * (float)(16 + 64 * c + iq - key);
                else { const int jj = key - 16; const int d = 128 + iq - jj; v = a[r] * 0.125f - slope * (float)(d < 0 ? -d : d); if (64 * (c - 2) + jj < 0) v = -1e30f; }
                a[r] = v; mx = fmaxf(mx, v); }
            s[kt] = a; }
        mx = fmaxf(mx, __shfl_xor(mx, 16)); mx = fmaxf(mx, __shfl_xor(mx, 32));
        float sum = 0.f;
#pragma unroll
        for (int kt = 0; kt < 13; ++kt)
#pragma unroll
            for (int r = 0; r < 4; ++r) { const float p = __builtin_amdgcn_exp2f((s[kt][r] - mx) * 1.4426950408889634f); s[kt][r] = p; sum += p; }
        sum += __shfl_xor(sum, 16); sum += __shfl_xor(sum, 32);
        sum += __builtin_amdgcn_exp2f((sink - mx) * 1.4426950408889634f);
        const float rinv = 1.0f / sum;
        f32x4 o[4];
#pragma unroll
        for (int dt = 0; dt < 4; ++dt) o[dt] = (f32x4){0.f, 0.f, 0.f, 0.f};
#pragma unroll
        for (int ks = 0; ks < 7; ++ks) { const int ta = 2 * ks, tb = 2 * ks + 1; v4u pw;
            pw.x = pk2(s[ta][0], s[ta][1]); pw.y = pk2(s[ta][2], s[ta][3]);
            if (tb < 13) { pw.z = pk2(s[tb][0], s[tb][1]); pw.w = pk2(s[tb][2], s[tb][3]); } else { pw.z = 0u; pw.w = 0u; }
            const bf16x8 pf = __builtin_bit_cast(bf16x8, pw);
#pragma unroll
            for (int dt = 0; dt < 4; ++dt) { const bf16* vp = Vt + (16 * dt + fr) * VT_LD + 4 * fq; const v2u va = *(const v2u*)(vp + 16 * ta), vb = *(const v2u*)(vp + 16 * tb);
                const v4u vv = (v4u){va.x, va.y, vb.x, vb.y};
                o[dt] = __builtin_amdgcn_mfma_f32_16x16x32_bf16(__builtin_bit_cast(bf16x8, vv), pf, o[dt], 0, 0, 0); } }
#pragma unroll
        for (int dt = 0; dt < 4; ++dt) { v2u w; w.x = pk2(o[dt][0] * rinv, o[dt][1] * rinv); w.y = pk2(o[dt][2] * rinv, o[dt][3] * rinv);
            *(v2u*)(Y + mrow * DM + 512 + 64 * hq + 16 * dt + 4 * fq) = w; }
    }
}
template <int CTRL> __device__ __forceinline__ float dppf(float x) { return __builtin_bit_cast(float, __builtin_amdgcn_update_dpp(0, __builtin_bit_cast(int, x), CTRL, 0xF, 0xF, true)); }
template <int CTRL> __device__ __forceinline__ float dppf_old(float old, float x) { return __builtin_bit_cast(float, __builtin_amdgcn_update_dpp(__builtin_bit_cast(int, old), __builtin_bit_cast(int, x), CTRL, 0xF, 0xF, false)); }
__device__ __forceinline__ float red8(float x) { x += dppf<0xB1>(x); x += dppf<0x4E>(x); x += dppf<0x141>(x); return x; }
__device__ __forceinline__ float red16(float x) { x = red8(x); x += dppf<0x140>(x); return x; }
__device__ __forceinline__ float scan16(float x) { x += dppf<0x111>(x); x += dppf<0x112>(x); x += dppf<0x114>(x); x += dppf<0x118>(x); return x; }
constexpr int NCHUNK = 257, NSUPER = 65;
constexpr int CB_A = 0, CB_R = 2048, CB_BK = 4096, CB_VT = 8192, CB_TT = 10240, CB_AR = 11264, CB_G = 12288, CB_BON = 12544, CB_SIZE = 12800;
constexpr int CB_GATE = 12800, IMG_SIZE = 14848;
constexpr int WL_HS = IMG_SIZE, WL_SIZE = IMG_SIZE + 2048;
constexpr int SC_YB = 8 * CB_SIZE, SC_END = SC_YB + 8 * 4096, SC_CST = 768;
static_assert(8 * WL_SIZE <= LDSCTL_OFF && SC_END + SC_CST <= LDSCTL_OFF, "LDS map");
__device__ __forceinline__ bf16x8 pack8(const float* v) { v4u o; o.x = pk2(v[0], v[1]); o.y = pk2(v[2], v[3]); o.z = pk2(v[4], v[5]); o.w = pk2(v[6], v[7]); return __builtin_bit_cast(bf16x8, o); }
__device__ __forceinline__ void unpack8(v4u w, float* v) { v[0] = bflo(w.x); v[1] = bfhi(w.x); v[2] = bflo(w.y); v[3] = bfhi(w.y); v[4] = bflo(w.z); v[5] = bfhi(w.z); v[6] = bflo(w.w); v[7] = bfhi(w.w); }


__device__ __forceinline__ void chunk_task(const Ptrs& P, unsigned char* ldsb, int woff, int b, int h, int ch, int lane) {
    int wo_ = woff; asm volatile("" : "+v"(wo_));
    unsigned char* wl = ldsb + wo_;
    unsigned char* ws = P.ws; const int fr = lane & 15, fq = lane >> 4, t = fr;
    const bf16* Z = (const bf16*)(ws + WS_BIG); const bf16* Zm = (const bf16*)(ws + WS_META + MO_ZM); const bf16* LT = (const bf16*)(ws + WS_LT);
    const bool meta = (ch == 0);
    const int tok = 16 * (ch - 1) + fr; const size_t m = (size_t)b * TSEQ + tok;
    const bf16* zc = meta ? Zm + (size_t)fr * NIN : Z + m * NIN;
    const bool pz = meta && fr == 0;
    const bf16* zp = meta ? Zm + (size_t)(fr > 0 ? fr - 1 : 0) * NIN : (tok == 0 ? Zm + (size_t)15 * NIN : Z + (m - 1) * NIN);
    const float* mu = P.in[9];
    bf16* sx = (bf16*)wl;
    {
    bf16x8 xf[5];
#pragma unroll
    for (int ks = 0; ks < 5; ++ks) { const int c0 = ZC_W + 32 * ks + 8 * fq; const v4u a = *(const v4u*)(zc + c0); v4u bq = *(const v4u*)(zp + c0); if (pz) bq = (v4u){0u, 0u, 0u, 0u};
        float va[8], vb[8], v[8]; unpack8(a, va); unpack8(bq, vb); const f32x4 m0 = *(const f32x4*)(mu + c0), m1 = *(const f32x4*)(mu + c0 + 4);
#pragma unroll
        for (int e = 0; e < 8; ++e) { const float mm = e < 4 ? m0[e & 3] : m1[e & 3]; const float z = va[e] + (vb[e] - va[e]) * mm; v[e] = (ks == 0) ? tanhf_(z) : (ks == 1) ? z : sigmoidf_(z); }
        xf[ks] = pack8(v); }
    f32x4 aw[4], aa[4], ag[4];
#pragma unroll
    for (int nt = 0; nt < 4; ++nt) { const bf16* lp = LT + (size_t)(h * 64 + 16 * nt + fr) * 160 + 8 * fq; const f32x4 z = (f32x4){0.f, 0.f, 0.f, 0.f};
        aw[nt] = __builtin_amdgcn_mfma_f32_16x16x32_bf16(*(const bf16x8*)(lp), xf[0], z, 0, 0, 0);
        aa[nt] = __builtin_amdgcn_mfma_f32_16x16x32_bf16(*(const bf16x8*)(lp + 32), xf[1], z, 0, 0, 0);
        ag[nt] = __builtin_amdgcn_mfma_f32_16x16x32_bf16(*(const bf16x8*)(lp + 64), xf[2], z, 0, 0, 0);
        ag[nt] = __builtin_amdgcn_mfma_f32_16x16x32_bf16(*(const bf16x8*)(lp + 96), xf[3], ag[nt], 0, 0, 0);
        ag[nt] = __builtin_amdgcn_mfma_f32_16x16x32_bf16(*(const bf16x8*)(lp + 128), xf[4], ag[nt], 0, 0, 0); }
    f32x4 kkr[4], kv[4], av[4]; float ss = 0.f;
#pragma unroll
    for (int nt = 0; nt < 4; ++nt) { const int c = h * 64 + 16 * nt + 4 * fq; const v2u a = *(const v2u*)(zc + 512 + c); v2u bq = *(const v2u*)(zp + 512 + c); if (pz) bq = (v2u){0u, 0u};
        const f32x4 za = unpack4(a), zb = unpack4(bq), mk = *(const f32x4*)(mu + 512 + c); const f32x4 zk = za + (zb - za) * mk;
        const f32x4 a0 = *(const f32x4*)(P.in[12] + c), kkw = *(const f32x4*)(P.in[15] + c), kaw = *(const f32x4*)(P.in[16] + c);
        f32x4 a_;
#pragma unroll
        for (int r = 0; r < 4; ++r) a_[r] = sigmoidf_(a0[r] + aa[nt][r]);
        av[nt] = a_; kkr[nt] = zk * kkw; kv[nt] = zk * (1.0f + (a_ - 1.0f) * kaw);
        ss += (kkr[nt][0] * kkr[nt][0] + kkr[nt][1] * kkr[nt][1]) + (kkr[nt][2] * kkr[nt][2] + kkr[nt][3] * kkr[nt][3]); }
    ss += __shfl_xor(ss, 16); ss += __shfl_xor(ss, 32);
    const float inv = 1.0f / fmaxf(sqrtf(ss), 1e-12f);
#pragma unroll
    for (int nt = 0; nt < 4; ++nt) { const int cl = 16 * nt + 4 * fq, c = h * 64 + cl; const f32x4 w0 = *(const f32x4*)(P.in[10] + c);
        const f32x4 kk = kkr[nt] * inv, bb = kk * av[nt]; f32x4 e;
#pragma unroll
        for (int r = 0; r < 4; ++r) e[r] = 0.6065306597126334f * sigmoidf_(w0[r] + aw[nt][r]);
        bf16* px = sx + t * 64 + cl; v2u o;
        o.x = pk2(kk[0], kk[1]); o.y = pk2(kk[2], kk[3]); *(v2u*)(px) = o;
        o.x = pk2(e[0], e[1]); o.y = pk2(e[2], e[3]); *(v2u*)(px + 1024) = o;
        o.x = pk2(bb[0], bb[1]); o.y = pk2(bb[2], bb[3]); *(v2u*)(px + 2048) = o;
        o.x = pk2(kv[nt][0], kv[nt][1]); o.y = pk2(kv[nt][2], kv[nt][3]); *(v2u*)(px + 3072) = o;
        o.x = pk2m(ag[nt][0], ag[nt][1]); o.y = pk2m(ag[nt][2], ag[nt][3]); *(v2u*)(px + 4096) = o; }
    }
    asm volatile("s_waitcnt lgkmcnt(0)" ::: "memory"); __builtin_amdgcn_sched_barrier(0);
    v4u xk[2], xe[2], xb[2], xx[2], xg[2];
#pragma unroll
    for (int ks = 0; ks < 2; ++ks) { const bf16* px = sx + t * 64 + 32 * ks + 8 * fq; xk[ks] = *(const v4u*)(px); xe[ks] = *(const v4u*)(px + 1024); xb[ks] = *(const v4u*)(px + 2048); xx[ks] = *(const v4u*)(px + 3072); xg[ks] = *(const v4u*)(px + 4096); }
    asm volatile("s_waitcnt lgkmcnt(0)" ::: "memory"); __builtin_amdgcn_sched_barrier(0);
    unsigned char* cb = wl; float* hs = (float*)(wl + WL_HS);
    const int cbase = h * 64 + 8 * fq;
    unsigned char* pbk = cb + CB_BK + ((((fq >> 1) * 4 + (t >> 2)) * 16 + 8 * (fq & 1)) * 8 + (t & 3)) * 2;
    unsigned char* pvt = cb + CB_VT + (((fq >> 1) * 4 + (t >> 2)) * 16 + 8 * (fq & 1)) * 8 + (t & 3) * 2;
    unsigned char* pgc = cb + CB_G + 8 * fq * 4;
    bf16x8 Af[2], Rf[2], Bf[2], Kf[2]; float bonp = 0.f;
#pragma unroll
    for (int ks = 0; ks < 2; ++ks) { const int c = cbase + 32 * ks, cl = 32 * ks + 8 * fq;
        asm volatile("" ::: "memory"); __builtin_amdgcn_sched_barrier(0);
        float kk[8], e_[8], bb[8], kx[8], rc[8], rp[8], vc[8], vp[8];
        unpack8(xk[ks], kk); unpack8(xe[ks], e_); unpack8(xb[ks], bb); unpack8(xx[ks], kx);
        unpack8(*(const v4u*)(zc + c), rc); unpack8(*(const v4u*)(zc + 1024 + c), vc);
        { v4u a = *(const v4u*)(zp + c), d = *(const v4u*)(zp + 1024 + c); if (pz) { a = (v4u){0u, 0u, 0u, 0u}; d = a; } unpack8(a, rp); unpack8(d, vp); }
        float At[8], Rt[8], Bt[8], Kt[8]; float mur[8], muv[8], rkk[8];
        { const f32x4 a0 = *(const f32x4*)(P.in[9] + c), a1 = *(const f32x4*)(P.in[9] + c + 4), b0 = *(const f32x4*)(P.in[9] + 1024 + c), b1 = *(const f32x4*)(P.in[9] + 1024 + c + 4), c0 = *(const f32x4*)(P.in[17] + c), c1 = *(const f32x4*)(P.in[17] + c + 4);
#pragma unroll
          for (int e = 0; e < 4; ++e) { mur[e] = a0[e]; mur[4 + e] = a1[e]; muv[e] = b0[e]; muv[4 + e] = b1[e]; rkk[e] = c0[e]; rkk[4 + e] = c1[e]; } }
#pragma unroll
        for (int e = 0; e < 8; ++e) { const float rr = rc[e] + (rp[e] - rc[e]) * mur[e]; const float vv = vc[e] + (vp[e] - vc[e]) * muv[e];
            bonp += rr * kx[e] * rkk[e];
            const float ec = scan16(e_[e]), etot = red16(e_[e]);
            const float g1 = __builtin_amdgcn_exp2f(-1.4426950408889634f * ec);
            const float gi = __builtin_amdgcn_exp2f(1.4426950408889634f * ec);
            const float gC = __builtin_amdgcn_exp2f(-1.4426950408889634f * etot);
            const float g0 = dppf_old<0x111>(1.0f, g1);
            At[e] = -kk[e] * g0; Rt[e] = rr * g1; Bt[e] = bb[e] * gi; Kt[e] = kx[e] * gi;
            const int ke = 32 * ks + e;
            *(bf16*)(pbk + ks * 2048 + e * 16) = (bf16)f2bf(Bt[e] * gC);
            *(bf16*)(pbk + ks * 2048 + e * 16 + 8) = (bf16)f2bf(Kt[e] * gC);
            *(bf16*)(pvt + ks * 1024 + e * 8) = (bf16)f2bf(vv);
            if (t == 15) *(float*)(pgc + ke * 4) = gC; }
        Af[ks] = pack8(At); Rf[ks] = pack8(Rt); Bf[ks] = pack8(Bt); Kf[ks] = pack8(Kt);
        { const int fqs = 2 * (fq & 1), bo = (fq >> 1) * 8; const v4u aw = __builtin_bit_cast(v4u, Af[ks]), rw = __builtin_bit_cast(v4u, Rf[ks]);
          *(v2u*)(cb + CB_A + ((ks * 4 + fqs) * 16 + t) * 16 + bo) = (v2u){aw.x, aw.y}; *(v2u*)(cb + CB_A + ((ks * 4 + fqs + 1) * 16 + t) * 16 + bo) = (v2u){aw.z, aw.w};
          *(v2u*)(cb + CB_R + ((ks * 4 + fqs) * 16 + t) * 16 + bo) = (v2u){rw.x, rw.y}; *(v2u*)(cb + CB_R + ((ks * 4 + fqs + 1) * 16 + t) * 16 + bo) = (v2u){rw.z, rw.w}; }
        *(v4u*)(cb + CB_GATE + (t * 64 + cl) * 2) = xg[ks]; }
    asm volatile("" ::: "memory"); __builtin_amdgcn_sched_barrier(0);
    bonp += __shfl_xor(bonp, 16); bonp += __shfl_xor(bonp, 32);
    if (fq == 0) *(float*)(cb + CB_BON + t * 4) = bonp;
    const f32x4 z4 = (f32x4){0.f, 0.f, 0.f, 0.f};
    f32x4 Mab = __builtin_amdgcn_mfma_f32_16x16x32_bf16(Af[0], Bf[0], z4, 0, 0, 0); Mab = __builtin_amdgcn_mfma_f32_16x16x32_bf16(Af[1], Bf[1], Mab, 0, 0, 0);
    f32x4 Mak = __builtin_amdgcn_mfma_f32_16x16x32_bf16(Af[0], Kf[0], z4, 0, 0, 0); Mak = __builtin_amdgcn_mfma_f32_16x16x32_bf16(Af[1], Kf[1], Mak, 0, 0, 0);
    f32x4 Mrb = __builtin_amdgcn_mfma_f32_16x16x32_bf16(Rf[0], Bf[0], z4, 0, 0, 0); Mrb = __builtin_amdgcn_mfma_f32_16x16x32_bf16(Rf[1], Bf[1], Mrb, 0, 0, 0);
    f32x4 Mrk = __builtin_amdgcn_mfma_f32_16x16x32_bf16(Rf[0], Kf[0], z4, 0, 0, 0); Mrk = __builtin_amdgcn_mfma_f32_16x16x32_bf16(Rf[1], Kf[1], Mrk, 0, 0, 0);
#pragma unroll
    for (int r = 0; r < 4; ++r) { const int tt = 4 * fq + r, i = fr;
        const float mab = (tt > i) ? Mab[r] : 0.f, mak = (tt > i) ? Mak[r] : 0.f, mrb = (tt >= i) ? Mrb[r] : 0.f, mrk = (tt >= i) ? Mrk[r] : 0.f;
        hs[tt * 16 + i] = mab; hs[256 + tt * 16 + i] = mak;
        const unsigned w = pk2m(mrb, mrk);
        *(bf16*)(cb + CB_AR + (((i >> 2) * 16 + tt) * 8 + (i & 3)) * 2) = (bf16)(w & 0xffffu);
        *(bf16*)(cb + CB_AR + (((i >> 2) * 16 + tt) * 8 + 4 + (i & 3)) * 2) = (bf16)(w >> 16); }
    asm volatile("s_waitcnt lgkmcnt(0)" ::: "memory");
    { const int c = lane & 31, cc = c & 15; const bool isT = c < 16; float out[16];
#pragma unroll
      for (int tt = 0; tt < 16; ++tt) { float acc = isT ? (tt == cc ? 1.0f : 0.0f) : hs[256 + tt * 16 + cc];
#pragma unroll
          for (int i4 = 0; i4 < (tt + 3) / 4; ++i4) { const f32x4 l = *(const f32x4*)(hs + tt * 16 + 4 * i4);
#pragma unroll
              for (int e = 0; e < 4; ++e) if (4 * i4 + e < tt) acc += l[e] * out[4 * i4 + e]; }
          out[tt] = acc;
          if (lane < 32) *(bf16*)(cb + CB_TT + (((cc >> 2) * 16 + tt) * 8 + (isT ? 0 : 4) + (cc & 3)) * 2) = (bf16)f2bf(acc); } }
    asm volatile("s_waitcnt lgkmcnt(0)" ::: "memory");
    { unsigned char* gi = ws + WS_IMG + ((size_t)(b * NHEAD + h) * NCHUNK + ch) * IMG_SIZE;
      for (int i = lane; i < IMG_SIZE / 16; i += 64) *(v4u*)(gi + i * 16) = *(const v4u*)(cb + i * 16); }
    asm volatile("s_waitcnt lgkmcnt(0)" ::: "memory"); __builtin_amdgcn_sched_barrier(0);
}

struct ScanOps { bf16x8 a0, a1, r0, r1, tt, ar, bk[4]; v2u vt; f32x4 g[4]; };
__device__ __forceinline__ void scan_load(ScanOps& o, const unsigned char* ib, int fr, int fq, int vcol) {
    const int ln = (fq * 16 + fr) * 16;
    o.a0 = *(const bf16x8*)(ib + CB_A + ln); o.a1 = *(const bf16x8*)(ib + CB_A + 1024 + ln);
    o.r0 = *(const bf16x8*)(ib + CB_R + ln); o.r1 = *(const bf16x8*)(ib + CB_R + 1024 + ln);
    o.tt = *(const bf16x8*)(ib + CB_TT + ln); o.ar = *(const bf16x8*)(ib + CB_AR + ln);
    o.vt = *(const v2u*)(ib + CB_VT + (((vcol >> 4) * 4 + fq) * 16 + fr) * 8);
#pragma unroll
    for (int kt = 0; kt < 4; ++kt) { o.g[kt] = *(const f32x4*)(ib + CB_G + (16 * kt + 4 * fq) * 4); o.bk[kt] = *(const bf16x8*)(ib + CB_BK + kt * 1024 + ln); }
}
__device__ __forceinline__ void scan_step(f32x4 (&H)[4], const ScanOps& o, float* yb, int fq, int vcol) {
    v4u hb0, hb1;
    hb0.x = pk2m(H[0][0], H[0][1]); hb0.y = pk2m(H[0][2], H[0][3]); hb0.z = pk2m(H[1][0], H[1][1]); hb0.w = pk2m(H[1][2], H[1][3]);
    hb1.x = pk2m(H[2][0], H[2][1]); hb1.y = pk2m(H[2][2], H[2][3]); hb1.z = pk2m(H[3][0], H[3][1]); hb1.w = pk2m(H[3][2], H[3][3]);
    const bf16x8 h0 = __builtin_bit_cast(bf16x8, hb0), h1 = __builtin_bit_cast(bf16x8, hb1);
    const f32x4 z4 = (f32x4){0.f, 0.f, 0.f, 0.f};
    f32x4 X = __builtin_amdgcn_mfma_f32_16x16x32_bf16(o.a0, h0, z4, 0, 0, 0); X = __builtin_amdgcn_mfma_f32_16x16x32_bf16(o.a1, h1, X, 0, 0, 0);
    f32x4 Y = __builtin_amdgcn_mfma_f32_16x16x32_bf16(o.r0, h0, z4, 0, 0, 0); Y = __builtin_amdgcn_mfma_f32_16x16x32_bf16(o.r1, h1, Y, 0, 0, 0);
    v4u xb; xb.x = pk2m(X[0], X[1]); xb.y = pk2m(X[2], X[3]); xb.z = o.vt.x; xb.w = o.vt.y;
    const f32x4 U = __builtin_amdgcn_mfma_f32_16x16x32_bf16(o.tt, __builtin_bit_cast(bf16x8, xb), z4, 0, 0, 0);
    v4u ub; ub.x = pk2m(U[0], U[1]); ub.y = pk2m(U[2], U[3]); ub.z = o.vt.x; ub.w = o.vt.y;
    const bf16x8 uf = __builtin_bit_cast(bf16x8, ub);
    Y = __builtin_amdgcn_mfma_f32_16x16x32_bf16(o.ar, uf, Y, 0, 0, 0);
#pragma unroll
    for (int kt = 0; kt < 4; ++kt) H[kt] = __builtin_amdgcn_mfma_f32_16x16x32_bf16(o.bk[kt], uf, H[kt] * o.g[kt], 0, 0, 0);
#pragma unroll
    for (int r = 0; r < 4; ++r) yb[(4 * fq + r) * 64 + vcol] = Y[r];
}
__device__ __forceinline__ void scan_phase(const Ptrs& P, unsigned char* lds, int sb, int tid, int wave, int lane, int never) {
    const int b = sb >> 3, h = sb & 7, fr = lane & 15, fq = lane >> 4;
    const unsigned char* img = P.ws + WS_IMG + (size_t)(b * NHEAD + h) * NCHUNK * IMG_SIZE;
    if (wave < 4) {
        f32x4 H[4];
#pragma unroll
        for (int kt = 0; kt < 4; ++kt) H[kt] = (f32x4){0.f, 0.f, 0.f, 0.f};
        const int vcol = 16 * wave + fr;
#pragma unroll 1
        for (int s = 0; s <= NSUPER + 1; ++s) {
            __syncthreads();
            if (s < 1 || s > NSUPER) continue;
            const int set = (s - 1) & 1;
#pragma unroll 1
            for (int j = 0; j < 4; ++j) { const int ch = 4 * (s - 1) + j; if (ch >= NCHUNK) break;
                ScanOps o; scan_load(o, lds + (set * 4 + j) * CB_SIZE, fr, fq, vcol);
                scan_step(H, o, (float*)(lds + SC_YB + (set * 4 + j) * 4096), fq, vcol); }
        }
    } else {
        const int hw = wave - 4, t = fr;
        const bf16* Z = (const bf16*)(P.ws + WS_BIG); const bf16* Zm = (const bf16*)(P.ws + WS_META + MO_ZM);
        bf16* Yo = (bf16*)(P.ws + WS_XB);
        const int cbase = h * 64 + 8 * fq;
        float* cst = (float*)(lds + SC_END);
        if (lane < 48) { const int a_ = lane >> 4, c4 = (lane & 15) * 4; const float* src = a_ == 0 ? P.in[9] + 1024 + h * 64 : a_ == 1 ? P.in[18] + h * 64 : P.in[19] + h * 64;
            *(f32x4*)(cst + a_ * 64 + c4) = *(const f32x4*)(src + c4); }
        v4u cg0[2], cg1[2]; v4u im0[13], im1[13];
        const int pvt_off = CB_VT + (((fq >> 1) * 4 + (t >> 2)) * 16 + 8 * (fq & 1)) * 8 + (t & 3) * 2;
#define GLD16(dst, ptr) asm volatile("global_load_dwordx4 %0, %1, off" : "=v"(dst) : "v"(ptr) : "memory")
#define GLD4(dst, ptr) asm volatile("global_load_dword %0, %1, off" : "=v"(dst) : "v"(ptr) : "memory")
#define IMG_LOAD(IM, chx) do { const unsigned char* ip_ = img + (size_t)(chx) * IMG_SIZE + lane * 16; _Pragma("unroll") for (int i_ = 0; i_ < 13; ++i_) GLD16(IM[i_], ip_ + i_ * 1024); } while (0)
#define VM_WAIT_ALL(N) asm volatile("s_waitcnt vmcnt(" #N ")" : "+v"(im0[0]), "+v"(im0[1]), "+v"(im0[2]), "+v"(im0[3]), "+v"(im0[4]), "+v"(im0[5]), "+v"(im0[6]), "+v"(im0[7]), "+v"(im0[8]), "+v"(im0[9]), "+v"(im0[10]), "+v"(im0[11]), "+v"(im0[12]), \
            "+v"(im1[0]), "+v"(im1[1]), "+v"(im1[2]), "+v"(im1[3]), "+v"(im1[4]), "+v"(im1[5]), "+v"(im1[6]), "+v"(im1[7]), "+v"(im1[8]), "+v"(im1[9]), "+v"(im1[10]), "+v"(im1[11]), "+v"(im1[12]) :: "memory")
#define VM_WAIT_POST(N) asm volatile("s_waitcnt vmcnt(" #N ")" : "+v"(cg0[0]), "+v"(cg0[1]), "+v"(cg1[0]), "+v"(cg1[1]) :: "memory")
#define POST_LOAD(CG, sx) do { int chn_ = 4 * ((sx) - 2) + hw; chn_ = chn_ < 1 ? 1 : (chn_ >= NCHUNK ? NCHUNK - 1 : chn_);     \
            const unsigned char* ib_ = img + (size_t)chn_ * IMG_SIZE; \
            _Pragma("unroll") for (int ks = 0; ks < 2; ++ks) GLD16(CG[ks], ib_ + CB_GATE + (t * 64 + 32 * ks + 8 * fq) * 2); } while (0)
        POST_LOAD(cg0, 0); IMG_LOAD(im0, hw);
        POST_LOAD(cg1, 1); IMG_LOAD(im1, 4 + hw);
#define HELPER_ITER(IM, CG) do { \
            __syncthreads(); \
            VM_WAIT_ALL(15); VM_WAIT_POST(15);        \
            unsigned char* cbw = lds + ((s & 1) * 4 + hw) * CB_SIZE;            \
            { const int ch = 4 * (s - 2) + hw; \
              if (s >= 2 && ch >= 1 && ch < NCHUNK) { const float* yb = (const float*)(lds + SC_YB + ((s & 1) * 4 + hw) * 4096); \
                const int tok = 16 * (ch - 1) + t; const size_t m = (size_t)b * TSEQ + tok; \
                float y[16]; float sm = 0.f; \
                _Pragma("unroll") for (int ks = 0; ks < 2; ++ks) { const f32x4 y0 = *(const f32x4*)(yb + t * 64 + 32 * ks + 8 * fq), y1 = *(const f32x4*)(yb + t * 64 + 32 * ks + 8 * fq + 4); \
                    _Pragma("unroll") for (int e = 0; e < 4; ++e) { y[8 * ks + e] = y0[e]; y[8 * ks + 4 + e] = y1[e]; sm += y0[e] + y1[e]; } } \
                sm += __shfl_xor(sm, 16); sm += __shfl_xor(sm, 32); const float mean = sm * (1.0f / 64.0f); float sq = 0.f; \
                _Pragma("unroll") for (int i = 0; i < 16; ++i) { y[i] -= mean; sq += y[i] * y[i]; } \
                sq += __shfl_xor(sq, 16); sq += __shfl_xor(sq, 32); const float rs = __builtin_amdgcn_rsqf(sq * (1.0f / 64.0f) + 64e-5f); \
                const float bon = *(const float*)(cbw + CB_BON + t * 4); \
                _Pragma("unroll") for (int ks = 0; ks < 2; ++ks) { const int c = cbase + 32 * ks; \
                    float g[8], o[8]; unpack8(CG[ks], g); \
                    const float* cq = cst + 32 * ks + 8 * fq; const f32x4 wA = *(const f32x4*)(cq + 64), wB = *(const f32x4*)(cq + 68), bA = *(const f32x4*)(cq + 128), bB = *(const f32x4*)(cq + 132); \
                    _Pragma("unroll") for (int e = 0; e < 8; ++e) { const float lw_ = e < 4 ? wA[e & 3] : wB[e & 3], lb_ = e < 4 ? bA[e & 3] : bB[e & 3]; \
                        const float vv = __builtin_bit_cast(float, (unsigned)(*(const bf16*)(cbw + pvt_off + ks * 1024 + e * 8)) << 16); \
                        o[e] = (y[8 * ks + e] * rs * lw_ + lb_ + bon * vv) * g[e]; } \
                    *(bf16x8*)(Yo + m * DM + c) = pack8(o); } } } \
            asm volatile("s_waitcnt lgkmcnt(0)" ::: "memory");                   \
            if (4 * s + hw < NCHUNK) { \
                _Pragma("unroll") for (int i_ = 0; i_ < 13; ++i_) if (i_ < 12 || lane < 32) *(v4u*)(cbw + (i_ * 64 + lane) * 16) = IM[i_]; } \
            POST_LOAD(CG, s + 2); \
            { const int cl_ = 4 * (s + 2) + hw; IMG_LOAD(IM, cl_ < NCHUNK ? cl_ : NCHUNK - 1); } \
        } while (0)
#pragma unroll 1
        for (int s2 = 0; s2 <= NSUPER + 1; s2 += 2) {
            { const int s = s2; HELPER_ITER(im0, cg0); }
            if (s2 + 1 <= NSUPER + 1) { const int s = s2 + 1; HELPER_ITER(im1, cg1); }
        }
        asm volatile("s_waitcnt vmcnt(0)" ::: "memory");
#undef HELPER_ITER
#undef POST_LOAD
#undef VM_WAIT_ALL
#undef VM_WAIT_POST
#undef GLD16
#undef GLD4
#undef IMG_LOAD
    }
}
__device__ __forceinline__ void final_norm(const Ptrs& P, int gw, int NGW, int lane) {
    const float* ssq = (const float*)(P.ws + WS_SSQ4); const GAS f32x4* g4 = (const GAS f32x4*)P.in[26] + lane;
    f32x4 g[4];
#pragma unroll
    for (int j = 0; j < 4; ++j) g[j] = g4[64 * j];
    for (int m = gw; m < MR; m += NGW) { const float rs = pg8::rstd_from16(ssq, m); GAS f32x4* o = (GAS f32x4*)(P.out + (size_t)m * DM) + lane;
#pragma unroll
        for (int j = 0; j < 4; ++j) o[64 * j] = o[64 * j] * rs * g[j]; }
}
#ifndef MK_N_LAUNCHES
#define MK_N_LAUNCHES 1
#endif
constexpr int N_PHASES = 10;
struct Args { Ptrs p; int ph_lo, ph_hi, use_cg, pad; };
__global__ void __launch_bounds__(NWAVES * 64, 2) hymba_fwd(Args args) {
    extern __shared__ __attribute__((aligned(16))) unsigned char lds[];
    LAS unsigned char* ldsl = (LAS unsigned char*)lds;
    volatile LAS unsigned* MISC = (volatile LAS unsigned*)(ldsl + MISC_OFF);
    const int tid = threadIdx.x, lane = tid & 63, wave = __builtin_amdgcn_readfirstlane(tid >> 6);
    const int G = gridDim.x, bx = blockIdx.x, vcu = (G % 8 == 0) ? (bx % 8) * (G / 8) + bx / 8 : bx;
    const Ptrs& P = args.p; unsigned char* ws = P.ws;
    if (args.use_cg) cg::this_grid().sync();
    for (int u = tid; u < (LDS_BYTES - LDSCTL_OFF) / 4; u += NWAVES * 64) ((LAS unsigned*)(ldsl + LDSCTL_OFF))[u] = 0u;
    __syncthreads();
    const int lo = args.ph_lo, hi = args.ph_hi;
    XcdBarrier bar; bar.bar = (unsigned*)(ws + WS_CTL) + CW_BAR; bar.x = 0; bar.st = nullptr;
    if (hi - lo > 1) bar = xcd_barrier_post((unsigned*)(ws + WS_CTL) + CW_BAR, MISC + 8);
#define IN(k) (lo <= (k) && (k) < hi)
#define SEAM(k) do { if (IN(k) && IN((k) + 1)) xcd_barrier(bar); } while (0)
    const int gw = vcu * NWAVES + wave, NGW = G * NWAVES;
    const int gwm = bx + G * wave;

#ifndef REP_P0
#define REP_P0 1
#endif
    if (IN(0)) { for (int rep = 0; rep < REP_P0; ++rep) p0_prologue(P, ldsl, vcu, G, wave, lane); SEAM(0); }
    if (IN(1)) {
        meta_up(ws, gwm, NGW, lane);
        pg8::Gemm g{(const bf16*)(ws + WS_XB), (const bf16*)(ws + WS_WGU1), MR, NGU, DM}; pg8::StaticOrder S; S.init(MR, NGU, G, bx);
        LAS float* rcache = (LAS float*)(ldsl + RING_BYTES); pg8::fill_rstd_cache(rcache, (const float*)(ws + WS_SSQ1), S);
        pg8::EpiSwiglu E{(bf16*)(ws + WS_BIG), (const float*)(ws + WS_SSQ1), FF, rcache};
#ifndef REP_P1
#define REP_P1 1
#endif
        for (int rep = 0; rep < REP_P1; ++rep) pg8::gemm_phase<pg8::EpiSwiglu, pg8::StaticOrder, true, true>(ldsl, g, S, E);
        SEAM(1);
    }
    if (IN(2)) {
        meta_down(P, gwm, NGW, lane);
        pg8::Gemm g{(const bf16*)(ws + WS_BIG), (const bf16*)(ws + WS_WD1), MR, DM, FF}; pg8::StaticOrder S; S.init(MR, DM, G, bx);
        pg8::EpiResid<true> E{P.in[0], P.out, (bf16*)(ws + WS_XB), (float*)(ws + WS_SSQ2), 0.5f};
#ifndef REP_P2
#define REP_P2 1
#endif
        for (int rep = 0; rep < REP_P2; ++rep) pg8::gemm_phase<pg8::EpiResid<true>, pg8::StaticOrder, true, true>(ldsl, g, S, E);
        SEAM(2);
    }
    if (IN(3)) {
        meta_win(P, gwm, NGW, lane);
        pg8::Gemm g{(const bf16*)(ws + WS_XB), (const bf16*)(ws + WS_WIN), MR, NINP, DM}; pg8::StaticOrder S; S.init(MR, NINP, G, bx);
        LAS float* rcache = (LAS float*)(ldsl + RING_BYTES); pg8::fill_rstd_cache(rcache, (const float*)(ws + WS_SSQ2), S);
        pg8::EpiZ E{(bf16*)(ws + WS_BIG), (const float*)(ws + WS_SSQ2), P.in[8], NIN, NIN, ZC_Q, rcache};
        pg8::gemm_phase<pg8::EpiZ, pg8::StaticOrder, true, true>(ldsl, g, S, E);
        SEAM(3);
    }
    if (IN(4)) {
#ifndef REP_PREP
#define REP_PREP 1
#endif
        for (int rep = 0; rep < REP_PREP; ++rep) for (int task = gw; task < NBATCH * NHEAD * NCHUNK; task += NGW) { const int bc = task >> 3; chunk_task(P, lds, wave * WL_SIZE, bc / NCHUNK, task & 7, bc % NCHUNK, lane); }
        SEAM(4);
    }
    if (IN(5)) {
#ifndef REP_SCAN
#define REP_SCAN 1
#endif
#ifndef REP_ATTN
#define REP_ATTN 1
#endif
        if (bx < 64) { for (int rep = 0; rep < REP_SCAN; ++rep) { scan_phase(P, lds, bx, tid, wave, lane, args.use_cg); __syncthreads(); } }
        else { for (int rep = 0; rep < REP_ATTN; ++rep) for (int u = bx - 64; u < NBATCH * 2 * 64; u += G - 64) attn_unit(P, lds, u >> 7, (u >> 6) & 1, u & 63, tid, wave, lane);
            __syncthreads();
#ifndef REP_TR1
#define REP_TR1 1
#endif
            for (int rep = 0; rep < REP_TR1; ++rep) p0_transposes(P, ldsl, 1, (bx - 64) * NWAVES + wave, (G - 64) * NWAVES, wave, lane); }
        __syncthreads();
        SEAM(5);
    }
    if (IN(6)) {
        pg8::Gemm g{(const bf16*)(ws + WS_XB), (const bf16*)(ws + WS_WOUT), MR, DM, DM}; pg8::StaticOrder S; S.init(MR, DM, G, bx);
        pg8::EpiResid<true> E{P.out, P.out, (bf16*)(ws + WS_P), (float*)(ws + WS_SSQ3), 1.0f};
        pg8::gemm_phase<pg8::EpiResid<true>, pg8::StaticOrder, true, true>(ldsl, g, S, E);
        SEAM(6);
    }
    if (IN(7)) {
        pg8::Gemm g{(const bf16*)(ws + WS_P), (const bf16*)(ws + WS_WGU2), MR, NGU, DM}; pg8::StaticOrder S; S.init(MR, NGU, G, bx);
        LAS float* rcache = (LAS float*)(ldsl + RING_BYTES); pg8::fill_rstd_cache(rcache, (const float*)(ws + WS_SSQ3), S);
        pg8::EpiSwiglu E{(bf16*)(ws + WS_BIG), (const float*)(ws + WS_SSQ3), FF, rcache};
        pg8::gemm_phase<pg8::EpiSwiglu, pg8::StaticOrder, true, true>(ldsl, g, S, E);
        SEAM(7);
    }
    if (IN(8)) {
        pg8::Gemm g{(const bf16*)(ws + WS_BIG), (const bf16*)(ws + WS_WD2), MR, DM, FF}; pg8::StaticOrder S; S.init(MR, DM, G, bx);
        pg8::EpiResid<false> E{P.out, P.out, nullptr, (float*)(ws + WS_SSQ4), 0.5f};
        pg8::gemm_phase<pg8::EpiResid<false>, pg8::StaticOrder, true, true>(ldsl, g, S, E);
        SEAM(8);
    }
    if (IN(9)) final_norm(P, gw, NGW, lane);
#undef IN
#undef SEAM
}

extern "C" void kernel_launch(void* const* d_in, const int* in_sizes, int n_in, void* d_out, int out_size, void* d_ws, size_t ws_size, hipStream_t stream) {
    static int grid = 0;
    if (grid == 0) {
        if (n_in != 27 || in_sizes[0] != MR * DM || out_size != MR * DM || ws_size < WS_END) { fprintf(stderr, "kernel_launch: unexpected shapes (n_in %d, in0 %d, out %d, ws %zu)\n", n_in, n_in > 0 ? in_sizes[0] : -1, out_size, ws_size); grid = -1; return; }
        int dev = 0, cus = 0, per_cu = 0;
        if (hipGetDevice(&dev) != hipSuccess || hipDeviceGetAttribute(&cus, hipDeviceAttributeMultiprocessorCount, dev) != hipSuccess) { grid = -1; return; }
        if (hipFuncSetAttribute((const void*)hymba_fwd, hipFuncAttributeMaxDynamicSharedMemorySize, LDS_BYTES) != hipSuccess) { fprintf(stderr, "kernel_launch: hipFuncSetAttribute failed\n"); grid = -1; return; }
        if (hipOccupancyMaxActiveBlocksPerMultiprocessor(&per_cu, (const void*)hymba_fwd, NWAVES * 64, LDS_BYTES) != hipSuccess || per_cu < 1) fprintf(stderr, "kernel_launch: occupancy query says %d blocks per CU\n", per_cu);
        (void)hipGetLastError();
        grid = cus;
    }
    if (grid < 0) return;
    if (hipMemsetAsync((char*)d_ws + WS_CTL, 0, CTL_ZERO_BYTES, stream) != hipSuccess) { fprintf(stderr, "kernel_launch: memset failed\n"); return; }
    Args a{};
    for (int i = 0; i < 27; ++i) a.p.in[i] = (const float*)d_in[i];
    a.p.out = (float*)d_out; a.p.ws = (unsigned char*)d_ws; a.use_cg = 0; a.pad = 0;
#if MK_N_LAUNCHES == 1
    a.ph_lo = 0; a.ph_hi = N_PHASES;
    void* kargs[] = {&a};
    hipError_t e = hipLaunchCooperativeKernel((const void*)hymba_fwd, dim3(grid), dim3(NWAVES * 64), kargs, LDS_BYTES, stream);
    if (e != hipSuccess) fprintf(stderr, "kernel_launch: cooperative launch failed: %s (grid %d)\n", hipGetErrorString(e), grid);
#else
    for (int li = 0; li < N_PHASES; ++li) { a.ph_lo = li; a.ph_hi = li + 1;
        hipLaunchKernelGGL(hymba_fwd, dim3(grid), dim3(NWAVES * 64), LDS_BYTES, stream, a);
        const hipError_t le = hipPeekAtLastError(); if (le != hipSuccess) { fprintf(stderr, "kernel_launch: launch %d failed: %s\n", li, hipGetErrorName(le)); break; } }
#endif
}
```

```cpp
#include <hip/hip_runtime.h>
#include <cstdio>
#include <cstdint>
namespace pg8 {
#define PG8_LAS __attribute__((address_space(3)))
typedef unsigned short bf16_t;
typedef short bf16x8 __attribute__((ext_vector_type(8)));
typedef float f32x4 __attribute__((ext_vector_type(4)));
typedef unsigned u32x4 __attribute__((ext_vector_type(4)));
constexpr int BM = 256, BK = 64, HALF = 128, HTB = HALF * BK * 2  , STAGE_BYTES = 8 * HTB, NXCD = 8, WGM = 8;

__host__ __device__ __forceinline__ int lds_byte(int r, int c) { const int st = (r >> 4) * 2 + (c >> 5), rr = r & 15, cc = c & 31, ob = rr * 64 + cc * 2; return st * 1024 + (ob ^ (((ob >> 9) & 1) << 5)); }
__host__ __device__ __forceinline__ void stage_rc(int b, int& R, int& C) { const int st = b / 1024, sb = b % 1024, swz = sb ^ (((sb >> 9) & 1) << 5); R = (st >> 1) * 16 + swz / 64; C = (st & 1) * 32 + (swz % 64) / 2; }
__host__ __device__ __forceinline__ int perm32(int rho) { const int n = rho >> 4, i = rho & 15; return 8 * (i >> 2) + 4 * n + (i & 3); }

struct Unit { int pm, pn; };
struct Gemm { const bf16_t* A; const bf16_t* Bt; int M, N, K; };

struct StaticOrder {
    int nM, nN, nwg, G, c;
    __host__ __device__ void init(int M, int N, int G_, int c_) { nM = M / BM; nN = N / BM; nwg = nM * nN; G = G_; c = c_; }
    __host__ __device__ bool next(int i, Unit& u) const {
        const long L = (long)i * G + c; if (L >= nwg) return false;
        int wgid = (int)L; { const int q = nwg / NXCD, r = nwg % NXCD, xcd = wgid % NXCD, off = wgid / NXCD; wgid = (xcd < r ? xcd * (q + 1) : r * (q + 1) + (xcd - r) * q) + off; }
        const int nig = WGM * nN, gid = wgid / nig, fm = gid * WGM, gsz = (nM - fm) < WGM ? (nM - fm) : WGM;
        u.pm = fm + ((wgid % nig) % gsz); u.pn = (wgid % nig) / gsz; return true;
    }
    __device__ __forceinline__ void a_ready(const Unit&) const {}
    __device__ __forceinline__ void done(const Unit&) const {}
};

__device__ __forceinline__ unsigned cvt_pk_bf16(float lo, float hi) { unsigned r; asm volatile("v_cvt_pk_bf16_f32 %0, %1, %2" : "=v"(r) : "v"(lo), "v"(hi)); return r; }
typedef float f32x2 __attribute__((ext_vector_type(2)));
typedef unsigned u32x2 __attribute__((ext_vector_type(2)));
__device__ __forceinline__ float rstd_from16(const float* ssq, int row) {
    const f32x4* p = (const f32x4*)(ssq + (size_t)row * 16);
    const f32x4 a = p[0], b = p[1], c = p[2], d = p[3];
    const float s = ((a[0] + a[1]) + (a[2] + a[3])) + ((b[0] + b[1]) + (b[2] + b[3])) + ((c[0] + c[1]) + (c[2] + c[3])) + ((d[0] + d[1]) + (d[2] + d[3]));
    return __builtin_amdgcn_rsqf(s * (1.0f / 1024.0f) + 1e-5f);
}
__device__ __forceinline__ float silu_mul(float g, float u) { return g * __builtin_amdgcn_rcpf(1.0f + __builtin_amdgcn_exp2f(-1.4426950408889634f * g)) * u; }
template <class Sched> __device__ __forceinline__ void fill_rstd_cache(PG8_LAS float* tab, const float* ssq, const Sched& S) {
    const int tid = threadIdx.x; int t0 = -1, t1 = -1, t2 = -1, t3 = -1; Unit u;
    for (int i = 0; S.next(i, u); ++i) { const int pm = u.pm;
        if (pm == t0 || pm == t1 || pm == t2 || pm == t3) continue;
        if (t0 < 0) t0 = pm; else if (t1 < 0) t1 = pm; else if (t2 < 0) t2 = pm; else if (t3 < 0) t3 = pm; }
    if (tid == 0) { tab[0] = __builtin_bit_cast(float, t0); tab[1] = __builtin_bit_cast(float, t1); tab[2] = __builtin_bit_cast(float, t2); tab[3] = __builtin_bit_cast(float, t3); }
    if (tid < 256) { if (t0 >= 0) tab[4 + tid] = rstd_from16(ssq, t0 * BM + tid); if (t1 >= 0) tab[4 + 256 + tid] = rstd_from16(ssq, t1 * BM + tid);
        if (t2 >= 0) tab[4 + 512 + tid] = rstd_from16(ssq, t2 * BM + tid); if (t3 >= 0) tab[4 + 768 + tid] = rstd_from16(ssq, t3 * BM + tid); }
    __syncthreads();
}
__device__ __forceinline__ int rstd_slot(const PG8_LAS float* tab, int pm) {
    const int a = __builtin_bit_cast(int, tab[0]), b = __builtin_bit_cast(int, tab[1]), c = __builtin_bit_cast(int, tab[2]), d = __builtin_bit_cast(int, tab[3]);
    return pm == a ? 0 : pm == b ? 1 : pm == c ? 2 : pm == d ? 3 : -1;
}
struct EpiSwiglu {
    static constexpr bool PERM = true, AFTER_DRAIN = false;
    bf16_t* U; const float* ssq; int ldu; const PG8_LAS float* rc;
    __device__ __forceinline__ void operator()(const f32x4 (&acc)[2][2][4][2], const Unit& u, int wr, int wc, int fr, int fq) const {
        const int row0 = u.pm * BM + wr * 64 + fr, col0 = u.pn * HALF + wc * 32 + 8 * fq; const int slot = rstd_slot(rc, u.pm);
#pragma unroll
        for (int ai = 0; ai < 2; ++ai)
#pragma unroll
            for (int m = 0; m < 4; ++m) { const int row = row0 + ai * HALF + m * 16; const float rs = slot >= 0 ? rc[4 + slot * 256 + (row - u.pm * BM)] : rstd_from16(ssq, row);
                const float rs2 = rs * rs, cc = -1.4426950408889634f * rs;
                f32x4 o0, o1;
                { const f32x4 g = acc[ai][0][m][0], uu = acc[ai][1][m][0]; const f32x4 a = g * cc; f32x4 e; e[0] = __builtin_amdgcn_exp2f(a[0]); e[1] = __builtin_amdgcn_exp2f(a[1]); e[2] = __builtin_amdgcn_exp2f(a[2]); e[3] = __builtin_amdgcn_exp2f(a[3]);
                  const f32x4 d = e + 1.0f; f32x4 r; r[0] = __builtin_amdgcn_rcpf(d[0]); r[1] = __builtin_amdgcn_rcpf(d[1]); r[2] = __builtin_amdgcn_rcpf(d[2]); r[3] = __builtin_amdgcn_rcpf(d[3]); o0 = (g * rs2) * uu * r; }
                { const f32x4 g = acc[ai][0][m][1], uu = acc[ai][1][m][1]; const f32x4 a = g * cc; f32x4 e; e[0] = __builtin_amdgcn_exp2f(a[0]); e[1] = __builtin_amdgcn_exp2f(a[1]); e[2] = __builtin_amdgcn_exp2f(a[2]); e[3] = __builtin_amdgcn_exp2f(a[3]);
                  const f32x4 d = e + 1.0f; f32x4 r; r[0] = __builtin_amdgcn_rcpf(d[0]); r[1] = __builtin_amdgcn_rcpf(d[1]); r[2] = __builtin_amdgcn_rcpf(d[2]); r[3] = __builtin_amdgcn_rcpf(d[3]); o1 = (g * rs2) * uu * r; }
                u32x4 w; w.x = cvt_pk_bf16(o0[0], o0[1]); w.y = cvt_pk_bf16(o0[2], o0[3]); w.z = cvt_pk_bf16(o1[0], o1[1]); w.w = cvt_pk_bf16(o1[2], o1[3]);
                *(u32x4*)(U + (size_t)row * ldu + col0) = w; }
    }
};
struct EpiZ {
    static constexpr bool PERM = true, AFTER_DRAIN = false;
    bf16_t* Z; const float* ssq; const float* bias; int ldz, ncols, bias_from; const PG8_LAS float* rc;
    __device__ __forceinline__ void operator()(const f32x4 (&acc)[2][2][4][2], const Unit& u, int wr, int wc, int fr, int fq) const {
        const int row0 = u.pm * BM + wr * 64 + fr, col0 = u.pn * BM + wc * 32 + 8 * fq; const int slot = rstd_slot(rc, u.pm);
        f32x4 bv[2][2];
#pragma unroll
        for (int bj = 0; bj < 2; ++bj)
#pragma unroll
            for (int n = 0; n < 2; ++n) { const int c = col0 + bj * HALF + 4 * n; bv[bj][n] = (c >= bias_from && c < ncols) ? *(const f32x4*)(bias + (c - bias_from)) : (f32x4){0.f, 0.f, 0.f, 0.f}; }
#pragma unroll
        for (int ai = 0; ai < 2; ++ai)
#pragma unroll
            for (int m = 0; m < 4; ++m) { const int row = row0 + ai * HALF + m * 16; const float rs = slot >= 0 ? rc[4 + slot * 256 + (row - u.pm * BM)] : rstd_from16(ssq, row);
#pragma unroll
                for (int bj = 0; bj < 2; ++bj) { const int c = col0 + bj * HALF; if (c < ncols) {
                    const f32x4 v0 = acc[ai][bj][m][0] * rs + bv[bj][0], v1 = acc[ai][bj][m][1] * rs + bv[bj][1];
                    u32x4 w; w.x = cvt_pk_bf16(v0[0], v0[1]); w.y = cvt_pk_bf16(v0[2], v0[3]); w.z = cvt_pk_bf16(v1[0], v1[1]); w.w = cvt_pk_bf16(v1[2], v1[3]);
                    *(u32x4*)(Z + (size_t)row * ldz + c) = w; } } }
    }
};
template <bool WB> struct EpiResid {
    static constexpr bool PERM = false, AFTER_DRAIN = false;
    const float* base; float* out; bf16_t* outb; float* ssq; float scale;
    __device__ __forceinline__ void operator()(const f32x4 (&acc)[2][2][4][2], const Unit& u, int wr, int wc, int fr, int fq) const {
        const int row0 = u.pm * BM + wr * 64 + fr, col0 = u.pn * BM + wc * 32 + 4 * fq;
        f32x4 nb[4]; float ssv[8];
        { const size_t off = (size_t)row0 * 1024 + col0;
#pragma unroll
          for (int q = 0; q < 4; ++q) nb[q] = *(const f32x4*)(base + off + (q >> 1) * HALF + (q & 1) * 16); }
#pragma unroll
        for (int ri = 0; ri < 8; ++ri) { const int ai = ri >> 2, m = ri & 3; const int row = row0 + ai * HALF + m * 16; const size_t off = (size_t)row * 1024 + col0;
            f32x4 cb[4];
#pragma unroll
            for (int q = 0; q < 4; ++q) cb[q] = nb[q];
            if (ri < 7) { const int r2 = ri + 1; const size_t off2 = (size_t)(row0 + (r2 >> 2) * HALF + (r2 & 3) * 16) * 1024 + col0;
#pragma unroll
                for (int q = 0; q < 4; ++q) nb[q] = *(const f32x4*)(base + off2 + (q >> 1) * HALF + (q & 1) * 16);
                asm volatile("" ::: "memory"); }
            float ss = 0.f;
#pragma unroll
            for (int q = 0; q < 4; ++q) { const int bj = q >> 1, n = q & 1; const size_t o2 = off + bj * HALF + n * 16; const f32x4 o = cb[q] + acc[ai][bj][m][n] * scale;
                *(f32x4*)(out + o2) = o; ss += (o[0] * o[0] + o[1] * o[1]) + (o[2] * o[2] + o[3] * o[3]);
                if (WB) { u32x2 w; w.x = cvt_pk_bf16(o[0], o[1]); w.y = cvt_pk_bf16(o[2], o[3]); *(u32x2*)(outb + o2) = w; } }
            ssv[ri] = ss; }
#pragma unroll
        for (int ri = 0; ri < 8; ++ri) ssv[ri] += __shfl_xor(ssv[ri], 16);
#pragma unroll
        for (int ri = 0; ri < 8; ++ri) ssv[ri] += __shfl_xor(ssv[ri], 32);
        if (fq == 0) {
#pragma unroll
            for (int ri = 0; ri < 8; ++ri) ssq[(size_t)(row0 + (ri >> 2) * HALF + (ri & 3) * 16) * 16 + u.pn * 4 + wc] = ssv[ri]; }
    }
};
template <class Epi, class Sched, bool ALIGN_EPI = false, bool SP2 = false>
__device__ __forceinline__ void gemm_phase(PG8_LAS unsigned char* lds, const Gemm g, const Sched& S, const Epi& E) {
    const int tid = threadIdx.x, wid = __builtin_amdgcn_readfirstlane(tid >> 6), lane = tid & 63, wr = wid >> 2, wc = wid & 3, fr = lane & 15, fq = lane >> 4;
    const int K = g.K, nt = K / BK;
    unsigned voffA[2], voffB[2];
#pragma unroll
    for (int i = 0; i < 2; ++i) { int R, C; stage_rc(tid * 16 + i * 8192, R, C); const int Rb = Epi::PERM ? ((R & ~31) + perm32(R & 31)) : R;
        voffA[i] = (unsigned)(R * K + C) * 2u; voffB[i] = (unsigned)(Rb * K + C) * 2u; }
    const size_t kstep = (size_t)(BK * 2);
    const size_t hstep = (size_t)HALF * K * 2;
    const size_t tstep = 2 * hstep;
    const unsigned ldsw = (unsigned)wid * 1024u;
    const int aoff = lds_byte(wr * 64 + fr, fq * 8), boff = lds_byte(wc * 32 + fr, fq * 8);
#define PG8_SA(b, h) (((b) * 2 + (h)) * HTB)
#define PG8_SB(b, h) ((4 + (b) * 2 + (h)) * HTB)
#define PG8_STAGE(bufoff, gbase, voff) do { _Pragma("unroll") for (int _i = 0; _i < 2; ++_i) \
        __builtin_amdgcn_global_load_lds((const unsigned*)((const char*)(gbase) + (voff)[_i]), (PG8_LAS unsigned*)(lds + (bufoff) + ldsw + _i * 8192), 16, 0, 0); } while (0)
#define PG8_LDA(dst, b, h) do { _Pragma("unroll") for (int m = 0; m < 4; ++m) _Pragma("unroll") for (int k = 0; k < 2; ++k) dst[m][k] = *(const PG8_LAS bf16x8*)(lds + PG8_SA(b, h) + aoff + m * 2048 + k * 1024); } while (0)
#define PG8_LDB(dst, b, h) do { _Pragma("unroll") for (int n = 0; n < 2; ++n) _Pragma("unroll") for (int k = 0; k < 2; ++k) dst[n][k] = *(const PG8_LAS bf16x8*)(lds + PG8_SB(b, h) + boff + n * 2048 + k * 1024); } while (0)
#define PG8_MMA(ai, bj, At, Bt) do { __builtin_amdgcn_s_setprio(1); _Pragma("unroll") for (int m = 0; m < 4; ++m) _Pragma("unroll") for (int n = 0; n < 2; ++n) _Pragma("unroll") for (int k = 0; k < 2; ++k) \
        acc[ai][bj][m][n] = __builtin_amdgcn_mfma_f32_16x16x32_bf16(Bt[n][k], At[m][k], acc[ai][bj][m][n], 0, 0, 0); __builtin_amdgcn_s_setprio(0); } while (0)
#define PG8_WAIT_V(n) asm volatile("s_waitcnt vmcnt(" #n ")" ::: "memory")
#define PG8_WAIT_L(n) asm volatile("s_waitcnt lgkmcnt(" #n ")" ::: "memory")
#define PG8_BAR __builtin_amdgcn_s_barrier()
#define PG8_SCHED __builtin_amdgcn_sched_barrier(0)
    Unit cur, nxt; int ui = 0;
    if (!S.next(0, cur)) return;
    f32x4 acc[2][2][4][2];
#pragma unroll
    for (int a = 0; a < 2; ++a)
#pragma unroll
        for (int b = 0; b < 2; ++b)
#pragma unroll
            for (int m = 0; m < 4; ++m)
#pragma unroll
                for (int n = 0; n < 2; ++n) acc[a][b][m][n] = (f32x4){0.f, 0.f, 0.f, 0.f};
    bf16x8 At[4][2], B0[2][2], B1[2][2];
    const char* cA = (const char*)g.A + (size_t)cur.pm * tstep; const char* cB = (const char*)g.Bt + (size_t)cur.pn * tstep;
    S.a_ready(cur);
    if constexpr (SP2) {
        PG8_STAGE(PG8_SB(0, 0), cB, voffB); PG8_STAGE(PG8_SB(0, 1), cB + hstep, voffB); PG8_STAGE(PG8_SA(0, 0), cA, voffA); PG8_STAGE(PG8_SA(0, 1), cA + hstep, voffA);
        if (wr == 1) PG8_BAR;
        PG8_WAIT_V(2); PG8_BAR;
        PG8_STAGE(PG8_SB(1, 0), cB + kstep, voffB); PG8_STAGE(PG8_SA(1, 0), cA + kstep, voffA); PG8_STAGE(PG8_SB(1, 1), cB + hstep + kstep, voffB);
        PG8_WAIT_V(6); PG8_BAR;
    } else {
        PG8_STAGE(PG8_SB(0, 0), cB, voffB); PG8_STAGE(PG8_SA(0, 0), cA, voffA); PG8_STAGE(PG8_SB(0, 1), cB + hstep, voffB); PG8_STAGE(PG8_SA(0, 1), cA + hstep, voffA);
        if (wr == 1) PG8_BAR;
        PG8_WAIT_V(4); PG8_BAR;
        PG8_STAGE(PG8_SB(1, 0), cB + kstep, voffB); PG8_STAGE(PG8_SA(1, 0), cA + kstep, voffA); PG8_STAGE(PG8_SB(1, 1), cB + hstep + kstep, voffB);
        PG8_WAIT_V(6); PG8_BAR;
    }
    for (;;) {
        const bool has_next = S.next(ui + 1, nxt);
        const char* nA = has_next ? (const char*)g.A + (size_t)nxt.pm * tstep : cA; const char* nB = has_next ? (const char*)g.Bt + (size_t)nxt.pn * tstep : cB;
        for (int t = 0; t < nt; t += 2) {
            const bool last = (t == nt - 2);
            const char* a1 = cA + (size_t)(t + 1) * kstep;
            const char* a2 = last ? nA : cA + (size_t)(t + 2) * kstep; const char* b2 = last ? nB : cB + (size_t)(t + 2) * kstep;
            const char* a3 = a2 + kstep; const char* b3 = b2 + kstep;
            if (last && has_next) S.a_ready(nxt);
            if constexpr (SP2) {
            PG8_LDB(B0, 0, 0); PG8_LDB(B1, 0, 1); PG8_SCHED; PG8_LDA(At, 0, 0); PG8_STAGE(PG8_SA(1, 1), a1 + hstep, voffA);
            PG8_WAIT_V(8); PG8_WAIT_L(0); PG8_BAR; PG8_MMA(0, 0, At, B0); PG8_MMA(0, 1, At, B1); PG8_BAR; PG8_SCHED;
            PG8_LDA(At, 0, 1); PG8_STAGE(PG8_SB(0, 0), b2, voffB); PG8_STAGE(PG8_SB(0, 1), b2 + hstep, voffB); PG8_STAGE(PG8_SA(0, 0), a2, voffA);
            PG8_WAIT_V(8); PG8_WAIT_L(0); PG8_BAR; PG8_MMA(1, 0, At, B0); PG8_MMA(1, 1, At, B1); PG8_BAR; PG8_SCHED;
            PG8_LDB(B0, 1, 0); PG8_LDB(B1, 1, 1); PG8_SCHED; PG8_LDA(At, 1, 0); PG8_STAGE(PG8_SA(0, 1), a2 + hstep, voffA);
            PG8_WAIT_V(8); PG8_WAIT_L(0); PG8_BAR; PG8_MMA(0, 0, At, B0); PG8_MMA(0, 1, At, B1); PG8_BAR; PG8_SCHED;
            PG8_LDA(At, 1, 1); PG8_STAGE(PG8_SB(1, 0), b3, voffB); PG8_STAGE(PG8_SB(1, 1), b3 + hstep, voffB); PG8_STAGE(PG8_SA(1, 0), a3, voffA);
            PG8_WAIT_V(8); PG8_WAIT_L(0); PG8_BAR; PG8_MMA(1, 0, At, B0); PG8_MMA(1, 1, At, B1); PG8_BAR; PG8_SCHED;
            } else {
            PG8_LDB(B0, 0, 0); PG8_SCHED; PG8_LDA(At, 0, 0); PG8_STAGE(PG8_SA(1, 1), a1 + hstep, voffA);
            PG8_WAIT_L(8); PG8_BAR; PG8_WAIT_L(0); PG8_MMA(0, 0, At, B0); PG8_BAR; PG8_SCHED;
            PG8_LDB(B1, 0, 1); PG8_STAGE(PG8_SB(0, 0), b2, voffB);
            PG8_BAR; PG8_WAIT_L(0); PG8_MMA(0, 1, At, B1); PG8_BAR;
            PG8_LDA(At, 0, 1); PG8_STAGE(PG8_SA(0, 0), a2, voffA);
            PG8_BAR; PG8_WAIT_L(0); PG8_MMA(1, 0, At, B0); PG8_BAR; PG8_SCHED;
            PG8_STAGE(PG8_SB(0, 1), b2 + hstep, voffB);
            PG8_WAIT_V(6); PG8_BAR; PG8_MMA(1, 1, At, B1); PG8_BAR;
            PG8_LDB(B0, 1, 0); PG8_SCHED; PG8_LDA(At, 1, 0); PG8_STAGE(PG8_SA(0, 1), a2 + hstep, voffA);
            PG8_WAIT_L(8); PG8_BAR; PG8_WAIT_L(0); PG8_MMA(0, 0, At, B0); PG8_BAR; PG8_SCHED;
            PG8_LDB(B1, 1, 1); PG8_STAGE(PG8_SB(1, 0), b3, voffB);
            PG8_BAR; PG8_WAIT_L(0); PG8_MMA(0, 1, At, B1); PG8_BAR;
            PG8_LDA(At, 1, 1); PG8_STAGE(PG8_SA(1, 0), a3, voffA);
            PG8_BAR; PG8_WAIT_L(0); PG8_MMA(1, 0, At, B0); PG8_BAR; PG8_SCHED;
            PG8_STAGE(PG8_SB(1, 1), b3 + hstep, voffB);
            PG8_WAIT_V(6); PG8_BAR; PG8_MMA(1, 1, At, B1); PG8_BAR;
            }
        }
        if constexpr (ALIGN_EPI) { if (wr == 0) PG8_BAR; }
        if constexpr (!Epi::AFTER_DRAIN) { E(acc, cur, wr, wc, fr, fq); S.done(cur); }
        if (!has_next) break;
#pragma unroll
        for (int a = 0; a < 2; ++a)
#pragma unroll
            for (int b = 0; b < 2; ++b)
#pragma unroll
                for (int m = 0; m < 4; ++m)
#pragma unroll
                    for (int n = 0; n < 2; ++n) acc[a][b][m][n] = (f32x4){0.f, 0.f, 0.f, 0.f};
        cur = nxt; cA = nA; cB = nB; ++ui;
        if constexpr (ALIGN_EPI) { if (wr == 1) PG8_BAR; }
    }
    PG8_WAIT_V(0);
    if constexpr (!ALIGN_EPI) { if (wr == 0) PG8_BAR; }
    PG8_BAR;
    if constexpr (Epi::AFTER_DRAIN) { E.fused(acc, cur, wr, wc, fr, fq, lds, wid, lane); S.done(cur); }
#undef PG8_SA
#undef PG8_SB
#undef PG8_STAGE
#undef PG8_LDA
#undef PG8_LDB
#undef PG8_MMA
#undef PG8_WAIT_V
#undef PG8_WAIT_L
#undef PG8_BAR
#undef PG8_SCHED
}
}
#include <hip/hip_cooperative_groups.h>
namespace cg = cooperative_groups;
constexpr int NWAVES = 8;
constexpr int MR = 32768, DM = 1024, FF = 2816, NGU = 5632, NIN = 2464, NINP = 2560, TSEQ = 4096, NBATCH = 8, NHEAD = 8, NMETA = 16;
constexpr int ZC_W = 1536, ZC_Q = 1696, ZC_K = 2208, ZC_V = 2336;
constexpr int PV = 320;
constexpr size_t MiB = 1u << 20;
constexpr size_t WS_CTL = 0, CTL_ZERO_BYTES = 1 * MiB;
constexpr size_t WS_WGU1 = 2 * MiB, WS_WD1 = 13 * MiB, WS_WIN = 19 * MiB, WS_WOUT = 24 * MiB, WS_WGU2 = 26 * MiB, WS_WD2 = 37 * MiB, WS_LT = 43 * MiB;
constexpr size_t WS_SSQ1 = 44 * MiB, WS_SSQ2 = 46 * MiB, WS_SSQ3 = 48 * MiB, WS_SSQ4 = 50 * MiB, WS_META = 52 * MiB;
constexpr size_t MO_XMB = 0, MO_UM = 64 * 1024, MO_H1MB = 256 * 1024, MO_SSQM1 = 320 * 1024, MO_SSQM2 = 324 * 1024, MO_ZM = 384 * 1024, MO_PM = 512 * 1024;
constexpr size_t WS_XB = 56 * MiB, WS_BIG = 120 * MiB, WS_IMG = 274 * MiB, WS_P = 296 * MiB, WS_END = 507 * MiB;
constexpr int CW_BAR = 4096;
constexpr int RING_BYTES = 131072, LDSCTL_OFF = 143360, MISC_OFF = LDSCTL_OFF + 320, LDS_BYTES = 147456;

#define GAS __attribute__((address_space(1)))
#define LAS __attribute__((address_space(3)))
typedef unsigned short bf16;
typedef unsigned v4u __attribute__((ext_vector_type(4)));
typedef unsigned v2u __attribute__((ext_vector_type(2)));
typedef float f32x4 __attribute__((ext_vector_type(4)));
typedef float f32x2 __attribute__((ext_vector_type(2)));
typedef short bf16x8 __attribute__((ext_vector_type(8)));
typedef short bf16x4 __attribute__((ext_vector_type(4)));
typedef GAS unsigned gu32;
#define LDS_WAIT() asm volatile("s_waitcnt lgkmcnt(0)" ::: "memory")
__device__ __forceinline__ unsigned f2bf(float f) { unsigned u = __builtin_bit_cast(unsigned, f); return (u + 0x7fffu + ((u >> 16) & 1u)) >> 16; }
typedef __bf16 bf16x2_t __attribute__((ext_vector_type(2)));
__device__ __forceinline__ unsigned pk2m(float lo, float hi) { f32x2 v = {lo, hi}; bf16x2_t b = __builtin_convertvector(v, bf16x2_t); return __builtin_bit_cast(unsigned, b); }
__device__ __forceinline__ unsigned pk2(float lo, float hi) { return pg8::cvt_pk_bf16(lo, hi); }
__device__ __forceinline__ float bflo(unsigned w) { return __builtin_bit_cast(float, w << 16); }
__device__ __forceinline__ float bfhi(unsigned w) { return __builtin_bit_cast(float, w & 0xffff0000u); }
__device__ __forceinline__ f32x4 unpack4(v2u w) { return (f32x4){bflo(w.x), bfhi(w.x), bflo(w.y), bfhi(w.y)}; }
__device__ __forceinline__ float sigmoidf_(float x) { return __builtin_amdgcn_rcpf(1.0f + __builtin_amdgcn_exp2f(-1.4426950408889634f * x)); }
__device__ __forceinline__ float tanhf_(float x) { return 2.0f * sigmoidf_(2.0f * x) - 1.0f; }
#define XB_TMO      128
#define XB_XCNT(j)  (256  + 64 * (j))
#define XB_XSUB(j)  (1280 + 64 * (j))
#define XB_XGEN(j)  (2304 + 64 * (j))
#define XB_TOP      3328
#define XB_TOPGEN   3392
#define XCD_BAR_WORDS 3456
#define XB_SPIN_CAP (1u << 18)

__device__ __forceinline__ unsigned xb_ld(unsigned* p)              { return __hip_atomic_load(p, __ATOMIC_RELAXED, __HIP_MEMORY_SCOPE_AGENT); }
__device__ __forceinline__ unsigned xb_add(unsigned* p, unsigned v) { return __hip_atomic_fetch_add(p, v, __ATOMIC_RELAXED, __HIP_MEMORY_SCOPE_AGENT); }
__device__ __forceinline__ unsigned xb_xcc_id() { return (unsigned)__builtin_amdgcn_s_getreg((3 << 11) | 20) & 0xFu; }
#define XB_SPIN(cond, bar) do { unsigned _sp = 0; while (cond) { __builtin_amdgcn_s_sleep(1); \
    if ((++_sp & 255u) == 0u) { if (xb_ld(&(bar)[XB_TMO])) break; if (_sp > XB_SPIN_CAP) { atomicAdd(&(bar)[XB_TMO], 1u); break; } } } } while (0)

struct XcdBarrier {
    unsigned* bar; unsigned x;
    volatile LAS unsigned* st;
};

__device__ __forceinline__ XcdBarrier xcd_barrier_post(unsigned* bar, volatile LAS unsigned* st) {
    XcdBarrier b; b.bar = bar; b.x = xb_xcc_id(); b.st = st;
    if (threadIdx.x == 0) (void)xb_add(&bar[XB_XCNT(b.x)], 1u);
    return b;
}
__device__ __forceinline__ void xcd_barrier_complete(unsigned* bar, unsigned x, unsigned& nloc, unsigned& nx) {
    const unsigned G = gridDim.x * gridDim.y * gridDim.z;
    unsigned sum, cnt, mine, sp = 0u;
    for (;;) {
        sum = 0u; cnt = 0u; mine = 0u;
#pragma unroll
        for (unsigned j = 0; j < 16; ++j) { const unsigned c = xb_ld(&bar[XB_XCNT(j)]); sum += c; cnt += (c > 0u) ? 1u : 0u; mine = (j == x) ? c : mine; }
        if (sum == G) break;
        __builtin_amdgcn_s_sleep(1);
        if ((++sp & 255u) == 0u) { if (xb_ld(&bar[XB_TMO])) break; if (sp > XB_SPIN_CAP) { atomicAdd(&bar[XB_TMO], 1u); break; } }
    }
    nloc = mine > 0u ? mine : 1u; nx = cnt > 0u ? cnt : 1u;
}

__device__ __forceinline__ void xcd_barrier(const XcdBarrier& b) {
    asm volatile("s_waitcnt vmcnt(0)" ::: "memory");
    __syncthreads();
    if (threadIdx.x == 0) {
        unsigned* bar = b.bar;
        __builtin_amdgcn_s_waitcnt(0);
        unsigned nloc = b.st[0], nx = b.st[1];
        if (nloc == 0u) { xcd_barrier_complete(bar, b.x, nloc, nx); b.st[0] = nloc; b.st[1] = nx; }
        const unsigned old = xb_add(&bar[XB_XSUB(b.x)], 1u);
        const unsigned gen = old / nloc;
        if (old + 1u == (gen + 1u) * nloc) {
            __builtin_amdgcn_fence(__ATOMIC_RELEASE, "agent");
            asm volatile("s_waitcnt vmcnt(0)" ::: "memory");
            const unsigned og = xb_add(&bar[XB_TOP], 1u);
            const unsigned tg = og / nx;
            if (og + 1u == (tg + 1u) * nx) xb_add(&bar[XB_TOPGEN], 1u);
            else XB_SPIN(xb_ld(&bar[XB_TOPGEN]) == tg, bar);
            __builtin_amdgcn_fence(__ATOMIC_ACQUIRE, "agent");
            xb_add(&bar[XB_XGEN(b.x)], 1u);
            asm volatile("s_waitcnt vmcnt(0)" ::: "memory");
        } else {
            XB_SPIN(xb_ld(&bar[XB_XGEN(b.x)]) == gen, bar);
            __builtin_amdgcn_fence(__ATOMIC_ACQUIRE, "agent");
            asm volatile("s_waitcnt vmcnt(0)" ::: "memory");
        }
    }
    __syncthreads();
}
__device__ __forceinline__ float wave_sum(float v) {
#pragma unroll
    for (int o = 1; o < 64; o <<= 1) v += __shfl_xor(v, o);
    return v;
}
__device__ __forceinline__ void p0_transpose_item(const float* W, int K, int N, bf16* WT, const float* gain, int k0, int n0, int drow0, LAS float* scr, int lane) {
#pragma unroll
    for (int i = 0; i < 32; ++i) { const int kk = 2 * i + (lane >> 5); float w = W[(size_t)(k0 + kk) * N + n0 + (lane & 31)]; if (gain) w *= gain[k0 + kk]; scr[kk * 33 + (lane & 31)] = w; }
    LDS_WAIT(); asm volatile("" ::: "memory");
    const int c = lane & 7;
#pragma unroll
    for (int j = 0; j < 4; ++j) { const int n = (lane >> 3) + 8 * j; const LAS float* s = scr + (8 * c) * 33 + n;
        v4u o; o.x = pk2(s[0 * 33], s[1 * 33]); o.y = pk2(s[2 * 33], s[3 * 33]); o.z = pk2(s[4 * 33], s[5 * 33]); o.w = pk2(s[6 * 33], s[7 * 33]);
        *(GAS v4u*)(WT + (size_t)(drow0 + n) * K + k0 + 8 * c) = o; }
    LDS_WAIT(); asm volatile("" ::: "memory");
}
__device__ __forceinline__ void rows4_to_bf16(const float* const (&xrow)[4], bf16* const (&orow)[4], float* const (&ssq16)[4], int lane) {
    f32x4 v[4][4]; float s[4];
#pragma unroll
    for (int r = 0; r < 4; ++r) { const GAS f32x4* xr = (const GAS f32x4*)xrow[r] + lane;
#pragma unroll
        for (int j = 0; j < 4; ++j) v[r][j] = xr[64 * j]; }
#pragma unroll
    for (int r = 0; r < 4; ++r) { float a = 0.f;
#pragma unroll
        for (int j = 0; j < 4; ++j) a += (v[r][j].x * v[r][j].x + v[r][j].y * v[r][j].y) + (v[r][j].z * v[r][j].z + v[r][j].w * v[r][j].w);
        s[r] = a; }
#pragma unroll
    for (int o = 1; o < 64; o <<= 1) {
#pragma unroll
        for (int r = 0; r < 4; ++r) s[r] += __shfl_xor(s[r], o); }
#pragma unroll
    for (int r = 0; r < 4; ++r) { GAS v2u* o8 = (GAS v2u*)orow[r] + lane;
#pragma unroll
        for (int j = 0; j < 4; ++j) { v2u w; w.x = pk2(v[r][j].x, v[r][j].y); w.y = pk2(v[r][j].z, v[r][j].w); o8[64 * j] = w; }
        if (lane < 16) ssq16[r][lane] = (lane == 0) ? s[r] : 0.f; }
}
struct Ptrs {
    const float* in[27]; float* out; unsigned char* ws;
};
__device__ __forceinline__ void p0_transposes(const Ptrs& P, LAS unsigned char* lds, int part, int gw, int NGW, int wave, int lane) {
    unsigned char* ws = P.ws; LAS float* scr = (LAS float*)(lds + wave * 16384);
    constexpr int I_G = (DM / 64) * (FF / 32), I_D = (FF / 64) * (DM / 32), I_IN = (DM / 64) * (NIN / 32), I_O = (DM / 64) * (DM / 32);
    const int nitems = 2 * I_G + I_D + (part ? I_O : I_IN);
    for (int it = gw; it < nitems; it += NGW) {
        int r = it;
        if (r < 2 * I_G) { const int isup = r / I_G; r -= isup * I_G; const int nblk = FF / 32, kb = r / nblk, nb = r % nblk, n0 = 32 * nb;
            const float* W = P.in[part ? (isup ? 24 : 23) : (isup ? 4 : 3)]; const float* gain = P.in[part ? 22 : 2];
            bf16* WT = (bf16*)(ws + (part ? WS_WGU2 : WS_WGU1));
            const int drow0 = 256 * (n0 / 128) + 128 * isup + (n0 % 128);
            p0_transpose_item(W, DM, FF, WT, gain, 64 * kb, n0, drow0, scr, lane); continue; }
        r -= 2 * I_G;
        if (r < I_D) { const int nblk = DM / 32, kb = r / nblk, nb = r % nblk;
            p0_transpose_item(P.in[part ? 25 : 5], FF, DM, (bf16*)(ws + (part ? WS_WD2 : WS_WD1)), nullptr, 64 * kb, 32 * nb, 32 * nb, scr, lane); continue; }
        r -= I_D;
        if (!part) { const int nblk = NIN / 32, kb = r / nblk, nb = r % nblk;
            p0_transpose_item(P.in[7], DM, NIN, (bf16*)(ws + WS_WIN), P.in[6], 64 * kb, 32 * nb, 32 * nb, scr, lane); }
        else { const int nblk = DM / 32, kb = r / nblk, nb = r % nblk;
            p0_transpose_item(P.in[21], DM, DM, (bf16*)(ws + WS_WOUT), nullptr, 64 * kb, 32 * nb, 32 * nb, scr, lane); }
    }
}
__device__ __forceinline__ void p0_prologue(const Ptrs& P, LAS unsigned char* lds, int vcu, int G, int wave, int lane) {
    const int gw = vcu * NWAVES + wave, NGW = G * NWAVES;
    unsigned char* ws = P.ws;
    p0_transposes(P, lds, 0, gw, NGW, wave, lane);
    { GAS v4u* z = (GAS v4u*)(ws + WS_WIN + (size_t)NIN * DM * 2); const int n16 = (NINP - NIN) * DM * 2 / 16;
      for (int i = gw * 64 + lane; i < n16; i += NGW * 64) z[i] = (v4u){0u, 0u, 0u, 0u}; }
    { bf16* LT = (bf16*)(ws + WS_LT);
      for (int i = gw * 64 + lane; i < 512 * 160; i += NGW * 64) { const int n = i / 160, j = i % 160;
          const float v = j < 32 ? P.in[11][j * 512 + n] : j < 64 ? P.in[13][(j - 32) * 512 + n] : P.in[14][(j - 64) * 512 + n];
          LT[i] = (bf16)f2bf(v); } }
#ifndef REP_ROWS
#define REP_ROWS 1
#endif
    for (int rep_ = 0; rep_ < REP_ROWS; ++rep_)
    for (int m4 = gw; m4 < (MR + NMETA) / 4; m4 += NGW) { const float* xr[4]; bf16* orow[4]; float* sq[4];
#pragma unroll
        for (int r = 0; r < 4; ++r) { const int m = 4 * m4 + r;
            if (m < MR) { xr[r] = P.in[0] + (size_t)m * DM; orow[r] = (bf16*)(ws + WS_XB) + (size_t)m * DM; sq[r] = (float*)(ws + WS_SSQ1) + (size_t)m * 16; }
            else { const int i = m - MR; xr[r] = P.in[1] + (size_t)i * DM; orow[r] = (bf16*)(ws + WS_META + MO_XMB) + (size_t)i * DM; sq[r] = (float*)(ws + WS_META + MO_SSQM1) + i * 16; } }
        rows4_to_bf16(xr, orow, sq, lane); }
}
template <int NSTEP> __device__ __forceinline__ f32x4 skinny16_part(const bf16* A, const bf16* Bt, int K, int n0, int kb, int lane) {
    const int fr = lane & 15, fq = lane >> 4;
    const bf16* ap = A + (size_t)fr * K + kb + 8 * fq; const bf16* bp = Bt + (size_t)(n0 + fr) * K + kb + 8 * fq;
    bf16x8 a[NSTEP], b[NSTEP];
#pragma unroll
    for (int j = 0; j < NSTEP; ++j) { a[j] = *(const bf16x8*)(ap + 32 * j); b[j] = *(const bf16x8*)(bp + 32 * j); }
    f32x4 acc = (f32x4){0.f, 0.f, 0.f, 0.f};
#pragma unroll
    for (int j = 0; j < NSTEP; ++j) acc = __builtin_amdgcn_mfma_f32_16x16x32_bf16(a[j], b[j], acc, 0, 0, 0);
    return acc;
}
__device__ __forceinline__ f32x4 red8(const LAS f32x4* red, int which, int lane) { f32x4 s = red[(0 * 2 + which) * 64 + lane];
#pragma unroll
    for (int w = 1; w < 8; ++w) s += red[(w * 2 + which) * 64 + lane];
    return s; }
__device__ __forceinline__ float rstd_m16(const float* ssq16) { float s = 0.f;
#pragma unroll
    for (int i = 0; i < 16; ++i) s += ssq16[i];
    return __builtin_amdgcn_rsqf(s * (1.0f / 1024.0f) + 1e-5f); }
__device__ __forceinline__ void meta_up(unsigned char* ws, LAS unsigned char* lds, int bx, int G, int wave, int lane) {
    const bf16* A = (const bf16*)(ws + WS_META + MO_XMB); const bf16* Bt = (const bf16*)(ws + WS_WGU1); bf16* Um = (bf16*)(ws + WS_META + MO_UM);
    const float* ssq = (const float*)(ws + WS_META + MO_SSQM1); const int fr = lane & 15, fq = lane >> 4; LAS f32x4* red = (LAS f32x4*)lds;
    for (int t0 = 0; t0 < FF / 16; t0 += G) { const int t = t0 + bx; const bool on = t < FF / 16; const int c0 = 16 * t, nr = 256 * (c0 / 128) + (c0 % 128);
        if (on) { red[(wave * 2 + 0) * 64 + lane] = skinny16_part<4>(A, Bt, DM, nr, 128 * wave, lane); red[(wave * 2 + 1) * 64 + lane] = skinny16_part<4>(A, Bt, DM, nr + 128, 128 * wave, lane); }
        __syncthreads();
        if (on && wave == 0) { const f32x4 g = red8(red, 0, lane), u = red8(red, 1, lane);
#pragma unroll
            for (int r = 0; r < 4; ++r) { const int row = 4 * fq + r; const float rs = rstd_m16(ssq + row * 16); Um[(size_t)row * FF + c0 + fr] = (bf16)f2bf(pg8::silu_mul(g[r] * rs, u[r] * rs)); } }
        __syncthreads(); }
}
__device__ __forceinline__ void meta_down(const Ptrs& P, LAS unsigned char* lds, int bx, int G, int wave, int lane) {
    unsigned char* ws = P.ws; const bf16* A = (const bf16*)(ws + WS_META + MO_UM); const bf16* Bt = (const bf16*)(ws + WS_WD1); bf16* H = (bf16*)(ws + WS_META + MO_H1MB);
    float* ssq = (float*)(ws + WS_META + MO_SSQM2); const int fr = lane & 15, fq = lane >> 4; LAS f32x4* red = (LAS f32x4*)lds;
    for (int t0 = 0; t0 < DM / 16; t0 += G) { const int t = t0 + bx; const bool on = t < DM / 16;
        if (on) red[(wave * 2 + 0) * 64 + lane] = skinny16_part<11>(A, Bt, FF, 16 * t, 352 * wave, lane);
        __syncthreads();
        if (on && wave == 0) { const f32x4 a = red8(red, 0, lane);
#pragma unroll
            for (int r = 0; r < 4; ++r) { const int row = 4 * fq + r; const float o = P.in[1][row * DM + 16 * t + fr] + 0.5f * a[r]; H[row * DM + 16 * t + fr] = (bf16)f2bf(o);
                float s = o * o; s += __shfl_xor(s, 1); s += __shfl_xor(s, 2); s += __shfl_xor(s, 4); s += __shfl_xor(s, 8); if (fr == 0) ssq[row * 64 + t] = s; } }
        __syncthreads(); }
}
__device__ __forceinline__ void meta_win(const Ptrs& P, LAS unsigned char* lds, int bx, int G, int wave, int lane) {
    unsigned char* ws = P.ws; const bf16* A = (const bf16*)(ws + WS_META + MO_H1MB); const bf16* Bt = (const bf16*)(ws + WS_WIN); bf16* Zm = (bf16*)(ws + WS_META + MO_ZM);
    const float* ssq = (const float*)(ws + WS_META + MO_SSQM2); const int fr = lane & 15, fq = lane >> 4; LAS f32x4* red = (LAS f32x4*)lds;
    for (int t0 = 0; t0 < NIN / 16; t0 += G) { const int t = t0 + bx; const bool on = t < NIN / 16;
        if (on) red[(wave * 2 + 0) * 64 + lane] = skinny16_part<4>(A, Bt, DM, 16 * t, 128 * wave, lane);
        __syncthreads();
        if (on && wave == 0) { const f32x4 a = red8(red, 0, lane); const int c = 16 * t + fr; const float bias = c >= ZC_Q ? P.in[8][c - ZC_Q] : 0.f;
#pragma unroll
            for (int r = 0; r < 4; ++r) { const int row = 4 * fq + r; float s = 0.f;
#pragma unroll 8
                for (int i = 0; i < 64; ++i) s += ssq[row * 64 + i];
                Zm[(size_t)row * NIN + c] = (bf16)f2bf(a[r] * __builtin_amdgcn_rsqf(s * (1.0f / 1024.0f) + 1e-5f) + bias); } }
        __syncthreads(); }
}
constexpr int KS_LD = 72, VT_LD = 232, ATT_KS_BYTES = 208 * KS_LD * 2, ATT_VT_BYTES = 64 * VT_LD * 2;
__device__ __forceinline__ void attn_unit(const Ptrs& P, unsigned char* lds, int b, int g, int c, int tid, int wave, int lane) {
    unsigned char* ws = P.ws; const bf16* Z = (const bf16*)(ws + WS_BIG); const bf16* Zm = (const bf16*)(ws + WS_META + MO_ZM); bf16* Y = (bf16*)(ws + WS_XB);
    bf16* Ks = (bf16*)lds; bf16* Vt = (bf16*)(lds + ATT_KS_BYTES);
    const int fr = lane & 15, fq = lane >> 4;
    __syncthreads();
    for (int it = tid; it < 208 * 8; it += NWAVES * 64) { const int key = it >> 3, pc = it & 7; const bf16* src; bool valid = true;
        if (key < 16) src = Zm + (size_t)key * NIN; else { const int t = 64 * (c - 2) + (key - 16); valid = t >= 0; src = Z + ((size_t)b * TSEQ + (valid ? t : 0)) * NIN; }
        v4u kq = *(const v4u*)(src + ZC_K + 64 * g + 8 * pc), vq = *(const v4u*)(src + ZC_V + 64 * g + 8 * pc);
        if (!valid) { kq = (v4u){0u, 0u, 0u, 0u}; vq = kq; }
        *(v4u*)(Ks + key * KS_LD + 8 * pc) = kq;
#pragma unroll
        for (int e = 0; e < 4; ++e) { Vt[(8 * pc + 2 * e) * VT_LD + key] = (bf16)(vq[e] & 0xffffu); Vt[(8 * pc + 2 * e + 1) * VT_LD + key] = (bf16)(vq[e] >> 16); } }
    for (int it = tid; it < 64 * 16; it += NWAVES * 64) Vt[(it >> 4) * VT_LD + 208 + (it & 15)] = 0;
    __syncthreads();
    const int hq = 4 * g + (wave >> 1);
    const float slope = __builtin_amdgcn_exp2f(-(float)(hq + 1)), sink = P.in[20][hq];
#pragma unroll 1
    for (int sub = 0; sub < 2; ++sub) {
        const int i0 = 16 * (2 * (wave & 1) + sub), iq = i0 + fr;
        const size_t mrow = (size_t)b * TSEQ + 64 * c + iq;
        const bf16x8 q0 = *(const bf16x8*)(Z + mrow * NIN + ZC_Q + 64 * hq + 8 * fq), q1 = *(const bf16x8*)(Z + mrow * NIN + ZC_Q + 64 * hq + 32 + 8 * fq);
        f32x4 s[13]; float mx = sink;
#pragma unroll
        for (int kt = 0; kt < 13; ++kt) { const bf16* kp = Ks + (16 * kt + fr) * KS_LD + 8 * fq; f32x4 a = (f32x4){0.f, 0.f, 0.f, 0.f};
            a = __builtin_amdgcn_mfma_f32_16x16x32_bf16(*(const bf16x8*)(kp), q0, a, 0, 0, 0);
            a = __builtin_amdgcn_mfma_f32_16x16x32_bf16(*(const bf16x8*)(kp + 32), q1, a, 0, 0, 0);
#pragma unroll
            for (int r = 0; r < 4; ++r) { const int key = 16 * kt + 4 * fq + r; float v;
                if (kt == 0) v = a[r] * 0.125f - slope * (float)(16 + 64 * c + iq - key);
                else { const int jj = key - 16; const int d = 128 + iq - jj; v = a[r] * 0.125f - slope * (float)(d < 0 ? -d : d); if (64 * (c - 2) + jj < 0) v = -1e30f; }
                a[r] = v; mx = fmaxf(mx, v); }
            s[kt] = a; }
        mx = fmaxf(mx, __shfl_xor(mx, 16)); mx = fmaxf(mx, __shfl_xor(mx, 32));
        float sum = 0.f;
#pragma unroll
        for (int kt = 0; kt < 13; ++kt)
#pragma unroll
            for (int r = 0; r < 4; ++r) { const float p = __builtin_amdgcn_exp2f((s[kt][r] - mx) * 1.4426950408889634f); s[kt][r] = p; sum += p; }
        sum += __shfl_xor(sum, 16); sum += __shfl_xor(sum, 32);
        sum += __builtin_amdgcn_exp2f((sink - mx) * 1.4426950408889634f);
        const float rinv = 1.0f / sum;
        f32x4 o[4];
#pragma unroll
        for (int dt = 0; dt < 4; ++dt) o[dt] = (f32x4){0.f, 0.f, 0.f, 0.f};
#pragma unroll
        for (int ks = 0; ks < 7; ++ks) { const int ta = 2 * ks, tb = 2 * ks + 1; v4u pw;
            pw.x = pk2(s[ta][0], s[ta][1]); pw.y = pk2(s[ta][2], s[ta][3]);
            if (tb < 13) { pw.z = pk2(s[tb][0], s[tb][1]); pw.w = pk2(s[tb][2], s[tb][3]); } else { pw.z = 0u; pw.w = 0u; }
            const bf16x8 pf = __builtin_bit_cast(bf16x8, pw);
#pragma unroll
            for (int dt = 0; dt < 4; ++dt) { const bf16* vp = Vt + (16 * dt + fr) * VT_LD + 4 * fq; const v2u va = *(const v2u*)(vp + 16 * ta), vb = *(const v2u*)(vp + 16 * tb);
                const v4u vv = (v4u){va.x, va.y, vb.x, vb.y};
                o[dt] = __builtin_amdgcn_mfma_f32_16x16x32_bf16(__builtin_bit_cast(bf16x8, vv), pf, o[dt], 0, 0, 0); } }
#pragma unroll
        for (int dt = 0; dt < 4; ++dt) { v2u w; w.x = pk2(o[dt][0] * rinv, o[dt][1] * rinv); w.y = pk2(o[dt][2] * rinv, o[dt][3] * rinv);
            *(v2u*)(Y + mrow * DM + 512 + 64 * hq + 16 * dt + 4 * fq) = w; }
    }
}
template <int CTRL> __device__ __forceinline__ float dppf(float x) { return __builtin_bit_cast(float, __builtin_amdgcn_update_dpp(0, __builtin_bit_cast(int, x), CTRL, 0xF, 0xF, true)); }
template <int CTRL> __device__ __forceinline__ float dppf_old(float old, float x) { return __builtin_bit_cast(float, __builtin_amdgcn_update_dpp(__builtin_bit_cast(int, old), __builtin_bit_cast(int, x), CTRL, 0xF, 0xF, false)); }
__device__ __forceinline__ float red8(float x) { x += dppf<0xB1>(x); x += dppf<0x4E>(x); x += dppf<0x141>(x); return x; }
__device__ __forceinline__ float red16(float x) { x = red8(x); x += dppf<0x140>(x); return x; }
__device__ __forceinline__ float scan16(float x) { x += dppf<0x111>(x); x += dppf<0x112>(x); x += dppf<0x114>(x); x += dppf<0x118>(x); return x; }
constexpr int NCHUNK = 257, NSUPER = 65;
constexpr int CB_A = 0, CB_R = 2048, CB_BK = 4096, CB_VT = 8192, CB_TT = 10240, CB_AR = 11264, CB_G = 12288, CB_BON = 12544, CB_SIZE = 12800;
constexpr int CB_GATE = 12800, IMG_SIZE = 14848;
constexpr int WL_HS = IMG_SIZE, WL_SIZE = IMG_SIZE + 2048;
constexpr int SC_YB = 8 * CB_SIZE, SC_END = SC_YB + 8 * 4096, SC_CST = 768;
static_assert(8 * WL_SIZE <= LDSCTL_OFF && SC_END + SC_CST <= LDSCTL_OFF, "LDS map");
__device__ __forceinline__ bf16x8 pack8(const float* v) { v4u o; o.x = pk2(v[0], v[1]); o.y = pk2(v[2], v[3]); o.z = pk2(v[4], v[5]); o.w = pk2(v[6], v[7]); return __builtin_bit_cast(bf16x8, o); }
__device__ __forceinline__ void unpack8(v4u w, float* v) { v[0] = bflo(w.x); v[1] = bfhi(w.x); v[2] = bflo(w.y); v[3] = bfhi(w.y); v[4] = bflo(w.z); v[5] = bfhi(w.z); v[6] = bflo(w.w); v[7] = bfhi(w.w); }


__device__ __forceinline__ void chunk_task(const Ptrs& P, unsigned char* ldsb, int woff, int b, int h, int ch, int lane) {
    int wo_ = woff; asm volatile("" : "+v"(wo_));
    unsigned char* wl = ldsb + wo_;
    unsigned char* ws = P.ws; const int fr = lane & 15, fq = lane >> 4, t = fr;
    const bf16* Z = (const bf16*)(ws + WS_BIG); const bf16* Zm = (const bf16*)(ws + WS_META + MO_ZM); const bf16* LT = (const bf16*)(ws + WS_LT);
    const bool meta = (ch == 0);
    const int tok = 16 * (ch - 1) + fr; const size_t m = (size_t)b * TSEQ + tok;
    const bf16* zc = meta ? Zm + (size_t)fr * NIN : Z + m * NIN;
    const bool pz = meta && fr == 0;
    const bf16* zp = meta ? Zm + (size_t)(fr > 0 ? fr - 1 : 0) * NIN : (tok == 0 ? Zm + (size_t)15 * NIN : Z + (m - 1) * NIN);
    const float* mu = P.in[9];
    bf16* sx = (bf16*)wl;
    {
    bf16x8 xf[5];
#pragma unroll
    for (int ks = 0; ks < 5; ++ks) { const int c0 = ZC_W + 32 * ks + 8 * fq; const v4u a = *(const v4u*)(zc + c0); v4u bq = *(const v4u*)(zp + c0); if (pz) bq = (v4u){0u, 0u, 0u, 0u};
        float va[8], vb[8], v[8]; unpack8(a, va); unpack8(bq, vb); const f32x4 m0 = *(const f32x4*)(mu + c0), m1 = *(const f32x4*)(mu + c0 + 4);
#pragma unroll
        for (int e = 0; e < 8; ++e) { const float mm = e < 4 ? m0[e & 3] : m1[e & 3]; const float z = va[e] + (vb[e] - va[e]) * mm; v[e] = (ks == 0) ? tanhf_(z) : (ks == 1) ? z : sigmoidf_(z); }
        xf[ks] = pack8(v); }
    f32x4 aw[4], aa[4], ag[4];
#pragma unroll
    for (int nt = 0; nt < 4; ++nt) { const bf16* lp = LT + (size_t)(h * 64 + 16 * nt + fr) * 160 + 8 * fq; const f32x4 z = (f32x4){0.f, 0.f, 0.f, 0.f};
        aw[nt] = __builtin_amdgcn_mfma_f32_16x16x32_bf16(*(const bf16x8*)(lp), xf[0], z, 0, 0, 0);
        aa[nt] = __builtin_amdgcn_mfma_f32_16x16x32_bf16(*(const bf16x8*)(lp + 32), xf[1], z, 0, 0, 0);
        ag[nt] = __builtin_amdgcn_mfma_f32_16x16x32_bf16(*(const bf16x8*)(lp + 64), xf[2], z, 0, 0, 0);
        ag[nt] = __builtin_amdgcn_mfma_f32_16x16x32_bf16(*(const bf16x8*)(lp + 96), xf[3], ag[nt], 0, 0, 0);
        ag[nt] = __builtin_amdgcn_mfma_f32_16x16x32_bf16(*(const bf16x8*)(lp + 128), xf[4], ag[nt], 0, 0, 0); }
    f32x4 kkr[4], kv[4], av[4]; float ss = 0.f;
#pragma unroll
    for (int nt = 0; nt < 4; ++nt) { const int c = h * 64 + 16 * nt + 4 * fq; const v2u a = *(const v2u*)(zc + 512 + c); v2u bq = *(const v2u*)(zp + 512 + c); if (pz) bq = (v2u){0u, 0u};
        const f32x4 za = unpack4(a), zb = unpack4(bq), mk = *(const f32x4*)(mu + 512 + c); const f32x4 zk = za + (zb - za) * mk;
        const f32x4 a0 = *(const f32x4*)(P.in[12] + c), kkw = *(const f32x4*)(P.in[15] + c), kaw = *(const f32x4*)(P.in[16] + c);
        f32x4 a_;
#pragma unroll
        for (int r = 0; r < 4; ++r) a_[r] = sigmoidf_(a0[r] + aa[nt][r]);
        av[nt] = a_; kkr[nt] = zk * kkw; kv[nt] = zk * (1.0f + (a_ - 1.0f) * kaw);
        ss += (kkr[nt][0] * kkr[nt][0] + kkr[nt][1] * kkr[nt][1]) + (kkr[nt][2] * kkr[nt][2] + kkr[nt][3] * kkr[nt][3]); }
    ss += __shfl_xor(ss, 16); ss += __shfl_xor(ss, 32);
    const float inv = 1.0f / fmaxf(sqrtf(ss), 1e-12f);
#pragma unroll
    for (int nt = 0; nt < 4; ++nt) { const int cl = 16 * nt + 4 * fq, c = h * 64 + cl; const f32x4 w0 = *(const f32x4*)(P.in[10] + c);
        const f32x4 kk = kkr[nt] * inv, bb = kk * av[nt]; f32x4 e;
#pragma unroll
        for (int r = 0; r < 4; ++r) e[r] = 0.6065306597126334f * sigmoidf_(w0[r] + aw[nt][r]);
        bf16* px = sx + t * 64 + cl; v2u o;
        o.x = pk2(kk[0], kk[1]); o.y = pk2(kk[2], kk[3]); *(v2u*)(px) = o;
        o.x = pk2(e[0], e[1]); o.y = pk2(e[2], e[3]); *(v2u*)(px + 1024) = o;
        o.x = pk2(bb[0], bb[1]); o.y = pk2(bb[2], bb[3]); *(v2u*)(px + 2048) = o;
        o.x = pk2(kv[nt][0], kv[nt][1]); o.y = pk2(kv[nt][2], kv[nt][3]); *(v2u*)(px + 3072) = o;
        o.x = pk2m(ag[nt][0], ag[nt][1]); o.y = pk2m(ag[nt][2], ag[nt][3]); *(v2u*)(px + 4096) = o; }
    }
    asm volatile("s_waitcnt lgkmcnt(0)" ::: "memory"); __builtin_amdgcn_sched_barrier(0);
    v4u xk[2], xe[2], xb[2], xx[2], xg[2];
#pragma unroll
    for (int ks = 0; ks < 2; ++ks) { const bf16* px = sx + t * 64 + 32 * ks + 8 * fq; xk[ks] = *(const v4u*)(px); xe[ks] = *(const v4u*)(px + 1024); xb[ks] = *(const v4u*)(px + 2048); xx[ks] = *(const v4u*)(px + 3072); xg[ks] = *(const v4u*)(px + 4096); }
    asm volatile("s_waitcnt lgkmcnt(0)" ::: "memory"); __builtin_amdgcn_sched_barrier(0);
    unsigned char* cb = wl; float* hs = (float*)(wl + WL_HS);
    const int cbase = h * 64 + 8 * fq;
    unsigned char* pbk = cb + CB_BK + ((((fq >> 1) * 4 + (t >> 2)) * 16 + 8 * (fq & 1)) * 8 + (t & 3)) * 2;
    unsigned char* pvt = cb + CB_VT + (((fq >> 1) * 4 + (t >> 2)) * 16 + 8 * (fq & 1)) * 8 + (t & 3) * 2;
    unsigned char* pgc = cb + CB_G + 8 * fq * 4;
    bf16x8 Af[2], Rf[2], Bf[2], Kf[2]; float bonp = 0.f;
#pragma unroll
    for (int ks = 0; ks < 2; ++ks) { const int c = cbase + 32 * ks, cl = 32 * ks + 8 * fq;
        asm volatile("" ::: "memory"); __builtin_amdgcn_sched_barrier(0);
        float kk[8], e_[8], bb[8], kx[8], rc[8], rp[8], vc[8], vp[8];
        unpack8(xk[ks], kk); unpack8(xe[ks], e_); unpack8(xb[ks], bb); unpack8(xx[ks], kx);
        unpack8(*(const v4u*)(zc + c), rc); unpack8(*(const v4u*)(zc + 1024 + c), vc);
        { v4u a = *(const v4u*)(zp + c), d = *(const v4u*)(zp + 1024 + c); if (pz) { a = (v4u){0u, 0u, 0u, 0u}; d = a; } unpack8(a, rp); unpack8(d, vp); }
        float At[8], Rt[8], Bt[8], Kt[8]; float mur[8], muv[8], rkk[8];
        { const f32x4 a0 = *(const f32x4*)(P.in[9] + c), a1 = *(const f32x4*)(P.in[9] + c + 4), b0 = *(const f32x4*)(P.in[9] + 1024 + c), b1 = *(const f32x4*)(P.in[9] + 1024 + c + 4), c0 = *(const f32x4*)(P.in[17] + c), c1 = *(const f32x4*)(P.in[17] + c + 4);
#pragma unroll
          for (int e = 0; e < 4; ++e) { mur[e] = a0[e]; mur[4 + e] = a1[e]; muv[e] = b0[e]; muv[4 + e] = b1[e]; rkk[e] = c0[e]; rkk[4 + e] = c1[e]; } }
#pragma unroll
        for (int e = 0; e < 8; ++e) { const float rr = rc[e] + (rp[e] - rc[e]) * mur[e]; const float vv = vc[e] + (vp[e] - vc[e]) * muv[e];
            bonp += rr * kx[e] * rkk[e];
            const float ec = scan16(e_[e]), etot = red16(e_[e]);
            const float g1 = __builtin_amdgcn_exp2f(-1.4426950408889634f * ec);
            const float gi = __builtin_amdgcn_exp2f(1.4426950408889634f * ec);
            const float gC = __builtin_amdgcn_exp2f(-1.4426950408889634f * etot);
            const float g0 = dppf_old<0x111>(1.0f, g1);
            At[e] = -kk[e] * g0; Rt[e] = rr * g1; Bt[e] = bb[e] * gi; Kt[e] = kx[e] * gi;
            const int ke = 32 * ks + e;
            *(bf16*)(pbk + ks * 2048 + e * 16) = (bf16)f2bf(Bt[e] * gC);
            *(bf16*)(pbk + ks * 2048 + e * 16 + 8) = (bf16)f2bf(Kt[e] * gC);
            *(bf16*)(pvt + ks * 1024 + e * 8) = (bf16)f2bf(vv);
            if (t == 15) *(float*)(pgc + ke * 4) = gC; }
        Af[ks] = pack8(At); Rf[ks] = pack8(Rt); Bf[ks] = pack8(Bt); Kf[ks] = pack8(Kt);
        { const int fqs = 2 * (fq & 1), bo = (fq >> 1) * 8; const v4u aw = __builtin_bit_cast(v4u, Af[ks]), rw = __builtin_bit_cast(v4u, Rf[ks]);
          *(v2u*)(cb + CB_A + ((ks * 4 + fqs) * 16 + t) * 16 + bo) = (v2u){aw.x, aw.y}; *(v2u*)(cb + CB_A + ((ks * 4 + fqs + 1) * 16 + t) * 16 + bo) = (v2u){aw.z, aw.w};
          *(v2u*)(cb + CB_R + ((ks * 4 + fqs) * 16 + t) * 16 + bo) = (v2u){rw.x, rw.y}; *(v2u*)(cb + CB_R + ((ks * 4 + fqs + 1) * 16 + t) * 16 + bo) = (v2u){rw.z, rw.w}; }
        *(v4u*)(cb + CB_GATE + (t * 64 + cl) * 2) = xg[ks]; }
    asm volatile("" ::: "memory"); __builtin_amdgcn_sched_barrier(0);
    bonp += __shfl_xor(bonp, 16); bonp += __shfl_xor(bonp, 32);
    if (fq == 0) *(float*)(cb + CB_BON + t * 4) = bonp;
    const f32x4 z4 = (f32x4){0.f, 0.f, 0.f, 0.f};
    f32x4 Mab = __builtin_amdgcn_mfma_f32_16x16x32_bf16(Af[0], Bf[0], z4, 0, 0, 0); Mab = __builtin_amdgcn_mfma_f32_16x16x32_bf16(Af[1], Bf[1], Mab, 0, 0, 0);
    f32x4 Mak = __builtin_amdgcn_mfma_f32_16x16x32_bf16(Af[0], Kf[0], z4, 0, 0, 0); Mak = __builtin_amdgcn_mfma_f32_16x16x32_bf16(Af[1], Kf[1], Mak, 0, 0, 0);
    f32x4 Mrb = __builtin_amdgcn_mfma_f32_16x16x32_bf16(Rf[0], Bf[0], z4, 0, 0, 0); Mrb = __builtin_amdgcn_mfma_f32_16x16x32_bf16(Rf[1], Bf[1], Mrb, 0, 0, 0);
    f32x4 Mrk = __builtin_amdgcn_mfma_f32_16x16x32_bf16(Rf[0], Kf[0], z4, 0, 0, 0); Mrk = __builtin_amdgcn_mfma_f32_16x16x32_bf16(Rf[1], Kf[1], Mrk, 0, 0, 0);
#pragma unroll
    for (int r = 0; r < 4; ++r) { const int tt = 4 * fq + r, i = fr;
        const float mab = (tt > i) ? Mab[r] : 0.f, mak = (tt > i) ? Mak[r] : 0.f, mrb = (tt >= i) ? Mrb[r] : 0.f, mrk = (tt >= i) ? Mrk[r] : 0.f;
        hs[tt * 16 + i] = mab; hs[256 + tt * 16 + i] = mak;
        const unsigned w = pk2m(mrb, mrk);
        *(bf16*)(cb + CB_AR + (((i >> 2) * 16 + tt) * 8 + (i & 3)) * 2) = (bf16)(w & 0xffffu);
        *(bf16*)(cb + CB_AR + (((i >> 2) * 16 + tt) * 8 + 4 + (i & 3)) * 2) = (bf16)(w >> 16); }
    asm volatile("s_waitcnt lgkmcnt(0)" ::: "memory");
    { const int c = lane & 31, cc = c & 15; const bool isT = c < 16; float out[16];
#pragma unroll
      for (int tt = 0; tt < 16; ++tt) { float acc = isT ? (tt == cc ? 1.0f : 0.0f) : hs[256 + tt * 16 + cc];
#pragma unroll
          for (int i4 = 0; i4 < (tt + 3) / 4; ++i4) { const f32x4 l = *(const f32x4*)(hs + tt * 16 + 4 * i4);
#pragma unroll
              for (int e = 0; e < 4; ++e) if (4 * i4 + e < tt) acc += l[e] * out[4 * i4 + e]; }
          out[tt] = acc;
          if (lane < 32) *(bf16*)(cb + CB_TT + (((cc >> 2) * 16 + tt) * 8 + (isT ? 0 : 4) + (cc & 3)) * 2) = (bf16)f2bf(acc); } }
    asm volatile("s_waitcnt lgkmcnt(0)" ::: "memory");
    { unsigned char* gi = ws + WS_IMG + ((size_t)(b * NHEAD + h) * NCHUNK + ch) * IMG_SIZE;
      for (int i = lane; i < IMG_SIZE / 16; i += 64) *(v4u*)(gi + i * 16) = *(const v4u*)(cb + i * 16); }
    asm volatile("s_waitcnt lgkmcnt(0)" ::: "memory"); __builtin_amdgcn_sched_barrier(0);
}

struct ScanOps { bf16x8 a0, a1, r0, r1, tt, ar, bk[4]; v2u vt; f32x4 g[4]; };
__device__ __forceinline__ void scan_load(ScanOps& o, const unsigned char* ib, int fr, int fq, int vcol) {
    const int ln = (fq * 16 + fr) * 16;
    o.a0 = *(const bf16x8*)(ib + CB_A + ln); o.a1 = *(const bf16x8*)(ib + CB_A + 1024 + ln);
    o.r0 = *(const bf16x8*)(ib + CB_R + ln); o.r1 = *(const bf16x8*)(ib + CB_R + 1024 + ln);
    o.tt = *(const bf16x8*)(ib + CB_TT + ln); o.ar = *(const bf16x8*)(ib + CB_AR + ln);
    o.vt = *(const v2u*)(ib + CB_VT + (((vcol >> 4) * 4 + fq) * 16 + fr) * 8);
#pragma unroll
    for (int kt = 0; kt < 4; ++kt) { o.g[kt] = *(const f32x4*)(ib + CB_G + (16 * kt + 4 * fq) * 4); o.bk[kt] = *(const bf16x8*)(ib + CB_BK + kt * 1024 + ln); }
}
__device__ __forceinline__ void scan_step(f32x4 (&H)[4], const ScanOps& o, float* yb, int fq, int vcol) {
    v4u hb0, hb1;
    hb0.x = pk2m(H[0][0], H[0][1]); hb0.y = pk2m(H[0][2], H[0][3]); hb0.z = pk2m(H[1][0], H[1][1]); hb0.w = pk2m(H[1][2], H[1][3]);
    hb1.x = pk2m(H[2][0], H[2][1]); hb1.y = pk2m(H[2][2], H[2][3]); hb1.z = pk2m(H[3][0], H[3][1]); hb1.w = pk2m(H[3][2], H[3][3]);
    const bf16x8 h0 = __builtin_bit_cast(bf16x8, hb0), h1 = __builtin_bit_cast(bf16x8, hb1);
    const f32x4 z4 = (f32x4){0.f, 0.f, 0.f, 0.f};
    f32x4 X = __builtin_amdgcn_mfma_f32_16x16x32_bf16(o.a0, h0, z4, 0, 0, 0); X = __builtin_amdgcn_mfma_f32_16x16x32_bf16(o.a1, h1, X, 0, 0, 0);
    f32x4 Y = __builtin_amdgcn_mfma_f32_16x16x32_bf16(o.r0, h0, z4, 0, 0, 0); Y = __builtin_amdgcn_mfma_f32_16x16x32_bf16(o.r1, h1, Y, 0, 0, 0);
    v4u xb; xb.x = pk2m(X[0], X[1]); xb.y = pk2m(X[2], X[3]); xb.z = o.vt.x; xb.w = o.vt.y;
    const f32x4 U = __builtin_amdgcn_mfma_f32_16x16x32_bf16(o.tt, __builtin_bit_cast(bf16x8, xb), z4, 0, 0, 0);
    v4u ub; ub.x = pk2m(U[0], U[1]); ub.y = pk2m(U[2], U[3]); ub.z = o.vt.x; ub.w = o.vt.y;
    const bf16x8 uf = __builtin_bit_cast(bf16x8, ub);
    Y = __builtin_amdgcn_mfma_f32_16x16x32_bf16(o.ar, uf, Y, 0, 0, 0);
#pragma unroll
    for (int kt = 0; kt < 4; ++kt) H[kt] = __builtin_amdgcn_mfma_f32_16x16x32_bf16(o.bk[kt], uf, H[kt] * o.g[kt], 0, 0, 0);
#pragma unroll
    for (int r = 0; r < 4; ++r) yb[(4 * fq + r) * 64 + vcol] = Y[r];
}
__device__ __forceinline__ void scan_phase(const Ptrs& P, unsigned char* lds, int sb, int tid, int wave, int lane, int never) {
    const int b = sb >> 3, h = sb & 7, fr = lane & 15, fq = lane >> 4;
    const unsigned char* img = P.ws + WS_IMG + (size_t)(b * NHEAD + h) * NCHUNK * IMG_SIZE;
    if (wave < 4) {
        f32x4 H[4];
#pragma unroll
        for (int kt = 0; kt < 4; ++kt) H[kt] = (f32x4){0.f, 0.f, 0.f, 0.f};
        const int vcol = 16 * wave + fr;
#pragma unroll 1
        for (int s = 0; s <= NSUPER + 1; ++s) {
            __syncthreads();
            if (s < 1 || s > NSUPER) continue;
            const int set = (s - 1) & 1;
#pragma unroll 1
            for (int j = 0; j < 4; ++j) { const int ch = 4 * (s - 1) + j; if (ch >= NCHUNK) break;
                ScanOps o; scan_load(o, lds + (set * 4 + j) * CB_SIZE, fr, fq, vcol);
                scan_step(H, o, (float*)(lds + SC_YB + (set * 4 + j) * 4096), fq, vcol); }
        }
    } else {
        const int hw = wave - 4, t = fr;
        const bf16* Z = (const bf16*)(P.ws + WS_BIG); const bf16* Zm = (const bf16*)(P.ws + WS_META + MO_ZM);
        bf16* Yo = (bf16*)(P.ws + WS_XB);
        const int cbase = h * 64 + 8 * fq;
        float* cst = (float*)(lds + SC_END);
        if (lane < 48) { const int a_ = lane >> 4, c4 = (lane & 15) * 4; const float* src = a_ == 0 ? P.in[9] + 1024 + h * 64 : a_ == 1 ? P.in[18] + h * 64 : P.in[19] + h * 64;
            *(f32x4*)(cst + a_ * 64 + c4) = *(const f32x4*)(src + c4); }
        v4u cg0[2], cg1[2]; v4u im0[13], im1[13];
        const int pvt_off = CB_VT + (((fq >> 1) * 4 + (t >> 2)) * 16 + 8 * (fq & 1)) * 8 + (t & 3) * 2;
#define GLD16(dst, ptr) asm volatile("global_load_dwordx4 %0, %1, off" : "=v"(dst) : "v"(ptr) : "memory")
#define GLD4(dst, ptr) asm volatile("global_load_dword %0, %1, off" : "=v"(dst) : "v"(ptr) : "memory")
#define IMG_LOAD(IM, chx) do { const unsigned char* ip_ = img + (size_t)(chx) * IMG_SIZE + lane * 16; _Pragma("unroll") for (int i_ = 0; i_ < 13; ++i_) GLD16(IM[i_], ip_ + i_ * 1024); } while (0)
#define VM_WAIT_ALL(N) asm volatile("s_waitcnt vmcnt(" #N ")" : "+v"(im0[0]), "+v"(im0[1]), "+v"(im0[2]), "+v"(im0[3]), "+v"(im0[4]), "+v"(im0[5]), "+v"(im0[6]), "+v"(im0[7]), "+v"(im0[8]), "+v"(im0[9]), "+v"(im0[10]), "+v"(im0[11]), "+v"(im0[12]), \
            "+v"(im1[0]), "+v"(im1[1]), "+v"(im1[2]), "+v"(im1[3]), "+v"(im1[4]), "+v"(im1[5]), "+v"(im1[6]), "+v"(im1[7]), "+v"(im1[8]), "+v"(im1[9]), "+v"(im1[10]), "+v"(im1[11]), "+v"(im1[12]) :: "memory")
#define VM_WAIT_POST(N) asm volatile("s_waitcnt vmcnt(" #N ")" : "+v"(cg0[0]), "+v"(cg0[1]), "+v"(cg1[0]), "+v"(cg1[1]) :: "memory")
#define POST_LOAD(CG, sx) do { int chn_ = 4 * ((sx) - 2) + hw; chn_ = chn_ < 1 ? 1 : (chn_ >= NCHUNK ? NCHUNK - 1 : chn_);     \
            const unsigned char* ib_ = img + (size_t)chn_ * IMG_SIZE; \
            _Pragma("unroll") for (int ks = 0; ks < 2; ++ks) GLD16(CG[ks], ib_ + CB_GATE + (t * 64 + 32 * ks + 8 * fq) * 2); } while (0)
        POST_LOAD(cg0, 0); IMG_LOAD(im0, hw);
        POST_LOAD(cg1, 1); IMG_LOAD(im1, 4 + hw);
#define HELPER_ITER(IM, CG) do { \
            __syncthreads(); \
            VM_WAIT_ALL(15); VM_WAIT_POST(15);        \
            unsigned char* cbw = lds + ((s & 1) * 4 + hw) * CB_SIZE;            \
            { const int ch = 4 * (s - 2) + hw; \
              if (s >= 2 && ch >= 1 && ch < NCHUNK) { const float* yb = (const float*)(lds + SC_YB + ((s & 1) * 4 + hw) * 4096); \
                const int tok = 16 * (ch - 1) + t; const size_t m = (size_t)b * TSEQ + tok; \
                float y[16]; float sm = 0.f; \
                _Pragma("unroll") for (int ks = 0; ks < 2; ++ks) { const f32x4 y0 = *(const f32x4*)(yb + t * 64 + 32 * ks + 8 * fq), y1 = *(const f32x4*)(yb + t * 64 + 32 * ks + 8 * fq + 4); \
                    _Pragma("unroll") for (int e = 0; e < 4; ++e) { y[8 * ks + e] = y0[e]; y[8 * ks + 4 + e] = y1[e]; sm += y0[e] + y1[e]; } } \
                sm += __shfl_xor(sm, 16); sm += __shfl_xor(sm, 32); const float mean = sm * (1.0f / 64.0f); float sq = 0.f; \
                _Pragma("unroll") for (int i = 0; i < 16; ++i) { y[i] -= mean; sq += y[i] * y[i]; } \
                sq += __shfl_xor(sq, 16); sq += __shfl_xor(sq, 32); const float rs = __builtin_amdgcn_rsqf(sq * (1.0f / 64.0f) + 64e-5f); \
                const float bon = *(const float*)(cbw + CB_BON + t * 4); \
                _Pragma("unroll") for (int ks = 0; ks < 2; ++ks) { const int c = cbase + 32 * ks; \
                    float g[8], o[8]; unpack8(CG[ks], g); \
                    const float* cq = cst + 32 * ks + 8 * fq; const f32x4 wA = *(const f32x4*)(cq + 64), wB = *(const f32x4*)(cq + 68), bA = *(const f32x4*)(cq + 128), bB = *(const f32x4*)(cq + 132); \
                    _Pragma("unroll") for (int e = 0; e < 8; ++e) { const float lw_ = e < 4 ? wA[e & 3] : wB[e & 3], lb_ = e < 4 ? bA[e & 3] : bB[e & 3]; \
                        const float vv = __builtin_bit_cast(float, (unsigned)(*(const bf16*)(cbw + pvt_off + ks * 1024 + e * 8)) << 16); \
                        o[e] = (y[8 * ks + e] * rs * lw_ + lb_ + bon * vv) * g[e]; } \
                    *(bf16x8*)(Yo + m * DM + c) = pack8(o); } } } \
            asm volatile("s_waitcnt lgkmcnt(0)" ::: "memory");                   \
            if (4 * s + hw < NCHUNK) { \
                _Pragma("unroll") for (int i_ = 0; i_ < 13; ++i_) if (i_ < 12 || lane < 32) *(v4u*)(cbw + (i_ * 64 + lane) * 16) = IM[i_]; } \
            POST_LOAD(CG, s + 2); \
            { const int cl_ = 4 * (s + 2) + hw; IMG_LOAD(IM, cl_ < NCHUNK ? cl_ : NCHUNK - 1); } \
        } while (0)
#pragma unroll 1
        for (int s2 = 0; s2 <= NSUPER + 1; s2 += 2) {
            { const int s = s2; HELPER_ITER(im0, cg0); }
            if (s2 + 1 <= NSUPER + 1) { const int s = s2 + 1; HELPER_ITER(im1, cg1); }
        }
        asm volatile("s_waitcnt vmcnt(0)" ::: "memory");
#undef HELPER_ITER
#undef POST_LOAD
#undef VM_WAIT_ALL
#undef VM_WAIT_POST
#undef GLD16
#undef GLD4
#undef IMG_LOAD
    }
}
__device__ __forceinline__ void final_norm(const Ptrs& P, int gw, int NGW, int lane) {
    const float* ssq = (const float*)(P.ws + WS_SSQ4); const GAS f32x4* g4 = (const GAS f32x4*)P.in[26] + lane;
    f32x4 g[4];
#pragma unroll
    for (int j = 0; j < 4; ++j) g[j] = g4[64 * j];
    for (int m = gw; m < MR; m += NGW) { const float rs = pg8::rstd_from16(ssq, m); GAS f32x4* o = (GAS f32x4*)(P.out + (size_t)m * DM) + lane;
#pragma unroll
        for (int j = 0; j < 4; ++j) o[64 * j] = o[64 * j] * rs * g[j]; }
}
#ifndef MK_N_LAUNCHES
#define MK_N_LAUNCHES 1
#endif
constexpr int N_PHASES = 10;
struct Args { Ptrs p; int ph_lo, ph_hi, use_cg, pad; };
__global__ void __launch_bounds__(NWAVES * 64, 2) hymba_fwd(Args args) {
    extern __shared__ __attribute__((aligned(16))) unsigned char lds[];
    LAS unsigned char* ldsl = (LAS unsigned char*)lds;
    volatile LAS unsigned* MISC = (volatile LAS unsigned*)(ldsl + MISC_OFF);
    const int tid = threadIdx.x, lane = tid & 63, wave = __builtin_amdgcn_readfirstlane(tid >> 6);
    const int G = gridDim.x, bx = blockIdx.x, vcu = (G % 8 == 0) ? (bx % 8) * (G / 8) + bx / 8 : bx;
    const Ptrs& P = args.p; unsigned char* ws = P.ws;
    if (args.use_cg) cg::this_grid().sync();
    for (int u = tid; u < (LDS_BYTES - LDSCTL_OFF) / 4; u += NWAVES * 64) ((LAS unsigned*)(ldsl + LDSCTL_OFF))[u] = 0u;
    __syncthreads();
    const int lo = args.ph_lo, hi = args.ph_hi;
    XcdBarrier bar; bar.bar = (unsigned*)(ws + WS_CTL) + CW_BAR; bar.x = 0; bar.st = nullptr;
    if (hi - lo > 1) bar = xcd_barrier_post((unsigned*)(ws + WS_CTL) + CW_BAR, MISC + 8);
#define IN(k) (lo <= (k) && (k) < hi)
#define SEAM(k) do { if (IN(k) && IN((k) + 1)) xcd_barrier(bar); } while (0)
    const int gw = vcu * NWAVES + wave, NGW = G * NWAVES;
    const int gwm = bx + G * wave;

#ifndef REP_P0
#define REP_P0 1
#endif
    if (IN(0)) { for (int rep = 0; rep < REP_P0; ++rep) p0_prologue(P, ldsl, vcu, G, wave, lane); SEAM(0); }
    if (IN(1)) {
        meta_up(ws, ldsl, bx, G, wave, lane);
        pg8::Gemm g{(const bf16*)(ws + WS_XB), (const bf16*)(ws + WS_WGU1), MR, NGU, DM}; pg8::StaticOrder S; S.init(MR, NGU, G, bx);
        LAS float* rcache = (LAS float*)(ldsl + RING_BYTES); pg8::fill_rstd_cache(rcache, (const float*)(ws + WS_SSQ1), S);
        pg8::EpiSwiglu E{(bf16*)(ws + WS_BIG), (const float*)(ws + WS_SSQ1), FF, rcache};
#ifndef REP_P1
#define REP_P1 1
#endif
        for (int rep = 0; rep < REP_P1; ++rep) pg8::gemm_phase<pg8::EpiSwiglu, pg8::StaticOrder, true, true>(ldsl, g, S, E);
        SEAM(1);
    }
    if (IN(2)) {
        meta_down(P, ldsl, bx, G, wave, lane);
        pg8::Gemm g{(const bf16*)(ws + WS_BIG), (const bf16*)(ws + WS_WD1), MR, DM, FF}; pg8::StaticOrder S; S.init(MR, DM, G, bx);
        pg8::EpiResid<true> E{P.in[0], P.out, (bf16*)(ws + WS_XB), (float*)(ws + WS_SSQ2), 0.5f};
#ifndef REP_P2
#define REP_P2 1
#endif
        for (int rep = 0; rep < REP_P2; ++rep) pg8::gemm_phase<pg8::EpiResid<true>, pg8::StaticOrder, true, true>(ldsl, g, S, E);
        SEAM(2);
    }
    if (IN(3)) {
        meta_win(P, ldsl, bx, G, wave, lane);
        pg8::Gemm g{(const bf16*)(ws + WS_XB), (const bf16*)(ws + WS_WIN), MR, NINP, DM}; pg8::StaticOrder S; S.init(MR, NINP, G, bx);
        LAS float* rcache = (LAS float*)(ldsl + RING_BYTES); pg8::fill_rstd_cache(rcache, (const float*)(ws + WS_SSQ2), S);
        pg8::EpiZ E{(bf16*)(ws + WS_BIG), (const float*)(ws + WS_SSQ2), P.in[8], NIN, NIN, ZC_Q, rcache};
        pg8::gemm_phase<pg8::EpiZ, pg8::StaticOrder, true, true>(ldsl, g, S, E);
        SEAM(3);
    }
    if (IN(4)) {
#ifndef REP_PREP
#define REP_PREP 1
#endif
        for (int rep = 0; rep < REP_PREP; ++rep) for (int task = gw; task < NBATCH * NHEAD * NCHUNK; task += NGW) { const int bc = task >> 3; chunk_task(P, lds, wave * WL_SIZE, bc / NCHUNK, task & 7, bc % NCHUNK, lane); }
        SEAM(4);
    }
    if (IN(5)) {
#ifndef REP_SCAN
#define REP_SCAN 1
#endif
#ifndef REP_ATTN
#define REP_ATTN 1
#endif
        if (bx < 64) { for (int rep = 0; rep < REP_SCAN; ++rep) { scan_phase(P, lds, bx, tid, wave, lane, args.use_cg); __syncthreads(); } }
        else { for (int rep = 0; rep < REP_ATTN; ++rep) for (int u = bx - 64; u < NBATCH * 2 * 64; u += G - 64) attn_unit(P, lds, u >> 7, (u >> 6) & 1, u & 63, tid, wave, lane);
            __syncthreads();
#ifndef REP_TR1
#define REP_TR1 1
#endif
            for (int rep = 0; rep < REP_TR1; ++rep) p0_transposes(P, ldsl, 1, (bx - 64) * NWAVES + wave, (G - 64) * NWAVES, wave, lane); }
        __syncthreads();
        SEAM(5);
    }
    if (IN(6)) {
        pg8::Gemm g{(const bf16*)(ws + WS_XB), (const bf16*)(ws + WS_WOUT), MR, DM, DM}; pg8::StaticOrder S; S.init(MR, DM, G, bx);
        pg8::EpiResid<true> E{P.out, P.out, (bf16*)(ws + WS_P), (float*)(ws + WS_SSQ3), 1.0f};
        pg8::gemm_phase<pg8::EpiResid<true>, pg8::StaticOrder, true, true>(ldsl, g, S, E);
        SEAM(6);
    }
    if (IN(7)) {
        pg8::Gemm g{(const bf16*)(ws + WS_P), (const bf16*)(ws + WS_WGU2), MR, NGU, DM}; pg8::StaticOrder S; S.init(MR, NGU, G, bx);
        LAS float* rcache = (LAS float*)(ldsl + RING_BYTES); pg8::fill_rstd_cache(rcache, (const float*)(ws + WS_SSQ3), S);
        pg8::EpiSwiglu E{(bf16*)(ws + WS_BIG), (const float*)(ws + WS_SSQ3), FF, rcache};
        pg8::gemm_phase<pg8::EpiSwiglu, pg8::StaticOrder, true, true>(ldsl, g, S, E);
        SEAM(7);
    }
    if (IN(8)) {
        pg8::Gemm g{(const bf16*)(ws + WS_BIG), (const bf16*)(ws + WS_WD2), MR, DM, FF}; pg8::StaticOrder S; S.init(MR, DM, G, bx);
        pg8::EpiResid<false> E{P.out, P.out, nullptr, (float*)(ws + WS_SSQ4), 0.5f};
        pg8::gemm_phase<pg8::EpiResid<false>, pg8::StaticOrder, true, true>(ldsl, g, S, E);
        SEAM(8);
    }
    if (IN(9)) final_norm(P, gw, NGW, lane);
#undef IN
#undef SEAM
}

extern "C" void kernel_launch(void* const* d_in, const int* in_sizes, int n_in, void* d_out, int out_size, void* d_ws, size_t ws_size, hipStream_t stream) {
    static int grid = 0;
    if (grid == 0) {
        if (n_in != 27 || in_sizes[0] != MR * DM || out_size != MR * DM || ws_size < WS_END) { fprintf(stderr, "kernel_launch: unexpected shapes (n_in %d, in0 %d, out %d, ws %zu)\n", n_in, n_in > 0 ? in_sizes[0] : -1, out_size, ws_size); grid = -1; return; }
        int dev = 0, cus = 0, per_cu = 0;
        if (hipGetDevice(&dev) != hipSuccess || hipDeviceGetAttribute(&cus, hipDeviceAttributeMultiprocessorCount, dev) != hipSuccess) { grid = -1; return; }
        if (hipFuncSetAttribute((const void*)hymba_fwd, hipFuncAttributeMaxDynamicSharedMemorySize, LDS_BYTES) != hipSuccess) { fprintf(stderr, "kernel_launch: hipFuncSetAttribute failed\n"); grid = -1; return; }
        if (hipOccupancyMaxActiveBlocksPerMultiprocessor(&per_cu, (const void*)hymba_fwd, NWAVES * 64, LDS_BYTES) != hipSuccess || per_cu < 1) fprintf(stderr, "kernel_launch: occupancy query says %d blocks per CU\n", per_cu);
        (void)hipGetLastError();
        grid = cus;
    }
    if (grid < 0) return;
    if (hipMemsetAsync((char*)d_ws + WS_CTL, 0, CTL_ZERO_BYTES, stream) != hipSuccess) { fprintf(stderr, "kernel_launch: memset failed\n"); return; }
    Args a{};
    for (int i = 0; i < 27; ++i) a.p.in[i] = (const float*)d_in[i];
    a.p.out = (float*)d_out; a.p.ws = (unsigned char*)d_ws; a.use_cg = 0; a.pad = 0;
#if MK_N_LAUNCHES == 1
    a.ph_lo = 0; a.ph_hi = N_PHASES;
    void* kargs[] = {&a};
    hipError_t e = hipLaunchCooperativeKernel((const void*)hymba_fwd, dim3(grid), dim3(NWAVES * 64), kargs, LDS_BYTES, stream);
    if (e != hipSuccess) fprintf(stderr, "kernel_launch: cooperative launch failed: %s (grid %d)\n", hipGetErrorString(e), grid);
#else
    for (int li = 0; li < N_PHASES; ++li) { a.ph_lo = li; a.ph_hi = li + 1;
        hipLaunchKernelGGL(hymba_fwd, dim3(grid), dim3(NWAVES * 64), LDS_BYTES, stream, a);
        const hipError_t le = hipPeekAtLastError(); if (le != hipSuccess) { fprintf(stderr, "kernel_launch: launch %d failed: %s\n", li, hipGetErrorName(le)); break; } }
#endif
}
```

```cpp
#include <hip/hip_runtime.h>
#include <cstdio>
#include <cstdint>
namespace pg8 {
#define PG8_LAS __attribute__((address_space(3)))
typedef unsigned short bf16_t;
typedef short bf16x8 __attribute__((ext_vector_type(8)));
typedef float f32x4 __attribute__((ext_vector_type(4)));
typedef unsigned u32x4 __attribute__((ext_vector_type(4)));
constexpr int BM = 256, BK = 64, HALF = 128, HTB = HALF * BK * 2  , STAGE_BYTES = 8 * HTB, NXCD = 8, WGM = 8;

__host__ __device__ __forceinline__ int lds_byte(int r, int c) { const int st = (r >> 4) * 2 + (c >> 5), rr = r & 15, cc = c & 31, ob = rr * 64 + cc * 2; return st * 1024 + (ob ^ (((ob >> 9) & 1) << 5)); }
__host__ __device__ __forceinline__ void stage_rc(int b, int& R, int& C) { const int st = b / 1024, sb = b % 1024, swz = sb ^ (((sb >> 9) & 1) << 5); R = (st >> 1) * 16 + swz / 64; C = (st & 1) * 32 + (swz % 64) / 2; }
__host__ __device__ __forceinline__ int perm32(int rho) { const int n = rho >> 4, i = rho & 15; return 8 * (i >> 2) + 4 * n + (i & 3); }

struct Unit { int pm, pn; };
struct Gemm { const bf16_t* A; const bf16_t* Bt; int M, N, K; };

struct StaticOrder {
    int nM, nN, nwg, G, c;
    __host__ __device__ void init(int M, int N, int G_, int c_) { nM = M / BM; nN = N / BM; nwg = nM * nN; G = G_; c = c_; }
    __host__ __device__ bool next(int i, Unit& u) const {
        const long L = (long)i * G + c; if (L >= nwg) return false;
        int wgid = (int)L; { const int q = nwg / NXCD, r = nwg % NXCD, xcd = wgid % NXCD, off = wgid / NXCD; wgid = (xcd < r ? xcd * (q + 1) : r * (q + 1) + (xcd - r) * q) + off; }
        const int nig = WGM * nN, gid = wgid / nig, fm = gid * WGM, gsz = (nM - fm) < WGM ? (nM - fm) : WGM;
        u.pm = fm + ((wgid % nig) % gsz); u.pn = (wgid % nig) / gsz; return true;
    }
    __device__ __forceinline__ void a_ready(const Unit&) const {}
    __device__ __forceinline__ void done(const Unit&) const {}
};

__device__ __forceinline__ unsigned cvt_pk_bf16(float lo, float hi) { unsigned r; asm volatile("v_cvt_pk_bf16_f32 %0, %1, %2" : "=v"(r) : "v"(lo), "v"(hi)); return r; }
typedef float f32x2 __attribute__((ext_vector_type(2)));
typedef unsigned u32x2 __attribute__((ext_vector_type(2)));
__device__ __forceinline__ float rstd_from16(const float* ssq, int row) {
    const f32x4* p = (const f32x4*)(ssq + (size_t)row * 16);
    const f32x4 a = p[0], b = p[1], c = p[2], d = p[3];
    const float s = ((a[0] + a[1]) + (a[2] + a[3])) + ((b[0] + b[1]) + (b[2] + b[3])) + ((c[0] + c[1]) + (c[2] + c[3])) + ((d[0] + d[1]) + (d[2] + d[3]));
    return __builtin_amdgcn_rsqf(s * (1.0f / 1024.0f) + 1e-5f);
}
__device__ __forceinline__ float silu_mul(float g, float u) { return g * __builtin_amdgcn_rcpf(1.0f + __builtin_amdgcn_exp2f(-1.4426950408889634f * g)) * u; }
template <class Sched> __device__ __forceinline__ void fill_rstd_cache(PG8_LAS float* tab, const float* ssq, const Sched& S) {
    const int tid = threadIdx.x; int t0 = -1, t1 = -1, t2 = -1, t3 = -1; Unit u;
    for (int i = 0; S.next(i, u); ++i) { const int pm = u.pm;
        if (pm == t0 || pm == t1 || pm == t2 || pm == t3) continue;
        if (t0 < 0) t0 = pm; else if (t1 < 0) t1 = pm; else if (t2 < 0) t2 = pm; else if (t3 < 0) t3 = pm; }
    if (tid == 0) { tab[0] = __builtin_bit_cast(float, t0); tab[1] = __builtin_bit_cast(float, t1); tab[2] = __builtin_bit_cast(float, t2); tab[3] = __builtin_bit_cast(float, t3); }
    if (tid < 256) { if (t0 >= 0) tab[4 + tid] = rstd_from16(ssq, t0 * BM + tid); if (t1 >= 0) tab[4 + 256 + tid] = rstd_from16(ssq, t1 * BM + tid);
        if (t2 >= 0) tab[4 + 512 + tid] = rstd_from16(ssq, t2 * BM + tid); if (t3 >= 0) tab[4 + 768 + tid] = rstd_from16(ssq, t3 * BM + tid); }
    __syncthreads();
}
__device__ __forceinline__ int rstd_slot(const PG8_LAS float* tab, int pm) {
    const int a = __builtin_bit_cast(int, tab[0]), b = __builtin_bit_cast(int, tab[1]), c = __builtin_bit_cast(int, tab[2]), d = __builtin_bit_cast(int, tab[3]);
    return pm == a ? 0 : pm == b ? 1 : pm == c ? 2 : pm == d ? 3 : -1;
}
struct EpiSwiglu {
    static constexpr bool PERM = true, AFTER_DRAIN = false;
    bf16_t* U; const float* ssq; int ldu; const PG8_LAS float* rc;
    __device__ __forceinline__ void operator()(const f32x4 (&acc)[2][2][4][2], const Unit& u, int wr, int wc, int fr, int fq) const {
        const int row0 = u.pm * BM + wr * 64 + fr, col0 = u.pn * HALF + wc * 32 + 8 * fq; const int slot = rstd_slot(rc, u.pm);
#pragma unroll
        for (int ai = 0; ai < 2; ++ai)
#pragma unroll
            for (int m = 0; m < 4; ++m) { const int row = row0 + ai * HALF + m * 16; const float rs = slot >= 0 ? rc[4 + slot * 256 + (row - u.pm * BM)] : rstd_from16(ssq, row);
                const float rs2 = rs * rs, cc = -1.4426950408889634f * rs;
                f32x4 o0, o1;
                { const f32x4 g = acc[ai][0][m][0], uu = acc[ai][1][m][0]; const f32x4 a = g * cc; f32x4 e; e[0] = __builtin_amdgcn_exp2f(a[0]); e[1] = __builtin_amdgcn_exp2f(a[1]); e[2] = __builtin_amdgcn_exp2f(a[2]); e[3] = __builtin_amdgcn_exp2f(a[3]);
                  const f32x4 d = e + 1.0f; f32x4 r; r[0] = __builtin_amdgcn_rcpf(d[0]); r[1] = __builtin_amdgcn_rcpf(d[1]); r[2] = __builtin_amdgcn_rcpf(d[2]); r[3] = __builtin_amdgcn_rcpf(d[3]); o0 = (g * rs2) * uu * r; }
                { const f32x4 g = acc[ai][0][m][1], uu = acc[ai][1][m][1]; const f32x4 a = g * cc; f32x4 e; e[0] = __builtin_amdgcn_exp2f(a[0]); e[1] = __builtin_amdgcn_exp2f(a[1]); e[2] = __builtin_amdgcn_exp2f(a[2]); e[3] = __builtin_amdgcn_exp2f(a[3]);
                  const f32x4 d = e + 1.0f; f32x4 r; r[0] = __builtin_amdgcn_rcpf(d[0]); r[1] = __builtin_amdgcn_rcpf(d[1]); r[2] = __builtin_amdgcn_rcpf(d[2]); r[3] = __builtin_amdgcn_rcpf(d[3]); o1 = (g * rs2) * uu * r; }
                u32x4 w; w.x = cvt_pk_bf16(o0[0], o0[1]); w.y = cvt_pk_bf16(o0[2], o0[3]); w.z = cvt_pk_bf16(o1[0], o1[1]); w.w = cvt_pk_bf16(o1[2], o1[3]);
                *(u32x4*)(U + (size_t)row * ldu + col0) = w; }
    }
};
struct EpiZ {
    static constexpr bool PERM = true, AFTER_DRAIN = false;
    bf16_t* Z; const float* ssq; const float* bias; int ldz, ncols, bias_from; const PG8_LAS float* rc;
    __device__ __forceinline__ void operator()(const f32x4 (&acc)[2][2][4][2], const Unit& u, int wr, int wc, int fr, int fq) const {
        const int row0 = u.pm * BM + wr * 64 + fr, col0 = u.pn * BM + wc * 32 + 8 * fq; const int slot = rstd_slot(rc, u.pm);
        f32x4 bv[2][2];
#pragma unroll
        for (int bj = 0; bj < 2; ++bj)
#pragma unroll
            for (int n = 0; n < 2; ++n) { const int c = col0 + bj * HALF + 4 * n; bv[bj][n] = (c >= bias_from && c < ncols) ? *(const f32x4*)(bias + (c - bias_from)) : (f32x4){0.f, 0.f, 0.f, 0.f}; }
#pragma unroll
        for (int ai = 0; ai < 2; ++ai)
#pragma unroll
            for (int m = 0; m < 4; ++m) { const int row = row0 + ai * HALF + m * 16; const float rs = slot >= 0 ? rc[4 + slot * 256 + (row - u.pm * BM)] : rstd_from16(ssq, row);
#pragma unroll
                for (int bj = 0; bj < 2; ++bj) { const int c = col0 + bj * HALF; if (c < ncols) {
                    const f32x4 v0 = acc[ai][bj][m][0] * rs + bv[bj][0], v1 = acc[ai][bj][m][1] * rs + bv[bj][1];
                    u32x4 w; w.x = cvt_pk_bf16(v0[0], v0[1]); w.y = cvt_pk_bf16(v0[2], v0[3]); w.z = cvt_pk_bf16(v1[0], v1[1]); w.w = cvt_pk_bf16(v1[2], v1[3]);
                    *(u32x4*)(Z + (size_t)row * ldz + c) = w; } } }
    }
};
template <bool WB> struct EpiResid {
    static constexpr bool PERM = false, AFTER_DRAIN = false;
    const float* base; float* out; bf16_t* outb; float* ssq; float scale;
    __device__ __forceinline__ void operator()(const f32x4 (&acc)[2][2][4][2], const Unit& u, int wr, int wc, int fr, int fq) const {
        const int row0 = u.pm * BM + wr * 64 + fr, col0 = u.pn * BM + wc * 32 + 4 * fq;
        f32x4 nb[4]; float ssv[8];
        { const size_t off = (size_t)row0 * 1024 + col0;
#pragma unroll
          for (int q = 0; q < 4; ++q) nb[q] = *(const f32x4*)(base + off + (q >> 1) * HALF + (q & 1) * 16); }
#pragma unroll
        for (int ri = 0; ri < 8; ++ri) { const int ai = ri >> 2, m = ri & 3; const int row = row0 + ai * HALF + m * 16; const size_t off = (size_t)row * 1024 + col0;
            f32x4 cb[4];
#pragma unroll
            for (int q = 0; q < 4; ++q) cb[q] = nb[q];
            if (ri < 7) { const int r2 = ri + 1; const size_t off2 = (size_t)(row0 + (r2 >> 2) * HALF + (r2 & 3) * 16) * 1024 + col0;
#pragma unroll
                for (int q = 0; q < 4; ++q) nb[q] = *(const f32x4*)(base + off2 + (q >> 1) * HALF + (q & 1) * 16);
                asm volatile("" ::: "memory"); }
            float ss = 0.f;
#pragma unroll
            for (int q = 0; q < 4; ++q) { const int bj = q >> 1, n = q & 1; const size_t o2 = off + bj * HALF + n * 16; const f32x4 o = cb[q] + acc[ai][bj][m][n] * scale;
                *(f32x4*)(out + o2) = o; ss += (o[0] * o[0] + o[1] * o[1]) + (o[2] * o[2] + o[3] * o[3]);
                if (WB) { u32x2 w; w.x = cvt_pk_bf16(o[0], o[1]); w.y = cvt_pk_bf16(o[2], o[3]); *(u32x2*)(outb + o2) = w; } }
            ssv[ri] = ss; }
#pragma unroll
        for (int ri = 0; ri < 8; ++ri) ssv[ri] += __shfl_xor(ssv[ri], 16);
#pragma unroll
        for (int ri = 0; ri < 8; ++ri) ssv[ri] += __shfl_xor(ssv[ri], 32);
        if (fq == 0) {
#pragma unroll
            for (int ri = 0; ri < 8; ++ri) ssq[(size_t)(row0 + (ri >> 2) * HALF + (ri & 3) * 16) * 16 + u.pn * 4 + wc] = ssv[ri]; }
    }
};
template <class Epi, class Sched, bool ALIGN_EPI = false, bool SP2 = false>
__device__ __forceinline__ void gemm_phase(PG8_LAS unsigned char* lds, const Gemm g, const Sched& S, const Epi& E) {
    const int tid = threadIdx.x, wid = __builtin_amdgcn_readfirstlane(tid >> 6), lane = tid & 63, wr = wid >> 2, wc = wid & 3, fr = lane & 15, fq = lane >> 4;
    const int K = g.K, nt = K / BK;
    unsigned voffA[2], voffB[2];
#pragma unroll
    for (int i = 0; i < 2; ++i) { int R, C; stage_rc(tid * 16 + i * 8192, R, C); const int Rb = Epi::PERM ? ((R & ~31) + perm32(R & 31)) : R;
        voffA[i] = (unsigned)(R * K + C) * 2u; voffB[i] = (unsigned)(Rb * K + C) * 2u; }
    const size_t kstep = (size_t)(BK * 2);
    const size_t hstep = (size_t)HALF * K * 2;
    const size_t tstep = 2 * hstep;
    const unsigned ldsw = (unsigned)wid * 1024u;
    const int aoff = lds_byte(wr * 64 + fr, fq * 8), boff = lds_byte(wc * 32 + fr, fq * 8);
#define PG8_SA(b, h) (((b) * 2 + (h)) * HTB)
#define PG8_SB(b, h) ((4 + (b) * 2 + (h)) * HTB)
#define PG8_STAGE(bufoff, gbase, voff) do { _Pragma("unroll") for (int _i = 0; _i < 2; ++_i) \
        __builtin_amdgcn_global_load_lds((const unsigned*)((const char*)(gbase) + (voff)[_i]), (PG8_LAS unsigned*)(lds + (bufoff) + ldsw + _i * 8192), 16, 0, 0); } while (0)
#define PG8_LDA(dst, b, h) do { _Pragma("unroll") for (int m = 0; m < 4; ++m) _Pragma("unroll") for (int k = 0; k < 2; ++k) dst[m][k] = *(const PG8_LAS bf16x8*)(lds + PG8_SA(b, h) + aoff + m * 2048 + k * 1024); } while (0)
#define PG8_LDB(dst, b, h) do { _Pragma("unroll") for (int n = 0; n < 2; ++n) _Pragma("unroll") for (int k = 0; k < 2; ++k) dst[n][k] = *(const PG8_LAS bf16x8*)(lds + PG8_SB(b, h) + boff + n * 2048 + k * 1024); } while (0)
#define PG8_MMA(ai, bj, At, Bt) do { __builtin_amdgcn_s_setprio(1); _Pragma("unroll") for (int m = 0; m < 4; ++m) _Pragma("unroll") for (int n = 0; n < 2; ++n) _Pragma("unroll") for (int k = 0; k < 2; ++k) \
        acc[ai][bj][m][n] = __builtin_amdgcn_mfma_f32_16x16x32_bf16(Bt[n][k], At[m][k], acc[ai][bj][m][n], 0, 0, 0); __builtin_amdgcn_s_setprio(0); } while (0)
#define PG8_WAIT_V(n) asm volatile("s_waitcnt vmcnt(" #n ")" ::: "memory")
#define PG8_WAIT_L(n) asm volatile("s_waitcnt lgkmcnt(" #n ")" ::: "memory")
#define PG8_BAR __builtin_amdgcn_s_barrier()
#define PG8_SCHED __builtin_amdgcn_sched_barrier(0)
    Unit cur, nxt; int ui = 0;
    if (!S.next(0, cur)) return;
    f32x4 acc[2][2][4][2];
#pragma unroll
    for (int a = 0; a < 2; ++a)
#pragma unroll
        for (int b = 0; b < 2; ++b)
#pragma unroll
            for (int m = 0; m < 4; ++m)
#pragma unroll
                for (int n = 0; n < 2; ++n) acc[a][b][m][n] = (f32x4){0.f, 0.f, 0.f, 0.f};
    bf16x8 At[4][2], B0[2][2], B1[2][2];
    const char* cA = (const char*)g.A + (size_t)cur.pm * tstep; const char* cB = (const char*)g.Bt + (size_t)cur.pn * tstep;
    S.a_ready(cur);
    if constexpr (SP2) {
        PG8_STAGE(PG8_SB(0, 0), cB, voffB); PG8_STAGE(PG8_SB(0, 1), cB + hstep, voffB); PG8_STAGE(PG8_SA(0, 0), cA, voffA); PG8_STAGE(PG8_SA(0, 1), cA + hstep, voffA);
        if (wr == 1) PG8_BAR;
        PG8_WAIT_V(2); PG8_BAR;
        PG8_STAGE(PG8_SB(1, 0), cB + kstep, voffB); PG8_STAGE(PG8_SA(1, 0), cA + kstep, voffA); PG8_STAGE(PG8_SB(1, 1), cB + hstep + kstep, voffB);
        PG8_WAIT_V(6); PG8_BAR;
    } else {
        PG8_STAGE(PG8_SB(0, 0), cB, voffB); PG8_STAGE(PG8_SA(0, 0), cA, voffA); PG8_STAGE(PG8_SB(0, 1), cB + hstep, voffB); PG8_STAGE(PG8_SA(0, 1), cA + hstep, voffA);
        if (wr == 1) PG8_BAR;
        PG8_WAIT_V(4); PG8_BAR;
        PG8_STAGE(PG8_SB(1, 0), cB + kstep, voffB); PG8_STAGE(PG8_SA(1, 0), cA + kstep, voffA); PG8_STAGE(PG8_SB(1, 1), cB + hstep + kstep, voffB);
        PG8_WAIT_V(6); PG8_BAR;
    }
    for (;;) {
        const bool has_next = S.next(ui + 1, nxt);
        const char* nA = has_next ? (const char*)g.A + (size_t)nxt.pm * tstep : cA; const char* nB = has_next ? (const char*)g.Bt + (size_t)nxt.pn * tstep : cB;
        for (int t = 0; t < nt; t += 2) {
            const bool last = (t == nt - 2);
            const char* a1 = cA + (size_t)(t + 1) * kstep;
            const char* a2 = last ? nA : cA + (size_t)(t + 2) * kstep; const char* b2 = last ? nB : cB + (size_t)(t + 2) * kstep;
            const char* a3 = a2 + kstep; const char* b3 = b2 + kstep;
            if (last && has_next) S.a_ready(nxt);
            if constexpr (SP2) {
            PG8_LDB(B0, 0, 0); PG8_LDB(B1, 0, 1); PG8_SCHED; PG8_LDA(At, 0, 0); PG8_STAGE(PG8_SA(1, 1), a1 + hstep, voffA);
            PG8_WAIT_V(8); PG8_WAIT_L(0); PG8_BAR; PG8_MMA(0, 0, At, B0); PG8_MMA(0, 1, At, B1); PG8_BAR; PG8_SCHED;
            PG8_LDA(At, 0, 1); PG8_STAGE(PG8_SB(0, 0), b2, voffB); PG8_STAGE(PG8_SB(0, 1), b2 + hstep, voffB); PG8_STAGE(PG8_SA(0, 0), a2, voffA);
            PG8_WAIT_V(8); PG8_WAIT_L(0); PG8_BAR; PG8_MMA(1, 0, At, B0); PG8_MMA(1, 1, At, B1); PG8_BAR; PG8_SCHED;
            PG8_LDB(B0, 1, 0); PG8_LDB(B1, 1, 1); PG8_SCHED; PG8_LDA(At, 1, 0); PG8_STAGE(PG8_SA(0, 1), a2 + hstep, voffA);
            PG8_WAIT_V(8); PG8_WAIT_L(0); PG8_BAR; PG8_MMA(0, 0, At, B0); PG8_MMA(0, 1, At, B1); PG8_BAR; PG8_SCHED;
            PG8_LDA(At, 1, 1); PG8_STAGE(PG8_SB(1, 0), b3, voffB); PG8_STAGE(PG8_SB(1, 1), b3 + hstep, voffB); PG8_STAGE(PG8_SA(1, 0), a3, voffA);
            PG8_WAIT_V(8); PG8_WAIT_L(0); PG8_BAR; PG8_MMA(1, 0, At, B0); PG8_MMA(1, 1, At, B1); PG8_BAR; PG8_SCHED;
            } else {
            PG8_LDB(B0, 0, 0); PG8_SCHED; PG8_LDA(At, 0, 0); PG8_STAGE(PG8_SA(1, 1), a1 + hstep, voffA);
            PG8_WAIT_L(8); PG8_BAR; PG8_WAIT_L(0); PG8_MMA(0, 0, At, B0); PG8_BAR; PG8_SCHED;
            PG8_LDB(B1, 0, 1); PG8_STAGE(PG8_SB(0, 0), b2, voffB);
            PG8_BAR; PG8_WAIT_L(0); PG8_MMA(0, 1, At, B1); PG8_BAR;
            PG8_LDA(At, 0, 1); PG8_STAGE(PG8_SA(0, 0), a2, voffA);
            PG8_BAR; PG8_WAIT_L(0); PG8_MMA(1, 0, At, B0); PG8_BAR; PG8_SCHED;
            PG8_STAGE(PG8_SB(0, 1), b2 + hstep, voffB);
            PG8_WAIT_V(6); PG8_BAR; PG8_MMA(1, 1, At, B1); PG8_BAR;
            PG8_LDB(B0, 1, 0); PG8_SCHED; PG8_LDA(At, 1, 0); PG8_STAGE(PG8_SA(0, 1), a2 + hstep, voffA);
            PG8_WAIT_L(8); PG8_BAR; PG8_WAIT_L(0); PG8_MMA(0, 0, At, B0); PG8_BAR; PG8_SCHED;
            PG8_LDB(B1, 1, 1); PG8_STAGE(PG8_SB(1, 0), b3, voffB);
            PG8_BAR; PG8_WAIT_L(0); PG8_MMA(0, 1, At, B1); PG8_BAR;
            PG8_LDA(At, 1, 1); PG8_STAGE(PG8_SA(1, 0), a3, voffA);
            PG8_BAR; PG8_WAIT_L(0); PG8_MMA(1, 0, At, B0); PG8_BAR; PG8_SCHED;
            PG8_STAGE(PG8_SB(1, 1), b3 + hstep, voffB);
            PG8_WAIT_V(6); PG8_BAR; PG8_MMA(1, 1, At, B1); PG8_BAR;
            }
        }
        if constexpr (ALIGN_EPI) { if (wr == 0) PG8_BAR; }
        if constexpr (!Epi::AFTER_DRAIN) { E(acc, cur, wr, wc, fr, fq); S.done(cur); }
        if (!has_next) break;
#pragma unroll
        for (int a = 0; a < 2; ++a)
#pragma unroll
            for (int b = 0; b < 2; ++b)
#pragma unroll
                for (int m = 0; m < 4; ++m)
#pragma unroll
                    for (int n = 0; n < 2; ++n) acc[a][b][m][n] = (f32x4){0.f, 0.f, 0.f, 0.f};
        cur = nxt; cA = nA; cB = nB; ++ui;
        if constexpr (ALIGN_EPI) { if (wr == 1) PG8_BAR; }
    }
    PG8_WAIT_V(0);
    if constexpr (!ALIGN_EPI) { if (wr == 0) PG8_BAR; }
    PG8_BAR;
    if constexpr (Epi::AFTER_DRAIN) { E.fused(acc, cur, wr, wc, fr, fq, lds, wid, lane); S.done(cur); }
#undef PG8_SA
#undef PG8_SB
#undef PG8_STAGE
#undef PG8_LDA
#undef PG8_LDB
#undef PG8_MMA
#undef PG8_WAIT_V
#undef PG8_WAIT_L
#undef PG8_BAR
#undef PG8_SCHED
}
}
#include <hip/hip_cooperative_groups.h>
namespace cg = cooperative_groups;
constexpr int NWAVES = 8;
constexpr int MR = 32768, DM = 1024, FF = 2816, NGU = 5632, NIN = 2464, NINP = 2560, TSEQ = 4096, NBATCH = 8, NHEAD = 8, NMETA = 16;
constexpr int ZC_W = 1536, ZC_Q = 1696, ZC_K = 2208, ZC_V = 2336;
constexpr int PV = 320;
constexpr size_t MiB = 1u << 20;
constexpr size_t WS_CTL = 0, CTL_ZERO_BYTES = 1 * MiB;
constexpr size_t WS_WGU1 = 2 * MiB, WS_WD1 = 13 * MiB, WS_WIN = 19 * MiB, WS_WOUT = 24 * MiB, WS_WGU2 = 26 * MiB, WS_WD2 = 37 * MiB, WS_LT = 43 * MiB;
constexpr size_t WS_SSQ1 = 44 * MiB, WS_SSQ2 = 46 * MiB, WS_SSQ3 = 48 * MiB, WS_SSQ4 = 50 * MiB, WS_META = 52 * MiB;
constexpr size_t MO_XMB = 0, MO_UM = 64 * 1024, MO_H1MB = 256 * 1024, MO_SSQM1 = 320 * 1024, MO_SSQM2 = 324 * 1024, MO_ZM = 384 * 1024, MO_PM = 512 * 1024;
constexpr size_t WS_XB = 56 * MiB, WS_BIG = 120 * MiB, WS_IMG = 274 * MiB, WS_P = 296 * MiB, WS_END = 507 * MiB;
constexpr int CW_BAR = 4096;
constexpr int RING_BYTES = 131072, LDSCTL_OFF = 143360, MISC_OFF = LDSCTL_OFF + 320, LDS_BYTES = 147456;

#define GAS __attribute__((address_space(1)))
#define LAS __attribute__((address_space(3)))
typedef unsigned short bf16;
typedef unsigned v4u __attribute__((ext_vector_type(4)));
typedef unsigned v2u __attribute__((ext_vector_type(2)));
typedef float f32x4 __attribute__((ext_vector_type(4)));
typedef float f32x2 __attribute__((ext_vector_type(2)));
typedef short bf16x8 __attribute__((ext_vector_type(8)));
typedef short bf16x4 __attribute__((ext_vector_type(4)));
typedef GAS unsigned gu32;
#define LDS_WAIT() asm volatile("s_waitcnt lgkmcnt(0)" ::: "memory")
__device__ __forceinline__ unsigned f2bf(float f) { unsigned u = __builtin_bit_cast(unsigned, f); return (u + 0x7fffu + ((u >> 16) & 1u)) >> 16; }
typedef __bf16 bf16x2_t __attribute__((ext_vector_type(2)));
__device__ __forceinline__ unsigned pk2m(float lo, float hi) { f32x2 v = {lo, hi}; bf16x2_t b = __builtin_convertvector(v, bf16x2_t); return __builtin_bit_cast(unsigned, b); }
__device__ __forceinline__ unsigned pk2(float lo, float hi) { return pg8::cvt_pk_bf16(lo, hi); }
__device__ __forceinline__ float bflo(unsigned w) { return __builtin_bit_cast(float, w << 16); }
__device__ __forceinline__ float bfhi(unsigned w) { return __builtin_bit_cast(float, w & 0xffff0000u); }
__device__ __forceinline__ f32x4 unpack4(v2u w) { return (f32x4){bflo(w.x), bfhi(w.x), bflo(w.y), bfhi(w.y)}; }
__device__ __forceinline__ float sigmoidf_(float x) { return __builtin_amdgcn_rcpf(1.0f + __builtin_amdgcn_exp2f(-1.4426950408889634f * x)); }
__device__ __forceinline__ float tanhf_(float x) { return 2.0f * sigmoidf_(2.0f * x) - 1.0f; }
#define XB_TMO      128
#define XB_XCNT(j)  (256  + 64 * (j))
#define XB_XSUB(j)  (1280 + 64 * (j))
#define XB_XGEN(j)  (2304 + 64 * (j))
#define XB_TOP      3328
#define XB_TOPGEN   3392
#define XCD_BAR_WORDS 3456
#define XB_SPIN_CAP (1u << 18)

__device__ __forceinline__ unsigned xb_ld(unsigned* p)              { return __hip_atomic_load(p, __ATOMIC_RELAXED, __HIP_MEMORY_SCOPE_AGENT); }
__device__ __forceinline__ unsigned xb_add(unsigned* p, unsigned v) { return __hip_atomic_fetch_add(p, v, __ATOMIC_RELAXED, __HIP_MEMORY_SCOPE_AGENT); }
__device__ __forceinline__ unsigned xb_xcc_id() { return (unsigned)__builtin_amdgcn_s_getreg((3 << 11) | 20) & 0xFu; }
#define XB_SPIN(cond, bar) do { unsigned _sp = 0; while (cond) { __builtin_amdgcn_s_sleep(1); \
    if ((++_sp & 255u) == 0u) { if (xb_ld(&(bar)[XB_TMO])) break; if (_sp > XB_SPIN_CAP) { atomicAdd(&(bar)[XB_TMO], 1u); break; } } } } while (0)

struct XcdBarrier {
    unsigned* bar; unsigned x;
    volatile LAS unsigned* st;
};

__device__ __forceinline__ XcdBarrier xcd_barrier_post(unsigned* bar, volatile LAS unsigned* st) {
    XcdBarrier b; b.bar = bar; b.x = xb_xcc_id(); b.st = st;
    if (threadIdx.x == 0) (void)xb_add(&bar[XB_XCNT(b.x)], 1u);
    return b;
}
__device__ __forceinline__ void xcd_barrier_complete(unsigned* bar, unsigned x, unsigned& nloc, unsigned& nx) {
    const unsigned G = gridDim.x * gridDim.y * gridDim.z;
    unsigned sum, cnt, mine, sp = 0u;
    for (;;) {
        sum = 0u; cnt = 0u; mine = 0u;
#pragma unroll
        for (unsigned j = 0; j < 16; ++j) { const unsigned c = xb_ld(&bar[XB_XCNT(j)]); sum += c; cnt += (c > 0u) ? 1u : 0u; mine = (j == x) ? c : mine; }
        if (sum == G) break;
        __builtin_amdgcn_s_sleep(1);
        if ((++sp & 255u) == 0u) { if (xb_ld(&bar[XB_TMO])) break; if (sp > XB_SPIN_CAP) { atomicAdd(&bar[XB_TMO], 1u); break; } }
    }
    nloc = mine > 0u ? mine : 1u; nx = cnt > 0u ? cnt : 1u;
}

__device__ __forceinline__ void xcd_barrier(const XcdBarrier& b) {
    asm volatile("s_waitcnt vmcnt(0)" ::: "memory");
    __syncthreads();
    if (threadIdx.x == 0) {
        unsigned* bar = b.bar;
        __builtin_amdgcn_s_waitcnt(0);
        unsigned nloc = b.st[0], nx = b.st[1];
        if (nloc == 0u) { xcd_barrier_complete(bar, b.x, nloc, nx); b.st[0] = nloc; b.st[1] = nx; }
        const unsigned old = xb_add(&bar[XB_XSUB(b.x)], 1u);
        const unsigned gen = old / nloc;
        if (old + 1u == (gen + 1u) * nloc) {
            __builtin_amdgcn_fence(__ATOMIC_RELEASE, "agent");
            asm volatile("s_waitcnt vmcnt(0)" ::: "memory");
            const unsigned og = xb_add(&bar[XB_TOP], 1u);
            const unsigned tg = og / nx;
            if (og + 1u == (tg + 1u) * nx) xb_add(&bar[XB_TOPGEN], 1u);
            else XB_SPIN(xb_ld(&bar[XB_TOPGEN]) == tg, bar);
            __builtin_amdgcn_fence(__ATOMIC_ACQUIRE, "agent");
            xb_add(&bar[XB_XGEN(b.x)], 1u);
            asm volatile("s_waitcnt vmcnt(0)" ::: "memory");
        } else {
            XB_SPIN(xb_ld(&bar[XB_XGEN(b.x)]) == gen, bar);
            __builtin_amdgcn_fence(__ATOMIC_ACQUIRE, "agent");
            asm volatile("s_waitcnt vmcnt(0)" ::: "memory");
        }
    }
    __syncthreads();
}
__device__ __forceinline__ float wave_sum(float v) {
#pragma unroll
    for (int o = 1; o < 64; o <<= 1) v += __shfl_xor(v, o);
    return v;
}
__device__ __forceinline__ void p0_transpose_tile(const float* W, int K, int N, bf16* WT, const float* gain, int k0, int n0, int gu  , LAS unsigned char* lds, int tid, int wave, int lane) {
    LAS bf16* T = (LAS bf16*)lds; constexpr int TLD = 264;
    { const int nl = 4 * lane, n = n0 + nl;
#pragma unroll
      for (int j = 0; j < 8; ++j) { const int kl = 8 * wave + j; f32x4 v = (n < N) ? *(const f32x4*)(W + (size_t)(k0 + kl) * N + n) : (f32x4){0.f, 0.f, 0.f, 0.f};
          if (gain) v = v * gain[k0 + kl];
          v2u o; o.x = pk2(v[0], v[1]); o.y = pk2(v[2], v[3]); *(LAS v2u*)(T + kl * TLD + nl) = o; } }
    __syncthreads();
    { const int nl = tid >> 1, half = tid & 1, n = n0 + nl;
      if (n < N) { const int drow = gu < 0 ? n : 256 * (n / 128) + 128 * gu + (n % 128);
#pragma unroll
          for (int c = 0; c < 4; ++c) { const LAS bf16* tp = T + (32 * half + 8 * c) * TLD + nl; v4u o;
              o.x = (unsigned)tp[0] | ((unsigned)tp[TLD] << 16); o.y = (unsigned)tp[2 * TLD] | ((unsigned)tp[3 * TLD] << 16); o.z = (unsigned)tp[4 * TLD] | ((unsigned)tp[5 * TLD] << 16); o.w = (unsigned)tp[6 * TLD] | ((unsigned)tp[7 * TLD] << 16);
              *(GAS v4u*)(WT + (size_t)drow * K + k0 + 32 * half + 8 * c) = o; } } }
    __syncthreads();
}
__device__ __forceinline__ void rows4_to_bf16(const float* const (&xrow)[4], bf16* const (&orow)[4], float* const (&ssq16)[4], int lane) {
    f32x4 v[4][4]; float s[4];
#pragma unroll
    for (int r = 0; r < 4; ++r) { const GAS f32x4* xr = (const GAS f32x4*)xrow[r] + lane;
#pragma unroll
        for (int j = 0; j < 4; ++j) v[r][j] = xr[64 * j]; }
#pragma unroll
    for (int r = 0; r < 4; ++r) { float a = 0.f;
#pragma unroll
        for (int j = 0; j < 4; ++j) a += (v[r][j].x * v[r][j].x + v[r][j].y * v[r][j].y) + (v[r][j].z * v[r][j].z + v[r][j].w * v[r][j].w);
        s[r] = a; }
#pragma unroll
    for (int o = 1; o < 64; o <<= 1) {
#pragma unroll
        for (int r = 0; r < 4; ++r) s[r] += __shfl_xor(s[r], o); }
#pragma unroll
    for (int r = 0; r < 4; ++r) { GAS v2u* o8 = (GAS v2u*)orow[r] + lane;
#pragma unroll
        for (int j = 0; j < 4; ++j) { v2u w; w.x = pk2(v[r][j].x, v[r][j].y); w.y = pk2(v[r][j].z, v[r][j].w); o8[64 * j] = w; }
        if (lane < 16) ssq16[r][lane] = (lane == 0) ? s[r] : 0.f; }
}
struct Ptrs {
    const float* in[27]; float* out; unsigned char* ws;
};
__device__ __forceinline__ void p0_transposes(const Ptrs& P, LAS unsigned char* lds, int part, int bidx, int nblk, int tid, int wave, int lane) {
    unsigned char* ws = P.ws;
    constexpr int NB_F = FF / 256, NB_D = DM / 256, NB_I = (NIN + 255) / 256;
    constexpr int I_G = (DM / 64) * NB_F, I_D = (FF / 64) * NB_D, I_IN = (DM / 64) * NB_I, I_O = (DM / 64) * NB_D;
    const int nitems = 2 * I_G + I_D + (part ? I_O : I_IN);
    for (int it = bidx; it < nitems; it += nblk) {
        int r = it;
        if (r < 2 * I_G) { const int isup = r / I_G; r -= isup * I_G; const int kb = r / NB_F, nb = r % NB_F;
            p0_transpose_tile(P.in[part ? (isup ? 24 : 23) : (isup ? 4 : 3)], DM, FF, (bf16*)(ws + (part ? WS_WGU2 : WS_WGU1)), P.in[part ? 22 : 2], 64 * kb, 256 * nb, isup, lds, tid, wave, lane); continue; }
        r -= 2 * I_G;
        if (r < I_D) { const int kb = r / NB_D, nb = r % NB_D;
            p0_transpose_tile(P.in[part ? 25 : 5], FF, DM, (bf16*)(ws + (part ? WS_WD2 : WS_WD1)), nullptr, 64 * kb, 256 * nb, -1, lds, tid, wave, lane); continue; }
        r -= I_D;
        if (!part) { const int kb = r / NB_I, nb = r % NB_I;
            p0_transpose_tile(P.in[7], DM, NIN, (bf16*)(ws + WS_WIN), P.in[6], 64 * kb, 256 * nb, -1, lds, tid, wave, lane); }
        else { const int kb = r / NB_D, nb = r % NB_D;
            p0_transpose_tile(P.in[21], DM, DM, (bf16*)(ws + WS_WOUT), nullptr, 64 * kb, 256 * nb, -1, lds, tid, wave, lane); }
    }
}
__device__ __forceinline__ void p0_prologue(const Ptrs& P, LAS unsigned char* lds, int vcu, int G, int tid, int wave, int lane) {
    const int gw = vcu * NWAVES + wave, NGW = G * NWAVES;
    unsigned char* ws = P.ws;
    p0_transposes(P, lds, 0, vcu, G, tid, wave, lane);
    { GAS v4u* z = (GAS v4u*)(ws + WS_WIN + (size_t)NIN * DM * 2); const int n16 = (NINP - NIN) * DM * 2 / 16;
      for (int i = gw * 64 + lane; i < n16; i += NGW * 64) z[i] = (v4u){0u, 0u, 0u, 0u}; }
    { bf16* LT = (bf16*)(ws + WS_LT);
      for (int i = gw * 64 + lane; i < 512 * 160; i += NGW * 64) { const int n = i / 160, j = i % 160;
          const float v = j < 32 ? P.in[11][j * 512 + n] : j < 64 ? P.in[13][(j - 32) * 512 + n] : P.in[14][(j - 64) * 512 + n];
          LT[i] = (bf16)f2bf(v); } }
#ifndef REP_ROWS
#define REP_ROWS 1
#endif
    for (int rep_ = 0; rep_ < REP_ROWS; ++rep_)
    for (int m4 = gw; m4 < (MR + NMETA) / 4; m4 += NGW) { const float* xr[4]; bf16* orow[4]; float* sq[4];
#pragma unroll
        for (int r = 0; r < 4; ++r) { const int m = 4 * m4 + r;
            if (m < MR) { xr[r] = P.in[0] + (size_t)m * DM; orow[r] = (bf16*)(ws + WS_XB) + (size_t)m * DM; sq[r] = (float*)(ws + WS_SSQ1) + (size_t)m * 16; }
            else { const int i = m - MR; xr[r] = P.in[1] + (size_t)i * DM; orow[r] = (bf16*)(ws + WS_META + MO_XMB) + (size_t)i * DM; sq[r] = (float*)(ws + WS_META + MO_SSQM1) + i * 16; } }
        rows4_to_bf16(xr, orow, sq, lane); }
}
template <int NSTEP> __device__ __forceinline__ f32x4 skinny16_part(const bf16* A, const bf16* Bt, int K, int n0, int kb, int lane) {
    const int fr = lane & 15, fq = lane >> 4;
    const bf16* ap = A + (size_t)fr * K + kb + 8 * fq; const bf16* bp = Bt + (size_t)(n0 + fr) * K + kb + 8 * fq;
    bf16x8 a[NSTEP], b[NSTEP];
#pragma unroll
    for (int j = 0; j < NSTEP; ++j) { a[j] = *(const bf16x8*)(ap + 32 * j); b[j] = *(const bf16x8*)(bp + 32 * j); }
    f32x4 acc = (f32x4){0.f, 0.f, 0.f, 0.f};
#pragma unroll
    for (int j = 0; j < NSTEP; ++j) acc = __builtin_amdgcn_mfma_f32_16x16x32_bf16(a[j], b[j], acc, 0, 0, 0);
    return acc;
}
__device__ __forceinline__ f32x4 red8(const LAS f32x4* red, int which, int lane) { f32x4 s = red[(0 * 2 + which) * 64 + lane];
#pragma unroll
    for (int w = 1; w < 8; ++w) s += red[(w * 2 + which) * 64 + lane];
    return s; }
__device__ __forceinline__ float rstd_m16(const float* ssq16) { float s = 0.f;
#pragma unroll
    for (int i = 0; i < 16; ++i) s += ssq16[i];
    return __builtin_amdgcn_rsqf(s * (1.0f / 1024.0f) + 1e-5f); }
__device__ __forceinline__ void meta_up(unsigned char* ws, LAS unsigned char* lds, int bx, int G, int wave, int lane) {
    const bf16* A = (const bf16*)(ws + WS_META + MO_XMB); const bf16* Bt = (const bf16*)(ws + WS_WGU1); bf16* Um = (bf16*)(ws + WS_META + MO_UM);
    const float* ssq = (const float*)(ws + WS_META + MO_SSQM1); const int fr = lane & 15, fq = lane >> 4; LAS f32x4* red = (LAS f32x4*)lds;
    for (int t0 = 0; t0 < FF / 16; t0 += G) { const int t = t0 + bx; const bool on = t < FF / 16; const int c0 = 16 * t, nr = 256 * (c0 / 128) + (c0 % 128);
        if (on) { red[(wave * 2 + 0) * 64 + lane] = skinny16_part<4>(A, Bt, DM, nr, 128 * wave, lane); red[(wave * 2 + 1) * 64 + lane] = skinny16_part<4>(A, Bt, DM, nr + 128, 128 * wave, lane); }
        __syncthreads();
        if (on && wave == 0) { const f32x4 g = red8(red, 0, lane), u = red8(red, 1, lane);
#pragma unroll
            for (int r = 0; r < 4; ++r) { const int row = 4 * fq + r; const float rs = rstd_m16(ssq + row * 16); Um[(size_t)row * FF + c0 + fr] = (bf16)f2bf(pg8::silu_mul(g[r] * rs, u[r] * rs)); } }
        __syncthreads(); }
}
__device__ __forceinline__ void meta_down(const Ptrs& P, LAS unsigned char* lds, int bx, int G, int wave, int lane) {
    unsigned char* ws = P.ws; const bf16* A = (const bf16*)(ws + WS_META + MO_UM); const bf16* Bt = (const bf16*)(ws + WS_WD1); bf16* H = (bf16*)(ws + WS_META + MO_H1MB);
    float* ssq = (float*)(ws + WS_META + MO_SSQM2); const int fr = lane & 15, fq = lane >> 4; LAS f32x4* red = (LAS f32x4*)lds;
    for (int t0 = 0; t0 < DM / 16; t0 += G) { const int t = t0 + bx; const bool on = t < DM / 16;
        if (on) red[(wave * 2 + 0) * 64 + lane] = skinny16_part<11>(A, Bt, FF, 16 * t, 352 * wave, lane);
        __syncthreads();
        if (on && wave == 0) { const f32x4 a = red8(red, 0, lane);
#pragma unroll
            for (int r = 0; r < 4; ++r) { const int row = 4 * fq + r; const float o = P.in[1][row * DM + 16 * t + fr] + 0.5f * a[r]; H[row * DM + 16 * t + fr] = (bf16)f2bf(o);
                float s = o * o; s += __shfl_xor(s, 1); s += __shfl_xor(s, 2); s += __shfl_xor(s, 4); s += __shfl_xor(s, 8); if (fr == 0) ssq[row * 64 + t] = s; } }
        __syncthreads(); }
}
__device__ __forceinline__ void meta_win(const Ptrs& P, LAS unsigned char* lds, int bx, int G, int wave, int lane) {
    unsigned char* ws = P.ws; const bf16* A = (const bf16*)(ws + WS_META + MO_H1MB); const bf16* Bt = (const bf16*)(ws + WS_WIN); bf16* Zm = (bf16*)(ws + WS_META + MO_ZM);
    const float* ssq = (const float*)(ws + WS_META + MO_SSQM2); const int fr = lane & 15, fq = lane >> 4; LAS f32x4* red = (LAS f32x4*)lds;
    for (int t0 = 0; t0 < NIN / 16; t0 += G) { const int t = t0 + bx; const bool on = t < NIN / 16;
        if (on) red[(wave * 2 + 0) * 64 + lane] = skinny16_part<4>(A, Bt, DM, 16 * t, 128 * wave, lane);
        __syncthreads();
        if (on && wave == 0) { const f32x4 a = red8(red, 0, lane); const int c = 16 * t + fr; const float bias = c >= ZC_Q ? P.in[8][c - ZC_Q] : 0.f;
#pragma unroll
            for (int r = 0; r < 4; ++r) { const int row = 4 * fq + r; float s = 0.f;
#pragma unroll 8
                for (int i = 0; i < 64; ++i) s += ssq[row * 64 + i];
                Zm[(size_t)row * NIN + c] = (bf16)f2bf(a[r] * __builtin_amdgcn_rsqf(s * (1.0f / 1024.0f) + 1e-5f) + bias); } }
        __syncthreads(); }
}
constexpr int KS_LD = 72, VT_LD = 232, ATT_KS_BYTES = 208 * KS_LD * 2, ATT_VT_BYTES = 64 * VT_LD * 2;
__device__ __forceinline__ void attn_unit(const Ptrs& P, unsigned char* lds, int b, int g, int c, int tid, int wave, int lane) {
    unsigned char* ws = P.ws; const bf16* Z = (const bf16*)(ws + WS_BIG); const bf16* Zm = (const bf16*)(ws + WS_META + MO_ZM); bf16* Y = (bf16*)(ws + WS_XB);
    bf16* Ks = (bf16*)lds; bf16* Vt = (bf16*)(lds + ATT_KS_BYTES);
    const int fr = lane & 15, fq = lane >> 4;
    __syncthreads();
    for (int it = tid; it < 208 * 8; it += NWAVES * 64) { const int key = it >> 3, pc = it & 7; const bf16* src; bool valid = true;
        if (key < 16) src = Zm + (size_t)key * NIN; else { const int t = 64 * (c - 2) + (key - 16); valid = t >= 0; src = Z + ((size_t)b * TSEQ + (valid ? t : 0)) * NIN; }
        v4u kq = *(const v4u*)(src + ZC_K + 64 * g + 8 * pc), vq = *(const v4u*)(src + ZC_V + 64 * g + 8 * pc);
        if (!valid) { kq = (v4u){0u, 0u, 0u, 0u}; vq = kq; }
        *(v4u*)(Ks + key * KS_LD + 8 * pc) = kq;
#pragma unroll
        for (int e = 0; e < 4; ++e) { Vt[(8 * pc + 2 * e) * VT_LD + key] = (bf16)(vq[e] & 0xffffu); Vt[(8 * pc + 2 * e + 1) * VT_LD + key] = (bf16)(vq[e] >> 16); } }
    for (int it = tid; it < 64 * 16; it += NWAVES * 64) Vt[(it >> 4) * VT_LD + 208 + (it & 15)] = 0;
    __syncthreads();
    const int hq = 4 * g + (wave >> 1);
    const float slope = __builtin_amdgcn_exp2f(-(float)(hq + 1)), sink = P.in[20][hq];
#pragma unroll 1
    for (int sub = 0; sub < 2; ++sub) {
        const int i0 = 16 * (2 * (wave & 1) + sub), iq = i0 + fr;
        const size_t mrow = (size_t)b * TSEQ + 64 * c + iq;
        const bf16x8 q0 = *(const bf16x8*)(Z + mrow * NIN + ZC_Q + 64 * hq + 8 * fq), q1 = *(const bf16x8*)(Z + mrow * NIN + ZC_Q + 64 * hq + 32 + 8 * fq);
        f32x4 s[13]; float mx = sink;
#pragma unroll
        for (int kt = 0; kt < 13; ++kt) { const bf16* kp = Ks + (16 * kt + fr) * KS_LD + 8 * fq; f32x4 a = (f32x4){0.f, 0.f, 0.f, 0.f};
            a = __builtin_amdgcn_mfma_f32_16x16x32_bf16(*(const bf16x8*)(kp), q0, a, 0, 0, 0);
            a = __builtin_amdgcn_mfma_f32_16x16x32_bf16(*(const bf16x8*)(kp + 32), q1, a, 0, 0, 0);
#pragma unroll
            for (int r = 0; r < 4; ++r) { const int key = 16 * kt + 4 * fq + r; float v;
                if (kt == 0) v = a[r] * 0.125f - slope * (float)(16 + 64 * c + iq - key);
                else { const int jj = key - 16; const int d = 128 + iq - jj; v = a[r] * 0.125f - slope * (float)(d < 0 ? -d : d); if (64 * (c - 2) + jj < 0) v = -1e30f; }
                a[r] = v; mx = fmaxf(mx, v); }
            s[kt] = a; }
        mx = fmaxf(mx, __shfl_xor(mx, 16)); mx = fmaxf(mx, __shfl_xor(mx, 32));
        float sum = 0.f;
#pragma unroll
        for (int kt = 0; kt < 13; ++kt)
#pragma unroll
            for (int r = 0; r < 4; ++r) { const float p = __builtin_amdgcn_exp2f((s[kt][r] - mx) * 1.4426950408889634f); s[kt][r] = p; sum += p; }
        sum += __shfl_xor(sum, 16); sum += __shfl_xor(sum, 32);
        sum += __builtin_amdgcn_exp2f((sink - mx) * 1.4426950408889634f);
        const float rinv = 1.0f / sum;
        f32x4 o[4];
#pragma unroll
        for (int dt = 0; dt < 4; ++dt) o[dt] = (f32x4){0.f, 0.f, 0.f, 0.f};
#pragma unroll
        for (int ks = 0; ks < 7; ++ks) { const int ta = 2 * ks, tb = 2 * ks + 1; v4u pw;
            pw.x = pk2(s[ta][0], s[ta][1]); pw.y = pk2(s[ta][2], s[ta][3]);
            if (tb < 13) { pw.z = pk2(s[tb][0], s[tb][1]); pw.w = pk2(s[tb][2], s[tb][3]); } else { pw.z = 0u; pw.w = 0u; }
            const bf16x8 pf = __builtin_bit_cast(bf16x8, pw);
#pragma unroll
            for (int dt = 0; dt < 4; ++dt) { const bf16* vp = Vt + (16 * dt + fr) * VT_LD + 4 * fq; const v2u va = *(const v2u*)(vp + 16 * ta), vb = *(const v2u*)(vp + 16 * tb);
                const v4u vv = (v4u){va.x, va.y, vb.x, vb.y};
                o[dt] = __builtin_amdgcn_mfma_f32_16x16x32_bf16(__builtin_bit_cast(bf16x8, vv), pf, o[dt], 0, 0, 0); } }
#pragma unroll
        for (int dt = 0; dt < 4; ++dt) { v2u w; w.x = pk2(o[dt][0] * rinv, o[dt][1] * rinv); w.y = pk2(o[dt][2] * rinv, o[dt][3] * rinv);
            *(v2u*)(Y + mrow * DM + 512 + 64 * hq + 16 * dt + 4 * fq) = w; }
    }
}
template <int CTRL> __device__ __forceinline__ float dppf(float x) { return __builtin_bit_cast(float, __builtin_amdgcn_update_dpp(0, __builtin_bit_cast(int, x), CTRL, 0xF, 0xF, true)); }
template <int CTRL> __device__ __forceinline__ float dppf_old(float old, float x) { return __builtin_bit_cast(float, __builtin_amdgcn_update_dpp(__builtin_bit_cast(int, old), __builtin_bit_cast(int, x), CTRL, 0xF, 0xF, false)); }
__device__ __forceinline__ float red8(float x) { x += dppf<0xB1>(x); x += dppf<0x4E>(x); x += dppf<0x141>(x); return x; }
__device__ __forceinline__ float red16(float x) { x = red8(x); x += dppf<0x140>(x); return x; }
__device__ __forceinline__ float scan16(float x) { x += dppf<0x111>(x); x += dppf<0x112>(x); x += dppf<0x114>(x); x += dppf<0x118>(x); return x; }
constexpr int NCHUNK = 257, NSUPER = 65;
constexpr int CB_A = 0, CB_R = 2048, CB_BK = 4096, CB_VT = 8192, CB_TT = 10240, CB_AR = 11264, CB_G = 12288, CB_BON = 12544, CB_SIZE = 12800;
constexpr int CB_GATE = 12800, IMG_SIZE = 14848;
constexpr int WL_HS = IMG_SIZE, WL_SIZE = IMG_SIZE + 2048;
constexpr int SC_YB = 8 * CB_SIZE, SC_END = SC_YB + 8 * 4096, SC_CST = 768;
static_assert(8 * WL_SIZE <= LDSCTL_OFF && SC_END + SC_CST <= LDSCTL_OFF, "LDS map");
__device__ __forceinline__ bf16x8 pack8(const float* v) { v4u o; o.x = pk2(v[0], v[1]); o.y = pk2(v[2], v[3]); o.z = pk2(v[4], v[5]); o.w = pk2(v[6], v[7]); return __builtin_bit_cast(bf16x8, o); }
__device__ __forceinline__ void unpack8(v4u w, float* v) { v[0] = bflo(w.x); v[1] = bfhi(w.x); v[2] = bflo(w.y); v[3] = bfhi(w.y); v[4] = bflo(w.z); v[5] = bfhi(w.z); v[6] = bflo(w.w); v[7] = bfhi(w.w); }


__device__ __forceinline__ void chunk_task(const Ptrs& P, unsigned char* ldsb, int woff, int b, int h, int ch, int lane) {
    int wo_ = woff; asm volatile("" : "+v"(wo_));
    unsigned char* wl = ldsb + wo_;
    unsigned char* ws = P.ws; const int fr = lane & 15, fq = lane >> 4, t = fr;
    const bf16* Z = (const bf16*)(ws + WS_BIG); const bf16* Zm = (const bf16*)(ws + WS_META + MO_ZM); const bf16* LT = (const bf16*)(ws + WS_LT);
    const bool meta = (ch == 0);
    const int tok = 16 * (ch - 1) + fr; const size_t m = (size_t)b * TSEQ + tok;
    const bf16* zc = meta ? Zm + (size_t)fr * NIN : Z + m * NIN;
    const bool pz = meta && fr == 0;
    const bf16* zp = meta ? Zm + (size_t)(fr > 0 ? fr - 1 : 0) * NIN : (tok == 0 ? Zm + (size_t)15 * NIN : Z + (m - 1) * NIN);
    const float* mu = P.in[9];
    bf16* sx = (bf16*)wl;
    {
    bf16x8 xf[5];
#pragma unroll
    for (int ks = 0; ks < 5; ++ks) { const int c0 = ZC_W + 32 * ks + 8 * fq; const v4u a = *(const v4u*)(zc + c0); v4u bq = *(const v4u*)(zp + c0); if (pz) bq = (v4u){0u, 0u, 0u, 0u};
        float va[8], vb[8], v[8]; unpack8(a, va); unpack8(bq, vb); const f32x4 m0 = *(const f32x4*)(mu + c0), m1 = *(const f32x4*)(mu + c0 + 4);
#pragma unroll
        for (int e = 0; e < 8; ++e) { const float mm = e < 4 ? m0[e & 3] : m1[e & 3]; const float z = va[e] + (vb[e] - va[e]) * mm; v[e] = (ks == 0) ? tanhf_(z) : (ks == 1) ? z : sigmoidf_(z); }
        xf[ks] = pack8(v); }
    f32x4 aw[4], aa[4], ag[4];
#pragma unroll
    for (int nt = 0; nt < 4; ++nt) { const bf16* lp = LT + (size_t)(h * 64 + 16 * nt + fr) * 160 + 8 * fq; const f32x4 z = (f32x4){0.f, 0.f, 0.f, 0.f};
        aw[nt] = __builtin_amdgcn_mfma_f32_16x16x32_bf16(*(const bf16x8*)(lp), xf[0], z, 0, 0, 0);
        aa[nt] = __builtin_amdgcn_mfma_f32_16x16x32_bf16(*(const bf16x8*)(lp + 32), xf[1], z, 0, 0, 0);
        ag[nt] = __builtin_amdgcn_mfma_f32_16x16x32_bf16(*(const bf16x8*)(lp + 64), xf[2], z, 0, 0, 0);
        ag[nt] = __builtin_amdgcn_mfma_f32_16x16x32_bf16(*(const bf16x8*)(lp + 96), xf[3], ag[nt], 0, 0, 0);
        ag[nt] = __builtin_amdgcn_mfma_f32_16x16x32_bf16(*(const bf16x8*)(lp + 128), xf[4], ag[nt], 0, 0, 0); }
    f32x4 kkr[4], kv[4], av[4]; float ss = 0.f;
#pragma unroll
    for (int nt = 0; nt < 4; ++nt) { const int c = h * 64 + 16 * nt + 4 * fq; const v2u a = *(const v2u*)(zc + 512 + c); v2u bq = *(const v2u*)(zp + 512 + c); if (pz) bq = (v2u){0u, 0u};
        const f32x4 za = unpack4(a), zb = unpack4(bq), mk = *(const f32x4*)(mu + 512 + c); const f32x4 zk = za + (zb - za) * mk;
        const f32x4 a0 = *(const f32x4*)(P.in[12] + c), kkw = *(const f32x4*)(P.in[15] + c), kaw = *(const f32x4*)(P.in[16] + c);
        f32x4 a_;
#pragma unroll
        for (int r = 0; r < 4; ++r) a_[r] = sigmoidf_(a0[r] + aa[nt][r]);
        av[nt] = a_; kkr[nt] = zk * kkw; kv[nt] = zk * (1.0f + (a_ - 1.0f) * kaw);
        ss += (kkr[nt][0] * kkr[nt][0] + kkr[nt][1] * kkr[nt][1]) + (kkr[nt][2] * kkr[nt][2] + kkr[nt][3] * kkr[nt][3]); }
    ss += __shfl_xor(ss, 16); ss += __shfl_xor(ss, 32);
    const float inv = 1.0f / fmaxf(sqrtf(ss), 1e-12f);
#pragma unroll
    for (int nt = 0; nt < 4; ++nt) { const int cl = 16 * nt + 4 * fq, c = h * 64 + cl; const f32x4 w0 = *(const f32x4*)(P.in[10] + c);
        const f32x4 kk = kkr[nt] * inv, bb = kk * av[nt]; f32x4 e;
#pragma unroll
        for (int r = 0; r < 4; ++r) e[r] = 0.6065306597126334f * sigmoidf_(w0[r] + aw[nt][r]);
        bf16* px = sx + t * 64 + cl; v2u o;
        o.x = pk2(kk[0], kk[1]); o.y = pk2(kk[2], kk[3]); *(v2u*)(px) = o;
        o.x = pk2(e[0], e[1]); o.y = pk2(e[2], e[3]); *(v2u*)(px + 1024) = o;
        o.x = pk2(bb[0], bb[1]); o.y = pk2(bb[2], bb[3]); *(v2u*)(px + 2048) = o;
        o.x = pk2(kv[nt][0], kv[nt][1]); o.y = pk2(kv[nt][2], kv[nt][3]); *(v2u*)(px + 3072) = o;
        o.x = pk2m(ag[nt][0], ag[nt][1]); o.y = pk2m(ag[nt][2], ag[nt][3]); *(v2u*)(px + 4096) = o; }
    }
    asm volatile("s_waitcnt lgkmcnt(0)" ::: "memory"); __builtin_amdgcn_sched_barrier(0);
    v4u xk[2], xe[2], xb[2], xx[2], xg[2];
#pragma unroll
    for (int ks = 0; ks < 2; ++ks) { const bf16* px = sx + t * 64 + 32 * ks + 8 * fq; xk[ks] = *(const v4u*)(px); xe[ks] = *(const v4u*)(px + 1024); xb[ks] = *(const v4u*)(px + 2048); xx[ks] = *(const v4u*)(px + 3072); xg[ks] = *(const v4u*)(px + 4096); }
    asm volatile("s_waitcnt lgkmcnt(0)" ::: "memory"); __builtin_amdgcn_sched_barrier(0);
    unsigned char* cb = wl; float* hs = (float*)(wl + WL_HS);
    const int cbase = h * 64 + 8 * fq;
    unsigned char* pbk = cb + CB_BK + ((((fq >> 1) * 4 + (t >> 2)) * 16 + 8 * (fq & 1)) * 8 + (t & 3)) * 2;
    unsigned char* pvt = cb + CB_VT + (((fq >> 1) * 4 + (t >> 2)) * 16 + 8 * (fq & 1)) * 8 + (t & 3) * 2;
    unsigned char* pgc = cb + CB_G + 8 * fq * 4;
    bf16x8 Af[2], Rf[2], Bf[2], Kf[2]; float bonp = 0.f;
#pragma unroll
    for (int ks = 0; ks < 2; ++ks) { const int c = cbase + 32 * ks, cl = 32 * ks + 8 * fq;
        asm volatile("" ::: "memory"); __builtin_amdgcn_sched_barrier(0);
        float kk[8], e_[8], bb[8], kx[8], rc[8], rp[8], vc[8], vp[8];
        unpack8(xk[ks], kk); unpack8(xe[ks], e_); unpack8(xb[ks], bb); unpack8(xx[ks], kx);
        unpack8(*(const v4u*)(zc + c), rc); unpack8(*(const v4u*)(zc + 1024 + c), vc);
        { v4u a = *(const v4u*)(zp + c), d = *(const v4u*)(zp + 1024 + c); if (pz) { a = (v4u){0u, 0u, 0u, 0u}; d = a; } unpack8(a, rp); unpack8(d, vp); }
        float At[8], Rt[8], Bt[8], Kt[8]; float mur[8], muv[8], rkk[8];
        { const f32x4 a0 = *(const f32x4*)(P.in[9] + c), a1 = *(const f32x4*)(P.in[9] + c + 4), b0 = *(const f32x4*)(P.in[9] + 1024 + c), b1 = *(const f32x4*)(P.in[9] + 1024 + c + 4), c0 = *(const f32x4*)(P.in[17] + c), c1 = *(const f32x4*)(P.in[17] + c + 4);
#pragma unroll
          for (int e = 0; e < 4; ++e) { mur[e] = a0[e]; mur[4 + e] = a1[e]; muv[e] = b0[e]; muv[4 + e] = b1[e]; rkk[e] = c0[e]; rkk[4 + e] = c1[e]; } }
#pragma unroll
        for (int e = 0; e < 8; ++e) { const float rr = rc[e] + (rp[e] - rc[e]) * mur[e]; const float vv = vc[e] + (vp[e] - vc[e]) * muv[e];
            bonp += rr * kx[e] * rkk[e];
            const float ec = scan16(e_[e]), etot = red16(e_[e]);
            const float g1 = __builtin_amdgcn_exp2f(-1.4426950408889634f * ec);
            const float gi = __builtin_amdgcn_exp2f(1.4426950408889634f * ec);
            const float gC = __builtin_amdgcn_exp2f(-1.4426950408889634f * etot);
            const float g0 = dppf_old<0x111>(1.0f, g1);
            At[e] = -kk[e] * g0; Rt[e] = rr * g1; Bt[e] = bb[e] * gi; Kt[e] = kx[e] * gi;
            const int ke = 32 * ks + e;
            *(bf16*)(pbk + ks * 2048 + e * 16) = (bf16)f2bf(Bt[e] * gC);
            *(bf16*)(pbk + ks * 2048 + e * 16 + 8) = (bf16)f2bf(Kt[e] * gC);
            *(bf16*)(pvt + ks * 1024 + e * 8) = (bf16)f2bf(vv);
            if (t == 15) *(float*)(pgc + ke * 4) = gC; }
        Af[ks] = pack8(At); Rf[ks] = pack8(Rt); Bf[ks] = pack8(Bt); Kf[ks] = pack8(Kt);
        { const int fqs = 2 * (fq & 1), bo = (fq >> 1) * 8; const v4u aw = __builtin_bit_cast(v4u, Af[ks]), rw = __builtin_bit_cast(v4u, Rf[ks]);
          *(v2u*)(cb + CB_A + ((ks * 4 + fqs) * 16 + t) * 16 + bo) = (v2u){aw.x, aw.y}; *(v2u*)(cb + CB_A + ((ks * 4 + fqs + 1) * 16 + t) * 16 + bo) = (v2u){aw.z, aw.w};
          *(v2u*)(cb + CB_R + ((ks * 4 + fqs) * 16 + t) * 16 + bo) = (v2u){rw.x, rw.y}; *(v2u*)(cb + CB_R + ((ks * 4 + fqs + 1) * 16 + t) * 16 + bo) = (v2u){rw.z, rw.w}; }
        *(v4u*)(cb + CB_GATE + (t * 64 + cl) * 2) = xg[ks]; }
    asm volatile("" ::: "memory"); __builtin_amdgcn_sched_barrier(0);
    bonp += __shfl_xor(bonp, 16); bonp += __shfl_xor(bonp, 32);
    if (fq == 0) *(float*)(cb + CB_BON + t * 4) = bonp;
    const f32x4 z4 = (f32x4){0.f, 0.f, 0.f, 0.f};
    f32x4 Mab = __builtin_amdgcn_mfma_f32_16x16x32_bf16(Af[0], Bf[0], z4, 0, 0, 0); Mab = __builtin_amdgcn_mfma_f32_16x16x32_bf16(Af[1], Bf[1], Mab, 0, 0, 0);
    f32x4 Mak = __builtin_amdgcn_mfma_f32_16x16x32_bf16(Af[0], Kf[0], z4, 0, 0, 0); Mak = __builtin_amdgcn_mfma_f32_16x16x32_bf16(Af[1], Kf[1], Mak, 0, 0, 0);
    f32x4 Mrb = __builtin_amdgcn_mfma_f32_16x16x32_bf16(Rf[0], Bf[0], z4, 0, 0, 0); Mrb = __builtin_amdgcn_mfma_f32_16x16x32_bf16(Rf[1], Bf[1], Mrb, 0, 0, 0);
    f32x4 Mrk = __builtin_amdgcn_mfma_f32_16x16x32_bf16(Rf[0], Kf[0], z4, 0, 0, 0); Mrk = __builtin_amdgcn_mfma_f32_16x16x32_bf16(Rf[1], Kf[1], Mrk, 0, 0, 0);
#pragma unroll
    for (int r = 0; r < 4; ++r) { const int tt = 4 * fq + r, i = fr;
        const float mab = (tt > i) ? Mab[r] : 0.f, mak = (tt > i) ? Mak[r] : 0.f, mrb = (tt >= i) ? Mrb[r] : 0.f, mrk = (tt >= i) ? Mrk[r] : 0.f;
        hs[tt * 16 + i] = mab; hs[256 + tt * 16 + i] = mak;
        const unsigned w = pk2m(mrb, mrk);
        *(bf16*)(cb + CB_AR + (((i >> 2) * 16 + tt) * 8 + (i & 3)) * 2) = (bf16)(w & 0xffffu);
        *(bf16*)(cb + CB_AR + (((i >> 2) * 16 + tt) * 8 + 4 + (i & 3)) * 2) = (bf16)(w >> 16); }
    asm volatile("s_waitcnt lgkmcnt(0)" ::: "memory");
    { const int c = lane & 31, cc = c & 15; const bool isT = c < 16; float out[16];
#pragma unroll
      for (int tt = 0; tt < 16; ++tt) { float acc = isT ? (tt == cc ? 1.0f : 0.0f) : hs[256 + tt * 16 + cc];
#pragma unroll
          for (int i4 = 0; i4 < (tt + 3) / 4; ++i4) { const f32x4 l = *(const f32x4*)(hs + tt * 16 + 4 * i4);
#pragma unroll
              for (int e = 0; e < 4; ++e) if (4 * i4 + e < tt) acc += l[e] * out[4 * i4 + e]; }
          out[tt] = acc;
          if (lane < 32) *(bf16*)(cb + CB_TT + (((cc >> 2) * 16 + tt) * 8 + (isT ? 0 : 4) + (cc & 3)) * 2) = (bf16)f2bf(acc); } }
    asm volatile("s_waitcnt lgkmcnt(0)" ::: "memory");
    { unsigned char* gi = ws + WS_IMG + ((size_t)(b * NHEAD + h) * NCHUNK + ch) * IMG_SIZE;
      for (int i = lane; i < IMG_SIZE / 16; i += 64) *(v4u*)(gi + i * 16) = *(const v4u*)(cb + i * 16); }
    asm volatile("s_waitcnt lgkmcnt(0)" ::: "memory"); __builtin_amdgcn_sched_barrier(0);
}

struct ScanOps { bf16x8 a0, a1, r0, r1, tt, ar, bk[4]; v2u vt; f32x4 g[4]; };
__device__ __forceinline__ void scan_load(ScanOps& o, const unsigned char* ib, int fr, int fq, int vcol) {
    const int ln = (fq * 16 + fr) * 16;
    o.a0 = *(const bf16x8*)(ib + CB_A + ln); o.a1 = *(const bf16x8*)(ib + CB_A + 1024 + ln);
    o.r0 = *(const bf16x8*)(ib + CB_R + ln); o.r1 = *(const bf16x8*)(ib + CB_R + 1024 + ln);
    o.tt = *(const bf16x8*)(ib + CB_TT + ln); o.ar = *(const bf16x8*)(ib + CB_AR + ln);
    o.vt = *(const v2u*)(ib + CB_VT + (((vcol >> 4) * 4 + fq) * 16 + fr) * 8);
#pragma unroll
    for (int kt = 0; kt < 4; ++kt) { o.g[kt] = *(const f32x4*)(ib + CB_G + (16 * kt + 4 * fq) * 4); o.bk[kt] = *(const bf16x8*)(ib + CB_BK + kt * 1024 + ln); }
}
__device__ __forceinline__ void scan_step(f32x4 (&H)[4], const ScanOps& o, float* yb, int fq, int vcol) {
    v4u hb0, hb1;
    hb0.x = pk2m(H[0][0], H[0][1]); hb0.y = pk2m(H[0][2], H[0][3]); hb0.z = pk2m(H[1][0], H[1][1]); hb0.w = pk2m(H[1][2], H[1][3]);
    hb1.x = pk2m(H[2][0], H[2][1]); hb1.y = pk2m(H[2][2], H[2][3]); hb1.z = pk2m(H[3][0], H[3][1]); hb1.w = pk2m(H[3][2], H[3][3]);
    const bf16x8 h0 = __builtin_bit_cast(bf16x8, hb0), h1 = __builtin_bit_cast(bf16x8, hb1);
    const f32x4 z4 = (f32x4){0.f, 0.f, 0.f, 0.f};
    f32x4 X = __builtin_amdgcn_mfma_f32_16x16x32_bf16(o.a0, h0, z4, 0, 0, 0); X = __builtin_amdgcn_mfma_f32_16x16x32_bf16(o.a1, h1, X, 0, 0, 0);
    f32x4 Y = __builtin_amdgcn_mfma_f32_16x16x32_bf16(o.r0, h0, z4, 0, 0, 0); Y = __builtin_amdgcn_mfma_f32_16x16x32_bf16(o.r1, h1, Y, 0, 0, 0);
    v4u xb; xb.x = pk2m(X[0], X[1]); xb.y = pk2m(X[2], X[3]); xb.z = o.vt.x; xb.w = o.vt.y;
    const f32x4 U = __builtin_amdgcn_mfma_f32_16x16x32_bf16(o.tt, __builtin_bit_cast(bf16x8, xb), z4, 0, 0, 0);
    v4u ub; ub.x = pk2m(U[0], U[1]); ub.y = pk2m(U[2], U[3]); ub.z = o.vt.x; ub.w = o.vt.y;
    const bf16x8 uf = __builtin_bit_cast(bf16x8, ub);
    Y = __builtin_amdgcn_mfma_f32_16x16x32_bf16(o.ar, uf, Y, 0, 0, 0);
#pragma unroll
    for (int kt = 0; kt < 4; ++kt) H[kt] = __builtin_amdgcn_mfma_f32_16x16x32_bf16(o.bk[kt], uf, H[kt] * o.g[kt], 0, 0, 0);
#pragma unroll
    for (int r = 0; r < 4; ++r) yb[(4 * fq + r) * 64 + vcol] = Y[r];
}
__device__ __forceinline__ void scan_phase(const Ptrs& P, unsigned char* lds, int sb, int tid, int wave, int lane, int never) {
    const int b = sb >> 3, h = sb & 7, fr = lane & 15, fq = lane >> 4;
    const unsigned char* img = P.ws + WS_IMG + (size_t)(b * NHEAD + h) * NCHUNK * IMG_SIZE;
    if (wave < 4) {
        f32x4 H[4];
#pragma unroll
        for (int kt = 0; kt < 4; ++kt) H[kt] = (f32x4){0.f, 0.f, 0.f, 0.f};
        const int vcol = 16 * wave + fr;
#pragma unroll 1
        for (int s = 0; s <= NSUPER + 1; ++s) {
            __syncthreads();
            if (s < 1 || s > NSUPER) continue;
            const int set = (s - 1) & 1;
#pragma unroll 1
            for (int j = 0; j < 4; ++j) { const int ch = 4 * (s - 1) + j; if (ch >= NCHUNK) break;
                ScanOps o; scan_load(o, lds + (set * 4 + j) * CB_SIZE, fr, fq, vcol);
                scan_step(H, o, (float*)(lds + SC_YB + (set * 4 + j) * 4096), fq, vcol); }
        }
    } else {
        const int hw = wave - 4, t = fr;
        const bf16* Z = (const bf16*)(P.ws + WS_BIG); const bf16* Zm = (const bf16*)(P.ws + WS_META + MO_ZM);
        bf16* Yo = (bf16*)(P.ws + WS_XB);
        const int cbase = h * 64 + 8 * fq;
        float* cst = (float*)(lds + SC_END);
        if (lane < 48) { const int a_ = lane >> 4, c4 = (lane & 15) * 4; const float* src = a_ == 0 ? P.in[9] + 1024 + h * 64 : a_ == 1 ? P.in[18] + h * 64 : P.in[19] + h * 64;
            *(f32x4*)(cst + a_ * 64 + c4) = *(const f32x4*)(src + c4); }
        v4u cg0[2], cg1[2]; v4u im0[13], im1[13];
        const int pvt_off = CB_VT + (((fq >> 1) * 4 + (t >> 2)) * 16 + 8 * (fq & 1)) * 8 + (t & 3) * 2;
#define GLD16(dst, ptr) asm volatile("global_load_dwordx4 %0, %1, off" : "=v"(dst) : "v"(ptr) : "memory")
#define GLD4(dst, ptr) asm volatile("global_load_dword %0, %1, off" : "=v"(dst) : "v"(ptr) : "memory")
#define IMG_LOAD(IM, chx) do { const unsigned char* ip_ = img + (size_t)(chx) * IMG_SIZE + lane * 16; _Pragma("unroll") for (int i_ = 0; i_ < 13; ++i_) GLD16(IM[i_], ip_ + i_ * 1024); } while (0)
#define VM_WAIT_ALL(N) asm volatile("s_waitcnt vmcnt(" #N ")" : "+v"(im0[0]), "+v"(im0[1]), "+v"(im0[2]), "+v"(im0[3]), "+v"(im0[4]), "+v"(im0[5]), "+v"(im0[6]), "+v"(im0[7]), "+v"(im0[8]), "+v"(im0[9]), "+v"(im0[10]), "+v"(im0[11]), "+v"(im0[12]), \
            "+v"(im1[0]), "+v"(im1[1]), "+v"(im1[2]), "+v"(im1[3]), "+v"(im1[4]), "+v"(im1[5]), "+v"(im1[6]), "+v"(im1[7]), "+v"(im1[8]), "+v"(im1[9]), "+v"(im1[10]), "+v"(im1[11]), "+v"(im1[12]) :: "memory")
#define VM_WAIT_POST(N) asm volatile("s_waitcnt vmcnt(" #N ")" : "+v"(cg0[0]), "+v"(cg0[1]), "+v"(cg1[0]), "+v"(cg1[1]) :: "memory")
#define POST_LOAD(CG, sx) do { int chn_ = 4 * ((sx) - 2) + hw; chn_ = chn_ < 1 ? 1 : (chn_ >= NCHUNK ? NCHUNK - 1 : chn_);     \
            const unsigned char* ib_ = img + (size_t)chn_ * IMG_SIZE; \
            _Pragma("unroll") for (int ks = 0; ks < 2; ++ks) GLD16(CG[ks], ib_ + CB_GATE + (t * 64 + 32 * ks + 8 * fq) * 2); } while (0)
        POST_LOAD(cg0, 0); IMG_LOAD(im0, hw);
        POST_LOAD(cg1, 1); IMG_LOAD(im1, 4 + hw);
#define HELPER_ITER(IM, CG) do { \
            __syncthreads(); \
            VM_WAIT_ALL(15); VM_WAIT_POST(15);        \
            unsigned char* cbw = lds + ((s & 1) * 4 + hw) * CB_SIZE;            \
            { const int ch = 4 * (s - 2) + hw; \
              if (s >= 2 && ch >= 1 && ch < NCHUNK) { const float* yb = (const float*)(lds + SC_YB + ((s & 1) * 4 + hw) * 4096); \
                const int tok = 16 * (ch - 1) + t; const size_t m = (size_t)b * TSEQ + tok; \
                float y[16]; float sm = 0.f; \
                _Pragma("unroll") for (int ks = 0; ks < 2; ++ks) { const f32x4 y0 = *(const f32x4*)(yb + t * 64 + 32 * ks + 8 * fq), y1 = *(const f32x4*)(yb + t * 64 + 32 * ks + 8 * fq + 4); \
                    _Pragma("unroll") for (int e = 0; e < 4; ++e) { y[8 * ks + e] = y0[e]; y[8 * ks + 4 + e] = y1[e]; sm += y0[e] + y1[e]; } } \
                sm += __shfl_xor(sm, 16); sm += __shfl_xor(sm, 32); const float mean = sm * (1.0f / 64.0f); float sq = 0.f; \
                _Pragma("unroll") for (int i = 0; i < 16; ++i) { y[i] -= mean; sq += y[i] * y[i]; } \
                sq += __shfl_xor(sq, 16); sq += __shfl_xor(sq, 32); const float rs = __builtin_amdgcn_rsqf(sq * (1.0f / 64.0f) + 64e-5f); \
                const float bon = *(const float*)(cbw + CB_BON + t * 4); \
                _Pragma("unroll") for (int ks = 0; ks < 2; ++ks) { const int c = cbase + 32 * ks; \
                    float g[8], o[8]; unpack8(CG[ks], g); \
                    const float* cq = cst + 32 * ks + 8 * fq; const f32x4 wA = *(const f32x4*)(cq + 64), wB = *(const f32x4*)(cq + 68), bA = *(const f32x4*)(cq + 128), bB = *(const f32x4*)(cq + 132); \
                    _Pragma("unroll") for (int e = 0; e < 8; ++e) { const float lw_ = e < 4 ? wA[e & 3] : wB[e & 3], lb_ = e < 4 ? bA[e & 3] : bB[e & 3]; \
                        const float vv = __builtin_bit_cast(float, (unsigned)(*(const bf16*)(cbw + pvt_off + ks * 1024 + e * 8)) << 16); \
                        o[e] = (y[8 * ks + e] * rs * lw_ + lb_ + bon * vv) * g[e]; } \
                    *(bf16x8*)(Yo + m * DM + c) = pack8(o); } } } \
            asm volatile("s_waitcnt lgkmcnt(0)" ::: "memory");                   \
            if (4 * s + hw < NCHUNK) { \
                _Pragma("unroll") for (int i_ = 0; i_ < 13; ++i_) if (i_ < 12 || lane < 32) *(v4u*)(cbw + (i_ * 64 + lane) * 16) = IM[i_]; } \
            POST_LOAD(CG, s + 2); \
            { const int cl_ = 4 * (s + 2) + hw; IMG_LOAD(IM, cl_ < NCHUNK ? cl_ : NCHUNK - 1); } \
        } while (0)
#pragma unroll 1
        for (int s2 = 0; s2 <= NSUPER + 1; s2 += 2) {
            { const int s = s2; HELPER_ITER(im0, cg0); }
            if (s2 + 1 <= NSUPER + 1) { const int s = s2 + 1; HELPER_ITER(im1, cg1); }
        }
        asm volatile("s_waitcnt vmcnt(0)" ::: "memory");
#undef HELPER_ITER
#undef POST_LOAD
#undef VM_WAIT_ALL
#undef VM_WAIT_POST
#undef GLD16
#undef GLD4
#undef IMG_LOAD
    }
}
__device__ __forceinline__ void final_norm(const Ptrs& P, int gw, int NGW, int lane) {
    const float* ssq = (const float*)(P.ws + WS_SSQ4); const GAS f32x4* g4 = (const GAS f32x4*)P.in[26] + lane;
    f32x4 g[4];
#pragma unroll
    for (int j = 0; j < 4; ++j) g[j] = g4[64 * j];
    for (int m = gw; m < MR; m += NGW) { const float rs = pg8::rstd_from16(ssq, m); GAS f32x4* o = (GAS f32x4*)(P.out + (size_t)m * DM) + lane;
#pragma unroll
        for (int j = 0; j < 4; ++j) o[64 * j] = o[64 * j] * rs * g[j]; }
}
#ifndef MK_N_LAUNCHES
#define MK_N_LAUNCHES 1
#endif
constexpr int N_PHASES = 10;
struct Args { Ptrs p; int ph_lo, ph_hi, use_cg, pad; };
__global__ void __launch_bounds__(NWAVES * 64, 2) hymba_fwd(Args args) {
    extern __shared__ __attribute__((aligned(16))) unsigned char lds[];
    LAS unsigned char* ldsl = (LAS unsigned char*)lds;
    volatile LAS unsigned* MISC = (volatile LAS unsigned*)(ldsl + MISC_OFF);
    const int tid = threadIdx.x, lane = tid & 63, wave = __builtin_amdgcn_readfirstlane(tid >> 6);
    const int G = gridDim.x, bx = blockIdx.x, vcu = (G % 8 == 0) ? (bx % 8) * (G / 8) + bx / 8 : bx;
    const Ptrs& P = args.p; unsigned char* ws = P.ws;
    if (args.use_cg) cg::this_grid().sync();
    for (int u = tid; u < (LDS_BYTES - LDSCTL_OFF) / 4; u += NWAVES * 64) ((LAS unsigned*)(ldsl + LDSCTL_OFF))[u] = 0u;
    __syncthreads();
    const int lo = args.ph_lo, hi = args.ph_hi;
    XcdBarrier bar; bar.bar = (unsigned*)(ws + WS_CTL) + CW_BAR; bar.x = 0; bar.st = nullptr;
    if (hi - lo > 1) bar = xcd_barrier_post((unsigned*)(ws + WS_CTL) + CW_BAR, MISC + 8);
#define IN(k) (lo <= (k) && (k) < hi)
#define SEAM(k) do { if (IN(k) && IN((k) + 1)) xcd_barrier(bar); } while (0)
    const int gw = vcu * NWAVES + wave, NGW = G * NWAVES;
    const int gwm = bx + G * wave;

#ifndef REP_P0
#define REP_P0 1
#endif
    if (IN(0)) { for (int rep = 0; rep < REP_P0; ++rep) p0_prologue(P, ldsl, vcu, G, tid, wave, lane); SEAM(0); }
    if (IN(1)) {
        meta_up(ws, ldsl, bx, G, wave, lane);
        pg8::Gemm g{(const bf16*)(ws + WS_XB), (const bf16*)(ws + WS_WGU1), MR, NGU, DM}; pg8::StaticOrder S; S.init(MR, NGU, G, bx);
        LAS float* rcache = (LAS float*)(ldsl + RING_BYTES); pg8::fill_rstd_cache(rcache, (const float*)(ws + WS_SSQ1), S);
        pg8::EpiSwiglu E{(bf16*)(ws + WS_BIG), (const float*)(ws + WS_SSQ1), FF, rcache};
#ifndef REP_P1
#define REP_P1 1
#endif
        for (int rep = 0; rep < REP_P1; ++rep) pg8::gemm_phase<pg8::EpiSwiglu, pg8::StaticOrder, true, true>(ldsl, g, S, E);
        SEAM(1);
    }
    if (IN(2)) {
        meta_down(P, ldsl, bx, G, wave, lane);
        pg8::Gemm g{(const bf16*)(ws + WS_BIG), (const bf16*)(ws + WS_WD1), MR, DM, FF}; pg8::StaticOrder S; S.init(MR, DM, G, bx);
        pg8::EpiResid<true> E{P.in[0], P.out, (bf16*)(ws + WS_XB), (float*)(ws + WS_SSQ2), 0.5f};
#ifndef REP_P2
#define REP_P2 1
#endif
        for (int rep = 0; rep < REP_P2; ++rep) pg8::gemm_phase<pg8::EpiResid<true>, pg8::StaticOrder, true, true>(ldsl, g, S, E);
        SEAM(2);
    }
    if (IN(3)) {
        meta_win(P, ldsl, bx, G, wave, lane);
        pg8::Gemm g{(const bf16*)(ws + WS_XB), (const bf16*)(ws + WS_WIN), MR, NINP, DM}; pg8::StaticOrder S; S.init(MR, NINP, G, bx);
        LAS float* rcache = (LAS float*)(ldsl + RING_BYTES); pg8::fill_rstd_cache(rcache, (const float*)(ws + WS_SSQ2), S);
        pg8::EpiZ E{(bf16*)(ws + WS_BIG), (const float*)(ws + WS_SSQ2), P.in[8], NIN, NIN, ZC_Q, rcache};
        pg8::gemm_phase<pg8::EpiZ, pg8::StaticOrder, true, true>(ldsl, g, S, E);
        SEAM(3);
    }
    if (IN(4)) {
#ifndef REP_PREP
#define REP_PREP 1
#endif
        for (int rep = 0; rep < REP_PREP; ++rep) for (int task = gw; task < NBATCH * NHEAD * NCHUNK; task += NGW) { const int bc = task >> 3; chunk_task(P, lds, wave * WL_SIZE, bc / NCHUNK, task & 7, bc % NCHUNK, lane); }
        SEAM(4);
    }
    if (IN(5)) {
#ifndef REP_SCAN
#define REP_SCAN 1
#endif
#ifndef REP_ATTN
#define REP_ATTN 1
#endif
        if (bx < 64) { for (int rep = 0; rep < REP_SCAN; ++rep) { scan_phase(P, lds, bx, tid, wave, lane, args.use_cg); __syncthreads(); } }
        else { for (int rep = 0; rep < REP_ATTN; ++rep) for (int u = bx - 64; u < NBATCH * 2 * 64; u += G - 64) attn_unit(P, lds, u >> 7, (u >> 6) & 1, u & 63, tid, wave, lane);
            __syncthreads();
#ifndef REP_TR1
#define REP_TR1 1
#endif
            for (int rep = 0; rep < REP_TR1; ++rep) p0_transposes(P, ldsl, 1, bx - 64, G - 64, tid, wave, lane); }
        __syncthreads();
        SEAM(5);
    }
    if (IN(6)) {
        pg8::Gemm g{(const bf16*)(ws + WS_XB), (const bf16*)(ws + WS_WOUT), MR, DM, DM}; pg8::StaticOrder S; S.init(MR, DM, G, bx);
        pg8::EpiResid<true> E{P.out, P.out, (bf16*)(ws + WS_P), (float*)(ws + WS_SSQ3), 1.0f};
        pg8::gemm_phase<pg8::EpiResid<true>, pg8::StaticOrder, true, true>(ldsl, g, S, E);
        SEAM(6);
    }
    if (IN(7)) {
        pg8::Gemm g{(const bf16*)(ws + WS_P), (const bf16*)(ws + WS_WGU2), MR, NGU, DM}; pg8::StaticOrder S; S.init(MR, NGU, G, bx);
        LAS float* rcache = (LAS float*)(ldsl + RING_BYTES); pg8::fill_rstd_cache(rcache, (const float*)(ws + WS_SSQ3), S);
        pg8::EpiSwiglu E{(bf16*)(ws + WS_BIG), (const float*)(ws + WS_SSQ3), FF, rcache};
        pg8::gemm_phase<pg8::EpiSwiglu, pg8::StaticOrder, true, true>(ldsl, g, S, E);
        SEAM(7);
    }
    if (IN(8)) {
        pg8::Gemm g{(const bf16*)(ws + WS_BIG), (const bf16*)(ws + WS_WD2), MR, DM, FF}; pg8::StaticOrder S; S.init(MR, DM, G, bx);
        pg8::EpiResid<false> E{P.out, P.out, nullptr, (float*)(ws + WS_SSQ4), 0.5f};
        pg8::gemm_phase<pg8::EpiResid<false>, pg8::StaticOrder, true, true>(ldsl, g, S, E);
        SEAM(8);
    }
    if (IN(9)) final_norm(P, gw, NGW, lane);
#undef IN
#undef SEAM
}

extern "C" void kernel_launch(void* const* d_in, const int* in_sizes, int n_in, void* d_out, int out_size, void* d_ws, size_t ws_size, hipStream_t stream) {
    static int grid = 0;
    if (grid == 0) {
        if (n_in != 27 || in_sizes[0] != MR * DM || out_size != MR * DM || ws_size < WS_END) { fprintf(stderr, "kernel_launch: unexpected shapes (n_in %d, in0 %d, out %d, ws %zu)\n", n_in, n_in > 0 ? in_sizes[0] : -1, out_size, ws_size); grid = -1; return; }
        int dev = 0, cus = 0, per_cu = 0;
        if (hipGetDevice(&dev) != hipSuccess || hipDeviceGetAttribute(&cus, hipDeviceAttributeMultiprocessorCount, dev) != hipSuccess) { grid = -1; return; }
        if (hipFuncSetAttribute((const void*)hymba_fwd, hipFuncAttributeMaxDynamicSharedMemorySize, LDS_BYTES) != hipSuccess) { fprintf(stderr, "kernel_launch: hipFuncSetAttribute failed\n"); grid = -1; return; }
        if (hipOccupancyMaxActiveBlocksPerMultiprocessor(&per_cu, (const void*)hymba_fwd, NWAVES * 64, LDS_BYTES) != hipSuccess || per_cu < 1) fprintf(stderr, "kernel_launch: occupancy query says %d blocks per CU\n", per_cu);
        (void)hipGetLastError();
        grid = cus;
    }
    if (grid < 0) return;
    if (hipMemsetAsync((char*)d_ws + WS_CTL, 0, CTL_ZERO_BYTES, stream) != hipSuccess) { fprintf(stderr, "kernel_launch: memset failed\n"); return; }
    Args a{};
    for (int i = 0; i < 27; ++i) a.p.in[i] = (const float*)d_in[i];
    a.p.out = (float*)d_out; a.p.ws = (unsigned char*)d_ws; a.use_cg = 0; a.pad = 0;
#if MK_N_LAUNCHES == 1
    a.ph_lo = 0; a.ph_hi = N_PHASES;
    void* kargs[] = {&a};
    hipError_t e = hipLaunchCooperativeKernel((const void*)hymba_fwd, dim3(grid), dim3(NWAVES * 64), kargs, LDS_BYTES, stream);
    if (e != hipSuccess) fprintf(stderr, "kernel_launch: cooperative launch failed: %s (grid %d)\n", hipGetErrorString(e), grid);
#else
    for (int li = 0; li < N_PHASES; ++li) { a.ph_lo = li; a.ph_hi = li + 1;
        hipLaunchKernelGGL(hymba_fwd, dim3(grid), dim3(NWAVES * 64), LDS_BYTES, stream, a);
        const hipError_t le = hipPeekAtLastError(); if (le != hipSuccess) { fprintf(stderr, "kernel_launch: launch %d failed: %s\n", li, hipGetErrorName(le)); break; } }
#endif
}
```
